# Optimizing an MI355X kernel written in HIP

```python
import jax, jax.numpy as jnp
from jax import lax
import numpy as np

D_MODEL = 2048
BATCH = 1
SEQ = 8192
DEPTH = 4

D_FF = 5632
N_BRANCH = 4
BRANCH_W = 512
POOL_WINDOWS = (2, 4, 8, 16)
POOL_GROUPS = len(POOL_WINDOWS)
POOL_GW = BRANCH_W // POOL_GROUPS
DIL_PATTERNS = ((128, 1), (512, 4), (2048, 16))
DIL_GROUPS = len(DIL_PATTERNS)
DIL_HEADS_PER_GROUP = 4
DIL_HEADS = DIL_GROUPS * DIL_HEADS_PER_GROUP
DIL_HEAD_DIM = BRANCH_W // DIL_HEADS_PER_GROUP
DIL_QKV = 3 * DIL_HEADS * DIL_HEAD_DIM
SGU_CHUNK = 128
SGU_GROUPS = 4
SGU_GW = BRANCH_W // SGU_GROUPS
MLA_HEADS = 4
MLA_Q_LORA = 384
MLA_KV_LORA = 128
MLA_NOPE = 128
MLA_ROPE = 64
MLA_V = BRANCH_W // MLA_HEADS
MLA_QK = MLA_NOPE + MLA_ROPE
MLA_QBLOCK = 128
ROPE_THETA = 10000.0
EPS = 1e-6

OFF_POOL = 0
OFF_DIL = OFF_POOL + BRANCH_W
OFF_SGU = OFF_DIL + DIL_QKV
OFF_MLA_Q = OFF_SGU + 2 * BRANCH_W
OFF_MLA_KV = OFF_MLA_Q + MLA_Q_LORA
OFF_MLA_KR = OFF_MLA_KV + MLA_KV_LORA
OFF_GATE = OFF_MLA_KR + MLA_ROPE
N_IN = OFF_GATE + N_BRANCH * D_MODEL

kernel_name = 'hybrid_gated_encoder_block'


def rmsnorm(x, g):
    xf = x.astype(jnp.float32)
    y = xf * lax.rsqrt(jnp.mean(xf * xf, axis=-1, keepdims=True) + EPS)
    return (y * g.astype(jnp.float32)).astype(x.dtype)


def swiglu(x, w_gate, w_up, w_down):
    return (jax.nn.silu(x @ w_gate) * (x @ w_up)) @ w_down


def alibi_slopes(n):
    return jnp.exp2(-8.0 * jnp.arange(1, n + 1, dtype=jnp.float32) / n)


def rope(x, cos, sin):
    half = x.shape[-1] // 2
    x1 = x[..., :half].astype(jnp.float32)
    x2 = x[..., half:].astype(jnp.float32)
    return jnp.concatenate([x1 * cos - x2 * sin, x1 * sin + x2 * cos], axis=-1).astype(x.dtype)


def pool_mixer(a, pool_w, pool_scale):
    b, s, _ = a.shape
    af = a.astype(jnp.float32)
    cs = jnp.concatenate([jnp.zeros_like(af[:, :1]), jnp.cumsum(af, axis=1)], axis=1)
    t = jnp.arange(s)
    outs = []
    for g, w in enumerate(POOL_WINDOWS):
        lo = jnp.clip(t - w // 2, 0, s)
        hi = jnp.clip(t + w // 2, 0, s)
        sl = slice(g * POOL_GW, (g + 1) * POOL_GW)
        csg = cs[:, :, sl]
        mean = (csg[:, hi] - csg[:, lo]) / (hi - lo).astype(jnp.float32)[None, :, None]
        outs.append(mean - af[:, :, sl])
    d = jnp.stack(outs, axis=2).astype(a.dtype)
    y = jnp.einsum('bsgc,gcd->bsgd', d, pool_w)
    return y.reshape(b, s, BRANCH_W) * pool_scale


def banded_attention(q, k, v, n_side, step_penalty):
    n, l, h, dh = q.shape
    blk = n_side
    nb = -(-l // blk)
    lp = nb * blk
    padq = lp - l
    qb = jnp.pad(q, ((0, 0), (0, padq), (0, 0), (0, 0))).reshape(n, nb, blk, h, dh)

    def windows(z):
        zp = jnp.pad(z, ((0, 0), (blk, padq + blk), (0, 0), (0, 0))).reshape(n, nb + 2, blk, h, z.shape[-1])
        return jnp.concatenate([zp[:, :-2], zp[:, 1:-1], zp[:, 2:]], axis=2)

    kw = windows(k)
    vw = windows(v)
    s = jnp.einsum('nbqhd,nbkhd->nbhqk', qb, kw).astype(jnp.float32) * (dh ** -0.5)
    rel = jnp.arange(3 * blk)[None, :] - blk - jnp.arange(blk)[:, None]
    kpos = jnp.arange(nb)[:, None] * blk + jnp.arange(3 * blk)[None, :] - blk
    valid = (jnp.abs(rel) <= n_side)[None] & ((kpos >= 0) & (kpos < l))[:, None, :]
    s = s - step_penalty[:, None, None] * jnp.abs(rel).astype(jnp.float32)
    s = jnp.where(valid[None, :, None], s, -jnp.inf)
    m = jnp.max(s, axis=-1, keepdims=True)
    p = jnp.exp(s - m)
    den = jnp.sum(p, axis=-1, keepdims=True)
    o = jnp.einsum('nbhqk,nbkhd->nbqhd', (p / den).astype(v.dtype), vw)
    lse = (m + jnp.log(den))[..., 0]
    o = o.reshape(n, lp, h, dh)[:, :l]
    lse = lse.transpose(0, 1, 3, 2).reshape(n, lp, h)[:, :l]
    return o, lse


def dilated_mixer(qkv, q_norm_g, k_norm_g):
    b, s, _ = qkv.shape
    q, k, v = jnp.split(qkv.reshape(b, s, 3, DIL_HEADS, DIL_HEAD_DIM), 3, axis=2)
    q = rmsnorm(q[:, :, 0], q_norm_g)
    k = rmsnorm(k[:, :, 0], k_norm_g)
    v = v[:, :, 0]
    slopes = alibi_slopes(DIL_HEADS)
    outs, lses = [], []
    for g, (w, d) in enumerate(DIL_PATTERNS):
        hs = slice(g * DIL_HEADS_PER_GROUP, (g + 1) * DIL_HEADS_PER_GROUP)

        def to_sub(z):
            return z.reshape(b, s // d, d, *z.shape[2:]).swapaxes(1, 2).reshape(b * d, s // d, *z.shape[2:])

        o, lse = banded_attention(to_sub(q[:, :, hs]), to_sub(k[:, :, hs]), to_sub(v[:, :, hs]),
                                  w // (2 * d), slopes[hs] * d)
        outs.append(o.reshape(b, d, s // d, DIL_HEADS_PER_GROUP, DIL_HEAD_DIM).swapaxes(1, 2).reshape(b, s, DIL_HEADS_PER_GROUP, DIL_HEAD_DIM))
        lses.append(lse.reshape(b, d, s // d, DIL_HEADS_PER_GROUP).swapaxes(1, 2).reshape(b, s, DIL_HEADS_PER_GROUP))
    o = jnp.stack(outs, axis=2)
    wts = jax.nn.softmax(jnp.stack(lses, axis=2), axis=2)
    out = jnp.sum(wts[..., None].astype(o.dtype) * o, axis=2)
    return out.reshape(b, s, BRANCH_W)


def sgu_mixer(z, v_norm_g, w_s, b_s):
    b, s, _ = z.shape
    z = jax.nn.gelu(z)
    u, vv = z[..., :BRANCH_W], z[..., BRANCH_W:]
    vv = rmsnorm(vv, v_norm_g).reshape(b, s // SGU_CHUNK, SGU_CHUNK, SGU_GROUPS, SGU_GW)
    mixed = jnp.einsum('gts,bnsgc->bntgc', w_s, vv) + b_s.T[None, None, :, :, None]
    return u * mixed.reshape(b, s, BRANCH_W)


def mla_mixer(cq, ckv, kr, q_a_norm, w_uq, kv_a_norm, w_ukv, q_norm_g, k_norm_g, cos, sin):
    b, s, _ = cq.shape
    q = (rmsnorm(cq, q_a_norm) @ w_uq).reshape(b, s, MLA_HEADS, MLA_QK)
    kv = (rmsnorm(ckv, kv_a_norm) @ w_ukv).reshape(b, s, MLA_HEADS, MLA_NOPE + MLA_V)
    k_nope, v = kv[..., :MLA_NOPE], kv[..., MLA_NOPE:]
    k = jnp.concatenate([k_nope, jnp.broadcast_to(kr[:, :, None, :], (b, s, MLA_HEADS, MLA_ROPE))], axis=-1)
    q = rmsnorm(q, q_norm_g)
    k = rmsnorm(k, k_norm_g)
    q = jnp.concatenate([q[..., :MLA_NOPE], rope(q[..., MLA_NOPE:], cos, sin)], axis=-1)
    k = jnp.concatenate([k[..., :MLA_NOPE], rope(k[..., MLA_NOPE:], cos, sin)], axis=-1)
    scale = MLA_QK ** -0.5
    qb = q.reshape(b, s // MLA_QBLOCK, MLA_QBLOCK, MLA_HEADS, MLA_QK).swapaxes(0, 1)

    def attend(qblk):
        sc = jnp.einsum('bqhd,bkhd->bhqk', qblk, k).astype(jnp.float32) * scale
        p = jax.nn.softmax(sc, axis=-1)
        return jnp.einsum('bhqk,bkhd->bqhd', p.astype(v.dtype), v)

    o = lax.map(attend, qb)
    return o.swapaxes(0, 1).reshape(b, s, MLA_HEADS * MLA_V)


def setup_inputs(seed: int = 0) -> dict:
    key = jax.random.key(seed)
    ks = jax.random.split(key, 26)
    L = DEPTH

    def dense(k, shape, fan_in):
        return jax.random.normal(k, shape, jnp.float32) * (fan_in ** -0.5)

    def gain(k, shape):
        return 1.0 + 0.02 * jax.random.normal(k, shape, jnp.float32)

    return {
        'x': jax.random.normal(ks[0], (BATCH, SEQ, D_MODEL), jnp.float32),
        'ffn1_norm': gain(ks[1], (L, D_MODEL)),
        'ffn1_w_gate': dense(ks[2], (L, D_MODEL, D_FF), D_MODEL),
        'ffn1_w_up': dense(ks[3], (L, D_MODEL, D_FF), D_MODEL),
        'ffn1_w_down': dense(ks[4], (L, D_FF, D_MODEL), D_FF),
        'mix_norm': gain(ks[5], (L, D_MODEL)),
        'w_in': dense(ks[6], (L, D_MODEL, N_IN), D_MODEL),
        'pool_w': dense(ks[7], (L, POOL_GROUPS, POOL_GW, POOL_GW), POOL_GW),
        'pool_scale': gain(ks[8], (L, BRANCH_W)),
        'dil_q_norm': gain(ks[9], (L, DIL_HEAD_DIM)),
        'dil_k_norm': gain(ks[10], (L, DIL_HEAD_DIM)),
        'sgu_v_norm': gain(ks[11], (L, BRANCH_W)),
        'sgu_w': dense(ks[12], (L, SGU_GROUPS, SGU_CHUNK, SGU_CHUNK), SGU_CHUNK),
        'sgu_b': gain(ks[13], (L, SGU_GROUPS, SGU_CHUNK)),
        'mla_q_a_norm': gain(ks[14], (L, MLA_Q_LORA)),
        'mla_w_uq': dense(ks[15], (L, MLA_Q_LORA, MLA_HEADS * MLA_QK), MLA_Q_LORA),
        'mla_kv_a_norm': gain(ks[16], (L, MLA_KV_LORA)),
        'mla_w_ukv': dense(ks[17], (L, MLA_KV_LORA, MLA_HEADS * (MLA_NOPE + MLA_V)), MLA_KV_LORA),
        'mla_q_norm': gain(ks[18], (L, MLA_QK)),
        'mla_k_norm': gain(ks[19], (L, MLA_QK)),
        'w_branch': dense(ks[20], (L, N_BRANCH, BRANCH_W, D_MODEL), BRANCH_W),
        'w_out': dense(ks[21], (L, D_MODEL, D_MODEL), D_MODEL),
        'ffn2_norm': gain(ks[22], (L, D_MODEL)),
        'ffn2_w_gate': dense(ks[23], (L, D_MODEL, D_FF), D_MODEL),
        'ffn2_w_up': dense(ks[24], (L, D_MODEL, D_FF), D_MODEL),
        'ffn2_w_down': dense(ks[25], (L, D_FF, D_MODEL), D_FF),
    }


def reference(x, ffn1_norm, ffn1_w_gate, ffn1_w_up, ffn1_w_down, mix_norm, w_in, pool_w, pool_scale,
              dil_q_norm, dil_k_norm, sgu_v_norm, sgu_w, sgu_b, mla_q_a_norm, mla_w_uq, mla_kv_a_norm,
              mla_w_ukv, mla_q_norm, mla_k_norm, w_branch, w_out, ffn2_norm, ffn2_w_gate, ffn2_w_up,
              ffn2_w_down):
    b, s, _ = x.shape
    pos = jnp.arange(s, dtype=jnp.float32)
    inv_freq = ROPE_THETA ** (-jnp.arange(0, MLA_ROPE, 2, dtype=jnp.float32) / MLA_ROPE)
    ang = pos[:, None] * inv_freq[None, :]
    cos = jnp.cos(ang)[None, :, None, :]
    sin = jnp.sin(ang)[None, :, None, :]
    for l in range(DEPTH):
        x = x + 0.5 * swiglu(rmsnorm(x, ffn1_norm[l]), ffn1_w_gate[l], ffn1_w_up[l], ffn1_w_down[l])
        h = rmsnorm(x, mix_norm[l])
        p = h @ w_in[l]
        z_a = pool_mixer(p[..., OFF_POOL:OFF_DIL], pool_w[l], pool_scale[l])
        z_b = dilated_mixer(p[..., OFF_DIL:OFF_SGU], dil_q_norm[l], dil_k_norm[l])
        z_c = sgu_mixer(p[..., OFF_SGU:OFF_MLA_Q], sgu_v_norm[l], sgu_w[l], sgu_b[l])
        z_d = mla_mixer(p[..., OFF_MLA_Q:OFF_MLA_KV], p[..., OFF_MLA_KV:OFF_MLA_KR], p[..., OFF_MLA_KR:OFF_GATE],
                        mla_q_a_norm[l], mla_w_uq[l], mla_kv_a_norm[l], mla_w_ukv[l],
                        mla_q_norm[l], mla_k_norm[l], cos, sin)
        gates = jax.nn.sigmoid(p[..., OFF_GATE:].reshape(b, s, N_BRANCH, D_MODEL))
        z = jnp.stack([z_a, z_b, z_c, z_d], axis=2)
        merged = jnp.sum(gates * jnp.einsum('bsnc,ncd->bsnd', z, w_branch[l]), axis=2)
        x = x + merged @ w_out[l]
        x = x + 0.5 * swiglu(rmsnorm(x, ffn2_norm[l]), ffn2_w_gate[l], ffn2_w_up[l], ffn2_w_down[l])
    return x
```

```cpp
#include <hip/hip_runtime.h>
#include <cstdio>
#include <cstdint>
namespace pg8 {
#define PG8_LAS __attribute__((address_space(3)))
typedef unsigned short bf16_t;
typedef short bf16x8 __attribute__((ext_vector_type(8)));
typedef float f32x4 __attribute__((ext_vector_type(4)));
typedef unsigned u32x4 __attribute__((ext_vector_type(4)));
constexpr int BM = 256, BK = 64, HALF = 128, HTB = HALF * BK * 2  , STAGE_BYTES = 8 * HTB, NXCD = 8, WGM = 8;

__host__ __device__ __forceinline__ int lds_byte(int r, int c) { const int st = (r >> 4) * 2 + (c >> 5), rr = r & 15, cc = c & 31, ob = rr * 64 + cc * 2; return st * 1024 + (ob ^ (((ob >> 9) & 1) << 5)); }
__host__ __device__ __forceinline__ void stage_rc(int b, int& R, int& C) { const int st = b / 1024, sb = b % 1024, swz = sb ^ (((sb >> 9) & 1) << 5); R = (st >> 1) * 16 + swz / 64; C = (st & 1) * 32 + (swz % 64) / 2; }
__host__ __device__ __forceinline__ int perm32(int rho) { const int n = rho >> 4, i = rho & 15; return 8 * (i >> 2) + 4 * n + (i & 3); }

struct Unit { int pm, pn; };
struct Gemm { const bf16_t* A; const bf16_t* Bt; int M, N, K; };

struct StaticOrder {
    int nM, nN, nwg, G, c;
    __host__ __device__ void init(int M, int N, int G_, int c_) { nM = M / BM; nN = N / BM; nwg = nM * nN; G = G_; c = c_; }
    __host__ __device__ bool next(int i, Unit& u) const {
        const long L = (long)i * G + c; if (L >= nwg) return false;
        int wgid = (int)L; { const int q = nwg / NXCD, r = nwg % NXCD, xcd = wgid % NXCD, off = wgid / NXCD; wgid = (xcd < r ? xcd * (q + 1) : r * (q + 1) + (xcd - r) * q) + off; }
        const int nig = WGM * nN, gid = wgid / nig, fm = gid * WGM, gsz = (nM - fm) < WGM ? (nM - fm) : WGM;
        u.pm = fm + ((wgid % nig) % gsz); u.pn = (wgid % nig) / gsz; return true;
    }
    __device__ __forceinline__ void a_ready(const Unit&) const {}
    __device__ __forceinline__ void done(const Unit&) const {}
};
__device__ __forceinline__ unsigned cvt_pk_bf16(float lo, float hi) { unsigned r; asm volatile("v_cvt_pk_bf16_f32 %0, %1, %2" : "=v"(r) : "v"(lo), "v"(hi)); return r; }
typedef float f32x2 __attribute__((ext_vector_type(2)));
__device__ __forceinline__ f32x2 gelu_pk(f32x2 v) {
    const f32x2 av = __builtin_elementwise_abs(v), d = av * 0.2316418882f + 1.0f;
    f32x2 t; t.x = __builtin_amdgcn_rcpf(d.x); t.y = __builtin_amdgcn_rcpf(d.y);
    f32x2 q = t * 0.5307027145f + (-0.7265760135f); q = q * t + 0.7107068705f; q = q * t + (-0.142248368f); q = q * t + 0.127414796f; q = q * t;
    const f32x2 s = (v * v) * (-0.72134752044f);
    f32x2 e; e.x = __builtin_amdgcn_exp2f(s.x); e.y = __builtin_amdgcn_exp2f(s.y);
    const f32x2 m = v * (q * e), r = v - m;
    f32x2 o; o.x = v.x < 0.f ? m.x : r.x; o.y = v.y < 0.f ? m.y : r.y; return o;
}
template <class Epi, class Sched, bool ALIGN_EPI = false, bool SP2 = false>
__device__ __forceinline__ void gemm_phase(PG8_LAS unsigned char* lds, const Gemm g, const Sched& S, const Epi& E) {
    int tid_ = threadIdx.x; asm volatile("" : "+v"(tid_));
    const int tid = tid_, wid = __builtin_amdgcn_readfirstlane(tid >> 6), lane = tid & 63, wr = wid >> 2, wc = wid & 3, fr = lane & 15, fq = lane >> 4;
    const int K = g.K, nt = K / BK;
    unsigned voffA[2], voffB[2];
#pragma unroll
    for (int i = 0; i < 2; ++i) { int R, C; stage_rc(tid * 16 + i * 8192, R, C); const int Rb = Epi::PERM ? ((R & ~31) + perm32(R & 31)) : R;
        voffA[i] = (unsigned)(R * K + C) * 2u; voffB[i] = (unsigned)(Rb * K + C) * 2u; }
    const size_t kstep = (size_t)(BK * 2);
    const size_t hstep = (size_t)HALF * K * 2;
    const size_t tstep = 2 * hstep;
    const unsigned ldsw = (unsigned)wid * 1024u;
    const int aoff = lds_byte(wr * 64 + fr, fq * 8), boff = lds_byte(wc * 32 + fr, fq * 8);
#define PG8_SA(b, h) (((b) * 2 + (h)) * HTB)
#define PG8_SB(b, h) ((4 + (b) * 2 + (h)) * HTB)
#define PG8_STAGE(bufoff, gbase, voff) do { _Pragma("unroll") for (int _i = 0; _i < 2; ++_i) \
        __builtin_amdgcn_global_load_lds((const unsigned*)((const char*)(gbase) + (voff)[_i]), (PG8_LAS unsigned*)(lds + (bufoff) + ldsw + _i * 8192), 16, 0, 0); } while (0)
#define PG8_LDA(dst, b, h) do { _Pragma("unroll") for (int m = 0; m < 4; ++m) _Pragma("unroll") for (int k = 0; k < 2; ++k) dst[m][k] = *(const PG8_LAS bf16x8*)(lds + PG8_SA(b, h) + aoff + m * 2048 + k * 1024); } while (0)
#define PG8_LDB(dst, b, h) do { _Pragma("unroll") for (int n = 0; n < 2; ++n) _Pragma("unroll") for (int k = 0; k < 2; ++k) dst[n][k] = *(const PG8_LAS bf16x8*)(lds + PG8_SB(b, h) + boff + n * 2048 + k * 1024); } while (0)
#define PG8_MMA(ai, bj, At, Bt) do { __builtin_amdgcn_s_setprio(1); _Pragma("unroll") for (int m = 0; m < 4; ++m) _Pragma("unroll") for (int n = 0; n < 2; ++n) _Pragma("unroll") for (int k = 0; k < 2; ++k) \
        acc[ai][bj][m][n] = __builtin_amdgcn_mfma_f32_16x16x32_bf16(Bt[n][k], At[m][k], acc[ai][bj][m][n], 0, 0, 0); __builtin_amdgcn_s_setprio(0); } while (0)
#define PG8_WAIT_V(n) asm volatile("s_waitcnt vmcnt(" #n ")" ::: "memory")
#define PG8_WAIT_L(n) asm volatile("s_waitcnt lgkmcnt(" #n ")" ::: "memory")
#define PG8_BAR __builtin_amdgcn_s_barrier()
#define PG8_SCHED __builtin_amdgcn_sched_barrier(0)
    Unit cur, nxt; int ui = 0;
    if (!S.next(0, cur)) return;
    f32x4 acc[2][2][4][2];
#pragma unroll
    for (int a = 0; a < 2; ++a)
#pragma unroll
        for (int b = 0; b < 2; ++b)
#pragma unroll
            for (int m = 0; m < 4; ++m)
#pragma unroll
                for (int n = 0; n < 2; ++n) acc[a][b][m][n] = (f32x4){0.f, 0.f, 0.f, 0.f};
    bf16x8 At[4][2], B0[2][2], B1[2][2];
    const char* cA = (const char*)g.A + (size_t)cur.pm * tstep; const char* cB = (const char*)g.Bt + (size_t)cur.pn * tstep;
    S.a_ready(cur);
    if constexpr (SP2) {
        PG8_STAGE(PG8_SB(0, 0), cB, voffB); PG8_STAGE(PG8_SB(0, 1), cB + hstep, voffB); PG8_STAGE(PG8_SA(0, 0), cA, voffA); PG8_STAGE(PG8_SA(0, 1), cA + hstep, voffA);
        if (wr == 1) PG8_BAR;
        PG8_WAIT_V(2); PG8_BAR;
        PG8_STAGE(PG8_SB(1, 0), cB + kstep, voffB); PG8_STAGE(PG8_SA(1, 0), cA + kstep, voffA); PG8_STAGE(PG8_SB(1, 1), cB + hstep + kstep, voffB);
        PG8_WAIT_V(6); PG8_BAR;
    } else {
        PG8_STAGE(PG8_SB(0, 0), cB, voffB); PG8_STAGE(PG8_SA(0, 0), cA, voffA); PG8_STAGE(PG8_SB(0, 1), cB + hstep, voffB); PG8_STAGE(PG8_SA(0, 1), cA + hstep, voffA);
        if (wr == 1) PG8_BAR;
        PG8_WAIT_V(4); PG8_BAR;
        PG8_STAGE(PG8_SB(1, 0), cB + kstep, voffB); PG8_STAGE(PG8_SA(1, 0), cA + kstep, voffA); PG8_STAGE(PG8_SB(1, 1), cB + hstep + kstep, voffB);
        PG8_WAIT_V(6); PG8_BAR;
    }
    for (;;) {
        const bool has_next = S.next(ui + 1, nxt);
        const char* nA = has_next ? (const char*)g.A + (size_t)nxt.pm * tstep : cA; const char* nB = has_next ? (const char*)g.Bt + (size_t)nxt.pn * tstep : cB;
        for (int t = 0; t < nt; t += 2) {
            const bool last = (t == nt - 2);
            const char* a1 = cA + (size_t)(t + 1) * kstep;
            const char* a2 = last ? nA : cA + (size_t)(t + 2) * kstep; const char* b2 = last ? nB : cB + (size_t)(t + 2) * kstep;
            const char* a3 = a2 + kstep; const char* b3 = b2 + kstep;
            if (last && has_next) S.a_ready(nxt);
            if constexpr (SP2) {
            PG8_LDB(B0, 0, 0); PG8_LDB(B1, 0, 1); PG8_SCHED; PG8_LDA(At, 0, 0); PG8_STAGE(PG8_SA(1, 1), a1 + hstep, voffA);
            PG8_WAIT_V(8); PG8_WAIT_L(0); PG8_BAR; PG8_MMA(0, 0, At, B0); PG8_MMA(0, 1, At, B1); PG8_BAR; PG8_SCHED;
            PG8_LDA(At, 0, 1); PG8_STAGE(PG8_SB(0, 0), b2, voffB); PG8_STAGE(PG8_SB(0, 1), b2 + hstep, voffB); PG8_STAGE(PG8_SA(0, 0), a2, voffA);
            PG8_WAIT_V(8); PG8_WAIT_L(0); PG8_BAR; PG8_MMA(1, 0, At, B0); PG8_MMA(1, 1, At, B1); PG8_BAR; PG8_SCHED;
            PG8_LDB(B0, 1, 0); PG8_LDB(B1, 1, 1); PG8_SCHED; PG8_LDA(At, 1, 0); PG8_STAGE(PG8_SA(0, 1), a2 + hstep, voffA);
            PG8_WAIT_V(8); PG8_WAIT_L(0); PG8_BAR; PG8_MMA(0, 0, At, B0); PG8_MMA(0, 1, At, B1); PG8_BAR; PG8_SCHED;
            PG8_LDA(At, 1, 1); PG8_STAGE(PG8_SB(1, 0), b3, voffB); PG8_STAGE(PG8_SB(1, 1), b3 + hstep, voffB); PG8_STAGE(PG8_SA(1, 0), a3, voffA);
            PG8_WAIT_V(8); PG8_WAIT_L(0); PG8_BAR; PG8_MMA(1, 0, At, B0); PG8_MMA(1, 1, At, B1); PG8_BAR; PG8_SCHED;
            } else {
            PG8_LDB(B0, 0, 0); PG8_SCHED; PG8_LDA(At, 0, 0); PG8_STAGE(PG8_SA(1, 1), a1 + hstep, voffA);
            PG8_WAIT_L(8); PG8_BAR; PG8_WAIT_L(0); PG8_MMA(0, 0, At, B0); PG8_BAR; PG8_SCHED;
            PG8_LDB(B1, 0, 1); PG8_STAGE(PG8_SB(0, 0), b2, voffB);
            PG8_BAR; PG8_WAIT_L(0); PG8_MMA(0, 1, At, B1); PG8_BAR;
            PG8_LDA(At, 0, 1); PG8_STAGE(PG8_SA(0, 0), a2, voffA);
            PG8_BAR; PG8_WAIT_L(0); PG8_MMA(1, 0, At, B0); PG8_BAR; PG8_SCHED;
            PG8_STAGE(PG8_SB(0, 1), b2 + hstep, voffB);
            PG8_WAIT_V(6); PG8_BAR; PG8_MMA(1, 1, At, B1); PG8_BAR;
            PG8_LDB(B0, 1, 0); PG8_SCHED; PG8_LDA(At, 1, 0); PG8_STAGE(PG8_SA(0, 1), a2 + hstep, voffA);
            PG8_WAIT_L(8); PG8_BAR; PG8_WAIT_L(0); PG8_MMA(0, 0, At, B0); PG8_BAR; PG8_SCHED;
            PG8_LDB(B1, 1, 1); PG8_STAGE(PG8_SB(1, 0), b3, voffB);
            PG8_BAR; PG8_WAIT_L(0); PG8_MMA(0, 1, At, B1); PG8_BAR;
            PG8_LDA(At, 1, 1); PG8_STAGE(PG8_SA(1, 0), a3, voffA);
            PG8_BAR; PG8_WAIT_L(0); PG8_MMA(1, 0, At, B0); PG8_BAR; PG8_SCHED;
            PG8_STAGE(PG8_SB(1, 1), b3 + hstep, voffB);
            PG8_WAIT_V(6); PG8_BAR; PG8_MMA(1, 1, At, B1); PG8_BAR;
            }
        }
        if constexpr (ALIGN_EPI) { if (wr == 0) PG8_BAR; }
        if constexpr (!Epi::AFTER_DRAIN) { E(acc, cur, wr, wc, fr, fq); S.done(cur); }
        if (!has_next) break;
#pragma unroll
        for (int a = 0; a < 2; ++a)
#pragma unroll
            for (int b = 0; b < 2; ++b)
#pragma unroll
                for (int m = 0; m < 4; ++m)
#pragma unroll
                    for (int n = 0; n < 2; ++n) acc[a][b][m][n] = (f32x4){0.f, 0.f, 0.f, 0.f};
        cur = nxt; cA = nA; cB = nB; ++ui;
        if constexpr (ALIGN_EPI) { if (wr == 1) PG8_BAR; }
    }
    PG8_WAIT_V(0);
    if constexpr (!ALIGN_EPI) { if (wr == 0) PG8_BAR; }
    PG8_BAR;
    if constexpr (Epi::AFTER_DRAIN) { E.fused(acc, cur, wr, wc, fr, fq, lds, wid, lane); S.done(cur); }
#undef PG8_SA
#undef PG8_SB
#undef PG8_STAGE
#undef PG8_LDA
#undef PG8_LDB
#undef PG8_MMA
#undef PG8_WAIT_V
#undef PG8_WAIT_L
#undef PG8_BAR
#undef PG8_SCHED
}
}
#define GAS __attribute__((address_space(1)))
#define LAS __attribute__((address_space(3)))
typedef unsigned short bf16;
typedef unsigned v4u __attribute__((ext_vector_type(4)));
typedef float f32x4 __attribute__((ext_vector_type(4)));
typedef short bf16x8 __attribute__((ext_vector_type(8)));
typedef GAS unsigned gu32;
typedef GAS unsigned long long gu64;
#define RLX_AGENT __ATOMIC_RELAXED, __HIP_MEMORY_SCOPE_AGENT
#define LDS_WAIT() asm volatile("s_waitcnt lgkmcnt(0)" ::: "memory")
#define VM_WAIT() asm volatile("s_waitcnt vmcnt(0)" ::: "memory")
__device__ __forceinline__ unsigned long long rt() { return __builtin_amdgcn_s_memrealtime(); }
__device__ __forceinline__ unsigned f2bf(float f) { unsigned u = __builtin_bit_cast(unsigned, f); return (u + 0x7fffu + ((u >> 16) & 1u)) >> 16; }
__device__ __forceinline__ unsigned pk2(float lo, float hi) { return f2bf(lo) | (f2bf(hi) << 16); }
#define XB_TMO      128
#define XB_XCNT(j)  (256  + 64 * (j))
#define XB_XSUB(j)  (1280 + 64 * (j))
#define XB_XGEN(j)  (2304 + 64 * (j))
#define XB_TOP      3328
#define XB_TOPGEN   3392
#define XCD_BAR_WORDS 3456
#define XB_SPIN_CAP (1u << 18)

__device__ __forceinline__ unsigned xb_ld(unsigned* p)              { return __hip_atomic_load(p, __ATOMIC_RELAXED, __HIP_MEMORY_SCOPE_AGENT); }
__device__ __forceinline__ unsigned xb_add(unsigned* p, unsigned v) { return __hip_atomic_fetch_add(p, v, __ATOMIC_RELAXED, __HIP_MEMORY_SCOPE_AGENT); }
__device__ __forceinline__ unsigned xb_xcc_id() { return (unsigned)__builtin_amdgcn_s_getreg((3 << 11) | 20) & 0xFu; }
#define XB_SPIN(cond, bar) do { unsigned _sp = 0; while (cond) { __builtin_amdgcn_s_sleep(1); \
    if ((++_sp & 255u) == 0u) { if (xb_ld(&(bar)[XB_TMO])) break; if (_sp > XB_SPIN_CAP) { atomicAdd(&(bar)[XB_TMO], 1u); break; } } } } while (0)

struct XcdBarrier {
    unsigned* bar; unsigned x;
    volatile LAS unsigned* st;
};

__device__ __forceinline__ XcdBarrier xcd_barrier_post(unsigned* bar, volatile LAS unsigned* st) {
    XcdBarrier b; b.bar = bar; b.x = xb_xcc_id(); b.st = st;
    if (threadIdx.x == 0) (void)xb_add(&bar[XB_XCNT(b.x)], 1u);
    return b;
}
__device__ __forceinline__ void xcd_barrier_complete(unsigned* bar, unsigned x, unsigned& nloc, unsigned& nx) {
    const unsigned G = gridDim.x * gridDim.y * gridDim.z;
    unsigned sum, cnt, mine, sp = 0u;
    for (;;) {
        sum = 0u; cnt = 0u; mine = 0u;
#pragma unroll
        for (unsigned j = 0; j < 16; ++j) { const unsigned c = xb_ld(&bar[XB_XCNT(j)]); sum += c; cnt += (c > 0u) ? 1u : 0u; mine = (j == x) ? c : mine; }
        if (sum == G) break;
        __builtin_amdgcn_s_sleep(1);
        if ((++sp & 255u) == 0u) { if (xb_ld(&bar[XB_TMO])) break; if (sp > XB_SPIN_CAP) { atomicAdd(&bar[XB_TMO], 1u); break; } }
    }
    nloc = mine > 0u ? mine : 1u; nx = cnt > 0u ? cnt : 1u;
}

__device__ __forceinline__ void xcd_barrier(const XcdBarrier& b) {
    asm volatile("s_waitcnt vmcnt(0)" ::: "memory");
    __syncthreads();
    if (threadIdx.x == 0) {
        unsigned* bar = b.bar;
        __builtin_amdgcn_s_waitcnt(0);
        unsigned nloc = b.st[0], nx = b.st[1];
        if (nloc == 0u) { xcd_barrier_complete(bar, b.x, nloc, nx); b.st[0] = nloc; b.st[1] = nx; }
        const unsigned old = xb_add(&bar[XB_XSUB(b.x)], 1u);
        const unsigned gen = old / nloc;
        if (old + 1u == (gen + 1u) * nloc) {
            __builtin_amdgcn_fence(__ATOMIC_RELEASE, "agent");
            asm volatile("s_waitcnt vmcnt(0)" ::: "memory");
            const unsigned og = xb_add(&bar[XB_TOP], 1u);
            const unsigned tg = og / nx;
            if (og + 1u == (tg + 1u) * nx) xb_add(&bar[XB_TOPGEN], 1u);
            else XB_SPIN(xb_ld(&bar[XB_TOPGEN]) == tg, bar);
            __builtin_amdgcn_fence(__ATOMIC_ACQUIRE, "agent");
            xb_add(&bar[XB_XGEN(b.x)], 1u);
            asm volatile("s_waitcnt vmcnt(0)" ::: "memory");
        } else {
            XB_SPIN(xb_ld(&bar[XB_XGEN(b.x)]) == gen, bar);
            __builtin_amdgcn_fence(__ATOMIC_ACQUIRE, "agent");
            asm volatile("s_waitcnt vmcnt(0)" ::: "memory");
        }
    }
    __syncthreads();
}
constexpr int S = 8192, D = 2048, FF = 5632, NLAYER = 4;
constexpr int NIN = 14912, NINP = 15104;
constexpr int NGU = 2 * FF;
constexpr float EPS = 1e-6f;
constexpr int PC_GATE = 0, PC_POOL = 8192, PC_DIL = 8704, PC_SGU = 13312, PC_CQ = 14336, PC_CKV = 14720, PC_KR = 14848;
constexpr int NMLA = 1792;

namespace epi {
using pg8::f32x4; using pg8::u32x4; using pg8::Unit; using pg8::bf16_t;
typedef float f32x2_t __attribute__((ext_vector_type(2))); typedef __bf16 bf16x2_t __attribute__((ext_vector_type(2)));
__device__ __forceinline__ unsigned cvt_pk_bf16(float lo, float hi) { f32x2_t v = {lo, hi}; bf16x2_t b = __builtin_convertvector(v, bf16x2_t); return __builtin_bit_cast(unsigned, b); }
constexpr int BM = 256, HALF = 128;
typedef unsigned u32x2 __attribute__((ext_vector_type(2)));
__device__ __forceinline__ float fast_exp(float x) { return __builtin_amdgcn_exp2f(x * 1.44269504089f); }
__device__ __forceinline__ float sigmoid_f(float x) { return __builtin_amdgcn_rcpf(1.0f + fast_exp(-x)); }

struct EpiSwiglu {
    static constexpr bool PERM = true, AFTER_DRAIN = false;
    bf16_t* H;
    __device__ __forceinline__ void operator()(const f32x4 (&acc)[2][2][4][2], const Unit& u, int wr, int wc, int fr, int fq) const {
        const int row0 = u.pm * BM + wr * 64 + fr, col0 = u.pn * HALF + wc * 32 + 8 * fq;
#pragma unroll
        for (int ai = 0; ai < 2; ++ai)
#pragma unroll
            for (int m = 0; m < 4; ++m) {
                bf16_t* rowp = H + (size_t)(row0 + ai * HALF + m * 16) * FF + col0;
                float o[8];
#pragma unroll
                for (int n = 0; n < 2; ++n)
#pragma unroll
                    for (int j = 0; j < 4; ++j) { const float g = acc[ai][0][m][n][j], up = acc[ai][1][m][n][j]; o[n * 4 + j] = g * sigmoid_f(g) * up; }
                u32x4 w; w.x = cvt_pk_bf16(o[0], o[1]); w.y = cvt_pk_bf16(o[2], o[3]); w.z = cvt_pk_bf16(o[4], o[5]); w.w = cvt_pk_bf16(o[6], o[7]);
                *(u32x4*)rowp = w;
                asm volatile("" ::: "memory");
            }
    }
};
struct EpiResid {
    static constexpr bool PERM = false, AFTER_DRAIN = false;
    const float* base; float* out; float alpha;
    __device__ __forceinline__ void operator()(const f32x4 (&acc)[2][2][4][2], const Unit& u, int wr, int wc, int fr, int fq) const {
        const int row0 = u.pm * BM + wr * 64 + fr, col0 = u.pn * BM + wc * 32 + 4 * fq;
#pragma unroll
        for (int ai = 0; ai < 2; ++ai)
#pragma unroll
            for (int m = 0; m < 4; ++m) { const size_t off = (size_t)(row0 + ai * HALF + m * 16) * D + col0;
#pragma unroll
                for (int bj = 0; bj < 2; ++bj)
#pragma unroll
                    for (int n = 0; n < 2; ++n) { const f32x4 b = *(const f32x4*)(base + off + bj * HALF + n * 16); *(f32x4*)(out + off + bj * HALF + n * 16) = b + acc[ai][bj][m][n] * alpha; }
                asm volatile("" ::: "memory"); }
    }
};
struct EpiPin {
    static constexpr bool PERM = true, AFTER_DRAIN = false;
    bf16_t* P;
    __device__ __forceinline__ void operator()(const f32x4 (&acc)[2][2][4][2], const Unit& u, int wr, int wc, int fr, int fq) const {
        const int kind = (u.pn < 32) ? 1 : ((u.pn >= 52 && u.pn < 56) ? 2 : 0);
        const int row0 = u.pm * BM + wr * 64 + fr, col0 = u.pn * BM + wc * 32 + 8 * fq;
#pragma unroll
        for (int ai = 0; ai < 2; ++ai)
#pragma unroll
            for (int m = 0; m < 4; ++m) { bf16_t* rowp = P + (size_t)(row0 + ai * HALF + m * 16) * NINP + col0;
#pragma unroll
                for (int bj = 0; bj < 2; ++bj) { float o[8];
#pragma unroll
                    for (int n = 0; n < 2; ++n)
#pragma unroll
                        for (int j = 0; j < 4; ++j) { const float x = acc[ai][bj][m][n][j];
                            const float arg = (kind == 2) ? 1.5957691216f * (x + 0.044715f * x * x * x) : x;
                            const float r = sigmoid_f(arg);
                            o[n * 4 + j] = (kind == 0) ? x : ((kind == 1) ? r : x * r); }
                    u32x4 w; w.x = cvt_pk_bf16(o[0], o[1]); w.y = cvt_pk_bf16(o[2], o[3]); w.z = cvt_pk_bf16(o[4], o[5]); w.w = cvt_pk_bf16(o[6], o[7]);
                    *(u32x4*)(rowp + bj * HALF) = w; }
                asm volatile("" ::: "memory"); }
    }
};
struct EpiF32 {
    static constexpr bool PERM = false, AFTER_DRAIN = false;
    float* C; int ldc; int colmul;
    __device__ __forceinline__ void operator()(const f32x4 (&acc)[2][2][4][2], const Unit& u, int wr, int wc, int fr, int fq) const {
        const int row0 = u.pm * BM + wr * 64 + fr, col0 = colmul * u.pn * BM + wc * 32 + 4 * fq;
#pragma unroll
        for (int ai = 0; ai < 2; ++ai)
#pragma unroll
            for (int m = 0; m < 4; ++m) { float* rowp = C + (size_t)(row0 + ai * HALF + m * 16) * ldc + col0;
#pragma unroll
                for (int bj = 0; bj < 2; ++bj)
#pragma unroll
                    for (int n = 0; n < 2; ++n) *(f32x4*)(rowp + bj * HALF + n * 16) = acc[ai][bj][m][n]; }
    }
};
struct EpiExp {
    static constexpr bool PERM = true, AFTER_DRAIN = false;
    bf16_t* P;
    __device__ __forceinline__ void operator()(const f32x4 (&acc)[2][2][4][2], const Unit& u, int wr, int wc, int fr, int fq) const {
        const int row0 = u.pm * BM + wr * 64 + fr, col0 = (u.pn & 31) * BM + wc * 32 + 8 * fq;
#pragma unroll
        for (int ai = 0; ai < 2; ++ai)
#pragma unroll
            for (int m = 0; m < 4; ++m) { bf16_t* rowp = P + (size_t)(row0 + ai * HALF + m * 16) * S + col0;
#pragma unroll
                for (int bj = 0; bj < 2; ++bj) { float o[8];
#pragma unroll
                    for (int n = 0; n < 2; ++n)
#pragma unroll
                        for (int j = 0; j < 4; ++j) o[n * 4 + j] =
#ifdef DBG_NOEXP
                            acc[ai][bj][m][n][j];
#else
                            fast_exp(acc[ai][bj][m][n][j]);
#endif
                    u32x4 w; w.x = cvt_pk_bf16(o[0], o[1]); w.y = cvt_pk_bf16(o[2], o[3]); w.z = cvt_pk_bf16(o[4], o[5]); w.w = cvt_pk_bf16(o[6], o[7]);
                    *(u32x4*)(rowp + bj * HALF) = w; }
                asm volatile("" ::: "memory"); }
    }
};
struct EpiBranch {
    static constexpr bool PERM = false, AFTER_DRAIN = false;
    float* merged; bf16_t* mergedb; const bf16_t* gate; int b;
    __device__ __forceinline__ void operator()(const f32x4 (&acc)[2][2][4][2], const Unit& u, int wr, int wc, int fr, int fq) const {
        const int row0 = u.pm * BM + wr * 64 + fr, col0 = u.pn * BM + wc * 32 + 4 * fq;
#pragma unroll
        for (int ai = 0; ai < 2; ++ai)
#pragma unroll
            for (int m = 0; m < 4; ++m) { const int r = row0 + ai * HALF + m * 16;
#pragma unroll
                for (int bj = 0; bj < 2; ++bj)
#pragma unroll
                    for (int n = 0; n < 2; ++n) { const int c = col0 + bj * HALF + n * 16;
                        const u32x2 gv = *(const u32x2*)(gate + (size_t)r * NINP + c);
                        f32x4 g; g[0] = __uint_as_float(gv.x << 16); g[1] = __uint_as_float(gv.x & 0xffff0000u); g[2] = __uint_as_float(gv.y << 16); g[3] = __uint_as_float(gv.y & 0xffff0000u);
                        f32x4 v = acc[ai][bj][m][n] * g;
                        float* mp = merged + (size_t)r * D + c;
                        if (b != 0) v += *(const f32x4*)mp;
                        if (b != 3) *(f32x4*)mp = v;
                        else { u32x2 w; w.x = cvt_pk_bf16(v[0], v[1]); w.y = cvt_pk_bf16(v[2], v[3]); *(u32x2*)(mergedb + (size_t)r * D + c) = w; } }
                asm volatile("" ::: "memory"); }
    }
};
struct QKOrder {
    int G, c;
    __device__ bool next(int i, Unit& u) const { const int L = i * G + c; if (L >= 4096) return false; const int h = L >> 10, rem = L & 1023; u.pm = h * 32 + (rem >> 5); u.pn = h * 32 + (rem & 31); return true; }
    __device__ __forceinline__ void a_ready(const Unit&) const {}
    __device__ __forceinline__ void done(const Unit&) const {}
};
struct PVOrder {
    int G, c;
    __device__ bool next(int i, Unit& u) const { const int L = i * G + c; if (L >= 128) return false; u.pm = L; u.pn = L >> 5; return true; }
    __device__ __forceinline__ void a_ready(const Unit&) const {}
    __device__ __forceinline__ void done(const Unit&) const {}
};
}
constexpr size_t MiB = 1u << 20;
constexpr size_t WS_CTL = 0, CTL_ZERO_BYTES = 1 * MiB;
constexpr size_t WS_COS = 1 * MiB, WS_SIN = 2 * MiB;
constexpr size_t WS_WGU1 = 4 * MiB, WS_WD1 = 48 * MiB, WS_WGU2 = 70 * MiB, WS_WD2 = 114 * MiB;
constexpr size_t WS_WIN = 136 * MiB, WS_WBR = 195 * MiB, WS_WOUT = 203 * MiB, WS_WMLA = 211 * MiB;
constexpr size_t WS_X = 214 * MiB;
constexpr size_t WS_XN = 278 * MiB;
constexpr size_t WS_HID = 310 * MiB;
constexpr size_t WS_P = 398 * MiB;
constexpr size_t WS_Z = 634 * MiB;
constexpr size_t WS_VVN = 666 * MiB, WS_MLAA = 674 * MiB;
constexpr size_t WS_MLARAW = 682 * MiB;
constexpr size_t WS_QP = 1426 * MiB, WS_KP = 1458 * MiB, WS_VT = 770 * MiB;
constexpr int QKP = 256;
constexpr size_t WS_ORAW = 786 * MiB;
constexpr size_t WS_MERGED = 818 * MiB, WS_MERGEDB = 882 * MiB;
constexpr size_t WS_PEXP = 914 * MiB;
constexpr size_t WS_END = 1490 * MiB;
static_assert(WS_WGU1 + (size_t)NGU * D * 2 <= WS_WD1 && WS_WD1 + (size_t)D * FF * 2 <= WS_WGU2 && WS_WGU2 + (size_t)NGU * D * 2 <= WS_WD2 && WS_WD2 + (size_t)D * FF * 2 <= WS_WIN, "ws map 1");
static_assert(WS_WIN + (size_t)NINP * D * 2 <= WS_WBR && WS_WBR + (size_t)4 * D * 512 * 2 <= WS_WOUT && WS_WOUT + (size_t)D * D * 2 <= WS_WMLA && WS_WMLA + (size_t)NMLA * 512 * 2 <= WS_X, "ws map 2");
static_assert(WS_X + (size_t)S * D * 4 <= WS_XN && WS_XN + (size_t)S * D * 2 <= WS_HID && WS_HID + (size_t)S * FF * 2 <= WS_P && WS_P + (size_t)S * NINP * 2 <= WS_Z, "ws map 3");
static_assert(WS_Z + (size_t)4 * S * 512 * 2 <= WS_VVN && WS_MLARAW + (size_t)S * NMLA * 4 <= WS_VT && WS_KP + (size_t)4 * S * QKP * 2 <= WS_END && WS_ORAW + (size_t)4 * S * 256 * 4 <= WS_MERGED && WS_MERGED + (size_t)S * D * 4 <= WS_MERGEDB && WS_MERGEDB + (size_t)S * D * 2 <= WS_PEXP && WS_PEXP + (size_t)4 * S * S * 2 <= WS_QP, "ws map 4");
constexpr int CW_BAR = 4096;

constexpr int NWAVES = 8;
constexpr int RING_OFF = 0, RING_BYTES = 131072;
constexpr int LDSCTL_OFF = RING_BYTES, MISC_OFF = LDSCTL_OFF + 320;
constexpr int LDS_BYTES = 147456;

enum { I_X = 0, I_F1N, I_F1G, I_F1U, I_F1D, I_MIXN, I_WIN, I_POOLW, I_POOLS, I_DQN, I_DKN, I_SGUN, I_SGUW, I_SGUB, I_MQAN, I_MWUQ, I_MKVAN, I_MWUKV, I_MQN, I_MKN, I_WBR, I_WOUT, I_F2N, I_F2G, I_F2U, I_F2D, N_INPUTS };

struct Frame {
    LAS unsigned char* lds;
    volatile LAS unsigned* MISC;
    int wave, vcu, G;
    int gw, NGW, NGT;
};
constexpr int NPHASE = 17;
struct Args { const float* in[N_INPUTS]; float* out; unsigned char* ws; int l_lo, l_hi, ph_lo, ph_hi; };
typedef const __attribute__((address_space(4))) Args* ArgsP;
__device__ __forceinline__ ArgsP fresh_args() { ArgsP p = (ArgsP)__builtin_amdgcn_kernarg_segment_ptr(); asm volatile("" : "+s"(p)); return p; }
__device__ __forceinline__ int opq_s(int x) { asm volatile("" : "+s"(x)); return x; }
__device__ __forceinline__ Frame fresh_frame(const Frame& F) { Frame R = F; R.wave = opq_s(F.wave); R.vcu = opq_s(F.vcu); R.G = opq_s(F.G); R.gw = opq_s(F.gw); R.NGW = opq_s(F.NGW); R.NGT = opq_s(F.NGT); return R; }
__device__ __forceinline__ int opq_lane() { int l = (int)(threadIdx.x & 63u); asm volatile("" : "+v"(l)); return l; }
__device__ __forceinline__ float wave_sum(float v) {
#pragma unroll
    for (int o = 1; o < 64; o <<= 1) v += __shfl_xor(v, o);
    return v;
}
__device__ __forceinline__ float wave_max(float v) {
#pragma unroll
    for (int o = 1; o < 64; o <<= 1) v = fmaxf(v, __shfl_xor(v, o));
    return v;
}
__device__ __forceinline__ float bf2f(unsigned short b) { return __uint_as_float(((unsigned)b) << 16); }
__device__ __forceinline__ float bflo(unsigned u) { return __uint_as_float(u << 16); }
__device__ __forceinline__ float bfhi(unsigned u) { return __uint_as_float(u & 0xffff0000u); }
__device__ __forceinline__ float rsq(float x) { return 1.0f / sqrtf(x); }

__device__ __forceinline__ void transpose_item(const float* W, int ldw, int k0, int n0, bf16* WT, int ldt, int drow0, int dk0, LAS float* scr, int lane) {
#pragma unroll 8
    for (int i = 0; i < 32; ++i) { const int kk = 2 * i + (lane >> 5); scr[kk * 33 + (lane & 31)] = W[(size_t)(k0 + kk) * ldw + n0 + (lane & 31)]; }
    LDS_WAIT(); asm volatile("" ::: "memory");
    const int c = lane & 7;
#pragma unroll
    for (int j = 0; j < 4; ++j) { const int n = (lane >> 3) + 8 * j; const LAS float* s = scr + (8 * c) * 33 + n;
        v4u o; o.x = pk2(s[0 * 33], s[1 * 33]); o.y = pk2(s[2 * 33], s[3 * 33]); o.z = pk2(s[4 * 33], s[5 * 33]); o.w = pk2(s[6 * 33], s[7 * 33]);
        *(GAS v4u*)(WT + (size_t)(drow0 + n) * ldt + dk0 + k0 + 8 * c) = o; }
    LDS_WAIT(); asm volatile("" ::: "memory");
}
template <int MAP> __device__ __forceinline__ int map_row(int n0, int roff) {
    if (MAP == 0) return n0 + roff;
    if (MAP == 1) return (n0 >> 7) * 256 + roff + (n0 & 127);
    return (n0 < 6720) ? (n0 + 8192) : (n0 - 6720);
}
template <int MAP> __device__ __forceinline__ void transpose_matrix(const Frame& F, int gw, int lane, const float* W, int K, int N, bf16* WT, int ldt, int roff, int dk0) {
    LAS float* scr = (LAS float*)(F.lds + RING_OFF + (gw & 7) * 16384);
    const int nblk = N / 32, items = (K / 64) * nblk;
    for (int it = gw; it < items; it += F.NGW) { const int kb = it / nblk, nb = it % nblk; transpose_item(W, N, 64 * kb, 32 * nb, WT, ldt, map_row<MAP>(32 * nb, roff), dk0, scr, lane); }
}

__device__ __forceinline__ void phase_convert(ArgsP A, const Frame& F, int l) {
    unsigned char* ws = A->ws; const int lane = opq_lane(); const int gw = opq_s(F.gw); const int gt = gw * 64 + lane;
    transpose_matrix<1>(F, gw, lane, A->in[I_F1G] + (size_t)l * D * FF, D, FF, (bf16*)(ws + WS_WGU1), D, 0, 0);
    transpose_matrix<1>(F, gw, lane, A->in[I_F1U] + (size_t)l * D * FF, D, FF, (bf16*)(ws + WS_WGU1), D, 128, 0);
    transpose_matrix<0>(F, gw, lane, A->in[I_F1D] + (size_t)l * FF * D, FF, D, (bf16*)(ws + WS_WD1), FF, 0, 0);
    transpose_matrix<1>(F, gw, lane, A->in[I_F2G] + (size_t)l * D * FF, D, FF, (bf16*)(ws + WS_WGU2), D, 0, 0);
    transpose_matrix<1>(F, gw, lane, A->in[I_F2U] + (size_t)l * D * FF, D, FF, (bf16*)(ws + WS_WGU2), D, 128, 0);
    transpose_matrix<0>(F, gw, lane, A->in[I_F2D] + (size_t)l * FF * D, FF, D, (bf16*)(ws + WS_WD2), FF, 0, 0);
    transpose_matrix<2>(F, gw, lane, A->in[I_WIN] + (size_t)l * D * NIN, D, NIN, (bf16*)(ws + WS_WIN), D, 0, 0);
    for (int b = 1; b < 4; ++b) transpose_matrix<0>(F, gw, lane, A->in[I_WBR] + ((size_t)l * 4 + b) * 512 * D, 512, D, (bf16*)(ws + WS_WBR) + (size_t)b * D * 512, 512, 0, 0);
    transpose_matrix<0>(F, gw, lane, A->in[I_WOUT] + (size_t)l * D * D, D, D, (bf16*)(ws + WS_WOUT), D, 0, 0);
    transpose_matrix<0>(F, gw, lane, A->in[I_MWUQ] + (size_t)l * 384 * 768, 384, 768, (bf16*)(ws + WS_WMLA), 512, 0, 0);
    transpose_matrix<0>(F, gw, lane, A->in[I_MWUKV] + (size_t)l * 128 * 1024, 128, 1024, (bf16*)(ws + WS_WMLA), 512, 768, 384);
    { bf16* wm = (bf16*)(ws + WS_WMLA);
      for (int i = gt; i < 768 * 128; i += F.NGT) wm[(size_t)(i >> 7) * 512 + 384 + (i & 127)] = 0;
      for (int i = gt; i < 1024 * 384; i += F.NGT) wm[(size_t)(768 + i / 384) * 512 + (i % 384)] = 0;
      unsigned* wz = (unsigned*)((bf16*)(ws + WS_WIN) + (size_t)NIN * D);
      for (int i = gt; i < (NINP - NIN) * D / 2; i += F.NGT) wz[i] = 0u; }
    { const float* pw = A->in[I_POOLW] + (size_t)l * 4 * 128 * 128; const float* ps = A->in[I_POOLS] + (size_t)l * 512; const float* wb = A->in[I_WBR] + (size_t)l * 4 * 512 * D;
      bf16* wt = (bf16*)(ws + WS_WBR);
      for (int i = gt; i < 512 * D; i += F.NGT) { const int r = i >> 11, n = i & (D - 1), g = r >> 7;
          const float* pr = pw + (size_t)r * 128; float a = 0.f;
          for (int d = 0; d < 128; ++d) a += pr[d] * ps[g * 128 + d] * wb[(size_t)(g * 128 + d) * D + n];
          wt[(size_t)n * 512 + r] = (bf16)f2bf(a); } }
}
__device__ __forceinline__ void phase_rope_tables(ArgsP A, const Frame& F) {
    unsigned char* ws = A->ws; const int lane = opq_lane(); const int gw = opq_s(F.gw); const int gt = gw * 64 + lane;
    {
        float* ct = (float*)(ws + WS_COS); float* st = (float*)(ws + WS_SIN);
        for (int i = gt; i < S * 32; i += F.NGT) { const int pos = i >> 5, k = i & 31;
            double f = 1.0; for (int j = 0; j < k; ++j) f *= 0.74989420933245582730;
            const float ang = (float)pos * (float)f;
            const double a = (double)ang; const double kq = __builtin_rint(a * 0.63661977236758134308); const double r = (a - kq * 1.5707963267948966192) - kq * 6.123233995736766e-17;
            const double r2 = r * r;
            const double sn = r * (1.0 + r2 * (-1.0 / 6 + r2 * (1.0 / 120 + r2 * (-1.0 / 5040 + r2 * (1.0 / 362880 + r2 * (-1.0 / 39916800 + r2 * (1.0 / 6227020800.0)))))));
            const double cs = 1.0 + r2 * (-0.5 + r2 * (1.0 / 24 + r2 * (-1.0 / 720 + r2 * (1.0 / 40320 + r2 * (-1.0 / 3628800 + r2 * (1.0 / 479001600.0 + r2 * (-1.0 / 87178291200.0)))))));
            const int q = ((int)kq) & 3;
            const double sv = (q == 0) ? sn : (q == 1) ? cs : (q == 2) ? -sn : -cs;
            const double cv = (q == 0) ? cs : (q == 1) ? -sn : (q == 2) ? -cs : sn;
            ct[i] = (float)cv; st[i] = (float)sv; }
    }
}
__device__ __forceinline__ void phase_norm(const Frame& F, const float* x, const float* g, bf16* xn) {
    const int lane = opq_lane(); const int gw = opq_s(F.gw);
    for (int m = gw; m < S; m += F.NGW) {
        const GAS f32x4* xr = (const GAS f32x4*)(x + (size_t)m * D) + lane;
        f32x4 v[8]; float s = 0.f;
#pragma unroll
        for (int j = 0; j < 8; ++j) { v[j] = xr[64 * j]; s += (v[j].x * v[j].x + v[j].y * v[j].y) + (v[j].z * v[j].z + v[j].w * v[j].w); }
        const float rstd = rsq(wave_sum(s) * (1.f / D) + EPS);
        const GAS f32x4* gr = (const GAS f32x4*)g + lane;
        GAS unsigned long long* o8 = (GAS unsigned long long*)(xn + (size_t)m * D) + lane;
#pragma unroll
        for (int j = 0; j < 8; ++j) { const f32x4 gg = gr[64 * j];
            o8[64 * j] = (unsigned long long)pk2(v[j].x * rstd * gg.x, v[j].y * rstd * gg.y) | ((unsigned long long)pk2(v[j].z * rstd * gg.z, v[j].w * rstd * gg.w) << 32); }
    }
}
__device__ __forceinline__ void phase_mix1(ArgsP A, const Frame& F, int l) {
    unsigned char* ws = A->ws; const int lane = opq_lane(); const int gw = opq_s(F.gw); const int gt = gw * 64 + lane;
    bf16* p = (bf16*)(ws + WS_P); bf16* z0 = (bf16*)(ws + WS_Z); bf16* vvn = (bf16*)(ws + WS_VVN); bf16* mlaA = (bf16*)(ws + WS_MLAA);
    for (int idx = gt; idx < S * 512; idx += F.NGT) {
        const int t = idx >> 9, c = idx & 511, hw = 1 << (c >> 7);
        const int lo = (t - hw) < 0 ? 0 : (t - hw), hi = (t + hw) > S ? S : (t + hw);
        const bf16* col = p + PC_POOL + c; float s = 0.f;
        for (int tt = lo; tt < hi; ++tt) s += bf2f(col[(size_t)tt * NINP]);
        z0[idx] = (bf16)f2bf(s / (float)(hi - lo) - bf2f(col[(size_t)t * NINP]));
    }
    const float* gq = A->in[I_DQN] + l * 128; const float* gk = A->in[I_DKN] + l * 128; const float* gs = A->in[I_SGUN] + l * 512;
    const float* gqa = A->in[I_MQAN] + l * 384; const float* gkva = A->in[I_MKVAN] + l * 128;
    for (int t = gw; t < S; t += F.NGW) {
        bf16* prow = p + (size_t)t * NINP;
        for (int hh = 0; hh < 24; ++hh) {
            unsigned* ptr = (unsigned*)(prow + PC_DIL + hh * 128) + lane; const unsigned u = *ptr; const float a = bflo(u), b = bfhi(u);
            const float rstd = rsq(wave_sum(a * a + b * b) * (1.f / 128) + EPS); const float* gg = (hh < 12 ? gq : gk) + 2 * lane;
            *ptr = pk2(a * rstd * gg[0], b * rstd * gg[1]);
        }
        { const v4u u = *((const v4u*)(prow + PC_SGU + 512) + lane); float x[8] = {bflo(u.x), bfhi(u.x), bflo(u.y), bfhi(u.y), bflo(u.z), bfhi(u.z), bflo(u.w), bfhi(u.w)}; float ss = 0.f;
#pragma unroll
          for (int k = 0; k < 8; ++k) ss += x[k] * x[k];
          const float rstd = rsq(wave_sum(ss) * (1.f / 512) + EPS); const float* gg = gs + 8 * lane;
          v4u o; o.x = pk2(x[0] * rstd * gg[0], x[1] * rstd * gg[1]); o.y = pk2(x[2] * rstd * gg[2], x[3] * rstd * gg[3]); o.z = pk2(x[4] * rstd * gg[4], x[5] * rstd * gg[5]); o.w = pk2(x[6] * rstd * gg[6], x[7] * rstd * gg[7]);
          *((v4u*)(vvn + (size_t)t * 512) + lane) = o; }
        { const unsigned* cq = (const unsigned*)(prow + PC_CQ) + lane; const unsigned u0 = cq[0], u1 = cq[64], u2 = cq[128];
          const float a0 = bflo(u0), b0 = bfhi(u0), a1 = bflo(u1), b1 = bfhi(u1), a2 = bflo(u2), b2 = bfhi(u2);
          const float rstd = rsq(wave_sum((a0 * a0 + b0 * b0) + (a1 * a1 + b1 * b1) + (a2 * a2 + b2 * b2)) * (1.f / 384) + EPS);
          unsigned* o = (unsigned*)(mlaA + (size_t)t * 512) + lane; const float* gg = gqa + 2 * lane;
          o[0] = pk2(a0 * rstd * gg[0], b0 * rstd * gg[1]); o[64] = pk2(a1 * rstd * gg[128], b1 * rstd * gg[129]); o[128] = pk2(a2 * rstd * gg[256], b2 * rstd * gg[257]);
          const unsigned uk = *((const unsigned*)(prow + PC_CKV) + lane); const float ak = bflo(uk), bk = bfhi(uk);
          const float rk = rsq(wave_sum(ak * ak + bk * bk) * (1.f / 128) + EPS);
          o[192] = pk2(ak * rk * gkva[2 * lane], bk * rk * gkva[2 * lane + 1]); }
    }
}
__device__ __forceinline__ void phase_mix2(ArgsP A, const Frame& F, int l) {
    unsigned char* ws = A->ws; const int lane = opq_lane(); const int gw = opq_s(F.gw); const int gt = gw * 64 + lane;
    const bf16* p = (const bf16*)(ws + WS_P); const float* raw = (const float*)(ws + WS_MLARAW);
    bf16* Qp = (bf16*)(ws + WS_QP); bf16* Kp = (bf16*)(ws + WS_KP); bf16* VT = (bf16*)(ws + WS_VT);
    const float* ct = (const float*)(ws + WS_COS); const float* st = (const float*)(ws + WS_SIN);
    const float* gqn = A->in[I_MQN] + l * 192; const float* gkn = A->in[I_MKN] + l * 192;
    const float QSCL = 0.07216878364870322f;
    for (int u = gw; u < S * 4; u += F.NGW) {
        const int t = u >> 2, h = u & 3;
        const float cs = ct[t * 32 + (lane & 31)], sn = st[t * 32 + (lane & 31)];
        { const float* qr = raw + (size_t)t * NMLA + h * 192; float q0 = qr[lane], q1 = qr[lane + 64], q2 = qr[lane + 128];
          const float rstd = rsq(wave_sum(q0 * q0 + q1 * q1 + q2 * q2) * (1.f / 192) + EPS);
          q0 = q0 * rstd * gqn[lane]; q1 = q1 * rstd * gqn[lane + 64]; q2 = q2 * rstd * gqn[lane + 128];
          const float other = __shfl_xor(q2, 32); const float q2r = (lane < 32) ? (q2 * cs - other * sn) : (other * sn + q2 * cs);
          bf16* qo = Qp + ((size_t)h * S + t) * QKP;
          qo[lane] = (bf16)f2bf(q0 * QSCL); qo[lane + 64] = (bf16)f2bf(q1 * QSCL); qo[lane + 128] = (bf16)f2bf(q2r * QSCL);
          for (int c = 192 + lane; c < QKP; c += 64) qo[c] = 0; }
        { const float* kr = raw + (size_t)t * NMLA + 768 + h * 256; float k0 = kr[lane], k1 = kr[lane + 64], k2 = bf2f(p[(size_t)t * NINP + PC_KR + lane]);
          const float rstd = rsq(wave_sum(k0 * k0 + k1 * k1 + k2 * k2) * (1.f / 192) + EPS);
          k0 = k0 * rstd * gkn[lane]; k1 = k1 * rstd * gkn[lane + 64]; k2 = k2 * rstd * gkn[lane + 128];
          const float other = __shfl_xor(k2, 32); const float k2r = (lane < 32) ? (k2 * cs - other * sn) : (other * sn + k2 * cs);
          bf16* ko = Kp + ((size_t)h * S + t) * QKP;
          ko[lane] = (bf16)f2bf(k0); ko[lane + 64] = (bf16)f2bf(k1); ko[lane + 128] = (bf16)f2bf(k2r);
          for (int c = 192 + lane; c < QKP; c += 64) ko[c] = 0; }
    }
    for (int i = gt; i < 4 * 256 * S; i += F.NGT) {
        const int t = i & (S - 1), d = (i >> 13) & 255, h = i >> 21;
        VT[i] = (d < 128) ? (bf16)f2bf(raw[(size_t)t * NMLA + 768 + h * 256 + 128 + d]) : (d == 128 ? (bf16)0x3f80 : (bf16)0);
    }
    { const bf16* vvn = (const bf16*)(ws + WS_VVN); bf16* z2 = (bf16*)(ws + WS_Z) + (size_t)2 * S * 512;
      const float* sw = A->in[I_SGUW] + (size_t)l * 4 * 128 * 128; const float* sb = A->in[I_SGUB] + (size_t)l * 4 * 128;
      for (int idx = gt; idx < S * 512; idx += F.NGT) {
          const int t = idx >> 9, gc = idx & 511, g = gc >> 7, tl = t & 127, t0 = t & ~127;
          const float* w = sw + ((size_t)g * 128 + tl) * 128; const bf16* vc = vvn + (size_t)t0 * 512 + gc; float a = 0.f;
          for (int s = 0; s < 128; ++s) a += w[s] * bf2f(vc[(size_t)s * 512]);
          a += sb[g * 128 + tl];
          z2[idx] = (bf16)f2bf(bf2f(p[(size_t)t * NINP + PC_SGU + gc]) * a);
      } }
    { bf16* z1 = (bf16*)(ws + WS_Z) + (size_t)1 * S * 512;
      for (int u = gw; u < S * 4; u += F.NGW) {
          const int t = u >> 2, ih = u & 3;
          float sc[3][3]; float mx = -3.0e38f;
#pragma unroll
          for (int g = 0; g < 3; ++g) {
              const int dl = 1 << (2 * g), hq = 4 * g + ih;
              const float slope = __builtin_amdgcn_exp2f(-8.0f * (float)(hq + 1) / 12.0f) * (float)dl;
              const v4u* qv = (const v4u*)(p + (size_t)t * NINP + PC_DIL + hq * 128);
#pragma unroll
              for (int ps = 0; ps < 3; ++ps) {
                  const int j = lane - 64 + 64 * ps, tt = t + dl * j; const bool valid = (j <= 64) && (tt >= 0) && (tt < S);
                  float s = -3.0e38f;
                  if (valid) { const v4u* kv = (const v4u*)(p + (size_t)tt * NINP + PC_DIL + 1536 + hq * 128); float dot = 0.f;
                      for (int c = 0; c < 16; ++c) { const v4u a = qv[c], b = kv[c];
                          dot += bflo(a.x) * bflo(b.x) + bfhi(a.x) * bfhi(b.x) + bflo(a.y) * bflo(b.y) + bfhi(a.y) * bfhi(b.y) + bflo(a.z) * bflo(b.z) + bfhi(a.z) * bfhi(b.z) + bflo(a.w) * bflo(b.w) + bfhi(a.w) * bfhi(b.w); }
                      s = dot * 0.08838834764831845f - slope * (float)(j < 0 ? -j : j); }
                  sc[g][ps] = s; mx = fmaxf(mx, s);
              }
          }
          mx = wave_max(mx); float lsum = 0.f;
#pragma unroll
          for (int g = 0; g < 3; ++g)
#pragma unroll
              for (int ps = 0; ps < 3; ++ps) { const float e = (sc[g][ps] > -1.0e38f) ? epi::fast_exp(sc[g][ps] - mx) : 0.f; sc[g][ps] = e; lsum += e; }
          lsum = wave_sum(lsum);
          float o0 = 0.f, o1 = 0.f;
#pragma unroll
          for (int g = 0; g < 3; ++g) {
              const int dl = 1 << (2 * g), hq = 4 * g + ih;
              const bf16* vb = p + PC_DIL + 3072 + hq * 128 + 2 * lane;
#pragma unroll
              for (int ps = 0; ps < 3; ++ps) {
                  const int nsrc = (ps == 2) ? 1 : 64;
                  for (int src = 0; src < nsrc; ++src) {
                      const int j = src - 64 + 64 * ps, tt = t + dl * j; const float pe = __shfl(sc[g][ps], src);
                      if (tt >= 0 && tt < S) { const unsigned vv = *(const unsigned*)(vb + (size_t)tt * NINP); o0 += pe * bflo(vv); o1 += pe * bfhi(vv); }
                  }
              }
          }
          const float inv = 1.0f / lsum;
          *((unsigned*)(z1 + (size_t)t * 512 + ih * 128) + lane) = pk2(o0 * inv, o1 * inv);
      } }
}
__device__ __forceinline__ void phase_mix3(ArgsP A, const Frame& F) {
    unsigned char* ws = A->ws; const int lane = opq_lane(); const int gw = opq_s(F.gw); const int gt = gw * 64 + lane;
    const float* oraw = (const float*)(ws + WS_ORAW); bf16* z3 = (bf16*)(ws + WS_Z) + (size_t)3 * S * 512;
    for (int idx = gt; idx < S * 512; idx += F.NGT) { const int t = idx >> 9, c = idx & 511, h = c >> 7, d = c & 127;
        const float* row = oraw + ((size_t)h * S + t) * 256; z3[idx] = (bf16)f2bf(row[d] / row[128]); }
}

__global__ void __launch_bounds__(NWAVES * 64, 2) mk_fwd(Args args_unused) {
    extern __shared__ __attribute__((aligned(16))) unsigned char lds[];
    Frame F;
    F.lds = (LAS unsigned char*)lds;
    F.MISC = (volatile LAS unsigned*)(F.lds + MISC_OFF);
    F.wave = __builtin_amdgcn_readfirstlane((int)(threadIdx.x >> 6));
    F.G = gridDim.x; { const int bx = blockIdx.x; F.vcu = (F.G % 8 == 0) ? (bx % 8) * (F.G / 8) + bx / 8 : bx; }
    F.gw = F.vcu * NWAVES + F.wave; F.NGW = F.G * NWAVES; F.NGT = F.NGW * 64;
    for (int u = threadIdx.x; u < (LDS_BYTES - LDSCTL_OFF) / 4; u += NWAVES * 64) ((LAS unsigned*)(F.lds + LDSCTL_OFF))[u] = 0u;
    __syncthreads();
    int l_lo, l_hi; bool multi; XcdBarrier bar;
    { ArgsP A = fresh_args(); l_lo = A->l_lo; l_hi = A->l_hi;
      multi = !((l_hi - l_lo) == 1 && (A->ph_hi - A->ph_lo) == 1);
      unsigned* bw = (unsigned*)((gu32*)(A->ws + WS_CTL) + CW_BAR);
      bar.bar = bw; bar.x = 0; bar.st = F.MISC + 8;
      if (multi) bar = xcd_barrier_post(bw, F.MISC + 8); }
#define SEAM() do { if (multi) xcd_barrier(bar); } while (0)
#ifdef ONLY_PHASE
#define IN(k) ((k) == ONLY_PHASE && lo <= (k) && (k) < hi)
#else
#define IN(k) (lo <= (k) && (k) < hi)
#endif
#define GEMM(EPI, ORDER) pg8::gemm_phase<EPI, ORDER, true, true>(Fl.lds + RING_OFF, g, So, E)
    { ArgsP A = fresh_args(); if (A->l_lo == 0 && A->ph_lo == 0) phase_rope_tables(A, F); }
    for (int l = l_lo; l < l_hi; ++l) {
        int lo, hi; { ArgsP A = fresh_args(); lo = A->ph_lo; hi = A->ph_hi; }
        if (IN(0)) { ArgsP A = fresh_args(); const Frame Fl = fresh_frame(F); const int bx = opq_s((int)blockIdx.x); (void)bx; phase_convert(A, Fl, l); SEAM(); }
        if (IN(1)) { ArgsP A = fresh_args(); const Frame Fl = fresh_frame(F); const int bx = opq_s((int)blockIdx.x); (void)bx; unsigned char* ws = A->ws; const float* xin = (l == 0) ? A->in[I_X] : (const float*)(ws + WS_X);
            phase_norm(Fl, xin, A->in[I_F1N] + (size_t)l * D, (bf16*)(ws + WS_XN)); SEAM(); }
        if (IN(2)) { ArgsP A = fresh_args(); const Frame Fl = fresh_frame(F); const int bx = opq_s((int)blockIdx.x); (void)bx; unsigned char* ws = A->ws;
            pg8::Gemm g{(const bf16*)(ws + WS_XN), (const bf16*)(ws + WS_WGU1), S, NGU, D}; pg8::StaticOrder So; So.init(S, NGU, Fl.G, bx);
            epi::EpiSwiglu E{(bf16*)(ws + WS_HID)}; GEMM(epi::EpiSwiglu, pg8::StaticOrder); SEAM(); }
        if (IN(3)) { ArgsP A = fresh_args(); const Frame Fl = fresh_frame(F); const int bx = opq_s((int)blockIdx.x); (void)bx; unsigned char* ws = A->ws; const float* xin = (l == 0) ? A->in[I_X] : (const float*)(ws + WS_X);
            pg8::Gemm g{(const bf16*)(ws + WS_HID), (const bf16*)(ws + WS_WD1), S, D, FF}; pg8::StaticOrder So; So.init(S, D, Fl.G, bx);
            epi::EpiResid E{xin, (float*)(ws + WS_X), 0.5f}; GEMM(epi::EpiResid, pg8::StaticOrder); SEAM(); }
        if (IN(4)) { ArgsP A = fresh_args(); const Frame Fl = fresh_frame(F); const int bx = opq_s((int)blockIdx.x); (void)bx; unsigned char* ws = A->ws; phase_norm(Fl, (const float*)(ws + WS_X), A->in[I_MIXN] + (size_t)l * D, (bf16*)(ws + WS_XN)); SEAM(); }
        if (IN(5)) { ArgsP A = fresh_args(); const Frame Fl = fresh_frame(F); const int bx = opq_s((int)blockIdx.x); (void)bx; unsigned char* ws = A->ws;
            pg8::Gemm g{(const bf16*)(ws + WS_XN), (const bf16*)(ws + WS_WIN), S, NINP, D}; pg8::StaticOrder So; So.init(S, NINP, Fl.G, bx);
            epi::EpiPin E{(bf16*)(ws + WS_P)}; GEMM(epi::EpiPin, pg8::StaticOrder); SEAM(); }
        if (IN(6)) { ArgsP A = fresh_args(); const Frame Fl = fresh_frame(F); const int bx = opq_s((int)blockIdx.x); (void)bx; phase_mix1(A, Fl, l); SEAM(); }
        if (IN(7)) { ArgsP A = fresh_args(); const Frame Fl = fresh_frame(F); const int bx = opq_s((int)blockIdx.x); (void)bx; unsigned char* ws = A->ws;
            pg8::Gemm g{(const bf16*)(ws + WS_MLAA), (const bf16*)(ws + WS_WMLA), S, NMLA, opq_s(512)}; pg8::StaticOrder So; So.init(S, NMLA, Fl.G, bx);
            epi::EpiF32 E{(float*)(ws + WS_MLARAW), NMLA, 1}; GEMM(epi::EpiF32, pg8::StaticOrder); SEAM(); }
        if (IN(8)) { ArgsP A = fresh_args(); const Frame Fl = fresh_frame(F); const int bx = opq_s((int)blockIdx.x); (void)bx; phase_mix2(A, Fl, l); SEAM(); }
        if (IN(9)) { ArgsP A = fresh_args(); const Frame Fl = fresh_frame(F); const int bx = opq_s((int)blockIdx.x); (void)bx; unsigned char* ws = A->ws;
            pg8::Gemm g{(const bf16*)(ws + WS_QP), (const bf16*)(ws + WS_KP), 4 * S, 4 * S, opq_s(QKP)};
#ifdef DBG_QK_STATIC
            pg8::StaticOrder So; So.init(S, S, Fl.G, bx); epi::EpiExp E{(bf16*)(ws + WS_PEXP)}; GEMM(epi::EpiExp, pg8::StaticOrder); SEAM(); }
#else
            epi::QKOrder So{Fl.G, bx};
            epi::EpiExp E{(bf16*)(ws + WS_PEXP)}; GEMM(epi::EpiExp, epi::QKOrder); SEAM(); }
#endif
        if (IN(10)) { ArgsP A = fresh_args(); const Frame Fl = fresh_frame(F); const int bx = opq_s((int)blockIdx.x); (void)bx; unsigned char* ws = A->ws;
            pg8::Gemm g{(const bf16*)(ws + WS_PEXP), (const bf16*)(ws + WS_VT), 4 * S, 4 * 256, S}; epi::PVOrder So{Fl.G, bx};
            epi::EpiF32 E{(float*)(ws + WS_ORAW), 256, 0}; GEMM(epi::EpiF32, epi::PVOrder); SEAM(); }
        if (IN(11)) { ArgsP A = fresh_args(); const Frame Fl = fresh_frame(F); const int bx = opq_s((int)blockIdx.x); (void)bx; phase_mix3(A, Fl); SEAM(); }
        if (IN(12)) {
            for (int b = 0; b < 4; ++b) { ArgsP A = fresh_args(); const Frame Fl = fresh_frame(F); const int bx = opq_s((int)blockIdx.x); unsigned char* ws = A->ws;
                pg8::Gemm g{(const bf16*)(ws + WS_Z) + (size_t)b * S * 512, (const bf16*)(ws + WS_WBR) + (size_t)b * D * 512, S, D, opq_s(512)}; pg8::StaticOrder So; So.init(S, D, Fl.G, bx);
                epi::EpiBranch E{(float*)(ws + WS_MERGED), (bf16*)(ws + WS_MERGEDB), (const bf16*)(ws + WS_P) + PC_GATE + b * D, b};
                GEMM(epi::EpiBranch, pg8::StaticOrder); }
            SEAM(); }
        if (IN(13)) { ArgsP A = fresh_args(); const Frame Fl = fresh_frame(F); const int bx = opq_s((int)blockIdx.x); (void)bx; unsigned char* ws = A->ws;
            pg8::Gemm g{(const bf16*)(ws + WS_MERGEDB), (const bf16*)(ws + WS_WOUT), S, D, D}; pg8::StaticOrder So; So.init(S, D, Fl.G, bx);
            epi::EpiResid E{(const float*)(ws + WS_X), (float*)(ws + WS_X), 1.0f}; GEMM(epi::EpiResid, pg8::StaticOrder); SEAM(); }
        if (IN(14)) { ArgsP A = fresh_args(); const Frame Fl = fresh_frame(F); const int bx = opq_s((int)blockIdx.x); (void)bx; unsigned char* ws = A->ws; phase_norm(Fl, (const float*)(ws + WS_X), A->in[I_F2N] + (size_t)l * D, (bf16*)(ws + WS_XN)); SEAM(); }
        if (IN(15)) { ArgsP A = fresh_args(); const Frame Fl = fresh_frame(F); const int bx = opq_s((int)blockIdx.x); (void)bx; unsigned char* ws = A->ws;
            pg8::Gemm g{(const bf16*)(ws + WS_XN), (const bf16*)(ws + WS_WGU2), S, NGU, D}; pg8::StaticOrder So; So.init(S, NGU, Fl.G, bx);
            epi::EpiSwiglu E{(bf16*)(ws + WS_HID)}; GEMM(epi::EpiSwiglu, pg8::StaticOrder); SEAM(); }
        if (IN(16)) { ArgsP A = fresh_args(); const Frame Fl = fresh_frame(F); const int bx = opq_s((int)blockIdx.x); (void)bx; unsigned char* ws = A->ws; float* xout = (l == NLAYER - 1) ? A->out : (float*)(ws + WS_X);
            pg8::Gemm g{(const bf16*)(ws + WS_HID), (const bf16*)(ws + WS_WD2), S, D, FF}; pg8::StaticOrder So; So.init(S, D, Fl.G, bx);
            epi::EpiResid E{(const float*)(ws + WS_X), xout, 0.5f}; GEMM(epi::EpiResid, pg8::StaticOrder); SEAM(); }
    }
#undef IN
#undef SEAM
#undef GEMM
}


#ifdef DBG_DUMP_OFF
__global__ void dbg_dump(const unsigned char* ws, float* out, int n) {
    for (int i = blockIdx.x * blockDim.x + threadIdx.x; i < n; i += gridDim.x * blockDim.x) {
        if (i >= DBG_DUMP_N) { out[i] = 0.f; continue; }
#if DBG_DUMP_BF16
        out[i] = __uint_as_float(((unsigned)((const unsigned short*)(ws + DBG_DUMP_OFF))[i]) << 16);
#else
        out[i] = ((const float*)(ws + DBG_DUMP_OFF))[i];
#endif
    }
}
#endif
#ifndef MK_ONE_LAUNCH
#define MK_ONE_LAUNCH 0
#endif
extern "C" void kernel_launch(void* const* d_in, const int* in_sizes, int n_in, void* d_out, int out_size, void* d_ws, size_t ws_size, hipStream_t stream) {
    static int grid = 0;
    if (grid == 0) {
        if (n_in != N_INPUTS || out_size != S * D || ws_size < WS_END) { fprintf(stderr, "kernel_launch: unexpected shapes (n_in %d out %d ws %zu)\n", n_in, out_size, ws_size); grid = -1; return; }
        int dev = 0, cus = 0, per_cu = 0;
        if (hipGetDevice(&dev) != hipSuccess || hipDeviceGetAttribute(&cus, hipDeviceAttributeMultiprocessorCount, dev) != hipSuccess) { grid = -1; return; }
        if (hipFuncSetAttribute((const void*)mk_fwd, hipFuncAttributeMaxDynamicSharedMemorySize, LDS_BYTES) != hipSuccess) { fprintf(stderr, "kernel_launch: hipFuncSetAttribute failed\n"); grid = -1; return; }
        if (hipOccupancyMaxActiveBlocksPerMultiprocessor(&per_cu, (const void*)mk_fwd, NWAVES * 64, LDS_BYTES) != hipSuccess || per_cu < 1) fprintf(stderr, "kernel_launch: occupancy query reports %d\n", per_cu);
        (void)hipGetLastError();
        grid = cus;
    }
    if (grid < 0) return;
    if (hipMemsetAsync((char*)d_ws + WS_CTL, 0, CTL_ZERO_BYTES, stream) != hipSuccess) return;
    Args a{};
    for (int i = 0; i < N_INPUTS; ++i) a.in[i] = (const float*)d_in[i];
    a.out = (float*)d_out; a.ws = (unsigned char*)d_ws;
#if MK_ONE_LAUNCH
    a.l_lo = 0; a.l_hi = NLAYER; a.ph_lo = 0; a.ph_hi = NPHASE;
    hipLaunchKernelGGL(mk_fwd, dim3(grid), dim3(NWAVES * 64), LDS_BYTES, stream, a);
#else
    for (int l = 0; l < NLAYER; ++l)
        for (int ph = 0; ph < NPHASE; ++ph) {
#ifdef DBG_DUMP_OFF
            if (l * NPHASE + ph > DBG_LAST) continue;
#endif
            a.l_lo = l; a.l_hi = l + 1; a.ph_lo = ph; a.ph_hi = ph + 1;
            hipLaunchKernelGGL(mk_fwd, dim3(grid), dim3(NWAVES * 64), LDS_BYTES, stream, a); }
#ifdef DBG_DUMP_OFF
    hipLaunchKernelGGL(dbg_dump, dim3(2048), dim3(256), 0, stream, (const unsigned char*)d_ws, (float*)d_out, S * D);
#endif
#endif
}
```

```cpp
#define MK_ONE_LAUNCH 1
#define PG8_DMAMOVE 1
#include <hip/hip_runtime.h>
#include <cstdio>
#include <cstdint>
namespace pg8 {
#define PG8_LAS __attribute__((address_space(3)))
typedef unsigned short bf16_t;
typedef short bf16x8 __attribute__((ext_vector_type(8)));
typedef float f32x4 __attribute__((ext_vector_type(4)));
typedef unsigned u32x4 __attribute__((ext_vector_type(4)));
constexpr int BM = 256, BK = 64, HALF = 128, HTB = HALF * BK * 2  , STAGE_BYTES = 8 * HTB, NXCD = 8, WGM = 4;

__host__ __device__ __forceinline__ int lds_byte(int r, int c) { const int st = (r >> 4) * 2 + (c >> 5), rr = r & 15, cc = c & 31, ob = rr * 64 + cc * 2; return st * 1024 + (ob ^ (((ob >> 9) & 1) << 5)); }
__host__ __device__ __forceinline__ void stage_rc(int b, int& R, int& C) { const int st = b / 1024, sb = b % 1024, swz = sb ^ (((sb >> 9) & 1) << 5); R = (st >> 1) * 16 + swz / 64; C = (st & 1) * 32 + (swz % 64) / 2; }
__host__ __device__ __forceinline__ int perm32(int rho) { const int n = rho >> 4, i = rho & 15; return 8 * (i >> 2) + 4 * n + (i & 3); }

struct Unit { int pm, pn; };
struct Gemm { const bf16_t* A; const bf16_t* Bt; int M, N, K; };

struct StaticOrder {
    int nM, nN, nwg, G, c;
    __host__ __device__ void init(int M, int N, int G_, int c_) { nM = M / BM; nN = N / BM; nwg = nM * nN; G = G_; c = c_; }
    __host__ __device__ bool next(int i, Unit& u) const {
        const long L = (long)i * G + c; if (L >= nwg) return false;
        int wgid = (int)L; { const int q = nwg / NXCD, r = nwg % NXCD, xcd = wgid % NXCD, off = wgid / NXCD; wgid = (xcd < r ? xcd * (q + 1) : r * (q + 1) + (xcd - r) * q) + off; }
        const int nig = WGM * nN, gid = wgid / nig, fm = gid * WGM, gsz = (nM - fm) < WGM ? (nM - fm) : WGM;
        u.pm = fm + ((wgid % nig) % gsz); u.pn = (wgid % nig) / gsz; return true;
    }
    __device__ __forceinline__ void a_ready(const Unit&, int  ) const {}
    __device__ __forceinline__ void done(const Unit&) const {}
};
__device__ __forceinline__ unsigned cvt_pk_bf16(float lo, float hi) { unsigned r; asm volatile("v_cvt_pk_bf16_f32 %0, %1, %2" : "=v"(r) : "v"(lo), "v"(hi)); return r; }
typedef float f32x2 __attribute__((ext_vector_type(2)));
__device__ __forceinline__ f32x2 gelu_pk(f32x2 v) {
    const f32x2 av = __builtin_elementwise_abs(v), d = av * 0.2316418882f + 1.0f;
    f32x2 t; t.x = __builtin_amdgcn_rcpf(d.x); t.y = __builtin_amdgcn_rcpf(d.y);
    f32x2 q = t * 0.5307027145f + (-0.7265760135f); q = q * t + 0.7107068705f; q = q * t + (-0.142248368f); q = q * t + 0.127414796f; q = q * t;
    const f32x2 s = (v * v) * (-0.72134752044f);
    f32x2 e; e.x = __builtin_amdgcn_exp2f(s.x); e.y = __builtin_amdgcn_exp2f(s.y);
    const f32x2 m = v * (q * e), r = v - m;
    f32x2 o; o.x = v.x < 0.f ? m.x : r.x; o.y = v.y < 0.f ? m.y : r.y; return o;
}
#ifndef PG8_DMAMOVE
#define PG8_DMAMOVE 0
#endif
template <class Epi, class Sched, bool ALIGN_EPI = false, bool SP2 = false>
__device__ __forceinline__ void gemm_phase(PG8_LAS unsigned char* lds, const Gemm g, const Sched& S, const Epi& E, int wave_in  ) {
    int tid_ = wave_in * 64 + (int)__builtin_amdgcn_mbcnt_hi(~0u, __builtin_amdgcn_mbcnt_lo(~0u, 0u)); asm volatile("" : "+v"(tid_));
    const int tid = tid_, wid = __builtin_amdgcn_readfirstlane(tid >> 6), lane = tid & 63, wr = wid >> 2, wc = wid & 3, fr = lane & 15, fq = lane >> 4;
    const int K = g.K, nt = K / BK;
    unsigned voffA[2], voffB[2];
#pragma unroll
    for (int i = 0; i < 2; ++i) { int R, C; stage_rc(tid * 16 + i * 8192, R, C); const int Rb = Epi::PERM ? ((R & ~31) + perm32(R & 31)) : R;
        voffA[i] = (unsigned)(R * K + C) * 2u; voffB[i] = (unsigned)(Rb * K + C) * 2u; }
    const size_t kstep = (size_t)(BK * 2);
    const size_t hstep = (size_t)HALF * K * 2;
    const size_t tstep = 2 * hstep;
    const unsigned ldsw = (unsigned)wid * 1024u;
    const int aoff = lds_byte(wr * 64 + fr, fq * 8), boff = lds_byte(wc * 32 + fr, fq * 8);
#define PG8_SA(b, h) (((b) * 2 + (h)) * HTB)
#define PG8_SB(b, h) ((4 + (b) * 2 + (h)) * HTB)
#define PG8_STAGE(bufoff, gbase, voff) do { _Pragma("unroll") for (int _i = 0; _i < 2; ++_i) \
        __builtin_amdgcn_global_load_lds((const unsigned*)((const char*)(gbase) + (voff)[_i]), (PG8_LAS unsigned*)(lds + (bufoff) + ldsw + _i * 8192), 16, 0, 0); } while (0)
#define PG8_LDA(dst, b, h) do { _Pragma("unroll") for (int m = 0; m < 4; ++m) _Pragma("unroll") for (int k = 0; k < 2; ++k) dst[m][k] = *(const PG8_LAS bf16x8*)(lds + PG8_SA(b, h) + aoff + m * 2048 + k * 1024); } while (0)
#define PG8_LDB(dst, b, h) do { _Pragma("unroll") for (int n = 0; n < 2; ++n) _Pragma("unroll") for (int k = 0; k < 2; ++k) dst[n][k] = *(const PG8_LAS bf16x8*)(lds + PG8_SB(b, h) + boff + n * 2048 + k * 1024); } while (0)
#define PG8_MMA(ai, bj, At, Bt) do { __builtin_amdgcn_s_setprio(1); _Pragma("unroll") for (int m = 0; m < 4; ++m) _Pragma("unroll") for (int n = 0; n < 2; ++n) _Pragma("unroll") for (int k = 0; k < 2; ++k) \
        acc[ai][bj][m][n] = __builtin_amdgcn_mfma_f32_16x16x32_bf16(Bt[n][k], At[m][k], acc[ai][bj][m][n], 0, 0, 0); __builtin_amdgcn_s_setprio(0); } while (0)
#define PG8_WAIT_V(n) asm volatile("s_waitcnt vmcnt(" #n ")" ::: "memory")
#define PG8_WAIT_L(n) asm volatile("s_waitcnt lgkmcnt(" #n ")" ::: "memory")
#define PG8_BAR __builtin_amdgcn_s_barrier()
#define PG8_SCHED __builtin_amdgcn_sched_barrier(0)
    Unit cur, nxt; int ui = 0;
    if (!S.next(0, cur)) return;
    f32x4 acc[2][2][4][2];
#pragma unroll
    for (int a = 0; a < 2; ++a)
#pragma unroll
        for (int b = 0; b < 2; ++b)
#pragma unroll
            for (int m = 0; m < 4; ++m)
#pragma unroll
                for (int n = 0; n < 2; ++n) acc[a][b][m][n] = (f32x4){0.f, 0.f, 0.f, 0.f};
    bf16x8 At[4][2], B0[2][2], B1[2][2];
    const char* cA = (const char*)g.A + (size_t)cur.pm * tstep; const char* cB = (const char*)g.Bt + (size_t)cur.pn * tstep;
    S.a_ready(cur, 0);
    if constexpr (SP2) {
        PG8_STAGE(PG8_SB(0, 0), cB, voffB); PG8_STAGE(PG8_SB(0, 1), cB + hstep, voffB); PG8_STAGE(PG8_SA(0, 0), cA, voffA); PG8_STAGE(PG8_SA(0, 1), cA + hstep, voffA);
        if (wr == 1) PG8_BAR;
        PG8_WAIT_V(2); PG8_BAR;
        PG8_STAGE(PG8_SB(1, 0), cB + kstep, voffB); PG8_STAGE(PG8_SA(1, 0), cA + kstep, voffA); PG8_STAGE(PG8_SB(1, 1), cB + hstep + kstep, voffB);
        PG8_WAIT_V(6); PG8_BAR;
    } else {
        PG8_STAGE(PG8_SB(0, 0), cB, voffB); PG8_STAGE(PG8_SA(0, 0), cA, voffA); PG8_STAGE(PG8_SB(0, 1), cB + hstep, voffB); PG8_STAGE(PG8_SA(0, 1), cA + hstep, voffA);
        if (wr == 1) PG8_BAR;
        PG8_WAIT_V(4); PG8_BAR;
        PG8_STAGE(PG8_SB(1, 0), cB + kstep, voffB); PG8_STAGE(PG8_SA(1, 0), cA + kstep, voffA); PG8_STAGE(PG8_SB(1, 1), cB + hstep + kstep, voffB);
        PG8_WAIT_V(6); PG8_BAR;
    }
    for (;;) {
        const bool has_next = S.next(ui + 1, nxt);
        const char* nA = has_next ? (const char*)g.A + (size_t)nxt.pm * tstep : cA; const char* nB = has_next ? (const char*)g.Bt + (size_t)nxt.pn * tstep : cB;
        for (int t = 0; t < nt; t += 2) {
            const bool last = (t == nt - 2);
            const char* a1 = cA + (size_t)(t + 1) * kstep;
            const char* a2 = last ? nA : cA + (size_t)(t + 2) * kstep; const char* b2 = last ? nB : cB + (size_t)(t + 2) * kstep;
            const char* a3 = a2 + kstep; const char* b3 = b2 + kstep;
            if (last && has_next) S.a_ready(nxt, ui + 1);
            if constexpr (SP2) {
            PG8_LDB(B0, 0, 0); PG8_LDB(B1, 0, 1); PG8_SCHED; PG8_LDA(At, 0, 0); PG8_STAGE(PG8_SA(1, 1), a1 + hstep, voffA);
            PG8_WAIT_V(8); PG8_WAIT_L(0); PG8_BAR; PG8_MMA(0, 0, At, B0); PG8_MMA(0, 1, At, B1); PG8_BAR; PG8_SCHED;
#if PG8_DMAMOVE
            PG8_LDA(At, 0, 1); PG8_STAGE(PG8_SB(0, 0), b2, voffB); PG8_STAGE(PG8_SB(0, 1), b2 + hstep, voffB);
            PG8_WAIT_V(6); PG8_WAIT_L(0); PG8_BAR; asm volatile("" ::: "memory"); PG8_SCHED;
#if PG8_DMAMOVE == 1
            PG8_MMA(1, 0, At, B0); PG8_SCHED; PG8_STAGE(PG8_SA(0, 0), a2, voffA); PG8_SCHED; PG8_MMA(1, 1, At, B1); PG8_BAR; PG8_SCHED;
#else
            PG8_MMA(1, 0, At, B0); PG8_MMA(1, 1, At, B1); PG8_SCHED; PG8_STAGE(PG8_SA(0, 0), a2, voffA); PG8_BAR; PG8_SCHED;
#endif
#else
            PG8_LDA(At, 0, 1); PG8_STAGE(PG8_SB(0, 0), b2, voffB); PG8_STAGE(PG8_SB(0, 1), b2 + hstep, voffB); PG8_STAGE(PG8_SA(0, 0), a2, voffA);
            PG8_WAIT_V(8); PG8_WAIT_L(0); PG8_BAR; PG8_MMA(1, 0, At, B0); PG8_MMA(1, 1, At, B1); PG8_BAR; PG8_SCHED;
#endif
            PG8_LDB(B0, 1, 0); PG8_LDB(B1, 1, 1); PG8_SCHED; PG8_LDA(At, 1, 0); PG8_STAGE(PG8_SA(0, 1), a2 + hstep, voffA);
            PG8_WAIT_V(8); PG8_WAIT_L(0); PG8_BAR; PG8_MMA(0, 0, At, B0); PG8_MMA(0, 1, At, B1); PG8_BAR; PG8_SCHED;
#if PG8_DMAMOVE
            PG8_LDA(At, 1, 1); PG8_STAGE(PG8_SB(1, 0), b3, voffB); PG8_STAGE(PG8_SB(1, 1), b3 + hstep, voffB);
            PG8_WAIT_V(6); PG8_WAIT_L(0); PG8_BAR; asm volatile("" ::: "memory"); PG8_SCHED;
#if PG8_DMAMOVE == 1
            PG8_MMA(1, 0, At, B0); PG8_SCHED; PG8_STAGE(PG8_SA(1, 0), a3, voffA); PG8_SCHED; PG8_MMA(1, 1, At, B1); PG8_BAR; PG8_SCHED;
#else
            PG8_MMA(1, 0, At, B0); PG8_MMA(1, 1, At, B1); PG8_SCHED; PG8_STAGE(PG8_SA(1, 0), a3, voffA); PG8_BAR; PG8_SCHED;
#endif
#else
            PG8_LDA(At, 1, 1); PG8_STAGE(PG8_SB(1, 0), b3, voffB); PG8_STAGE(PG8_SB(1, 1), b3 + hstep, voffB); PG8_STAGE(PG8_SA(1, 0), a3, voffA);
            PG8_WAIT_V(8); PG8_WAIT_L(0); PG8_BAR; PG8_MMA(1, 0, At, B0); PG8_MMA(1, 1, At, B1); PG8_BAR; PG8_SCHED;
#endif
            } else {
            PG8_LDB(B0, 0, 0); PG8_SCHED; PG8_LDA(At, 0, 0); PG8_STAGE(PG8_SA(1, 1), a1 + hstep, voffA);
            PG8_WAIT_L(8); PG8_BAR; PG8_WAIT_L(0); PG8_MMA(0, 0, At, B0); PG8_BAR; PG8_SCHED;
            PG8_LDB(B1, 0, 1); PG8_STAGE(PG8_SB(0, 0), b2, voffB);
            PG8_BAR; PG8_WAIT_L(0); PG8_MMA(0, 1, At, B1); PG8_BAR;
            PG8_LDA(At, 0, 1); PG8_STAGE(PG8_SA(0, 0), a2, voffA);
            PG8_BAR; PG8_WAIT_L(0); PG8_MMA(1, 0, At, B0); PG8_BAR; PG8_SCHED;
            PG8_STAGE(PG8_SB(0, 1), b2 + hstep, voffB);
            PG8_WAIT_V(6); PG8_BAR; PG8_MMA(1, 1, At, B1); PG8_BAR;
            PG8_LDB(B0, 1, 0); PG8_SCHED; PG8_LDA(At, 1, 0); PG8_STAGE(PG8_SA(0, 1), a2 + hstep, voffA);
            PG8_WAIT_L(8); PG8_BAR; PG8_WAIT_L(0); PG8_MMA(0, 0, At, B0); PG8_BAR; PG8_SCHED;
            PG8_LDB(B1, 1, 1); PG8_STAGE(PG8_SB(1, 0), b3, voffB);
            PG8_BAR; PG8_WAIT_L(0); PG8_MMA(0, 1, At, B1); PG8_BAR;
            PG8_LDA(At, 1, 1); PG8_STAGE(PG8_SA(1, 0), a3, voffA);
            PG8_BAR; PG8_WAIT_L(0); PG8_MMA(1, 0, At, B0); PG8_BAR; PG8_SCHED;
            PG8_STAGE(PG8_SB(1, 1), b3 + hstep, voffB);
            PG8_WAIT_V(6); PG8_BAR; PG8_MMA(1, 1, At, B1); PG8_BAR;
            }
        }
        if constexpr (ALIGN_EPI) { if (wr == 0) PG8_BAR; }
        if constexpr (!Epi::AFTER_DRAIN) { E(acc, cur, wr, wc, fr, fq, ui); S.done(cur); }
        if (!has_next) break;
        if constexpr (!Epi::KEEP_ACC) {
#pragma unroll
        for (int a = 0; a < 2; ++a)
#pragma unroll
            for (int b = 0; b < 2; ++b)
#pragma unroll
                for (int m = 0; m < 4; ++m)
#pragma unroll
                    for (int n = 0; n < 2; ++n) acc[a][b][m][n] = (f32x4){0.f, 0.f, 0.f, 0.f};
        }
        cur = nxt; cA = nA; cB = nB; ++ui;
        if constexpr (ALIGN_EPI) { if (wr == 1) PG8_BAR; }
    }
    PG8_WAIT_V(0);
    if constexpr (!ALIGN_EPI) { if (wr == 0) PG8_BAR; }
    PG8_BAR;
    if constexpr (Epi::AFTER_DRAIN) { E.fused(acc, cur, wr, wc, fr, fq, lds, wid, lane); S.done(cur); }
#undef PG8_SA
#undef PG8_SB
#undef PG8_STAGE
#undef PG8_LDA
#undef PG8_LDB
#undef PG8_MMA
#undef PG8_WAIT_V
#undef PG8_WAIT_L
#undef PG8_BAR
#undef PG8_SCHED
}
}
#define GAS __attribute__((address_space(1)))
#define LAS __attribute__((address_space(3)))
typedef unsigned short bf16;
typedef unsigned v4u __attribute__((ext_vector_type(4)));
typedef float f32x4 __attribute__((ext_vector_type(4)));
typedef short bf16x8 __attribute__((ext_vector_type(8)));
typedef GAS unsigned gu32;
typedef GAS unsigned long long gu64;
#define RLX_AGENT __ATOMIC_RELAXED, __HIP_MEMORY_SCOPE_AGENT
#define LDS_WAIT() asm volatile("s_waitcnt lgkmcnt(0)" ::: "memory")
#define VM_WAIT() asm volatile("s_waitcnt vmcnt(0)" ::: "memory")
__device__ __forceinline__ unsigned long long rt() { return __builtin_amdgcn_s_memrealtime(); }
__device__ __forceinline__ unsigned f2bf(float f) { unsigned u = __builtin_bit_cast(unsigned, f); return (u + 0x7fffu + ((u >> 16) & 1u)) >> 16; }
__device__ __forceinline__ unsigned pk2(float lo, float hi) { return f2bf(lo) | (f2bf(hi) << 16); }
#define XB_TMO      128
#define XB_XCNT(j)  (256  + 64 * (j))
#define XB_XSUB(j)  (1280 + 64 * (j))
#define XB_XGEN(j)  (2304 + 64 * (j))
#define XB_TOP      3328
#define XB_TOPGEN   3392
#define XCD_BAR_WORDS 3456
#define XB_SPIN_CAP (1u << 18)

__device__ __forceinline__ unsigned xb_ld(unsigned* p)              { return __hip_atomic_load(p, __ATOMIC_RELAXED, __HIP_MEMORY_SCOPE_AGENT); }
__device__ __forceinline__ unsigned xb_add(unsigned* p, unsigned v) { return __hip_atomic_fetch_add(p, v, __ATOMIC_RELAXED, __HIP_MEMORY_SCOPE_AGENT); }
__device__ __forceinline__ unsigned xb_xcc_id() { return (unsigned)__builtin_amdgcn_s_getreg((3 << 11) | 20) & 0xFu; }
#define XB_SPIN(cond, bar) do { unsigned _sp = 0; while (cond) { __builtin_amdgcn_s_sleep(1); \
    if ((++_sp & 255u) == 0u) { if (xb_ld(&(bar)[XB_TMO])) break; if (_sp > XB_SPIN_CAP) { atomicAdd(&(bar)[XB_TMO], 1u); break; } } } } while (0)

struct XcdBarrier {
    unsigned* bar; unsigned x;
    volatile LAS unsigned* st;
};

__device__ __forceinline__ XcdBarrier xcd_barrier_post(unsigned* bar, volatile LAS unsigned* st) {
    XcdBarrier b; b.bar = bar; b.x = xb_xcc_id(); b.st = st;
    if (threadIdx.x == 0) (void)xb_add(&bar[XB_XCNT(b.x)], 1u);
    return b;
}
__device__ __forceinline__ void xcd_barrier_complete(unsigned* bar, unsigned x, unsigned& nloc, unsigned& nx) {
    const unsigned G = gridDim.x * gridDim.y * gridDim.z;
    unsigned sum, cnt, mine, sp = 0u;
    for (;;) {
        sum = 0u; cnt = 0u; mine = 0u;
#pragma unroll
        for (unsigned j = 0; j < 16; ++j) { const unsigned c = xb_ld(&bar[XB_XCNT(j)]); sum += c; cnt += (c > 0u) ? 1u : 0u; mine = (j == x) ? c : mine; }
        if (sum == G) break;
        __builtin_amdgcn_s_sleep(1);
        if ((++sp & 255u) == 0u) { if (xb_ld(&bar[XB_TMO])) break; if (sp > XB_SPIN_CAP) { atomicAdd(&bar[XB_TMO], 1u); break; } }
    }
    nloc = mine > 0u ? mine : 1u; nx = cnt > 0u ? cnt : 1u;
}

__device__ __forceinline__ void xcd_barrier(const XcdBarrier& b) {
    asm volatile("s_waitcnt vmcnt(0)" ::: "memory");
    __syncthreads();
    if (threadIdx.x == 0) {
        unsigned* bar = b.bar;
        __builtin_amdgcn_s_waitcnt(0);
        unsigned nloc = b.st[0], nx = b.st[1];
        if (nloc == 0u) { xcd_barrier_complete(bar, b.x, nloc, nx); b.st[0] = nloc; b.st[1] = nx; }
        const unsigned old = xb_add(&bar[XB_XSUB(b.x)], 1u);
        const unsigned gen = old / nloc;
        if (old + 1u == (gen + 1u) * nloc) {
            __builtin_amdgcn_fence(__ATOMIC_RELEASE, "agent");
            asm volatile("s_waitcnt vmcnt(0)" ::: "memory");
            const unsigned og = xb_add(&bar[XB_TOP], 1u);
            const unsigned tg = og / nx;
            if (og + 1u == (tg + 1u) * nx) xb_add(&bar[XB_TOPGEN], 1u);
            else XB_SPIN(xb_ld(&bar[XB_TOPGEN]) == tg, bar);
            __builtin_amdgcn_fence(__ATOMIC_ACQUIRE, "agent");
            xb_add(&bar[XB_XGEN(b.x)], 1u);
            asm volatile("s_waitcnt vmcnt(0)" ::: "memory");
        } else {
            XB_SPIN(xb_ld(&bar[XB_XGEN(b.x)]) == gen, bar);
            __builtin_amdgcn_fence(__ATOMIC_ACQUIRE, "agent");
            asm volatile("s_waitcnt vmcnt(0)" ::: "memory");
        }
    }
    __syncthreads();
}
constexpr int S = 8192, D = 2048, FF = 5632, NLAYER = 4;
constexpr int NIN = 14912, NINP = 15104;
constexpr int NGU = 2 * FF;
constexpr float EPS = 1e-6f;
constexpr int PC_GATE = 0, PC_POOL = 8192, PC_DIL = 8704, PC_SGU = 13312, PC_CQ = 14336, PC_CKV = 14720, PC_KR = 14848;
constexpr int NMLA = 1792;

namespace epi {
using pg8::f32x4; using pg8::u32x4; using pg8::Unit; using pg8::bf16_t;
typedef float f32x2_t __attribute__((ext_vector_type(2))); typedef __bf16 bf16x2_t __attribute__((ext_vector_type(2)));
__device__ __forceinline__ unsigned cvt_pk_bf16(float lo, float hi) { f32x2_t v = {lo, hi}; bf16x2_t b = __builtin_convertvector(v, bf16x2_t); return __builtin_bit_cast(unsigned, b); }
constexpr int BM = 256, HALF = 128;
typedef unsigned u32x2 __attribute__((ext_vector_type(2)));
__device__ __forceinline__ float fast_exp(float x) { return __builtin_amdgcn_exp2f(x * 1.44269504089f); }
__device__ __forceinline__ float sigmoid_f(float x) { return __builtin_amdgcn_rcpf(1.0f + fast_exp(-x)); }

struct EpiSwiglu {
    static constexpr bool PERM = true, AFTER_DRAIN = false, KEEP_ACC = false;
    bf16_t* H; const __attribute__((address_space(3))) float* tab;
    __device__ __forceinline__ void operator()(const f32x4 (&acc)[2][2][4][2], const Unit& u, int wr, int wc, int fr, int fq, int ui) const {
        const int row0 = u.pm * BM + wr * 64 + fr, col0 = u.pn * HALF + wc * 32 + 8 * fq; const __attribute__((address_space(3))) float* tb = tab + ui * 256 + wr * 64 + fr;
#pragma unroll
        for (int ai = 0; ai < 2; ++ai)
#pragma unroll
            for (int m = 0; m < 4; ++m) {
                bf16_t* rowp = H + (size_t)(row0 + ai * HALF + m * 16) * FF + col0; const float rs = tb[ai * HALF + m * 16];
                float o[8];
#pragma unroll
                for (int n = 0; n < 2; ++n)
#pragma unroll
                    for (int j = 0; j < 4; ++j) { const float g = acc[ai][0][m][n][j] * rs, up = acc[ai][1][m][n][j] * rs; o[n * 4 + j] = g * sigmoid_f(g) * up; }
                u32x4 w; w.x = cvt_pk_bf16(o[0], o[1]); w.y = cvt_pk_bf16(o[2], o[3]); w.z = cvt_pk_bf16(o[4], o[5]); w.w = cvt_pk_bf16(o[6], o[7]);
                *(u32x4*)rowp = w;
                asm volatile("" ::: "memory");
            }
    }
};
struct EpiResid {
    static constexpr bool PERM = false, AFTER_DRAIN = false, KEEP_ACC = false;
    const float* base; float* out; float alpha; bf16_t* xb; float* ssp;
    __device__ __forceinline__ void operator()(const f32x4 (&acc)[2][2][4][2], const Unit& u, int wr, int wc, int fr, int fq, int ui) const {
        const int row0 = u.pm * BM + wr * 64 + fr, col0 = u.pn * BM + wc * 32 + 4 * fq;
#pragma unroll
        for (int ai = 0; ai < 2; ++ai)
#pragma unroll
            for (int m = 0; m < 4; ++m) { const int r = row0 + ai * HALF + m * 16; const size_t off = (size_t)r * D + col0; float s = 0.f;
#pragma unroll
                for (int bj = 0; bj < 2; ++bj)
#pragma unroll
                    for (int n = 0; n < 2; ++n) { const f32x4 b = *(const f32x4*)(base + off + bj * HALF + n * 16); const f32x4 v = b + acc[ai][bj][m][n] * alpha;
                        *(f32x4*)(out + off + bj * HALF + n * 16) = v;
                        if (xb) { s += (v[0] * v[0] + v[1] * v[1]) + (v[2] * v[2] + v[3] * v[3]); u32x2 w; w.x = cvt_pk_bf16(v[0], v[1]); w.y = cvt_pk_bf16(v[2], v[3]); *(u32x2*)(xb + off + bj * HALF + n * 16) = w; } }
                if (xb) { s += __shfl_xor(s, 16); s += __shfl_xor(s, 32); if (fq == 0) ssp[(size_t)r * 32 + u.pn * 4 + wc] = s; }
                asm volatile("" ::: "memory"); }
    }
};
struct EpiPin {
    static constexpr bool PERM = true, AFTER_DRAIN = false, KEEP_ACC = false;
    bf16_t* P; const __attribute__((address_space(3))) float* tab;
    template <int KIND> __device__ __forceinline__ void run(const f32x4 (&acc)[2][2][4][2], const Unit& u, int wr, int wc, int fr, int fq, int ui) const {
        const __attribute__((address_space(3))) float* tb = tab + ui * 256 + wr * 64 + fr;
        const int row0 = u.pm * BM + wr * 64 + fr, col0 = u.pn * BM + wc * 32 + 8 * fq;
#pragma unroll
        for (int ai = 0; ai < 2; ++ai)
#pragma unroll
            for (int m = 0; m < 4; ++m) { bf16_t* rowp = P + (size_t)(row0 + ai * HALF + m * 16) * NINP + col0; const float rs = tb[ai * HALF + m * 16];
#pragma unroll
                for (int bj = 0; bj < 2; ++bj) { float o[8];
#pragma unroll
                    for (int n = 0; n < 2; ++n)
#pragma unroll
                        for (int j = 0; j < 4; ++j) { const float x = acc[ai][bj][m][n][j] * rs;
                            o[n * 4 + j] = (KIND == 0) ? x : ((KIND == 1) ? sigmoid_f(x) : x * sigmoid_f(1.5957691216f * (x + 0.044715f * x * x * x))); }
                    u32x4 w; w.x = cvt_pk_bf16(o[0], o[1]); w.y = cvt_pk_bf16(o[2], o[3]); w.z = cvt_pk_bf16(o[4], o[5]); w.w = cvt_pk_bf16(o[6], o[7]);
                    *(u32x4*)(rowp + bj * HALF) = w; }
                asm volatile("" ::: "memory"); }
    }
    __device__ __forceinline__ void operator()(const f32x4 (&acc)[2][2][4][2], const Unit& u, int wr, int wc, int fr, int fq, int ui) const {
        if (u.pn < 32) run<1>(acc, u, wr, wc, fr, fq, ui); else if (u.pn >= 52 && u.pn < 56) run<2>(acc, u, wr, wc, fr, fq, ui); else run<0>(acc, u, wr, wc, fr, fq, ui);
    }
};
struct EpiF32 {
    static constexpr bool PERM = false, AFTER_DRAIN = false, KEEP_ACC = false;
    float* C; int ldc; int colmul;
    __device__ __forceinline__ void operator()(const f32x4 (&acc)[2][2][4][2], const Unit& u, int wr, int wc, int fr, int fq, int ui) const {
        const int row0 = u.pm * BM + wr * 64 + fr, col0 = colmul * u.pn * BM + wc * 32 + 4 * fq;
#pragma unroll
        for (int ai = 0; ai < 2; ++ai)
#pragma unroll
            for (int m = 0; m < 4; ++m) { float* rowp = C + (size_t)(row0 + ai * HALF + m * 16) * ldc + col0;
#pragma unroll
                for (int bj = 0; bj < 2; ++bj)
#pragma unroll
                    for (int n = 0; n < 2; ++n) *(f32x4*)(rowp + bj * HALF + n * 16) = acc[ai][bj][m][n]; }
    }
};
struct EpiExp {
    static constexpr bool PERM = true, AFTER_DRAIN = false, KEEP_ACC = false;
    bf16_t* P;
    __device__ __forceinline__ void operator()(const f32x4 (&acc)[2][2][4][2], const Unit& u, int wr, int wc, int fr, int fq, int ui) const {
        const int row0 = u.pm * BM + wr * 64 + fr, col0 = (u.pn & 31) * BM + wc * 32 + 8 * fq;
#pragma unroll
        for (int ai = 0; ai < 2; ++ai)
#pragma unroll
            for (int m = 0; m < 4; ++m) { bf16_t* rowp = P + (size_t)(row0 + ai * HALF + m * 16) * S + col0;
#pragma unroll
                for (int bj = 0; bj < 2; ++bj) { float o[8];
#pragma unroll
                    for (int n = 0; n < 2; ++n)
#pragma unroll
                        for (int j = 0; j < 4; ++j) o[n * 4 + j] =
#ifdef DBG_NOEXP
                            acc[ai][bj][m][n][j];
#else
                            fast_exp(acc[ai][bj][m][n][j]);
#endif
                    u32x4 w; w.x = cvt_pk_bf16(o[0], o[1]); w.y = cvt_pk_bf16(o[2], o[3]); w.z = cvt_pk_bf16(o[4], o[5]); w.w = cvt_pk_bf16(o[6], o[7]);
                    *(u32x4*)(rowp + bj * HALF) = w; }
                asm volatile("" ::: "memory"); }
    }
};
struct EpiBranch {
    static constexpr bool PERM = false, AFTER_DRAIN = false, KEEP_ACC = false;
    float* merged; bf16_t* mergedb; const bf16_t* gate; int b;
    __device__ __forceinline__ void operator()(const f32x4 (&acc)[2][2][4][2], const Unit& u, int wr, int wc, int fr, int fq, int ui) const {
        const int row0 = u.pm * BM + wr * 64 + fr, col0 = u.pn * BM + wc * 32 + 4 * fq;
#pragma unroll
        for (int ai = 0; ai < 2; ++ai)
#pragma unroll
            for (int m = 0; m < 4; ++m) { const int r = row0 + ai * HALF + m * 16;
#pragma unroll
                for (int bj = 0; bj < 2; ++bj)
#pragma unroll
                    for (int n = 0; n < 2; ++n) { const int c = col0 + bj * HALF + n * 16;
                        const u32x2 gv = *(const u32x2*)(gate + (size_t)r * NINP + c);
                        f32x4 g; g[0] = __uint_as_float(gv.x << 16); g[1] = __uint_as_float(gv.x & 0xffff0000u); g[2] = __uint_as_float(gv.y << 16); g[3] = __uint_as_float(gv.y & 0xffff0000u);
                        f32x4 v = acc[ai][bj][m][n] * g;
                        float* mp = merged + (size_t)r * D + c;
                        if (b != 0) v += *(const f32x4*)mp;
                        if (b != 3) *(f32x4*)mp = v;
                        else { u32x2 w; w.x = cvt_pk_bf16(v[0], v[1]); w.y = cvt_pk_bf16(v[2], v[3]); *(u32x2*)(mergedb + (size_t)r * D + c) = w; } }
                asm volatile("" ::: "memory"); }
    }
};
struct QKOrder {
    int G, c;
    __device__ bool next(int i, Unit& u) const { const int L = i * G + c; if (L >= 4096) return false; const int h = L >> 10, rem = L & 1023; u.pm = h * 32 + (rem >> 5); u.pn = h * 32 + (rem & 31); return true; }
    __device__ __forceinline__ void a_ready(const Unit&, int) const {}
    __device__ __forceinline__ void done(const Unit&) const {}
};
struct PVOrder {
    int G, c;
    __device__ bool next(int i, Unit& u) const { const int L = i * G + c; if (L >= 128) return false; u.pm = L; u.pn = L >> 5; return true; }
    __device__ __forceinline__ void a_ready(const Unit&, int) const {}
    __device__ __forceinline__ void done(const Unit&) const {}
};
struct EpiBranchChain {
    static constexpr bool PERM = true, AFTER_DRAIN = false, KEEP_ACC = true;
    bf16_t* mergedb; const bf16_t* gate;
    __device__ __forceinline__ void operator()(f32x4 (&acc)[2][2][4][2], const Unit& u, int wr, int wc, int fr, int fq, int ui) const {
        const int b = u.pm >> 5, pm0 = u.pm & 31, pn0 = u.pn & 7;
        const int row0 = pm0 * BM + wr * 64 + fr, col0 = pn0 * BM + wc * 32 + 8 * fq;
#pragma unroll
        for (int ai = 0; ai < 2; ++ai)
#pragma unroll
            for (int m = 0; m < 4; ++m) { const int r = row0 + ai * HALF + m * 16;
#pragma unroll
                for (int bj = 0; bj < 2; ++bj) { const int c = col0 + bj * HALF;
                    const u32x4 gv = *(const u32x4*)(gate + (size_t)r * NINP + b * D + c);
                    float g[8] = {__uint_as_float(gv.x << 16), __uint_as_float(gv.x & 0xffff0000u), __uint_as_float(gv.y << 16), __uint_as_float(gv.y & 0xffff0000u),
                                  __uint_as_float(gv.z << 16), __uint_as_float(gv.z & 0xffff0000u), __uint_as_float(gv.w << 16), __uint_as_float(gv.w & 0xffff0000u)};
                    if (b != 3) {
                        const u32x4 hv = *(const u32x4*)(gate + (size_t)r * NINP + (b + 1) * D + c);
                        const float gn[8] = {__uint_as_float(hv.x << 16), __uint_as_float(hv.x & 0xffff0000u), __uint_as_float(hv.y << 16), __uint_as_float(hv.y & 0xffff0000u),
                                             __uint_as_float(hv.z << 16), __uint_as_float(hv.z & 0xffff0000u), __uint_as_float(hv.w << 16), __uint_as_float(hv.w & 0xffff0000u)};
#pragma unroll
                        for (int n = 0; n < 2; ++n)
#pragma unroll
                            for (int j = 0; j < 4; ++j) acc[ai][bj][m][n][j] *= fmaxf(g[n * 4 + j], 1e-30f) * __builtin_amdgcn_rcpf(fmaxf(gn[n * 4 + j], 1e-30f));
                    } else {
                        float o[8];
#pragma unroll
                        for (int n = 0; n < 2; ++n)
#pragma unroll
                            for (int j = 0; j < 4; ++j) o[n * 4 + j] = acc[ai][bj][m][n][j] * fmaxf(g[n * 4 + j], 1e-30f);
                        u32x4 w; w.x = cvt_pk_bf16(o[0], o[1]); w.y = cvt_pk_bf16(o[2], o[3]); w.z = cvt_pk_bf16(o[4], o[5]); w.w = cvt_pk_bf16(o[6], o[7]);
                        *(u32x4*)(mergedb + (size_t)r * D + c) = w;
                    } }
                asm volatile("" ::: "memory"); }
    }
};
template <class Sched> __device__ __forceinline__ void fill_rstd_table(const Sched& So, const float* ssp, __attribute__((address_space(3))) float* tab, int wave) {
    int t_ = wave * 64 + (int)__builtin_amdgcn_mbcnt_hi(~0u, __builtin_amdgcn_mbcnt_lo(~0u, 0u)); asm volatile("" : "+v"(t_));
    const int t = t_, row = t >> 1, half = t & 1;
#pragma unroll 1
    for (int ui = 0; ui < 8; ++ui) { Unit u; if (!So.next(ui, u)) break;
        const f32x4* p = (const f32x4*)(ssp + (size_t)(u.pm * BM + row) * 32 + half * 16); const f32x4 a = p[0], b = p[1], c = p[2], d = p[3];
        float s = (((a[0] + a[1]) + (a[2] + a[3])) + ((b[0] + b[1]) + (b[2] + b[3]))) + (((c[0] + c[1]) + (c[2] + c[3])) + ((d[0] + d[1]) + (d[2] + d[3])));
        s += __shfl_xor(s, 1);
        if (half == 0) tab[ui * 256 + row] = 1.0f / sqrtf(s * (1.0f / D) + EPS); }
}
struct BranchOrder {
    pg8::StaticOrder so;
    __device__ bool next(int i, Unit& u) const { if (i >= 4) return false; Unit t; if (!so.next(0, t)) return false; u.pm = i * 32 + t.pm; u.pn = i * 8 + t.pn; return true; }
    __device__ __forceinline__ void a_ready(const Unit&, int) const {}
    __device__ __forceinline__ void done(const Unit&) const {}
};
}
constexpr size_t MiB = 1u << 20;
constexpr size_t WS_CTL = 0, CTL_ZERO_BYTES = 1 * MiB;
constexpr size_t WS_COS = 1 * MiB, WS_SIN = 2 * MiB, WS_SSP = 3 * MiB;
constexpr size_t WS_WGU1 = 4 * MiB, WS_WD1 = 48 * MiB, WS_WGU2 = 70 * MiB, WS_WD2 = 114 * MiB;
constexpr size_t WS_WIN = 136 * MiB, WS_WBR = 195 * MiB, WS_WOUT = 203 * MiB, WS_WMLA = 211 * MiB;
constexpr size_t WS_X = 214 * MiB;
constexpr size_t WS_XN = 278 * MiB;
constexpr size_t WS_HID = 310 * MiB;
constexpr size_t WS_P = 398 * MiB;
constexpr size_t WS_Z = 634 * MiB;
constexpr size_t WS_VVN = 666 * MiB, WS_MLAA = 674 * MiB;
constexpr size_t WS_MLARAW = 682 * MiB;
constexpr size_t WS_QP = 1426 * MiB, WS_KP = 1458 * MiB, WS_VT = 770 * MiB;
constexpr int QKP = 256;
constexpr size_t WS_ORAW = 786 * MiB;
constexpr size_t WS_MERGED = 818 * MiB, WS_MERGEDB = 882 * MiB;
constexpr size_t WS_PEXP = 914 * MiB;
constexpr size_t WS_DILO = 1490 * MiB, WS_DILL = 1540 * MiB;
constexpr size_t WS_MQ = WS_QP, WS_MK = WS_KP, WS_MV = WS_VT, WS_MOP = WS_PEXP, WS_MLP = WS_ORAW;
constexpr size_t WS_END = 1541 * MiB;
static_assert(WS_WGU1 + (size_t)NGU * D * 2 <= WS_WD1 && WS_WD1 + (size_t)D * FF * 2 <= WS_WGU2 && WS_WGU2 + (size_t)NGU * D * 2 <= WS_WD2 && WS_WD2 + (size_t)D * FF * 2 <= WS_WIN, "ws map 1");
static_assert(WS_WIN + (size_t)NINP * D * 2 <= WS_WBR && WS_WBR + (size_t)4 * D * 512 * 2 <= WS_WOUT && WS_WOUT + (size_t)D * D * 2 <= WS_WMLA && WS_WMLA + (size_t)NMLA * 512 * 2 <= WS_X, "ws map 2");
static_assert(WS_X + (size_t)S * D * 4 <= WS_XN && WS_XN + (size_t)S * D * 2 <= WS_HID && WS_HID + (size_t)S * FF * 2 <= WS_P && WS_P + (size_t)S * NINP * 2 <= WS_Z, "ws map 3");
static_assert(WS_Z + (size_t)4 * S * 512 * 2 <= WS_VVN && WS_MLARAW + (size_t)S * NMLA * 4 <= WS_VT && WS_KP + (size_t)4 * S * QKP * 2 <= WS_END && WS_ORAW + (size_t)4 * S * 256 * 4 <= WS_MERGED && WS_MERGED + (size_t)S * D * 4 <= WS_MERGEDB && WS_MERGEDB + (size_t)S * D * 2 <= WS_PEXP && WS_PEXP + (size_t)4 * S * S * 2 <= WS_QP, "ws map 4");
constexpr size_t WS_SETD = 956 * MiB;
static_assert(WS_WGU1 + WS_SETD >= WS_PEXP + (size_t)2 * 4 * S * 128 * 4 && WS_X + WS_SETD <= WS_QP, "second weight set");
#ifndef TAILCONV
#define TAILCONV 0
#endif
constexpr int CPARTS = 416;
constexpr int CW_BAR = 4096;

constexpr int NWAVES = 8;
constexpr int RING_OFF = 0, RING_BYTES = 131072;
constexpr int LDSCTL_OFF = RING_BYTES, MISC_OFF = LDSCTL_OFF + 320;
constexpr int LDS_BYTES = 147456;
constexpr int RSTD_OFF = RING_BYTES + 1024;

enum { I_X = 0, I_F1N, I_F1G, I_F1U, I_F1D, I_MIXN, I_WIN, I_POOLW, I_POOLS, I_DQN, I_DKN, I_SGUN, I_SGUW, I_SGUB, I_MQAN, I_MWUQ, I_MKVAN, I_MWUKV, I_MQN, I_MKN, I_WBR, I_WOUT, I_F2N, I_F2G, I_F2U, I_F2D, N_INPUTS };

struct Frame {
    LAS unsigned char* lds;
    volatile LAS unsigned* MISC;
    int wave, vcu, G;
    int gw, NGW, NGT;
};
constexpr int NPHASE = 13;
struct Args { const float* in[N_INPUTS]; float* out; unsigned char* ws; int l_lo, l_hi, ph_lo, ph_hi; };
typedef const __attribute__((address_space(4))) Args* ArgsP;
__device__ __forceinline__ ArgsP fresh_args() { ArgsP p = (ArgsP)__builtin_amdgcn_kernarg_segment_ptr(); asm volatile("" : "+s"(p)); return p; }
__device__ __forceinline__ int opq_s(int x) { asm volatile("" : "+s"(x)); return x; }
__device__ __forceinline__ Frame fresh_frame(const Frame& F) { Frame R = F; R.wave = opq_s(F.wave); R.vcu = opq_s(F.vcu); R.G = opq_s(F.G); R.gw = opq_s(F.gw); R.NGW = opq_s(F.NGW); R.NGT = opq_s(F.NGT); return R; }
__device__ __forceinline__ int opq_lane() { int l = (int)__builtin_amdgcn_mbcnt_hi(~0u, __builtin_amdgcn_mbcnt_lo(~0u, 0u)); asm volatile("" : "+v"(l)); return l; }
__device__ __forceinline__ float wave_sum(float v) {
#pragma unroll
    for (int o = 1; o < 64; o <<= 1) v += __shfl_xor(v, o);
    return v;
}
__device__ __forceinline__ float wave_max(float v) {
#pragma unroll
    for (int o = 1; o < 64; o <<= 1) v = fmaxf(v, __shfl_xor(v, o));
    return v;
}
__device__ __forceinline__ float bf2f(unsigned short b) { return __uint_as_float(((unsigned)b) << 16); }
__device__ __forceinline__ float bflo(unsigned u) { return __uint_as_float(u << 16); }
__device__ __forceinline__ float bfhi(unsigned u) { return __uint_as_float(u & 0xffff0000u); }
__device__ __forceinline__ float rsq(float x) { return 1.0f / sqrtf(x); }

__device__ __forceinline__ void transpose_load(f32x4 (&v)[8], const float* W, int ldw, int k0, int n0, int lane) {
    const int pc = lane & 7, kr = lane >> 3;
#pragma unroll
    for (int i = 0; i < 8; ++i) v[i] = __builtin_nontemporal_load((const GAS f32x4*)(W + (size_t)(k0 + 8 * i + kr) * ldw + n0 + 4 * pc));
}
__device__ __forceinline__ void transpose_store(const f32x4 (&v)[8], int k0, bf16* WT, int ldt, int drow0, int dk0, LAS float* scr, int lane, const float* kgain) {
    const int pc = lane & 7, kr = lane >> 3;
#pragma unroll
    for (int i = 0; i < 8; ++i) { LAS float* d = scr + (8 * i + kr) * 33 + 4 * pc; const float gk = kgain ? kgain[k0 + 8 * i + kr] : 1.0f;
        d[0] = v[i].x * gk; d[1] = v[i].y * gk; d[2] = v[i].z * gk; d[3] = v[i].w * gk; }
    LDS_WAIT(); asm volatile("" ::: "memory");
    const int c = lane & 7;
#pragma unroll
    for (int j = 0; j < 4; ++j) { const int n = (lane >> 3) + 8 * j; const LAS float* s = scr + (8 * c) * 33 + n;
        v4u o; o.x = pk2(s[0 * 33], s[1 * 33]); o.y = pk2(s[2 * 33], s[3 * 33]); o.z = pk2(s[4 * 33], s[5 * 33]); o.w = pk2(s[6 * 33], s[7 * 33]);
        *(GAS v4u*)(WT + (size_t)(drow0 + n) * ldt + dk0 + k0 + 8 * c) = o; }
    LDS_WAIT(); asm volatile("" ::: "memory");
}
template <int MAP> __device__ __forceinline__ int map_row(int n0, int roff) {
    if (MAP == 0) return n0 + roff;
    if (MAP == 1) return (n0 >> 7) * 256 + roff + (n0 & 127);
    return (n0 < 6720) ? (n0 + 8192) : (n0 - 6720);
}
template <int MAP> __device__ __forceinline__ void transpose_matrix(const Frame& F, int vgw, int vNGW, int p0, int p1, int lane, const float* W, int K, int N, bf16* WT, int ldt, int roff, int dk0, const float* kgain = nullptr) {
    LAS float* scr = (LAS float*)(F.lds + RING_OFF + (vgw & 7) * 16384);
    const int nblk = N / 32, items = (K / 64) * nblk, lo = (int)((long)items * p0 / CPARTS), hi = (int)((long)items * p1 / CPARTS);
    int it = lo + vgw; if (it >= hi) return;
    f32x4 va[8], vb[8]; transpose_load(va, W, N, 64 * (it / nblk), 32 * (it % nblk), lane);
    for (;;) {
        const int itn = it + vNGW; const bool more = itn < hi;
        if (more) transpose_load(vb, W, N, 64 * (itn / nblk), 32 * (itn % nblk), lane);
        transpose_store(va, 64 * (it / nblk), WT, ldt, map_row<MAP>(32 * (it % nblk), roff), dk0, scr, lane, kgain);
        if (!more) break;
#pragma unroll
        for (int i = 0; i < 8; ++i) va[i] = vb[i];
        it = itn;
    }
}

__device__ __forceinline__ void phase_convert(ArgsP A, const Frame& F, int l, int vgw, int vNGW, int p0, int p1) {
    unsigned char* ws = A->ws + (size_t)(l & 1) * WS_SETD; const int lane = opq_lane(); const int vgt = vgw * 64 + lane, vNGT = vNGW * 64;
#define TM(MAP, ...) transpose_matrix<MAP>(F, vgw, vNGW, p0, p1, lane, __VA_ARGS__)
#define PART(n, lo, hi) const int lo = (int)((long)(n) * p0 / CPARTS), hi = (int)((long)(n) * p1 / CPARTS)
    TM(0, A->in[I_F2D] + (size_t)l * FF * D, FF, D, (bf16*)(ws + WS_WD2), FF, 0, 0);
    TM(1, A->in[I_F2G] + (size_t)l * D * FF, D, FF, (bf16*)(ws + WS_WGU2), D, 0, 0, A->in[I_F2N] + (size_t)l * D);
    TM(1, A->in[I_F2U] + (size_t)l * D * FF, D, FF, (bf16*)(ws + WS_WGU2), D, 128, 0, A->in[I_F2N] + (size_t)l * D);
    TM(0, A->in[I_WOUT] + (size_t)l * D * D, D, D, (bf16*)(ws + WS_WOUT), D, 0, 0);
    for (int b = 1; b < 4; ++b) TM(0, A->in[I_WBR] + ((size_t)l * 4 + b) * 512 * D, 512, D, (bf16*)(ws + WS_WBR) + (size_t)b * D * 512, 512, 0, 0);
    TM(0, A->in[I_MWUQ] + (size_t)l * 384 * 768, 384, 768, (bf16*)(ws + WS_WMLA), 512, 0, 0);
    TM(0, A->in[I_MWUKV] + (size_t)l * 128 * 1024, 128, 1024, (bf16*)(ws + WS_WMLA), 512, 768, 384);
    TM(2, A->in[I_WIN] + (size_t)l * D * NIN, D, NIN, (bf16*)(ws + WS_WIN), D, 0, 0, A->in[I_MIXN] + (size_t)l * D);
    TM(0, A->in[I_F1D] + (size_t)l * FF * D, FF, D, (bf16*)(ws + WS_WD1), FF, 0, 0);
    TM(1, A->in[I_F1G] + (size_t)l * D * FF, D, FF, (bf16*)(ws + WS_WGU1), D, 0, 0, A->in[I_F1N] + (size_t)l * D);
    TM(1, A->in[I_F1U] + (size_t)l * D * FF, D, FF, (bf16*)(ws + WS_WGU1), D, 128, 0, A->in[I_F1N] + (size_t)l * D);
    { bf16* wm = (bf16*)(ws + WS_WMLA);
      { PART(768 * 128, lo, hi); for (int i = lo + vgt; i < hi; i += vNGT) wm[(size_t)(i >> 7) * 512 + 384 + (i & 127)] = 0; }
      { PART(1024 * 384, lo, hi); for (int i = lo + vgt; i < hi; i += vNGT) wm[(size_t)(768 + i / 384) * 512 + (i % 384)] = 0; }
      unsigned* wz = (unsigned*)((bf16*)(ws + WS_WIN) + (size_t)NIN * D);
      { PART((NINP - NIN) * D / 2, lo, hi); for (int i = lo + vgt; i < hi; i += vNGT) wz[i] = 0u; } }
    { const float* pw = A->in[I_POOLW] + (size_t)l * 4 * 128 * 128; const float* ps = A->in[I_POOLS] + (size_t)l * 512; const float* wb = A->in[I_WBR] + (size_t)l * 4 * 512 * D;
      bf16* wt = (bf16*)(ws + WS_WBR);
      PART(128 * D, lo, hi);
      for (int i = lo + vgt; i < hi; i += vNGT) { const int r4 = (i >> 11) * 4, n = i & (D - 1), g = r4 >> 7;
          const float* pr = pw + (size_t)r4 * 128; const float* wcol = wb + (size_t)(g * 128) * D + n; const float* psg = ps + g * 128;
          float a0 = 0.f, a1 = 0.f, a2 = 0.f, a3 = 0.f;
#pragma unroll 8
          for (int d = 0; d < 128; ++d) { const float wv = wcol[(size_t)d * D] * psg[d]; a0 += pr[d] * wv; a1 += pr[128 + d] * wv; a2 += pr[256 + d] * wv; a3 += pr[384 + d] * wv; }
          bf16* o = wt + (size_t)n * 512 + r4;
          *(unsigned long long*)o = (unsigned long long)pk2(a0, a1) | ((unsigned long long)pk2(a2, a3) << 32); } }
#undef TM
#undef PART
}
__device__ __forceinline__ void tail_convert(ArgsP A, const Frame& F, int l, int bx, int nunits, int p0, int p1) {
#if !TAILCONV
    return;
#endif
    const int busy = nunits % F.G; if (busy == 0 || l + 1 >= NLAYER) return;
    const int slot = bx - busy; if (slot < 0) return;
    phase_convert(A, F, l + 1, slot * NWAVES + F.wave, (F.G - busy) * NWAVES, p0, p1);
}
__device__ __forceinline__ void phase_rope_tables(ArgsP A, const Frame& F) {
    unsigned char* ws = A->ws; const int lane = opq_lane(); const int gw = opq_s(F.gw); const int gt = gw * 64 + lane;
    {
        float* ct = (float*)(ws + WS_COS); float* st = (float*)(ws + WS_SIN);
        for (int i = gt; i < S * 32; i += F.NGT) { const int pos = i >> 5, k = i & 31;
            double f = 1.0; for (int j = 0; j < k; ++j) f *= 0.74989420933245582730;
            const float ang = (float)pos * (float)f;
            const double a = (double)ang; const double kq = __builtin_rint(a * 0.63661977236758134308); const double r = (a - kq * 1.5707963267948966192) - kq * 6.123233995736766e-17;
            const double r2 = r * r;
            const double sn = r * (1.0 + r2 * (-1.0 / 6 + r2 * (1.0 / 120 + r2 * (-1.0 / 5040 + r2 * (1.0 / 362880 + r2 * (-1.0 / 39916800 + r2 * (1.0 / 6227020800.0)))))));
            const double cs = 1.0 + r2 * (-0.5 + r2 * (1.0 / 24 + r2 * (-1.0 / 720 + r2 * (1.0 / 40320 + r2 * (-1.0 / 3628800 + r2 * (1.0 / 479001600.0 + r2 * (-1.0 / 87178291200.0)))))));
            const int q = ((int)kq) & 3;
            const double sv = (q == 0) ? sn : (q == 1) ? cs : (q == 2) ? -sn : -cs;
            const double cv = (q == 0) ? cs : (q == 1) ? -sn : (q == 2) ? -cs : sn;
            ct[i] = (float)cv; st[i] = (float)sv; }
    }
}
__device__ __forceinline__ void phase_prep(const Frame& F, const float* x, bf16* xb, float* ssp) {
    const int lane = opq_lane(); const int gw = opq_s(F.gw);
    for (int m = gw; m < S; m += F.NGW) {
        const GAS f32x4* xr = (const GAS f32x4*)(x + (size_t)m * D) + lane;
        f32x4 v[8]; float s = 0.f;
#pragma unroll
        for (int j = 0; j < 8; ++j) { v[j] = xr[64 * j]; s += (v[j].x * v[j].x + v[j].y * v[j].y) + (v[j].z * v[j].z + v[j].w * v[j].w); }
        s = wave_sum(s);
        GAS unsigned long long* o8 = (GAS unsigned long long*)(xb + (size_t)m * D) + lane;
#pragma unroll
        for (int j = 0; j < 8; ++j) o8[64 * j] = (unsigned long long)pk2(v[j].x, v[j].y) | ((unsigned long long)pk2(v[j].z, v[j].w) << 32);
        if (lane < 32) ssp[(size_t)m * 32 + lane] = (lane == 0) ? s : 0.f;
    }
}
__device__ __forceinline__ void phase_mix1(ArgsP A, const Frame& F, int l) {
    unsigned char* ws = A->ws; const int lane = opq_lane(); const int gw = opq_s(F.gw); const int gt = gw * 64 + lane;
    bf16* p = (bf16*)(ws + WS_P); bf16* z0 = (bf16*)(ws + WS_Z); bf16* vvn = (bf16*)(ws + WS_VVN); bf16* mlaA = (bf16*)(ws + WS_MLAA);
    for (int item = gt; item < (S / 16) * 256; item += F.NGT) {
        const int cp = item & 255, t0 = (item >> 8) * 16, g = cp >> 6;
        const bf16* col = p + PC_POOL + 2 * cp;
        float va[32], vb[32];
#pragma unroll
        for (int k = 0; k < 32; ++k) { const int tt = t0 - 8 + k; const bool in = (tt >= 0) && (tt < S); const unsigned u = in ? *(const unsigned*)(col + (size_t)(in ? tt : 0) * NINP) : 0u; va[k] = bflo(u); vb[k] = bfhi(u); }
        unsigned* zo = (unsigned*)(z0 + (size_t)t0 * 512 + 2 * cp);
#define POOL_GROUP(HW) do { \
        _Pragma("unroll") for (int i = 0; i < 16; ++i) { float sa = 0.f, sb = 0.f; \
            _Pragma("unroll") for (int k = 8 + i - (HW); k < 8 + i + (HW); ++k) { sa += va[k]; sb += vb[k]; }     \
            const int t = t0 + i, lo = (t - (HW)) < 0 ? 0 : (t - (HW)), hi = (t + (HW)) > S ? S : (t + (HW)); const float inv = 1.0f / (float)(hi - lo); \
            zo[(size_t)i * 256] = pk2(sa * inv - va[8 + i], sb * inv - vb[8 + i]); } } while (0)
        if (g == 0) POOL_GROUP(1); else if (g == 1) POOL_GROUP(2); else if (g == 2) POOL_GROUP(4); else POOL_GROUP(8);
#undef POOL_GROUP
    }
    const float* gq = A->in[I_DQN] + l * 128; const float* gk = A->in[I_DKN] + l * 128; const float* gs = A->in[I_SGUN] + l * 512;
    const float* gqa = A->in[I_MQAN] + l * 384; const float* gkva = A->in[I_MKVAN] + l * 128;
    for (int t = gw; t < S; t += F.NGW) {
        bf16* prow = p + (size_t)t * NINP;
        { unsigned* ptr = (unsigned*)(prow + PC_DIL) + lane; unsigned uu[24]; float ss[24];
#pragma unroll
          for (int hh = 0; hh < 24; ++hh) uu[hh] = ptr[hh * 64];
#pragma unroll
          for (int hh = 0; hh < 24; ++hh) { const float a = bflo(uu[hh]), b = bfhi(uu[hh]); ss[hh] = a * a + b * b; }
#pragma unroll
          for (int o = 1; o < 64; o <<= 1) {
#pragma unroll
              for (int hh = 0; hh < 24; ++hh) ss[hh] += __shfl_xor(ss[hh], o); }
          const float gq0 = gq[2 * lane], gq1 = gq[2 * lane + 1], gk0 = gk[2 * lane], gk1 = gk[2 * lane + 1];
#pragma unroll
          for (int hh = 0; hh < 24; ++hh) { const float rstd = rsq(ss[hh] * (1.f / 128) + EPS);
              ptr[hh * 64] = pk2(bflo(uu[hh]) * rstd * (hh < 12 ? gq0 : gk0), bfhi(uu[hh]) * rstd * (hh < 12 ? gq1 : gk1)); } }
        { const v4u u = *((const v4u*)(prow + PC_SGU + 512) + lane); float x[8] = {bflo(u.x), bfhi(u.x), bflo(u.y), bfhi(u.y), bflo(u.z), bfhi(u.z), bflo(u.w), bfhi(u.w)}; float ss = 0.f;
#pragma unroll
          for (int k = 0; k < 8; ++k) ss += x[k] * x[k];
          const float rstd = rsq(wave_sum(ss) * (1.f / 512) + EPS); const float* gg = gs + 8 * lane;
          v4u o; o.x = pk2(x[0] * rstd * gg[0], x[1] * rstd * gg[1]); o.y = pk2(x[2] * rstd * gg[2], x[3] * rstd * gg[3]); o.z = pk2(x[4] * rstd * gg[4], x[5] * rstd * gg[5]); o.w = pk2(x[6] * rstd * gg[6], x[7] * rstd * gg[7]);
          *((v4u*)(vvn + (size_t)t * 512) + lane) = o; }
        { const unsigned* cq = (const unsigned*)(prow + PC_CQ) + lane; const unsigned u0 = cq[0], u1 = cq[64], u2 = cq[128];
          const float a0 = bflo(u0), b0 = bfhi(u0), a1 = bflo(u1), b1 = bfhi(u1), a2 = bflo(u2), b2 = bfhi(u2);
          const float rstd = rsq(wave_sum((a0 * a0 + b0 * b0) + (a1 * a1 + b1 * b1) + (a2 * a2 + b2 * b2)) * (1.f / 384) + EPS);
          unsigned* o = (unsigned*)(mlaA + (size_t)t * 512) + lane; const float* gg = gqa + 2 * lane;
          o[0] = pk2(a0 * rstd * gg[0], b0 * rstd * gg[1]); o[64] = pk2(a1 * rstd * gg[128], b1 * rstd * gg[129]); o[128] = pk2(a2 * rstd * gg[256], b2 * rstd * gg[257]);
          const unsigned uk = *((const unsigned*)(prow + PC_CKV) + lane); const float ak = bflo(uk), bk = bfhi(uk);
          const float rk = rsq(wave_sum(ak * ak + bk * bk) * (1.f / 128) + EPS);
          o[192] = pk2(ak * rk * gkva[2 * lane], bk * rk * gkva[2 * lane + 1]); }
    }
}
typedef float f32x16 __attribute__((ext_vector_type(16)));
typedef short s16x4 __attribute__((ext_vector_type(4)));
typedef short v4i16_t __attribute__((ext_vector_type(4)));
#define MFMA32(a, b, c) __builtin_amdgcn_mfma_f32_32x32x16_bf16((a), (b), (c), 0, 0, 0)
__device__ __forceinline__ int crow(int reg, int h) { return (reg & 3) + 8 * (reg >> 2) + 4 * h; }
__device__ __forceinline__ bf16x8 pack8(const f32x16& x, int s) {
    v4u p; p.x = epi::cvt_pk_bf16(x[8 * s], x[8 * s + 1]); p.y = epi::cvt_pk_bf16(x[8 * s + 2], x[8 * s + 3]); p.z = epi::cvt_pk_bf16(x[8 * s + 4], x[8 * s + 5]); p.w = epi::cvt_pk_bf16(x[8 * s + 6], x[8 * s + 7]);
    return __builtin_bit_cast(bf16x8, p);
}
__device__ __forceinline__ s16x4 tr_read(const LAS unsigned char* p) { return __builtin_bit_cast(s16x4, __builtin_amdgcn_ds_read_tr16_b64_v4i16((LAS v4i16_t*)p)); }
__device__ __forceinline__ int vimg_off(int key, int piece  ) { return key * 256 + (((piece >> 2) ^ (key & 3)) << 6) + ((piece & 3) << 4); }
__device__ __forceinline__ bf16x8 vt_frag(const LAS unsigned char* img, int key0, int d0, int lane) {
    const int h = lane >> 5, blk = (lane >> 4) & 1, q = (lane & 15) >> 2, pp = lane & 3;
    const int ka = key0 + 4 * h + q, kb = ka + 8;
    const int col = ((d0 ^ q) << 6) + (16 * blk + 4 * pp) * 2;
    const s16x4 lo = tr_read(img + ka * 256 + col), hi = tr_read(img + kb * 256 + col);
    return __builtin_shufflevector(lo, hi, 0, 1, 2, 3, 4, 5, 6, 7);
}
__device__ __forceinline__ int vt_lane_off(int lane, int d0) { const int h = lane >> 5, blk = (lane >> 4) & 1, q = (lane & 15) >> 2, pp = lane & 3; return (4 * h + q) * 256 + ((d0 ^ q) << 6) + (16 * blk + 4 * pp) * 2; }
template <int KEY0> __device__ __forceinline__ bf16x8 vt_frag_o(const LAS unsigned char* img, int voff) {
    const s16x4 lo = tr_read(img + voff + KEY0 * 256), hi = tr_read(img + voff + (KEY0 + 8) * 256);
    return __builtin_shufflevector(lo, hi, 0, 1, 2, 3, 4, 5, 6, 7);
}
__device__ __forceinline__ bf16x8 tr_frag(const LAS unsigned char* img, int ra, int rb, int cb, int lane) {
    const int blk = (lane >> 4) & 1, q = (lane & 15) >> 2, pp = lane & 3;
    const int col = ((cb ^ q) << 6) + (16 * blk + 4 * pp) * 2;
    const s16x4 lo = tr_read(img + (ra + q) * 256 + col), hi = tr_read(img + (rb + q) * 256 + col);
    return __builtin_shufflevector(lo, hi, 0, 1, 2, 3, 4, 5, 6, 7);
}
__device__ __forceinline__ void sgu_mix_mfma(ArgsP A, const Frame& F, int l, int lane) {
    unsigned char* ws = A->ws; const bf16* p = (const bf16*)(ws + WS_P); const bf16* vvn = (const bf16*)(ws + WS_VVN); bf16* z2 = (bf16*)(ws + WS_Z) + (size_t)2 * S * 512;
    const float* sw = A->in[I_SGUW] + (size_t)l * 4 * 128 * 128; const float* sb = A->in[I_SGUB] + (size_t)l * 4 * 128;
    LAS unsigned char* img = F.lds + RING_OFF;
    const int w = F.wave, tid = w * 64 + lane, ql = lane & 31, h = lane >> 5, tb = 32 * (w & 3), cb0 = 2 * (w >> 2);
    for (int unit = F.vcu; unit < 256; unit += F.G) {
        const int n = unit >> 2, g = unit & 3;
#pragma unroll
        for (int i = 0; i < 4; ++i) { const int idx = i * 512 + tid, s = idx >> 4, piece = idx & 15;
            *(LAS v4u*)(img + vimg_off(s, piece)) = *(const v4u*)(vvn + (size_t)(n * 128 + s) * 512 + g * 128 + piece * 8); }
        __syncthreads();
        f32x16 acc0, acc1;
#pragma unroll
        for (int e = 0; e < 16; ++e) { acc0[e] = 0.f; acc1[e] = 0.f; }
        const float* wrow = sw + ((size_t)g * 128 + tb + ql) * 128 + 8 * h;
#pragma unroll
        for (int ks = 0; ks < 8; ++ks) {
            const f32x4 a0 = *(const f32x4*)(wrow + 16 * ks), a1 = *(const f32x4*)(wrow + 16 * ks + 4);
            v4u ap; ap.x = epi::cvt_pk_bf16(a0.x, a0.y); ap.y = epi::cvt_pk_bf16(a0.z, a0.w); ap.z = epi::cvt_pk_bf16(a1.x, a1.y); ap.w = epi::cvt_pk_bf16(a1.z, a1.w);
            const bf16x8 af = __builtin_bit_cast(bf16x8, ap);
            acc0 = MFMA32(af, tr_frag(img, 16 * ks + 8 * h, 16 * ks + 8 * h + 4, cb0, lane), acc0);
            acc1 = MFMA32(af, tr_frag(img, 16 * ks + 8 * h, 16 * ks + 8 * h + 4, cb0 + 1, lane), acc1);
        }
#pragma unroll
        for (int e = 0; e < 16; ++e) { const int tl = tb + crow(e, h), t = n * 128 + tl; const float bias = sb[g * 128 + tl];
            const int c0 = g * 128 + 32 * cb0 + ql;
            const float u0 = bf2f(p[(size_t)t * NINP + PC_SGU + c0]), u1 = bf2f(p[(size_t)t * NINP + PC_SGU + c0 + 32]);
            z2[(size_t)t * 512 + c0] = (bf16)f2bf(u0 * (acc0[e] + bias)); z2[(size_t)t * 512 + c0 + 32] = (bf16)f2bf(u1 * (acc1[e] + bias)); }
        __syncthreads();
    }
}
__device__ __forceinline__ void dil_attention(ArgsP A, const Frame& F, int l, int gw, int lane) {
    unsigned char* ws = A->ws; const bf16* p = (const bf16*)(ws + WS_P);
    float* OP = (float*)(ws + WS_DILO); float* LP = (float*)(ws + WS_DILL);
    LAS unsigned char* img = F.lds + RING_OFF + (gw & 7) * 8192;
    const float* gq = A->in[I_DQN] + l * 128; const float* gk = A->in[I_DKN] + l * 128;
    const float cbound = 11.313708499f * wave_max(fmaxf(fabsf(gq[lane]), fabsf(gq[lane + 64]))) * wave_max(fmaxf(fabsf(gk[lane]), fabsf(gk[lane + 64])));
    const int ql = lane & 31, h = lane >> 5;
    const int nun = ((gw & 7) < 4) ? 2 : 1;
    for (int kk = 0; kk < ((F.G == 256) ? nun : 1 << 30); ++kk) {
        const int unit = (F.G == 256) ? (gw >> 3) * 12 + (gw & 7) + 8 * kk : gw + kk * F.NGW; if (unit >= 12 * 256) break;
        const int hq = unit >> 8, blk = unit & 255, g = hq >> 2, ih = hq & 3, dl = 1 << (2 * g), L = S >> (2 * g), nb = 256 >> (2 * g);
        const int r = blk / nb, b = blk % nb;
        const float slope = __builtin_amdgcn_exp2f(-8.0f * (float)(hq + 1) / 12.0f) * (float)dl;
        const int tq = r + dl * (32 * b + ql);
        bf16x8 qf[8];
        { const v4u* src = (const v4u*)(p + (size_t)tq * NINP + PC_DIL + hq * 128 + 8 * h);
#pragma unroll
          for (int s = 0; s < 8; ++s) qf[s] = __builtin_bit_cast(bf16x8, src[2 * s]); }
        f32x16 o[4]; float lsum = 0.f;
#pragma unroll
        for (int d0 = 0; d0 < 4; ++d0)
#pragma unroll
            for (int e = 0; e < 16; ++e) o[d0][e] = 0.f;
#pragma unroll 1
        for (int c = -2; c <= 2; ++c) {
            const int mb = 32 * (b + c);
            if (mb < 0 || mb >= L) continue;
            f32x16 sacc;
#pragma unroll
            for (int e = 0; e < 16; ++e) sacc[e] = 0.f;
            v4u vreg[8];
#pragma unroll
            for (int i = 0; i < 8; ++i) { const int idx = i * 64 + lane, key = idx >> 4, piece = idx & 15;
                vreg[i] = *(const v4u*)(p + (size_t)(r + dl * (mb + key)) * NINP + PC_DIL + 3072 + hq * 128 + piece * 8); }
            { const int tk = r + dl * (mb + ql);
              const v4u* src = (const v4u*)(p + (size_t)tk * NINP + PC_DIL + 1536 + hq * 128 + 8 * h);
              bf16x8 kf[8];
#pragma unroll
              for (int s = 0; s < 8; ++s) kf[s] = __builtin_bit_cast(bf16x8, src[2 * s]);
#pragma unroll
              for (int s = 0; s < 8; ++s) sacc = MFMA32(kf[s], qf[s], sacc); }
#pragma unroll
            for (int i = 0; i < 8; ++i) { const int idx = i * 64 + lane, key = idx >> 4, piece = idx & 15; *(LAS v4u*)(img + vimg_off(key, piece)) = vreg[i]; }
#pragma unroll
            for (int e = 0; e < 16; ++e) { const int rel = 32 * c + crow(e, h) - ql, arel = rel < 0 ? -rel : rel;
                const float sv = sacc[e] * 0.08838834764831845f - slope * (float)arel - cbound;
                const float pe = (arel <= 64) ? epi::fast_exp(sv) : 0.f; sacc[e] = pe; lsum += pe; }
            const bf16x8 pb0 = pack8(sacc, 0), pb1 = pack8(sacc, 1);
#pragma unroll
            for (int d0 = 0; d0 < 4; ++d0) { o[d0] = MFMA32(vt_frag(img, 0, d0, lane), pb0, o[d0]); o[d0] = MFMA32(vt_frag(img, 16, d0, lane), pb1, o[d0]); }
        }
        lsum += __shfl_xor(lsum, 32);
        float* orow = OP + ((size_t)g * S + tq) * 512 + ih * 128 + 4 * h;
#pragma unroll
        for (int d0 = 0; d0 < 4; ++d0)
#pragma unroll
            for (int k = 0; k < 4; ++k) { f32x4 v; v.x = o[d0][4 * k]; v.y = o[d0][4 * k + 1]; v.z = o[d0][4 * k + 2]; v.w = o[d0][4 * k + 3]; *(f32x4*)(orow + 32 * d0 + 8 * k) = v; }
        if (h == 0) LP[((size_t)g * S + tq) * 4 + ih] = lsum;
    }
}
__device__ __forceinline__ void phase_mix2(ArgsP A, const Frame& F, int l) {
    unsigned char* ws = A->ws; const int lane = opq_lane(); const int gw = opq_s(F.gw); const int gt = gw * 64 + lane;
    const bf16* p = (const bf16*)(ws + WS_P); const float* raw = (const float*)(ws + WS_MLARAW);
    const float* ct = (const float*)(ws + WS_COS); const float* st = (const float*)(ws + WS_SIN);
    const float* gqn = A->in[I_MQN] + l * 192; const float* gkn = A->in[I_MKN] + l * 192;
    const float QSCL = 0.07216878364870322f * 1.4426950408889634f;
    bf16* MQ = (bf16*)(ws + WS_MQ); bf16* MK = (bf16*)(ws + WS_MK); bf16* MV = (bf16*)(ws + WS_MV);
    const int w8 = gw & 7, tok0 = (gw >> 3) * 32 + (w8 < 4 ? 2 * w8 : 8 + 6 * (w8 - 4)), npair = (w8 < 4) ? 1 : 3;
    const float gq0 = gqn[lane], gq1 = gqn[lane + 64], gq2 = gqn[lane + 128], gk0 = gkn[lane], gk1 = gkn[lane + 64], gk2 = gkn[lane + 128];
    for (int jj = 0; jj < ((F.G == 256) ? npair : 1 << 30); ++jj) { const int tb = (F.G == 256) ? tok0 + 2 * jj : 2 * (gw + jj * F.NGW); if (tb >= S) break;
        float cs[2], sn[2], krv[2], q0[2][4], q1[2][4], q2[2][4], k0[2][4], k1[2][4], v0[2][4], v1[2][4], sq[2][4], sk[2][4];
#pragma unroll
        for (int u = 0; u < 2; ++u) { const int t = tb + u; cs[u] = ct[t * 32 + (lane & 31)]; sn[u] = st[t * 32 + (lane & 31)];
            const float* rr = raw + (size_t)t * NMLA; krv[u] = bf2f(p[(size_t)t * NINP + PC_KR + lane]);
#pragma unroll
            for (int h = 0; h < 4; ++h) { q0[u][h] = rr[h * 192 + lane]; q1[u][h] = rr[h * 192 + 64 + lane]; q2[u][h] = rr[h * 192 + 128 + lane];
                k0[u][h] = rr[768 + h * 256 + lane]; k1[u][h] = rr[768 + h * 256 + 64 + lane]; v0[u][h] = rr[768 + h * 256 + 128 + lane]; v1[u][h] = rr[768 + h * 256 + 192 + lane]; } }
#pragma unroll
        for (int u = 0; u < 2; ++u)
#pragma unroll
            for (int h = 0; h < 4; ++h) { sq[u][h] = q0[u][h] * q0[u][h] + q1[u][h] * q1[u][h] + q2[u][h] * q2[u][h]; sk[u][h] = k0[u][h] * k0[u][h] + k1[u][h] * k1[u][h] + krv[u] * krv[u]; }
#pragma unroll
        for (int o = 1; o < 64; o <<= 1) {
#pragma unroll
            for (int u = 0; u < 2; ++u)
#pragma unroll
                for (int h = 0; h < 4; ++h) { sq[u][h] += __shfl_xor(sq[u][h], o); sk[u][h] += __shfl_xor(sk[u][h], o); } }
#pragma unroll
        for (int u = 0; u < 2; ++u) { const int t = tb + u;
#pragma unroll
        for (int h = 0; h < 4; ++h) {
            const float rq = rsq(sq[u][h] * (1.f / 192) + EPS) * QSCL, rk = rsq(sk[u][h] * (1.f / 192) + EPS);
            const float a2 = q2[u][h] * rq * gq2, oa = __shfl_xor(a2, 32), a2r = (lane < 32) ? (a2 * cs[u] - oa * sn[u]) : (oa * sn[u] + a2 * cs[u]);
            const float b2 = krv[u] * rk * gk2, ob = __shfl_xor(b2, 32), b2r = (lane < 32) ? (b2 * cs[u] - ob * sn[u]) : (ob * sn[u] + b2 * cs[u]);
            bf16* qo = MQ + ((size_t)h * S + t) * 192; bf16* ko = MK + ((size_t)h * S + t) * 192; bf16* vo = MV + ((size_t)h * S + t) * 128;
            qo[lane] = (bf16)f2bf(q0[u][h] * rq * gq0); qo[lane + 64] = (bf16)f2bf(q1[u][h] * rq * gq1); qo[lane + 128] = (bf16)f2bf(a2r);
            ko[lane] = (bf16)f2bf(k0[u][h] * rk * gk0); ko[lane + 64] = (bf16)f2bf(k1[u][h] * rk * gk1); ko[lane + 128] = (bf16)f2bf(b2r);
            vo[lane] = (bf16)f2bf(v0[u][h]); vo[lane + 64] = (bf16)f2bf(v1[u][h]); } }
    }
    sgu_mix_mfma(A, F, l, lane);
    dil_attention(A, F, l, gw, lane);
}


#ifndef MLA_SGB
#define MLA_SGB 1
#endif
constexpr int MLA_KROW = 400, MLA_KIMG = 64 * MLA_KROW, MLA_BUF = MLA_KIMG + 64 * 256;
__device__ __forceinline__ void phase_mla_flash(ArgsP A, const Frame& F, int l) {
    unsigned char* ws = A->ws; const int lane = opq_lane();
    const bf16* MQ = (const bf16*)(ws + WS_MQ); const bf16* MK = (const bf16*)(ws + WS_MK); const bf16* MV = (const bf16*)(ws + WS_MV);
    float* OP = (float*)(ws + WS_MOP); float* LP = (float*)(ws + WS_MLP);
    const float* gqn = A->in[I_MQN] + l * 192; const float* gkn = A->in[I_MKN] + l * 192;
    const float c2 = 19.990625f * wave_max(fmaxf(fmaxf(fabsf(gqn[lane]), fabsf(gqn[lane + 64])), fabsf(gqn[lane + 128]))) * wave_max(fmaxf(fmaxf(fabsf(gkn[lane]), fabsf(gkn[lane + 64])), fabsf(gkn[lane + 128])));
    LAS unsigned char* lds = F.lds + RING_OFF;
    const int w = F.wave, tid = w * 64 + lane, ql = lane & 31, hh = lane >> 5;
    int ksrc[3], kdst[3], vsrc[2], vdst[2];
#pragma unroll
    for (int i = 0; i < 3; ++i) { const int idx = i * 512 + tid, row = idx / 24, pc = idx - row * 24; ksrc[i] = row * 192 + pc * 8; kdst[i] = row * MLA_KROW + pc * 16; }
#pragma unroll
    for (int i = 0; i < 2; ++i) { const int idx = i * 512 + tid, row = idx >> 4, pc = idx & 15; vsrc[i] = row * 128 + pc * 8; vdst[i] = MLA_KIMG + vimg_off(row, pc); }
    int voff[4];
#pragma unroll
    for (int d0 = 0; d0 < 4; ++d0) voff[d0] = vt_lane_off(lane, d0);
    for (int unit = F.vcu; unit < 256; unit += F.G) {
        const int kh = unit & 1, qb = (unit >> 1) & 31, h = unit >> 6;
        const bf16* Kg = MK + ((size_t)h * S + kh * 4096) * 192; const bf16* Vg = MV + ((size_t)h * S + kh * 4096) * 128;
        const int tq = qb * 256 + w * 32 + ql;
        bf16x8 qf[12];
        { const v4u* src = (const v4u*)(MQ + ((size_t)h * S + tq) * 192 + 8 * hh);
#pragma unroll
          for (int s = 0; s < 12; ++s) qf[s] = __builtin_bit_cast(bf16x8, src[2 * s]); }
        f32x16 o[4]; float lsum = 0.f;
#pragma unroll
        for (int d0 = 0; d0 < 4; ++d0)
#pragma unroll
            for (int e = 0; e < 16; ++e) o[d0][e] = 0.f;
        v4u kst[3], vst[2];
#pragma unroll
        for (int i = 0; i < 3; ++i) kst[i] = *(const v4u*)(Kg + ksrc[i]);
#pragma unroll
        for (int i = 0; i < 2; ++i) vst[i] = *(const v4u*)(Vg + vsrc[i]);
#pragma unroll
        for (int i = 0; i < 3; ++i) *(LAS v4u*)(lds + kdst[i]) = kst[i];
#pragma unroll
        for (int i = 0; i < 2; ++i) *(LAS v4u*)(lds + vdst[i]) = vst[i];
        __syncthreads();
#pragma unroll 1
        for (int jt = 0; jt < 64; ++jt) {
            const LAS unsigned char* buf = lds + (jt & 1) * MLA_BUF; LAS unsigned char* nbuf = lds + ((jt + 1) & 1) * MLA_BUF;
            const int jn = (jt + 1 < 64) ? jt + 1 : jt;
#pragma unroll
            for (int i = 0; i < 3; ++i) kst[i] = *(const v4u*)(Kg + (size_t)jn * 64 * 192 + ksrc[i]);
#pragma unroll
            for (int i = 0; i < 2; ++i) vst[i] = *(const v4u*)(Vg + (size_t)jn * 64 * 128 + vsrc[i]);
            f32x16 s0, s1;
#pragma unroll
            for (int e = 0; e < 16; ++e) { s0[e] = -c2; s1[e] = -c2; }
            const LAS unsigned char* kr0 = buf + ql * MLA_KROW + 16 * hh;
            const LAS unsigned char* vimg = buf + MLA_KIMG;
#define KFRAG(f) (*(const LAS bf16x8*)(kr0 + ((f) >= 12 ? 32 * MLA_KROW : 0) + 32 * ((f) % 12)))
#define KLOAD(dst, f0) do { _Pragma("unroll") for (int i_ = 0; i_ < 4; ++i_) dst[i_] = KFRAG((f0) + i_); } while (0)
#define KMMA(src, f0) do { _Pragma("unroll") for (int i_ = 0; i_ < 4; ++i_) { if ((f0) + i_ < 12) s0 = MFMA32(src[i_], qf[((f0) + i_) % 12], s0); else s1 = MFMA32(src[i_], qf[((f0) + i_) % 12], s1); } } while (0)
#define SB() __builtin_amdgcn_sched_barrier(0)
            bf16x8 kA[4], kB[4];
            KLOAD(kA, 0);
            KLOAD(kB, 4);  SB(); KMMA(kA, 0);  SB();
            KLOAD(kA, 8);  SB(); KMMA(kB, 4);  SB();
            KLOAD(kB, 12); SB(); KMMA(kA, 8);  SB();
            KLOAD(kA, 16); SB(); KMMA(kB, 12); SB();
            KLOAD(kB, 20); SB(); KMMA(kA, 16); SB();
#define VLOAD(dst, key0, dd) do { dst[0] = vt_frag(vimg, key0, dd, lane); dst[1] = vt_frag(vimg, (key0) + 16, dd, lane); } while (0)
#define VMMA(src, pa, pb_, dd) do { o[dd] = MFMA32(src[0], pa, o[dd]); o[dd] = MFMA32(src[1], pb_, o[dd]); } while (0)
            bf16x8 vA[2], vB[2];
            VLOAD(vA, 0, 0); SB(); KMMA(kB, 20); SB();
#undef KFRAG
#undef KLOAD
#undef KMMA
#pragma unroll
            for (int e = 0; e < 16; ++e) { const float p0 = __builtin_amdgcn_exp2f(s0[e] - c2); s0[e] = p0; lsum += p0; }
            const bf16x8 pb00 = pack8(s0, 0), pb01 = pack8(s0, 1);
#pragma unroll
            for (int e = 0; e < 16; ++e) { const float p1 = __builtin_amdgcn_exp2f(s1[e] - c2); s1[e] = p1; lsum += p1; }
            const bf16x8 pb10 = pack8(s1, 0), pb11 = pack8(s1, 1);
            SB();
            VLOAD(vB, 0, 1);  SB(); VMMA(vA, pb00, pb01, 0); SB();
            VLOAD(vA, 0, 2);  SB(); VMMA(vB, pb00, pb01, 1); SB();
            VLOAD(vB, 0, 3);  SB(); VMMA(vA, pb00, pb01, 2); SB();
            VLOAD(vA, 32, 0); SB(); VMMA(vB, pb00, pb01, 3); SB();
            VLOAD(vB, 32, 1); SB(); VMMA(vA, pb10, pb11, 0); SB();
            VLOAD(vA, 32, 2); SB(); VMMA(vB, pb10, pb11, 1); SB();
            VLOAD(vB, 32, 3); SB(); VMMA(vA, pb10, pb11, 2); SB();
            VMMA(vB, pb10, pb11, 3);
#undef VLOAD
#undef VMMA
#undef SB
#pragma unroll
            for (int i = 0; i < 3; ++i) *(LAS v4u*)(nbuf + kdst[i]) = kst[i];
#pragma unroll
            for (int i = 0; i < 2; ++i) *(LAS v4u*)(nbuf + vdst[i]) = vst[i];
            __syncthreads();
        }
        lsum += __shfl_xor(lsum, 32);
        float* orow = OP + (((size_t)kh * 4 + h) * S + tq) * 128 + 4 * hh;
#pragma unroll
        for (int d0 = 0; d0 < 4; ++d0)
#pragma unroll
            for (int k = 0; k < 4; ++k) { f32x4 v; v.x = o[d0][4 * k]; v.y = o[d0][4 * k + 1]; v.z = o[d0][4 * k + 2]; v.w = o[d0][4 * k + 3]; *(f32x4*)(orow + 32 * d0 + 8 * k) = v; }
        if (hh == 0) LP[((size_t)kh * 4 + h) * S + tq] = lsum;
    }
}
__device__ __forceinline__ void dil_combine(ArgsP A, const Frame& F) {
    unsigned char* ws = A->ws; const int lane = opq_lane(); const int gw = opq_s(F.gw); const int gt = gw * 64 + lane;
    const float* OP = (const float*)(ws + WS_DILO); const float* LP = (const float*)(ws + WS_DILL); bf16* z1 = (bf16*)(ws + WS_Z) + (size_t)1 * S * 512;
    for (int idx = gt; idx < S * 512; idx += F.NGT) { const int t = idx >> 9, c = idx & 511, ih = c >> 7;
        const float num = OP[idx] + OP[(size_t)S * 512 + idx] + OP[(size_t)2 * S * 512 + idx];
        const float den = LP[(size_t)t * 4 + ih] + LP[((size_t)S + t) * 4 + ih] + LP[((size_t)2 * S + t) * 4 + ih];
        z1[idx] = (bf16)f2bf(num / den); }
}
__device__ __forceinline__ void phase_mix3(ArgsP A, const Frame& F) {
    unsigned char* ws = A->ws; const int lane = opq_lane(); const int gw = opq_s(F.gw); const int gt = gw * 64 + lane;
    { const float* MO = (const float*)(ws + WS_MOP); const float* ML = (const float*)(ws + WS_MLP); bf16* z3 = (bf16*)(ws + WS_Z) + (size_t)3 * S * 512;
      for (int idx = gt; idx < S * 512; idx += F.NGT) { const int t = idx >> 9, c = idx & 511, h = c >> 7, d = c & 127;
          const size_t r0 = (size_t)h * S + t, r1 = ((size_t)4 + h) * S + t;
          z3[idx] = (bf16)f2bf((MO[r0 * 128 + d] + MO[r1 * 128 + d]) / (ML[r0] + ML[r1])); } }
}

__global__ void __launch_bounds__(NWAVES * 64, 2) mk_fwd(Args args_unused) {
    extern __shared__ __attribute__((aligned(16))) unsigned char lds[];
    Frame F;
    F.lds = (LAS unsigned char*)lds;
    F.MISC = (volatile LAS unsigned*)(F.lds + MISC_OFF);
    F.wave = __builtin_amdgcn_readfirstlane((int)(threadIdx.x >> 6));
    F.G = gridDim.x; { const int bx = blockIdx.x; F.vcu = (F.G % 8 == 0) ? (bx % 8) * (F.G / 8) + bx / 8 : bx; }
    F.gw = F.vcu * NWAVES + F.wave; F.NGW = F.G * NWAVES; F.NGT = F.NGW * 64;
    for (int u = threadIdx.x; u < (LDS_BYTES - LDSCTL_OFF) / 4; u += NWAVES * 64) ((LAS unsigned*)(F.lds + LDSCTL_OFF))[u] = 0u;
    __syncthreads();
    int l_lo, l_hi; bool multi; XcdBarrier bar;
    { ArgsP A = fresh_args(); l_lo = A->l_lo; l_hi = A->l_hi;
      multi = !((l_hi - l_lo) == 1 && (A->ph_hi - A->ph_lo) == 1);
      unsigned* bw = (unsigned*)((gu32*)(A->ws + WS_CTL) + CW_BAR);
      bar.bar = bw; bar.x = 0; bar.st = F.MISC + 8;
      if (multi) bar = xcd_barrier_post(bw, F.MISC + 8); }
#define SEAM() do { if (multi) xcd_barrier(bar); } while (0)
#ifdef ONLY_PHASE
#define IN(k) ((k) == ONLY_PHASE && lo <= (k) && (k) < hi)
#else
#define IN(k) (lo <= (k) && (k) < hi)
#endif
#ifndef G_ALIGN
#define G_ALIGN true
#endif
#ifndef G_SP2
#define G_SP2 true
#endif
#define GEMM(EPI, ORDER) pg8::gemm_phase<EPI, ORDER, G_ALIGN, G_SP2>(Fl.lds + RING_OFF, g, So, E, Fl.wave)
    { ArgsP A = fresh_args(); if (A->l_lo == 0 && A->ph_lo == 0) phase_rope_tables(A, F); }
    for (int l = l_lo; l < l_hi; ++l) {
        int lo, hi; { ArgsP A = fresh_args(); lo = A->ph_lo; hi = A->ph_hi; }
        if (IN(0)) { ArgsP A = fresh_args(); const Frame Fl = fresh_frame(F); unsigned char* ws = A->ws;
            phase_convert(A, Fl, l, Fl.gw, Fl.NGW, 0, CPARTS);
            if (l == 0) phase_prep(Fl, A->in[I_X], (bf16*)(ws + WS_XN), (float*)(ws + WS_SSP));
            SEAM(); }
        if (IN(1)) { ArgsP A = fresh_args(); const Frame Fl = fresh_frame(F); const int bx = opq_s((int)blockIdx.x); unsigned char* ws = A->ws;
            pg8::Gemm g{(const bf16*)(ws + WS_XN), (const bf16*)(ws + (size_t)(l & 1) * WS_SETD + WS_WGU1), S, NGU, D};
            pg8::StaticOrder So; So.init(S, NGU, Fl.G, bx); epi::fill_rstd_table(So, (const float*)(ws + WS_SSP), (LAS float*)(Fl.lds + RSTD_OFF), Fl.wave); __syncthreads();
            epi::EpiSwiglu E{(bf16*)(ws + WS_HID), (const LAS float*)(Fl.lds + RSTD_OFF)}; GEMM(epi::EpiSwiglu, pg8::StaticOrder); tail_convert(A, Fl, l, bx, (S / 256) * (NGU / 256), 0, 128); SEAM(); }
        if (IN(2)) { ArgsP A = fresh_args(); const Frame Fl = fresh_frame(F); const int bx = opq_s((int)blockIdx.x); unsigned char* ws = A->ws; const float* xin = (l == 0) ? A->in[I_X] : (const float*)(ws + WS_X);
            pg8::Gemm g{(const bf16*)(ws + WS_HID), (const bf16*)(ws + (size_t)(l & 1) * WS_SETD + WS_WD1), S, D, FF}; pg8::StaticOrder So; So.init(S, D, Fl.G, bx);
            epi::EpiResid E{xin, (float*)(ws + WS_X), 0.5f, (bf16*)(ws + WS_XN), (float*)(ws + WS_SSP)}; GEMM(epi::EpiResid, pg8::StaticOrder); SEAM(); }
        if (IN(3)) { ArgsP A = fresh_args(); const Frame Fl = fresh_frame(F); const int bx = opq_s((int)blockIdx.x); unsigned char* ws = A->ws;
            pg8::Gemm g{(const bf16*)(ws + WS_XN), (const bf16*)(ws + (size_t)(l & 1) * WS_SETD + WS_WIN), S, NINP, D};
            pg8::StaticOrder So; So.init(S, NINP, Fl.G, bx); epi::fill_rstd_table(So, (const float*)(ws + WS_SSP), (LAS float*)(Fl.lds + RSTD_OFF), Fl.wave); __syncthreads();
            epi::EpiPin E{(bf16*)(ws + WS_P), (const LAS float*)(Fl.lds + RSTD_OFF)}; GEMM(epi::EpiPin, pg8::StaticOrder); tail_convert(A, Fl, l, bx, (S / 256) * (NINP / 256), 128, 288); SEAM(); }
        if (IN(4)) { ArgsP A = fresh_args(); const Frame Fl = fresh_frame(F); phase_mix1(A, Fl, l); SEAM(); }
        if (IN(5)) { ArgsP A = fresh_args(); const Frame Fl = fresh_frame(F); const int bx = opq_s((int)blockIdx.x); unsigned char* ws = A->ws;
            pg8::Gemm g{(const bf16*)(ws + WS_MLAA), (const bf16*)(ws + (size_t)(l & 1) * WS_SETD + WS_WMLA), S, NMLA, opq_s(512)}; pg8::StaticOrder So; So.init(S, NMLA, Fl.G, bx);
            epi::EpiF32 E{(float*)(ws + WS_MLARAW), NMLA, 1}; GEMM(epi::EpiF32, pg8::StaticOrder); SEAM(); }
        if (IN(6)) { ArgsP A = fresh_args(); const Frame Fl = fresh_frame(F); phase_mix2(A, Fl, l); SEAM(); }
        if (IN(7)) { ArgsP A = fresh_args(); const Frame Fl = fresh_frame(F); phase_mla_flash(A, Fl, l); dil_combine(A, Fl); SEAM(); }
        if (IN(8)) { ArgsP A = fresh_args(); const Frame Fl = fresh_frame(F); phase_mix3(A, Fl); SEAM(); }
        if (IN(9)) { ArgsP A = fresh_args(); const Frame Fl = fresh_frame(F); const int bx = opq_s((int)blockIdx.x); unsigned char* ws = A->ws;
            pg8::Gemm g{(const bf16*)(ws + WS_Z), (const bf16*)(ws + (size_t)(l & 1) * WS_SETD + WS_WBR), 4 * S, 4 * D, opq_s(512)}; epi::BranchOrder So; So.so.init(S, D, Fl.G, bx);
            epi::EpiBranchChain E{(bf16*)(ws + WS_MERGEDB), (const bf16*)(ws + WS_P) + PC_GATE}; GEMM(epi::EpiBranchChain, epi::BranchOrder); SEAM(); }
        if (IN(10)) { ArgsP A = fresh_args(); const Frame Fl = fresh_frame(F); const int bx = opq_s((int)blockIdx.x); unsigned char* ws = A->ws;
            pg8::Gemm g{(const bf16*)(ws + WS_MERGEDB), (const bf16*)(ws + (size_t)(l & 1) * WS_SETD + WS_WOUT), S, D, D}; pg8::StaticOrder So; So.init(S, D, Fl.G, bx);
            epi::EpiResid E{(const float*)(ws + WS_X), (float*)(ws + WS_X), 1.0f, (bf16*)(ws + WS_XN), (float*)(ws + WS_SSP)}; GEMM(epi::EpiResid, pg8::StaticOrder); SEAM(); }
        if (IN(11)) { ArgsP A = fresh_args(); const Frame Fl = fresh_frame(F); const int bx = opq_s((int)blockIdx.x); unsigned char* ws = A->ws;
            pg8::Gemm g{(const bf16*)(ws + WS_XN), (const bf16*)(ws + (size_t)(l & 1) * WS_SETD + WS_WGU2), S, NGU, D};
            pg8::StaticOrder So; So.init(S, NGU, Fl.G, bx); epi::fill_rstd_table(So, (const float*)(ws + WS_SSP), (LAS float*)(Fl.lds + RSTD_OFF), Fl.wave); __syncthreads();
            epi::EpiSwiglu E{(bf16*)(ws + WS_HID), (const LAS float*)(Fl.lds + RSTD_OFF)}; GEMM(epi::EpiSwiglu, pg8::StaticOrder); tail_convert(A, Fl, l, bx, (S / 256) * (NGU / 256), 288, CPARTS); SEAM(); }
        if (IN(12)) { ArgsP A = fresh_args(); const Frame Fl = fresh_frame(F); const int bx = opq_s((int)blockIdx.x); unsigned char* ws = A->ws; const bool lastl = (l == NLAYER - 1);
            pg8::Gemm g{(const bf16*)(ws + WS_HID), (const bf16*)(ws + (size_t)(l & 1) * WS_SETD + WS_WD2), S, D, FF}; pg8::StaticOrder So; So.init(S, D, Fl.G, bx);
            epi::EpiResid E{(const float*)(ws + WS_X), lastl ? A->out : (float*)(ws + WS_X), 0.5f, lastl ? (bf16*)nullptr : (bf16*)(ws + WS_XN), (float*)(ws + WS_SSP)}; GEMM(epi::EpiResid, pg8::StaticOrder);
            SEAM(); }
    }
#undef IN
#undef SEAM
#undef GEMM
}


#ifdef DBG_DUMP_OFF
__global__ void dbg_dump(const unsigned char* ws, float* out, int n) {
    for (int i = blockIdx.x * blockDim.x + threadIdx.x; i < n; i += gridDim.x * blockDim.x) {
        if (i >= DBG_DUMP_N) { out[i] = 0.f; continue; }
#if DBG_DUMP_BF16
        out[i] = __uint_as_float(((unsigned)((const unsigned short*)(ws + DBG_DUMP_OFF))[i]) << 16);
#else
        out[i] = ((const float*)(ws + DBG_DUMP_OFF))[i];
#endif
    }
}
#endif
#ifndef MK_ONE_LAUNCH
#define MK_ONE_LAUNCH 0
#endif
extern "C" void kernel_launch(void* const* d_in, const int* in_sizes, int n_in, void* d_out, int out_size, void* d_ws, size_t ws_size, hipStream_t stream) {
    static int grid = 0;
    if (grid == 0) {
        if (n_in != N_INPUTS || out_size != S * D || ws_size < WS_END) { fprintf(stderr, "kernel_launch: unexpected shapes (n_in %d out %d ws %zu)\n", n_in, out_size, ws_size); grid = -1; return; }
        int dev = 0, cus = 0, per_cu = 0;
        if (hipGetDevice(&dev) != hipSuccess || hipDeviceGetAttribute(&cus, hipDeviceAttributeMultiprocessorCount, dev) != hipSuccess) { grid = -1; return; }
        if (hipFuncSetAttribute((const void*)mk_fwd, hipFuncAttributeMaxDynamicSharedMemorySize, LDS_BYTES) != hipSuccess) { fprintf(stderr, "kernel_launch: hipFuncSetAttribute failed\n"); grid = -1; return; }
        if (hipOccupancyMaxActiveBlocksPerMultiprocessor(&per_cu, (const void*)mk_fwd, NWAVES * 64, LDS_BYTES) != hipSuccess || per_cu < 1) fprintf(stderr, "kernel_launch: occupancy query reports %d\n", per_cu);
        (void)hipGetLastError();
        grid = cus;
    }
    if (grid < 0) return;
    if (hipMemsetAsync((char*)d_ws + WS_CTL, 0, CTL_ZERO_BYTES, stream) != hipSuccess) return;
    Args a{};
    for (int i = 0; i < N_INPUTS; ++i) a.in[i] = (const float*)d_in[i];
    a.out = (float*)d_out; a.ws = (unsigned char*)d_ws;
#if MK_ONE_LAUNCH
    a.l_lo = 0; a.l_hi = NLAYER; a.ph_lo = 0; a.ph_hi = NPHASE;
    hipLaunchKernelGGL(mk_fwd, dim3(grid), dim3(NWAVES * 64), LDS_BYTES, stream, a);
#else
    for (int l = 0; l < NLAYER; ++l)
        for (int ph = 0; ph < NPHASE; ++ph) {
#ifdef DBG_DUMP_OFF
            if (l * NPHASE + ph > DBG_LAST) continue;
#endif
            a.l_lo = l; a.l_hi = l + 1; a.ph_lo = ph; a.ph_hi = ph + 1;
            hipLaunchKernelGGL(mk_fwd, dim3(grid), dim3(NWAVES * 64), LDS_BYTES, stream, a);
#ifdef DUP_MASK
            if ((DUP_MASK >> ph) & 1) hipLaunchKernelGGL(mk_fwd, dim3(grid), dim3(NWAVES * 64), LDS_BYTES, stream, a);
#endif
            }
#ifdef DBG_DUMP_OFF
    hipLaunchKernelGGL(dbg_dump, dim3(2048), dim3(256), 0, stream, (const unsigned char*)d_ws, (float*)d_out, S * D);
#endif
#endif
}
```

```cpp
#define MK_ONE_LAUNCH 1
#define PG8_DMAMOVE 2
#include <hip/hip_runtime.h>
#include <cstdio>
#include <cstdint>
namespace pg8 {
#define PG8_LAS __attribute__((address_space(3)))
typedef unsigned short bf16_t;
typedef short bf16x8 __attribute__((ext_vector_type(8)));
typedef float f32x4 __attribute__((ext_vector_type(4)));
typedef unsigned u32x4 __attribute__((ext_vector_type(4)));
constexpr int BM = 256, BK = 64, HALF = 128, HTB = HALF * BK * 2  , STAGE_BYTES = 8 * HTB, NXCD = 8, WGM = 4;

__host__ __device__ __forceinline__ int lds_byte(int r, int c) { const int st = (r >> 4) * 2 + (c >> 5), rr = r & 15, cc = c & 31, ob = rr * 64 + cc * 2; return st * 1024 + (ob ^ (((ob >> 9) & 1) << 5)); }
__host__ __device__ __forceinline__ void stage_rc(int b, int& R, int& C) { const int st = b / 1024, sb = b % 1024, swz = sb ^ (((sb >> 9) & 1) << 5); R = (st >> 1) * 16 + swz / 64; C = (st & 1) * 32 + (swz % 64) / 2; }
__host__ __device__ __forceinline__ int perm32(int rho) { const int n = rho >> 4, i = rho & 15; return 8 * (i >> 2) + 4 * n + (i & 3); }

struct Unit { int pm, pn; };
struct Gemm { const bf16_t* A; const bf16_t* Bt; int M, N, K; };

struct StaticOrder {
    int nM, nN, nwg, G, c;
    __host__ __device__ void init(int M, int N, int G_, int c_) { nM = M / BM; nN = N / BM; nwg = nM * nN; G = G_; c = c_; }
    __host__ __device__ bool next(int i, Unit& u) const {
        const long L = (long)i * G + c; if (L >= nwg) return false;
        int wgid = (int)L; { const int q = nwg / NXCD, r = nwg % NXCD, xcd = wgid % NXCD, off = wgid / NXCD; wgid = (xcd < r ? xcd * (q + 1) : r * (q + 1) + (xcd - r) * q) + off; }
        const int nig = WGM * nN, gid = wgid / nig, fm = gid * WGM, gsz = (nM - fm) < WGM ? (nM - fm) : WGM;
        u.pm = fm + ((wgid % nig) % gsz); u.pn = (wgid % nig) / gsz; return true;
    }
    __device__ __forceinline__ void a_ready(const Unit&, int  ) const {}
    __device__ __forceinline__ void done(const Unit&) const {}
};
__device__ __forceinline__ unsigned cvt_pk_bf16(float lo, float hi) { unsigned r; asm volatile("v_cvt_pk_bf16_f32 %0, %1, %2" : "=v"(r) : "v"(lo), "v"(hi)); return r; }
typedef float f32x2 __attribute__((ext_vector_type(2)));
__device__ __forceinline__ f32x2 gelu_pk(f32x2 v) {
    const f32x2 av = __builtin_elementwise_abs(v), d = av * 0.2316418882f + 1.0f;
    f32x2 t; t.x = __builtin_amdgcn_rcpf(d.x); t.y = __builtin_amdgcn_rcpf(d.y);
    f32x2 q = t * 0.5307027145f + (-0.7265760135f); q = q * t + 0.7107068705f; q = q * t + (-0.142248368f); q = q * t + 0.127414796f; q = q * t;
    const f32x2 s = (v * v) * (-0.72134752044f);
    f32x2 e; e.x = __builtin_amdgcn_exp2f(s.x); e.y = __builtin_amdgcn_exp2f(s.y);
    const f32x2 m = v * (q * e), r = v - m;
    f32x2 o; o.x = v.x < 0.f ? m.x : r.x; o.y = v.y < 0.f ? m.y : r.y; return o;
}
#ifndef PG8_DMAMOVE
#define PG8_DMAMOVE 0
#endif
template <class Epi, class Sched, bool ALIGN_EPI = false, bool SP2 = false>
__device__ __forceinline__ void gemm_phase(PG8_LAS unsigned char* lds, const Gemm g, const Sched& S, const Epi& E, int wave_in  ) {
    int tid_ = wave_in * 64 + (int)__builtin_amdgcn_mbcnt_hi(~0u, __builtin_amdgcn_mbcnt_lo(~0u, 0u)); asm volatile("" : "+v"(tid_));
    const int tid = tid_, wid = __builtin_amdgcn_readfirstlane(tid >> 6), lane = tid & 63, wr = wid >> 2, wc = wid & 3, fr = lane & 15, fq = lane >> 4;
    const int K = g.K, nt = K / BK;
    unsigned voffA[2], voffB[2];
#pragma unroll
    for (int i = 0; i < 2; ++i) { int R, C; stage_rc(tid * 16 + i * 8192, R, C); const int Rb = Epi::PERM ? ((R & ~31) + perm32(R & 31)) : R;
        voffA[i] = (unsigned)(R * K + C) * 2u; voffB[i] = (unsigned)(Rb * K + C) * 2u; }
    const size_t kstep = (size_t)(BK * 2);
    const size_t hstep = (size_t)HALF * K * 2;
    const size_t tstep = 2 * hstep;
    const unsigned ldsw = (unsigned)wid * 1024u;
    const int aoff = lds_byte(wr * 64 + fr, fq * 8), boff = lds_byte(wc * 32 + fr, fq * 8);
#define PG8_SA(b, h) (((b) * 2 + (h)) * HTB)
#define PG8_SB(b, h) ((4 + (b) * 2 + (h)) * HTB)
#define PG8_STAGE(bufoff, gbase, voff) do { _Pragma("unroll") for (int _i = 0; _i < 2; ++_i) \
        __builtin_amdgcn_global_load_lds((const unsigned*)((const char*)(gbase) + (voff)[_i]), (PG8_LAS unsigned*)(lds + (bufoff) + ldsw + _i * 8192), 16, 0, 0); } while (0)
#define PG8_LDA(dst, b, h) do { _Pragma("unroll") for (int m = 0; m < 4; ++m) _Pragma("unroll") for (int k = 0; k < 2; ++k) dst[m][k] = *(const PG8_LAS bf16x8*)(lds + PG8_SA(b, h) + aoff + m * 2048 + k * 1024); } while (0)
#define PG8_LDB(dst, b, h) do { _Pragma("unroll") for (int n = 0; n < 2; ++n) _Pragma("unroll") for (int k = 0; k < 2; ++k) dst[n][k] = *(const PG8_LAS bf16x8*)(lds + PG8_SB(b, h) + boff + n * 2048 + k * 1024); } while (0)
#define PG8_MMA(ai, bj, At, Bt) do { __builtin_amdgcn_s_setprio(1); _Pragma("unroll") for (int m = 0; m < 4; ++m) _Pragma("unroll") for (int n = 0; n < 2; ++n) _Pragma("unroll") for (int k = 0; k < 2; ++k) \
        acc[ai][bj][m][n] = __builtin_amdgcn_mfma_f32_16x16x32_bf16(Bt[n][k], At[m][k], acc[ai][bj][m][n], 0, 0, 0); __builtin_amdgcn_s_setprio(0); } while (0)
#define PG8_WAIT_V(n) asm volatile("s_waitcnt vmcnt(" #n ")" ::: "memory")
#define PG8_WAIT_L(n) asm volatile("s_waitcnt lgkmcnt(" #n ")" ::: "memory")
#define PG8_BAR __builtin_amdgcn_s_barrier()
#define PG8_SCHED __builtin_amdgcn_sched_barrier(0)
    Unit cur, nxt; int ui = 0;
    if (!S.next(0, cur)) return;
    f32x4 acc[2][2][4][2];
#pragma unroll
    for (int a = 0; a < 2; ++a)
#pragma unroll
        for (int b = 0; b < 2; ++b)
#pragma unroll
            for (int m = 0; m < 4; ++m)
#pragma unroll
                for (int n = 0; n < 2; ++n) acc[a][b][m][n] = (f32x4){0.f, 0.f, 0.f, 0.f};
    bf16x8 At[4][2], B0[2][2], B1[2][2];
    const char* cA = (const char*)g.A + (size_t)cur.pm * tstep; const char* cB = (const char*)g.Bt + (size_t)cur.pn * tstep;
    S.a_ready(cur, 0);
    if constexpr (SP2) {
        PG8_STAGE(PG8_SB(0, 0), cB, voffB); PG8_STAGE(PG8_SB(0, 1), cB + hstep, voffB); PG8_STAGE(PG8_SA(0, 0), cA, voffA); PG8_STAGE(PG8_SA(0, 1), cA + hstep, voffA);
        if (wr == 1) PG8_BAR;
        PG8_WAIT_V(2); PG8_BAR;
        PG8_STAGE(PG8_SB(1, 0), cB + kstep, voffB); PG8_STAGE(PG8_SA(1, 0), cA + kstep, voffA); PG8_STAGE(PG8_SB(1, 1), cB + hstep + kstep, voffB);
        PG8_WAIT_V(6); PG8_BAR;
    } else {
        PG8_STAGE(PG8_SB(0, 0), cB, voffB); PG8_STAGE(PG8_SA(0, 0), cA, voffA); PG8_STAGE(PG8_SB(0, 1), cB + hstep, voffB); PG8_STAGE(PG8_SA(0, 1), cA + hstep, voffA);
        if (wr == 1) PG8_BAR;
        PG8_WAIT_V(4); PG8_BAR;
        PG8_STAGE(PG8_SB(1, 0), cB + kstep, voffB); PG8_STAGE(PG8_SA(1, 0), cA + kstep, voffA); PG8_STAGE(PG8_SB(1, 1), cB + hstep + kstep, voffB);
        PG8_WAIT_V(6); PG8_BAR;
    }
    for (;;) {
        const bool has_next = S.next(ui + 1, nxt);
        const char* nA = has_next ? (const char*)g.A + (size_t)nxt.pm * tstep : cA; const char* nB = has_next ? (const char*)g.Bt + (size_t)nxt.pn * tstep : cB;
        for (int t = 0; t < nt; t += 2) {
            const bool last = (t == nt - 2);
            const char* a1 = cA + (size_t)(t + 1) * kstep;
            const char* a2 = last ? nA : cA + (size_t)(t + 2) * kstep; const char* b2 = last ? nB : cB + (size_t)(t + 2) * kstep;
            const char* a3 = a2 + kstep; const char* b3 = b2 + kstep;
            if (last && has_next) S.a_ready(nxt, ui + 1);
            if constexpr (SP2) {
            PG8_LDB(B0, 0, 0); PG8_LDB(B1, 0, 1); PG8_SCHED; PG8_LDA(At, 0, 0); PG8_STAGE(PG8_SA(1, 1), a1 + hstep, voffA);
            PG8_WAIT_V(8); PG8_WAIT_L(0); PG8_BAR; PG8_MMA(0, 0, At, B0); PG8_MMA(0, 1, At, B1); PG8_BAR; PG8_SCHED;
#if PG8_DMAMOVE
            PG8_LDA(At, 0, 1); PG8_STAGE(PG8_SB(0, 0), b2, voffB); PG8_STAGE(PG8_SB(0, 1), b2 + hstep, voffB);
            PG8_WAIT_V(6); PG8_WAIT_L(0); PG8_BAR; asm volatile("" ::: "memory"); PG8_SCHED;
#if PG8_DMAMOVE == 1
            PG8_MMA(1, 0, At, B0); PG8_SCHED; PG8_STAGE(PG8_SA(0, 0), a2, voffA); PG8_SCHED; PG8_MMA(1, 1, At, B1); PG8_BAR; PG8_SCHED;
#else
            PG8_MMA(1, 0, At, B0); PG8_MMA(1, 1, At, B1); PG8_SCHED; PG8_STAGE(PG8_SA(0, 0), a2, voffA); PG8_BAR; PG8_SCHED;
#endif
#else
            PG8_LDA(At, 0, 1); PG8_STAGE(PG8_SB(0, 0), b2, voffB); PG8_STAGE(PG8_SB(0, 1), b2 + hstep, voffB); PG8_STAGE(PG8_SA(0, 0), a2, voffA);
            PG8_WAIT_V(8); PG8_WAIT_L(0); PG8_BAR; PG8_MMA(1, 0, At, B0); PG8_MMA(1, 1, At, B1); PG8_BAR; PG8_SCHED;
#endif
            PG8_LDB(B0, 1, 0); PG8_LDB(B1, 1, 1); PG8_SCHED; PG8_LDA(At, 1, 0); PG8_STAGE(PG8_SA(0, 1), a2 + hstep, voffA);
            PG8_WAIT_V(8); PG8_WAIT_L(0); PG8_BAR; PG8_MMA(0, 0, At, B0); PG8_MMA(0, 1, At, B1); PG8_BAR; PG8_SCHED;
#if PG8_DMAMOVE
            PG8_LDA(At, 1, 1); PG8_STAGE(PG8_SB(1, 0), b3, voffB); PG8_STAGE(PG8_SB(1, 1), b3 + hstep, voffB);
            PG8_WAIT_V(6); PG8_WAIT_L(0); PG8_BAR; asm volatile("" ::: "memory"); PG8_SCHED;
#if PG8_DMAMOVE == 1
            PG8_MMA(1, 0, At, B0); PG8_SCHED; PG8_STAGE(PG8_SA(1, 0), a3, voffA); PG8_SCHED; PG8_MMA(1, 1, At, B1); PG8_BAR; PG8_SCHED;
#else
            PG8_MMA(1, 0, At, B0); PG8_MMA(1, 1, At, B1); PG8_SCHED; PG8_STAGE(PG8_SA(1, 0), a3, voffA); PG8_BAR; PG8_SCHED;
#endif
#else
            PG8_LDA(At, 1, 1); PG8_STAGE(PG8_SB(1, 0), b3, voffB); PG8_STAGE(PG8_SB(1, 1), b3 + hstep, voffB); PG8_STAGE(PG8_SA(1, 0), a3, voffA);
            PG8_WAIT_V(8); PG8_WAIT_L(0); PG8_BAR; PG8_MMA(1, 0, At, B0); PG8_MMA(1, 1, At, B1); PG8_BAR; PG8_SCHED;
#endif
            } else {
            PG8_LDB(B0, 0, 0); PG8_SCHED; PG8_LDA(At, 0, 0); PG8_STAGE(PG8_SA(1, 1), a1 + hstep, voffA);
            PG8_WAIT_L(8); PG8_BAR; PG8_WAIT_L(0); PG8_MMA(0, 0, At, B0); PG8_BAR; PG8_SCHED;
            PG8_LDB(B1, 0, 1); PG8_STAGE(PG8_SB(0, 0), b2, voffB);
            PG8_BAR; PG8_WAIT_L(0); PG8_MMA(0, 1, At, B1); PG8_BAR;
            PG8_LDA(At, 0, 1); PG8_STAGE(PG8_SA(0, 0), a2, voffA);
            PG8_BAR; PG8_WAIT_L(0); PG8_MMA(1, 0, At, B0); PG8_BAR; PG8_SCHED;
            PG8_STAGE(PG8_SB(0, 1), b2 + hstep, voffB);
            PG8_WAIT_V(6); PG8_BAR; PG8_MMA(1, 1, At, B1); PG8_BAR;
            PG8_LDB(B0, 1, 0); PG8_SCHED; PG8_LDA(At, 1, 0); PG8_STAGE(PG8_SA(0, 1), a2 + hstep, voffA);
            PG8_WAIT_L(8); PG8_BAR; PG8_WAIT_L(0); PG8_MMA(0, 0, At, B0); PG8_BAR; PG8_SCHED;
            PG8_LDB(B1, 1, 1); PG8_STAGE(PG8_SB(1, 0), b3, voffB);
            PG8_BAR; PG8_WAIT_L(0); PG8_MMA(0, 1, At, B1); PG8_BAR;
            PG8_LDA(At, 1, 1); PG8_STAGE(PG8_SA(1, 0), a3, voffA);
            PG8_BAR; PG8_WAIT_L(0); PG8_MMA(1, 0, At, B0); PG8_BAR; PG8_SCHED;
            PG8_STAGE(PG8_SB(1, 1), b3 + hstep, voffB);
            PG8_WAIT_V(6); PG8_BAR; PG8_MMA(1, 1, At, B1); PG8_BAR;
            }
        }
        if constexpr (ALIGN_EPI) { if (wr == 0) PG8_BAR; }
        if constexpr (!Epi::AFTER_DRAIN) { E(acc, cur, wr, wc, fr, fq, ui); S.done(cur); }
        if (!has_next) break;
        if constexpr (!Epi::KEEP_ACC) {
#pragma unroll
        for (int a = 0; a < 2; ++a)
#pragma unroll
            for (int b = 0; b < 2; ++b)
#pragma unroll
                for (int m = 0; m < 4; ++m)
#pragma unroll
                    for (int n = 0; n < 2; ++n) acc[a][b][m][n] = (f32x4){0.f, 0.f, 0.f, 0.f};
        }
        cur = nxt; cA = nA; cB = nB; ++ui;
        if constexpr (ALIGN_EPI) { if (wr == 1) PG8_BAR; }
    }
    PG8_WAIT_V(0);
    if constexpr (!ALIGN_EPI) { if (wr == 0) PG8_BAR; }
    PG8_BAR;
    if constexpr (Epi::AFTER_DRAIN) { E.fused(acc, cur, wr, wc, fr, fq, lds, wid, lane); S.done(cur); }
#undef PG8_SA
#undef PG8_SB
#undef PG8_STAGE
#undef PG8_LDA
#undef PG8_LDB
#undef PG8_MMA
#undef PG8_WAIT_V
#undef PG8_WAIT_L
#undef PG8_BAR
#undef PG8_SCHED
}
}
#define GAS __attribute__((address_space(1)))
#define LAS __attribute__((address_space(3)))
typedef unsigned short bf16;
typedef unsigned v4u __attribute__((ext_vector_type(4)));
typedef float f32x4 __attribute__((ext_vector_type(4)));
typedef short bf16x8 __attribute__((ext_vector_type(8)));
typedef GAS unsigned gu32;
typedef GAS unsigned long long gu64;
#define RLX_AGENT __ATOMIC_RELAXED, __HIP_MEMORY_SCOPE_AGENT
#define LDS_WAIT() asm volatile("s_waitcnt lgkmcnt(0)" ::: "memory")
#define VM_WAIT() asm volatile("s_waitcnt vmcnt(0)" ::: "memory")
__device__ __forceinline__ unsigned long long rt() { return __builtin_amdgcn_s_memrealtime(); }
__device__ __forceinline__ unsigned f2bf(float f) { unsigned u = __builtin_bit_cast(unsigned, f); return (u + 0x7fffu + ((u >> 16) & 1u)) >> 16; }
__device__ __forceinline__ unsigned pk2(float lo, float hi) { return f2bf(lo) | (f2bf(hi) << 16); }
#define XB_TMO      128
#define XB_XCNT(j)  (256  + 64 * (j))
#define XB_XSUB(j)  (1280 + 64 * (j))
#define XB_XGEN(j)  (2304 + 64 * (j))
#define XB_TOP      3328
#define XB_TOPGEN   3392
#define XCD_BAR_WORDS 3456
#define XB_SPIN_CAP (1u << 18)

__device__ __forceinline__ unsigned xb_ld(unsigned* p)              { return __hip_atomic_load(p, __ATOMIC_RELAXED, __HIP_MEMORY_SCOPE_AGENT); }
__device__ __forceinline__ unsigned xb_add(unsigned* p, unsigned v) { return __hip_atomic_fetch_add(p, v, __ATOMIC_RELAXED, __HIP_MEMORY_SCOPE_AGENT); }
__device__ __forceinline__ unsigned xb_xcc_id() { return (unsigned)__builtin_amdgcn_s_getreg((3 << 11) | 20) & 0xFu; }
#define XB_SPIN(cond, bar) do { unsigned _sp = 0; while (cond) { __builtin_amdgcn_s_sleep(1); \
    if ((++_sp & 255u) == 0u) { if (xb_ld(&(bar)[XB_TMO])) break; if (_sp > XB_SPIN_CAP) { atomicAdd(&(bar)[XB_TMO], 1u); break; } } } } while (0)

struct XcdBarrier {
    unsigned* bar; unsigned x;
    volatile LAS unsigned* st;
};

__device__ __forceinline__ XcdBarrier xcd_barrier_post(unsigned* bar, volatile LAS unsigned* st) {
    XcdBarrier b; b.bar = bar; b.x = xb_xcc_id(); b.st = st;
    if (threadIdx.x == 0) (void)xb_add(&bar[XB_XCNT(b.x)], 1u);
    return b;
}
__device__ __forceinline__ void xcd_barrier_complete(unsigned* bar, unsigned x, unsigned& nloc, unsigned& nx) {
    const unsigned G = gridDim.x * gridDim.y * gridDim.z;
    unsigned sum, cnt, mine, sp = 0u;
    for (;;) {
        sum = 0u; cnt = 0u; mine = 0u;
#pragma unroll
        for (unsigned j = 0; j < 16; ++j) { const unsigned c = xb_ld(&bar[XB_XCNT(j)]); sum += c; cnt += (c > 0u) ? 1u : 0u; mine = (j == x) ? c : mine; }
        if (sum == G) break;
        __builtin_amdgcn_s_sleep(1);
        if ((++sp & 255u) == 0u) { if (xb_ld(&bar[XB_TMO])) break; if (sp > XB_SPIN_CAP) { atomicAdd(&bar[XB_TMO], 1u); break; } }
    }
    nloc = mine > 0u ? mine : 1u; nx = cnt > 0u ? cnt : 1u;
}

__device__ __forceinline__ void xcd_barrier(const XcdBarrier& b) {
    asm volatile("s_waitcnt vmcnt(0)" ::: "memory");
    __syncthreads();
    if (threadIdx.x == 0) {
        unsigned* bar = b.bar;
        __builtin_amdgcn_s_waitcnt(0);
        unsigned nloc = b.st[0], nx = b.st[1];
        if (nloc == 0u) { xcd_barrier_complete(bar, b.x, nloc, nx); b.st[0] = nloc; b.st[1] = nx; }
        const unsigned old = xb_add(&bar[XB_XSUB(b.x)], 1u);
        const unsigned gen = old / nloc;
        if (old + 1u == (gen + 1u) * nloc) {
            __builtin_amdgcn_fence(__ATOMIC_RELEASE, "agent");
            asm volatile("s_waitcnt vmcnt(0)" ::: "memory");
            const unsigned og = xb_add(&bar[XB_TOP], 1u);
            const unsigned tg = og / nx;
            if (og + 1u == (tg + 1u) * nx) xb_add(&bar[XB_TOPGEN], 1u);
            else XB_SPIN(xb_ld(&bar[XB_TOPGEN]) == tg, bar);
            __builtin_amdgcn_fence(__ATOMIC_ACQUIRE, "agent");
            xb_add(&bar[XB_XGEN(b.x)], 1u);
            asm volatile("s_waitcnt vmcnt(0)" ::: "memory");
        } else {
            XB_SPIN(xb_ld(&bar[XB_XGEN(b.x)]) == gen, bar);
            __builtin_amdgcn_fence(__ATOMIC_ACQUIRE, "agent");
            asm volatile("s_waitcnt vmcnt(0)" ::: "memory");
        }
    }
    __syncthreads();
}
constexpr int S = 8192, D = 2048, FF = 5632, NLAYER = 4;
constexpr int NIN = 14912, NINP = 15104;
constexpr int NGU = 2 * FF;
constexpr float EPS = 1e-6f;
constexpr int PC_GATE = 0, PC_POOL = 8192, PC_DIL = 8704, PC_SGU = 13312, PC_CQ = 14336, PC_CKV = 14720, PC_KR = 14848;
constexpr int NMLA = 1792;

namespace epi {
using pg8::f32x4; using pg8::u32x4; using pg8::Unit; using pg8::bf16_t;
typedef float f32x2_t __attribute__((ext_vector_type(2))); typedef __bf16 bf16x2_t __attribute__((ext_vector_type(2)));
__device__ __forceinline__ unsigned cvt_pk_bf16(float lo, float hi) { f32x2_t v = {lo, hi}; bf16x2_t b = __builtin_convertvector(v, bf16x2_t); return __builtin_bit_cast(unsigned, b); }
constexpr int BM = 256, HALF = 128;
typedef unsigned u32x2 __attribute__((ext_vector_type(2)));
__device__ __forceinline__ float fast_exp(float x) { return __builtin_amdgcn_exp2f(x * 1.44269504089f); }
__device__ __forceinline__ float sigmoid_f(float x) { return __builtin_amdgcn_rcpf(1.0f + fast_exp(-x)); }

struct EpiSwiglu {
    static constexpr bool PERM = true, AFTER_DRAIN = false, KEEP_ACC = false;
    bf16_t* H; const __attribute__((address_space(3))) float* tab;
    __device__ __forceinline__ void operator()(const f32x4 (&acc)[2][2][4][2], const Unit& u, int wr, int wc, int fr, int fq, int ui) const {
        const int row0 = u.pm * BM + wr * 64 + fr, col0 = u.pn * HALF + wc * 32 + 8 * fq; const __attribute__((address_space(3))) float* tb = tab + ui * 256 + wr * 64 + fr;
#pragma unroll
        for (int ai = 0; ai < 2; ++ai)
#pragma unroll
            for (int m = 0; m < 4; ++m) {
                bf16_t* rowp = H + (size_t)(row0 + ai * HALF + m * 16) * FF + col0; const float rs = tb[ai * HALF + m * 16];
                float o[8];
#pragma unroll
                for (int n = 0; n < 2; ++n)
#pragma unroll
                    for (int j = 0; j < 4; ++j) { const float g = acc[ai][0][m][n][j] * rs, up = acc[ai][1][m][n][j] * rs; o[n * 4 + j] = g * sigmoid_f(g) * up; }
                u32x4 w; w.x = cvt_pk_bf16(o[0], o[1]); w.y = cvt_pk_bf16(o[2], o[3]); w.z = cvt_pk_bf16(o[4], o[5]); w.w = cvt_pk_bf16(o[6], o[7]);
                *(u32x4*)rowp = w;
                asm volatile("" ::: "memory");
            }
    }
};
struct EpiResid {
    static constexpr bool PERM = false, AFTER_DRAIN = false, KEEP_ACC = false;
    const float* base; float* out; float alpha; bf16_t* xb; float* ssp;
    __device__ __forceinline__ void operator()(const f32x4 (&acc)[2][2][4][2], const Unit& u, int wr, int wc, int fr, int fq, int ui) const {
        const int row0 = u.pm * BM + wr * 64 + fr, col0 = u.pn * BM + wc * 32 + 4 * fq;
#pragma unroll
        for (int ai = 0; ai < 2; ++ai)
#pragma unroll
            for (int m = 0; m < 4; ++m) { const int r = row0 + ai * HALF + m * 16; const size_t off = (size_t)r * D + col0; float s = 0.f;
#pragma unroll
                for (int bj = 0; bj < 2; ++bj)
#pragma unroll
                    for (int n = 0; n < 2; ++n) { const f32x4 b = *(const f32x4*)(base + off + bj * HALF + n * 16); const f32x4 v = b + acc[ai][bj][m][n] * alpha;
                        *(f32x4*)(out + off + bj * HALF + n * 16) = v;
                        if (xb) { s += (v[0] * v[0] + v[1] * v[1]) + (v[2] * v[2] + v[3] * v[3]); u32x2 w; w.x = cvt_pk_bf16(v[0], v[1]); w.y = cvt_pk_bf16(v[2], v[3]); *(u32x2*)(xb + off + bj * HALF + n * 16) = w; } }
                if (xb) { s += __shfl_xor(s, 16); s += __shfl_xor(s, 32); if (fq == 0) ssp[(size_t)r * 32 + u.pn * 4 + wc] = s; }
                asm volatile("" ::: "memory"); }
    }
};
struct EpiPin {
    static constexpr bool PERM = true, AFTER_DRAIN = false, KEEP_ACC = false;
    bf16_t* P; const __attribute__((address_space(3))) float* tab;
    template <int KIND> __device__ __forceinline__ void run(const f32x4 (&acc)[2][2][4][2], const Unit& u, int wr, int wc, int fr, int fq, int ui) const {
        const __attribute__((address_space(3))) float* tb = tab + ui * 256 + wr * 64 + fr;
        const int row0 = u.pm * BM + wr * 64 + fr, col0 = u.pn * BM + wc * 32 + 8 * fq;
#pragma unroll
        for (int ai = 0; ai < 2; ++ai)
#pragma unroll
            for (int m = 0; m < 4; ++m) { bf16_t* rowp = P + (size_t)(row0 + ai * HALF + m * 16) * NINP + col0; const float rs = tb[ai * HALF + m * 16];
#pragma unroll
                for (int bj = 0; bj < 2; ++bj) { float o[8];
#pragma unroll
                    for (int n = 0; n < 2; ++n)
#pragma unroll
                        for (int j = 0; j < 4; ++j) { const float x = acc[ai][bj][m][n][j] * rs;
                            o[n * 4 + j] = (KIND == 0) ? x : ((KIND == 1) ? sigmoid_f(x) : x * sigmoid_f(1.5957691216f * (x + 0.044715f * x * x * x))); }
                    u32x4 w; w.x = cvt_pk_bf16(o[0], o[1]); w.y = cvt_pk_bf16(o[2], o[3]); w.z = cvt_pk_bf16(o[4], o[5]); w.w = cvt_pk_bf16(o[6], o[7]);
                    *(u32x4*)(rowp + bj * HALF) = w; }
                asm volatile("" ::: "memory"); }
    }
    __device__ __forceinline__ void operator()(const f32x4 (&acc)[2][2][4][2], const Unit& u, int wr, int wc, int fr, int fq, int ui) const {
        if (u.pn < 32) run<1>(acc, u, wr, wc, fr, fq, ui); else if (u.pn >= 52 && u.pn < 56) run<2>(acc, u, wr, wc, fr, fq, ui); else run<0>(acc, u, wr, wc, fr, fq, ui);
    }
};
struct EpiF32 {
    static constexpr bool PERM = false, AFTER_DRAIN = false, KEEP_ACC = false;
    float* C; int ldc; int colmul;
    __device__ __forceinline__ void operator()(const f32x4 (&acc)[2][2][4][2], const Unit& u, int wr, int wc, int fr, int fq, int ui) const {
        const int row0 = u.pm * BM + wr * 64 + fr, col0 = colmul * u.pn * BM + wc * 32 + 4 * fq;
#pragma unroll
        for (int ai = 0; ai < 2; ++ai)
#pragma unroll
            for (int m = 0; m < 4; ++m) { float* rowp = C + (size_t)(row0 + ai * HALF + m * 16) * ldc + col0;
#pragma unroll
                for (int bj = 0; bj < 2; ++bj)
#pragma unroll
                    for (int n = 0; n < 2; ++n) *(f32x4*)(rowp + bj * HALF + n * 16) = acc[ai][bj][m][n]; }
    }
};
struct EpiExp {
    static constexpr bool PERM = true, AFTER_DRAIN = false, KEEP_ACC = false;
    bf16_t* P;
    __device__ __forceinline__ void operator()(const f32x4 (&acc)[2][2][4][2], const Unit& u, int wr, int wc, int fr, int fq, int ui) const {
        const int row0 = u.pm * BM + wr * 64 + fr, col0 = (u.pn & 31) * BM + wc * 32 + 8 * fq;
#pragma unroll
        for (int ai = 0; ai < 2; ++ai)
#pragma unroll
            for (int m = 0; m < 4; ++m) { bf16_t* rowp = P + (size_t)(row0 + ai * HALF + m * 16) * S + col0;
#pragma unroll
                for (int bj = 0; bj < 2; ++bj) { float o[8];
#pragma unroll
                    for (int n = 0; n < 2; ++n)
#pragma unroll
                        for (int j = 0; j < 4; ++j) o[n * 4 + j] =
#ifdef DBG_NOEXP
                            acc[ai][bj][m][n][j];
#else
                            fast_exp(acc[ai][bj][m][n][j]);
#endif
                    u32x4 w; w.x = cvt_pk_bf16(o[0], o[1]); w.y = cvt_pk_bf16(o[2], o[3]); w.z = cvt_pk_bf16(o[4], o[5]); w.w = cvt_pk_bf16(o[6], o[7]);
                    *(u32x4*)(rowp + bj * HALF) = w; }
                asm volatile("" ::: "memory"); }
    }
};
struct EpiBranch {
    static constexpr bool PERM = false, AFTER_DRAIN = false, KEEP_ACC = false;
    float* merged; bf16_t* mergedb; const bf16_t* gate; int b;
    __device__ __forceinline__ void operator()(const f32x4 (&acc)[2][2][4][2], const Unit& u, int wr, int wc, int fr, int fq, int ui) const {
        const int row0 = u.pm * BM + wr * 64 + fr, col0 = u.pn * BM + wc * 32 + 4 * fq;
#pragma unroll
        for (int ai = 0; ai < 2; ++ai)
#pragma unroll
            for (int m = 0; m < 4; ++m) { const int r = row0 + ai * HALF + m * 16;
#pragma unroll
                for (int bj = 0; bj < 2; ++bj)
#pragma unroll
                    for (int n = 0; n < 2; ++n) { const int c = col0 + bj * HALF + n * 16;
                        const u32x2 gv = *(const u32x2*)(gate + (size_t)r * NINP + c);
                        f32x4 g; g[0] = __uint_as_float(gv.x << 16); g[1] = __uint_as_float(gv.x & 0xffff0000u); g[2] = __uint_as_float(gv.y << 16); g[3] = __uint_as_float(gv.y & 0xffff0000u);
                        f32x4 v = acc[ai][bj][m][n] * g;
                        float* mp = merged + (size_t)r * D + c;
                        if (b != 0) v += *(const f32x4*)mp;
                        if (b != 3) *(f32x4*)mp = v;
                        else { u32x2 w; w.x = cvt_pk_bf16(v[0], v[1]); w.y = cvt_pk_bf16(v[2], v[3]); *(u32x2*)(mergedb + (size_t)r * D + c) = w; } }
                asm volatile("" ::: "memory"); }
    }
};
struct QKOrder {
    int G, c;
    __device__ bool next(int i, Unit& u) const { const int L = i * G + c; if (L >= 4096) return false; const int h = L >> 10, rem = L & 1023; u.pm = h * 32 + (rem >> 5); u.pn = h * 32 + (rem & 31); return true; }
    __device__ __forceinline__ void a_ready(const Unit&, int) const {}
    __device__ __forceinline__ void done(const Unit&) const {}
};
struct PVOrder {
    int G, c;
    __device__ bool next(int i, Unit& u) const { const int L = i * G + c; if (L >= 128) return false; u.pm = L; u.pn = L >> 5; return true; }
    __device__ __forceinline__ void a_ready(const Unit&, int) const {}
    __device__ __forceinline__ void done(const Unit&) const {}
};
struct EpiBranchChain {
    static constexpr bool PERM = true, AFTER_DRAIN = false, KEEP_ACC = true;
    bf16_t* mergedb; const bf16_t* gate;
    __device__ __forceinline__ void operator()(f32x4 (&acc)[2][2][4][2], const Unit& u, int wr, int wc, int fr, int fq, int ui) const {
        const int b = u.pm >> 5, pm0 = u.pm & 31, pn0 = u.pn & 7;
        const int row0 = pm0 * BM + wr * 64 + fr, col0 = pn0 * BM + wc * 32 + 8 * fq;
#pragma unroll
        for (int ai = 0; ai < 2; ++ai)
#pragma unroll
            for (int m = 0; m < 4; ++m) { const int r = row0 + ai * HALF + m * 16;
#pragma unroll
                for (int bj = 0; bj < 2; ++bj) { const int c = col0 + bj * HALF;
                    const u32x4 gv = *(const u32x4*)(gate + (size_t)r * NINP + b * D + c);
                    float g[8] = {__uint_as_float(gv.x << 16), __uint_as_float(gv.x & 0xffff0000u), __uint_as_float(gv.y << 16), __uint_as_float(gv.y & 0xffff0000u),
                                  __uint_as_float(gv.z << 16), __uint_as_float(gv.z & 0xffff0000u), __uint_as_float(gv.w << 16), __uint_as_float(gv.w & 0xffff0000u)};
                    if (b != 3) {
                        const u32x4 hv = *(const u32x4*)(gate + (size_t)r * NINP + (b + 1) * D + c);
                        const float gn[8] = {__uint_as_float(hv.x << 16), __uint_as_float(hv.x & 0xffff0000u), __uint_as_float(hv.y << 16), __uint_as_float(hv.y & 0xffff0000u),
                                             __uint_as_float(hv.z << 16), __uint_as_float(hv.z & 0xffff0000u), __uint_as_float(hv.w << 16), __uint_as_float(hv.w & 0xffff0000u)};
#pragma unroll
                        for (int n = 0; n < 2; ++n)
#pragma unroll
                            for (int j = 0; j < 4; ++j) acc[ai][bj][m][n][j] *= fmaxf(g[n * 4 + j], 1e-30f) * __builtin_amdgcn_rcpf(fmaxf(gn[n * 4 + j], 1e-30f));
                    } else {
                        float o[8];
#pragma unroll
                        for (int n = 0; n < 2; ++n)
#pragma unroll
                            for (int j = 0; j < 4; ++j) o[n * 4 + j] = acc[ai][bj][m][n][j] * fmaxf(g[n * 4 + j], 1e-30f);
                        u32x4 w; w.x = cvt_pk_bf16(o[0], o[1]); w.y = cvt_pk_bf16(o[2], o[3]); w.z = cvt_pk_bf16(o[4], o[5]); w.w = cvt_pk_bf16(o[6], o[7]);
                        *(u32x4*)(mergedb + (size_t)r * D + c) = w;
                    } }
                asm volatile("" ::: "memory"); }
    }
};
template <class Sched> __device__ __forceinline__ void fill_rstd_table(const Sched& So, const float* ssp, __attribute__((address_space(3))) float* tab, int wave) {
    int t_ = wave * 64 + (int)__builtin_amdgcn_mbcnt_hi(~0u, __builtin_amdgcn_mbcnt_lo(~0u, 0u)); asm volatile("" : "+v"(t_));
    const int t = t_, row = t >> 1, half = t & 1;
#pragma unroll 1
    for (int ui = 0; ui < 8; ++ui) { Unit u; if (!So.next(ui, u)) break;
        const f32x4* p = (const f32x4*)(ssp + (size_t)(u.pm * BM + row) * 32 + half * 16); const f32x4 a = p[0], b = p[1], c = p[2], d = p[3];
        float s = (((a[0] + a[1]) + (a[2] + a[3])) + ((b[0] + b[1]) + (b[2] + b[3]))) + (((c[0] + c[1]) + (c[2] + c[3])) + ((d[0] + d[1]) + (d[2] + d[3])));
        s += __shfl_xor(s, 1);
        if (half == 0) tab[ui * 256 + row] = 1.0f / sqrtf(s * (1.0f / D) + EPS); }
}
struct BranchOrder {
    pg8::StaticOrder so;
    __device__ bool next(int i, Unit& u) const { if (i >= 4) return false; Unit t; if (!so.next(0, t)) return false; u.pm = i * 32 + t.pm; u.pn = i * 8 + t.pn; return true; }
    __device__ __forceinline__ void a_ready(const Unit&, int) const {}
    __device__ __forceinline__ void done(const Unit&) const {}
};
}
constexpr size_t MiB = 1u << 20;
constexpr size_t WS_CTL = 0, CTL_ZERO_BYTES = 1 * MiB;
constexpr size_t WS_COS = 1 * MiB, WS_SIN = 2 * MiB, WS_SSP = 3 * MiB;
constexpr size_t WS_WGU1 = 4 * MiB, WS_WD1 = 48 * MiB, WS_WGU2 = 70 * MiB, WS_WD2 = 114 * MiB;
constexpr size_t WS_WIN = 136 * MiB, WS_WBR = 195 * MiB, WS_WOUT = 203 * MiB, WS_WMLA = 211 * MiB;
constexpr size_t WS_X = 214 * MiB;
constexpr size_t WS_XN = 278 * MiB;
constexpr size_t WS_HID = 310 * MiB;
constexpr size_t WS_P = 398 * MiB;
constexpr size_t WS_Z = 634 * MiB;
constexpr size_t WS_VVN = 666 * MiB, WS_MLAA = 674 * MiB;
constexpr size_t WS_MLARAW = 682 * MiB;
constexpr size_t WS_QP = 1426 * MiB, WS_KP = 1458 * MiB, WS_VT = 770 * MiB;
constexpr int QKP = 256;
constexpr size_t WS_ORAW = 786 * MiB;
constexpr size_t WS_MERGED = 818 * MiB, WS_MERGEDB = 882 * MiB;
constexpr size_t WS_PEXP = 914 * MiB;
constexpr size_t WS_DILO = 1490 * MiB, WS_DILL = 1540 * MiB;
constexpr size_t WS_MQ = WS_QP, WS_MK = WS_KP, WS_MV = WS_VT, WS_MOP = WS_PEXP, WS_MLP = WS_ORAW;
constexpr size_t WS_END = 1541 * MiB;
static_assert(WS_WGU1 + (size_t)NGU * D * 2 <= WS_WD1 && WS_WD1 + (size_t)D * FF * 2 <= WS_WGU2 && WS_WGU2 + (size_t)NGU * D * 2 <= WS_WD2 && WS_WD2 + (size_t)D * FF * 2 <= WS_WIN, "ws map 1");
static_assert(WS_WIN + (size_t)NINP * D * 2 <= WS_WBR && WS_WBR + (size_t)4 * D * 512 * 2 <= WS_WOUT && WS_WOUT + (size_t)D * D * 2 <= WS_WMLA && WS_WMLA + (size_t)NMLA * 512 * 2 <= WS_X, "ws map 2");
static_assert(WS_X + (size_t)S * D * 4 <= WS_XN && WS_XN + (size_t)S * D * 2 <= WS_HID && WS_HID + (size_t)S * FF * 2 <= WS_P && WS_P + (size_t)S * NINP * 2 <= WS_Z, "ws map 3");
static_assert(WS_Z + (size_t)4 * S * 512 * 2 <= WS_VVN && WS_MLARAW + (size_t)S * NMLA * 4 <= WS_VT && WS_KP + (size_t)4 * S * QKP * 2 <= WS_END && WS_ORAW + (size_t)4 * S * 256 * 4 <= WS_MERGED && WS_MERGED + (size_t)S * D * 4 <= WS_MERGEDB && WS_MERGEDB + (size_t)S * D * 2 <= WS_PEXP && WS_PEXP + (size_t)4 * S * S * 2 <= WS_QP, "ws map 4");
constexpr size_t WS_SETD = 956 * MiB;
static_assert(WS_WGU1 + WS_SETD >= WS_PEXP + (size_t)2 * 4 * S * 128 * 4 && WS_X + WS_SETD <= WS_QP, "second weight set");
#ifndef TAILCONV
#define TAILCONV 0
#endif
constexpr int CPARTS = 416;
constexpr int CW_BAR = 4096;

constexpr int NWAVES = 8;
constexpr int RING_OFF = 0, RING_BYTES = 131072;
constexpr int LDSCTL_OFF = RING_BYTES, MISC_OFF = LDSCTL_OFF + 320;
constexpr int LDS_BYTES = 147456;
constexpr int RSTD_OFF = RING_BYTES + 1024;

enum { I_X = 0, I_F1N, I_F1G, I_F1U, I_F1D, I_MIXN, I_WIN, I_POOLW, I_POOLS, I_DQN, I_DKN, I_SGUN, I_SGUW, I_SGUB, I_MQAN, I_MWUQ, I_MKVAN, I_MWUKV, I_MQN, I_MKN, I_WBR, I_WOUT, I_F2N, I_F2G, I_F2U, I_F2D, N_INPUTS };

struct Frame {
    LAS unsigned char* lds;
    volatile LAS unsigned* MISC;
    int wave, vcu, G;
    int gw, NGW, NGT;
};
constexpr int NPHASE = 13;
struct Args { const float* in[N_INPUTS]; float* out; unsigned char* ws; int l_lo, l_hi, ph_lo, ph_hi; };
typedef const __attribute__((address_space(4))) Args* ArgsP;
__device__ __forceinline__ ArgsP fresh_args() { ArgsP p = (ArgsP)__builtin_amdgcn_kernarg_segment_ptr(); asm volatile("" : "+s"(p)); return p; }
__device__ __forceinline__ int opq_s(int x) { asm volatile("" : "+s"(x)); return x; }
__device__ __forceinline__ Frame fresh_frame(const Frame& F) { Frame R = F; R.wave = opq_s(F.wave); R.vcu = opq_s(F.vcu); R.G = opq_s(F.G); R.gw = opq_s(F.gw); R.NGW = opq_s(F.NGW); R.NGT = opq_s(F.NGT); return R; }
__device__ __forceinline__ int opq_lane() { int l = (int)__builtin_amdgcn_mbcnt_hi(~0u, __builtin_amdgcn_mbcnt_lo(~0u, 0u)); asm volatile("" : "+v"(l)); return l; }
__device__ __forceinline__ float wave_sum(float v) {
#pragma unroll
    for (int o = 1; o < 64; o <<= 1) v += __shfl_xor(v, o);
    return v;
}
__device__ __forceinline__ float wave_max(float v) {
#pragma unroll
    for (int o = 1; o < 64; o <<= 1) v = fmaxf(v, __shfl_xor(v, o));
    return v;
}
__device__ __forceinline__ float bf2f(unsigned short b) { return __uint_as_float(((unsigned)b) << 16); }
__device__ __forceinline__ float bflo(unsigned u) { return __uint_as_float(u << 16); }
__device__ __forceinline__ float bfhi(unsigned u) { return __uint_as_float(u & 0xffff0000u); }
__device__ __forceinline__ float rsq(float x) { return 1.0f / sqrtf(x); }

__device__ __forceinline__ void transpose_load(f32x4 (&v)[8], const float* W, int ldw, int k0, int n0, int lane) {
    const int pc = lane & 7, kr = lane >> 3;
#pragma unroll
    for (int i = 0; i < 8; ++i) v[i] = __builtin_nontemporal_load((const GAS f32x4*)(W + (size_t)(k0 + 8 * i + kr) * ldw + n0 + 4 * pc));
}
__device__ __forceinline__ void transpose_store(const f32x4 (&v)[8], int k0, bf16* WT, int ldt, int drow0, int dk0, LAS float* scr, int lane, const float* kgain) {
    const int pc = lane & 7, kr = lane >> 3;
#pragma unroll
    for (int i = 0; i < 8; ++i) { LAS float* d = scr + (8 * i + kr) * 33 + 4 * pc; const float gk = kgain ? kgain[k0 + 8 * i + kr] : 1.0f;
        d[0] = v[i].x * gk; d[1] = v[i].y * gk; d[2] = v[i].z * gk; d[3] = v[i].w * gk; }
    LDS_WAIT(); asm volatile("" ::: "memory");
    const int c = lane & 7;
#pragma unroll
    for (int j = 0; j < 4; ++j) { const int n = (lane >> 3) + 8 * j; const LAS float* s = scr + (8 * c) * 33 + n;
        v4u o; o.x = pk2(s[0 * 33], s[1 * 33]); o.y = pk2(s[2 * 33], s[3 * 33]); o.z = pk2(s[4 * 33], s[5 * 33]); o.w = pk2(s[6 * 33], s[7 * 33]);
        *(GAS v4u*)(WT + (size_t)(drow0 + n) * ldt + dk0 + k0 + 8 * c) = o; }
    LDS_WAIT(); asm volatile("" ::: "memory");
}
template <int MAP> __device__ __forceinline__ int map_row(int n0, int roff) {
    if (MAP == 0) return n0 + roff;
    if (MAP == 1) return (n0 >> 7) * 256 + roff + (n0 & 127);
    return (n0 < 6720) ? (n0 + 8192) : (n0 - 6720);
}
template <int MAP> __device__ __forceinline__ void transpose_matrix(const Frame& F, int vgw, int vNGW, int p0, int p1, int lane, const float* W, int K, int N, bf16* WT, int ldt, int roff, int dk0, const float* kgain = nullptr) {
    LAS float* scr = (LAS float*)(F.lds + RING_OFF + (vgw & 7) * 16384);
    const int nblk = N / 32, items = (K / 64) * nblk, lo = (int)((long)items * p0 / CPARTS), hi = (int)((long)items * p1 / CPARTS);
    int it = lo + vgw; if (it >= hi) return;
    f32x4 va[8], vb[8]; transpose_load(va, W, N, 64 * (it / nblk), 32 * (it % nblk), lane);
    for (;;) {
        const int itn = it + vNGW; const bool more = itn < hi;
        if (more) transpose_load(vb, W, N, 64 * (itn / nblk), 32 * (itn % nblk), lane);
        transpose_store(va, 64 * (it / nblk), WT, ldt, map_row<MAP>(32 * (it % nblk), roff), dk0, scr, lane, kgain);
        if (!more) break;
#pragma unroll
        for (int i = 0; i < 8; ++i) va[i] = vb[i];
        it = itn;
    }
}

__device__ __forceinline__ void phase_convert(ArgsP A, const Frame& F, int l, int vgw, int vNGW, int p0, int p1) {
    unsigned char* ws = A->ws + (size_t)(l & 1) * WS_SETD; const int lane = opq_lane(); const int vgt = vgw * 64 + lane, vNGT = vNGW * 64;
#define TM(MAP, ...) transpose_matrix<MAP>(F, vgw, vNGW, p0, p1, lane, __VA_ARGS__)
#define PART(n, lo, hi) const int lo = (int)((long)(n) * p0 / CPARTS), hi = (int)((long)(n) * p1 / CPARTS)
    TM(0, A->in[I_F2D] + (size_t)l * FF * D, FF, D, (bf16*)(ws + WS_WD2), FF, 0, 0);
    TM(1, A->in[I_F2G] + (size_t)l * D * FF, D, FF, (bf16*)(ws + WS_WGU2), D, 0, 0, A->in[I_F2N] + (size_t)l * D);
    TM(1, A->in[I_F2U] + (size_t)l * D * FF, D, FF, (bf16*)(ws + WS_WGU2), D, 128, 0, A->in[I_F2N] + (size_t)l * D);
    TM(0, A->in[I_WOUT] + (size_t)l * D * D, D, D, (bf16*)(ws + WS_WOUT), D, 0, 0);
    for (int b = 1; b < 4; ++b) TM(0, A->in[I_WBR] + ((size_t)l * 4 + b) * 512 * D, 512, D, (bf16*)(ws + WS_WBR) + (size_t)b * D * 512, 512, 0, 0);
    TM(0, A->in[I_MWUQ] + (size_t)l * 384 * 768, 384, 768, (bf16*)(ws + WS_WMLA), 512, 0, 0);
    TM(0, A->in[I_MWUKV] + (size_t)l * 128 * 1024, 128, 1024, (bf16*)(ws + WS_WMLA), 512, 768, 384);
    TM(2, A->in[I_WIN] + (size_t)l * D * NIN, D, NIN, (bf16*)(ws + WS_WIN), D, 0, 0, A->in[I_MIXN] + (size_t)l * D);
    TM(0, A->in[I_F1D] + (size_t)l * FF * D, FF, D, (bf16*)(ws + WS_WD1), FF, 0, 0);
    TM(1, A->in[I_F1G] + (size_t)l * D * FF, D, FF, (bf16*)(ws + WS_WGU1), D, 0, 0, A->in[I_F1N] + (size_t)l * D);
    TM(1, A->in[I_F1U] + (size_t)l * D * FF, D, FF, (bf16*)(ws + WS_WGU1), D, 128, 0, A->in[I_F1N] + (size_t)l * D);
    { bf16* wm = (bf16*)(ws + WS_WMLA);
      { PART(768 * 128, lo, hi); for (int i = lo + vgt; i < hi; i += vNGT) wm[(size_t)(i >> 7) * 512 + 384 + (i & 127)] = 0; }
      { PART(1024 * 384, lo, hi); for (int i = lo + vgt; i < hi; i += vNGT) wm[(size_t)(768 + i / 384) * 512 + (i % 384)] = 0; }
      unsigned* wz = (unsigned*)((bf16*)(ws + WS_WIN) + (size_t)NIN * D);
      { PART((NINP - NIN) * D / 2, lo, hi); for (int i = lo + vgt; i < hi; i += vNGT) wz[i] = 0u; } }
    { const float* pw = A->in[I_POOLW] + (size_t)l * 4 * 128 * 128; const float* ps = A->in[I_POOLS] + (size_t)l * 512; const float* wb = A->in[I_WBR] + (size_t)l * 4 * 512 * D;
      bf16* wt = (bf16*)(ws + WS_WBR);
      PART(128 * D, lo, hi);
      for (int i = lo + vgt; i < hi; i += vNGT) { const int r4 = (i >> 11) * 4, n = i & (D - 1), g = r4 >> 7;
          const float* pr = pw + (size_t)r4 * 128; const float* wcol = wb + (size_t)(g * 128) * D + n; const float* psg = ps + g * 128;
          float a0 = 0.f, a1 = 0.f, a2 = 0.f, a3 = 0.f;
#pragma unroll 8
          for (int d = 0; d < 128; ++d) { const float wv = wcol[(size_t)d * D] * psg[d]; a0 += pr[d] * wv; a1 += pr[128 + d] * wv; a2 += pr[256 + d] * wv; a3 += pr[384 + d] * wv; }
          bf16* o = wt + (size_t)n * 512 + r4;
          *(unsigned long long*)o = (unsigned long long)pk2(a0, a1) | ((unsigned long long)pk2(a2, a3) << 32); } }
#undef TM
#undef PART
}
__device__ __forceinline__ void tail_convert(ArgsP A, const Frame& F, int l, int bx, int nunits, int p0, int p1) {
#if !TAILCONV
    return;
#endif
    const int busy = nunits % F.G; if (busy == 0 || l + 1 >= NLAYER) return;
    const int slot = bx - busy; if (slot < 0) return;
    phase_convert(A, F, l + 1, slot * NWAVES + F.wave, (F.G - busy) * NWAVES, p0, p1);
}
__device__ __forceinline__ void phase_rope_tables(ArgsP A, const Frame& F) {
    unsigned char* ws = A->ws; const int lane = opq_lane(); const int gw = opq_s(F.gw); const int gt = gw * 64 + lane;
    {
        float* ct = (float*)(ws + WS_COS); float* st = (float*)(ws + WS_SIN);
        for (int i = gt; i < S * 32; i += F.NGT) { const int pos = i >> 5, k = i & 31;
            double f = 1.0; for (int j = 0; j < k; ++j) f *= 0.74989420933245582730;
            const float ang = (float)pos * (float)f;
            const double a = (double)ang; const double kq = __builtin_rint(a * 0.63661977236758134308); const double r = (a - kq * 1.5707963267948966192) - kq * 6.123233995736766e-17;
            const double r2 = r * r;
            const double sn = r * (1.0 + r2 * (-1.0 / 6 + r2 * (1.0 / 120 + r2 * (-1.0 / 5040 + r2 * (1.0 / 362880 + r2 * (-1.0 / 39916800 + r2 * (1.0 / 6227020800.0)))))));
            const double cs = 1.0 + r2 * (-0.5 + r2 * (1.0 / 24 + r2 * (-1.0 / 720 + r2 * (1.0 / 40320 + r2 * (-1.0 / 3628800 + r2 * (1.0 / 479001600.0 + r2 * (-1.0 / 87178291200.0)))))));
            const int q = ((int)kq) & 3;
            const double sv = (q == 0) ? sn : (q == 1) ? cs : (q == 2) ? -sn : -cs;
            const double cv = (q == 0) ? cs : (q == 1) ? -sn : (q == 2) ? -cs : sn;
            ct[i] = (float)cv; st[i] = (float)sv; }
    }
}
__device__ __forceinline__ void phase_prep(const Frame& F, const float* x, bf16* xb, float* ssp) {
    const int lane = opq_lane(); const int gw = opq_s(F.gw);
    for (int m = gw; m < S; m += F.NGW) {
        const GAS f32x4* xr = (const GAS f32x4*)(x + (size_t)m * D) + lane;
        f32x4 v[8]; float s = 0.f;
#pragma unroll
        for (int j = 0; j < 8; ++j) { v[j] = xr[64 * j]; s += (v[j].x * v[j].x + v[j].y * v[j].y) + (v[j].z * v[j].z + v[j].w * v[j].w); }
        s = wave_sum(s);
        GAS unsigned long long* o8 = (GAS unsigned long long*)(xb + (size_t)m * D) + lane;
#pragma unroll
        for (int j = 0; j < 8; ++j) o8[64 * j] = (unsigned long long)pk2(v[j].x, v[j].y) | ((unsigned long long)pk2(v[j].z, v[j].w) << 32);
        if (lane < 32) ssp[(size_t)m * 32 + lane] = (lane == 0) ? s : 0.f;
    }
}
__device__ __forceinline__ void phase_mix1(ArgsP A, const Frame& F, int l) {
    unsigned char* ws = A->ws; const int lane = opq_lane(); const int gw = opq_s(F.gw); const int gt = gw * 64 + lane;
    bf16* p = (bf16*)(ws + WS_P); bf16* z0 = (bf16*)(ws + WS_Z); bf16* vvn = (bf16*)(ws + WS_VVN); bf16* mlaA = (bf16*)(ws + WS_MLAA);
    for (int item = gt; item < (S / 16) * 256; item += F.NGT) {
        const int cp = item & 255, t0 = (item >> 8) * 16, g = cp >> 6;
        const bf16* col = p + PC_POOL + 2 * cp;
        float va[32], vb[32];
#pragma unroll
        for (int k = 0; k < 32; ++k) { const int tt = t0 - 8 + k; const bool in = (tt >= 0) && (tt < S); const unsigned u = in ? *(const unsigned*)(col + (size_t)(in ? tt : 0) * NINP) : 0u; va[k] = bflo(u); vb[k] = bfhi(u); }
        unsigned* zo = (unsigned*)(z0 + (size_t)t0 * 512 + 2 * cp);
#define POOL_GROUP(HW) do { \
        _Pragma("unroll") for (int i = 0; i < 16; ++i) { float sa = 0.f, sb = 0.f; \
            _Pragma("unroll") for (int k = 8 + i - (HW); k < 8 + i + (HW); ++k) { sa += va[k]; sb += vb[k]; }     \
            const int t = t0 + i, lo = (t - (HW)) < 0 ? 0 : (t - (HW)), hi = (t + (HW)) > S ? S : (t + (HW)); const float inv = 1.0f / (float)(hi - lo); \
            zo[(size_t)i * 256] = pk2(sa * inv - va[8 + i], sb * inv - vb[8 + i]); } } while (0)
        if (g == 0) POOL_GROUP(1); else if (g == 1) POOL_GROUP(2); else if (g == 2) POOL_GROUP(4); else POOL_GROUP(8);
#undef POOL_GROUP
    }
    const float* gq = A->in[I_DQN] + l * 128; const float* gk = A->in[I_DKN] + l * 128; const float* gs = A->in[I_SGUN] + l * 512;
    const float* gqa = A->in[I_MQAN] + l * 384; const float* gkva = A->in[I_MKVAN] + l * 128;
    for (int t = gw; t < S; t += F.NGW) {
        bf16* prow = p + (size_t)t * NINP;
        { unsigned* ptr = (unsigned*)(prow + PC_DIL) + lane; unsigned uu[24]; float ss[24];
#pragma unroll
          for (int hh = 0; hh < 24; ++hh) uu[hh] = ptr[hh * 64];
#pragma unroll
          for (int hh = 0; hh < 24; ++hh) { const float a = bflo(uu[hh]), b = bfhi(uu[hh]); ss[hh] = a * a + b * b; }
#pragma unroll
          for (int o = 1; o < 64; o <<= 1) {
#pragma unroll
              for (int hh = 0; hh < 24; ++hh) ss[hh] += __shfl_xor(ss[hh], o); }
          const float gq0 = gq[2 * lane], gq1 = gq[2 * lane + 1], gk0 = gk[2 * lane], gk1 = gk[2 * lane + 1];
#pragma unroll
          for (int hh = 0; hh < 24; ++hh) { const float rstd = rsq(ss[hh] * (1.f / 128) + EPS);
              ptr[hh * 64] = pk2(bflo(uu[hh]) * rstd * (hh < 12 ? gq0 : gk0), bfhi(uu[hh]) * rstd * (hh < 12 ? gq1 : gk1)); } }
        { const v4u u = *((const v4u*)(prow + PC_SGU + 512) + lane); float x[8] = {bflo(u.x), bfhi(u.x), bflo(u.y), bfhi(u.y), bflo(u.z), bfhi(u.z), bflo(u.w), bfhi(u.w)}; float ss = 0.f;
#pragma unroll
          for (int k = 0; k < 8; ++k) ss += x[k] * x[k];
          const float rstd = rsq(wave_sum(ss) * (1.f / 512) + EPS); const float* gg = gs + 8 * lane;
          v4u o; o.x = pk2(x[0] * rstd * gg[0], x[1] * rstd * gg[1]); o.y = pk2(x[2] * rstd * gg[2], x[3] * rstd * gg[3]); o.z = pk2(x[4] * rstd * gg[4], x[5] * rstd * gg[5]); o.w = pk2(x[6] * rstd * gg[6], x[7] * rstd * gg[7]);
          *((v4u*)(vvn + (size_t)t * 512) + lane) = o; }
        { const unsigned* cq = (const unsigned*)(prow + PC_CQ) + lane; const unsigned u0 = cq[0], u1 = cq[64], u2 = cq[128];
          const float a0 = bflo(u0), b0 = bfhi(u0), a1 = bflo(u1), b1 = bfhi(u1), a2 = bflo(u2), b2 = bfhi(u2);
          const float rstd = rsq(wave_sum((a0 * a0 + b0 * b0) + (a1 * a1 + b1 * b1) + (a2 * a2 + b2 * b2)) * (1.f / 384) + EPS);
          unsigned* o = (unsigned*)(mlaA + (size_t)t * 512) + lane; const float* gg = gqa + 2 * lane;
          o[0] = pk2(a0 * rstd * gg[0], b0 * rstd * gg[1]); o[64] = pk2(a1 * rstd * gg[128], b1 * rstd * gg[129]); o[128] = pk2(a2 * rstd * gg[256], b2 * rstd * gg[257]);
          const unsigned uk = *((const unsigned*)(prow + PC_CKV) + lane); const float ak = bflo(uk), bk = bfhi(uk);
          const float rk = rsq(wave_sum(ak * ak + bk * bk) * (1.f / 128) + EPS);
          o[192] = pk2(ak * rk * gkva[2 * lane], bk * rk * gkva[2 * lane + 1]); }
    }
}
typedef float f32x16 __attribute__((ext_vector_type(16)));
typedef short s16x4 __attribute__((ext_vector_type(4)));
typedef short v4i16_t __attribute__((ext_vector_type(4)));
#define MFMA32(a, b, c) __builtin_amdgcn_mfma_f32_32x32x16_bf16((a), (b), (c), 0, 0, 0)
__device__ __forceinline__ int crow(int reg, int h) { return (reg & 3) + 8 * (reg >> 2) + 4 * h; }
__device__ __forceinline__ bf16x8 pack8(const f32x16& x, int s) {
    v4u p; p.x = epi::cvt_pk_bf16(x[8 * s], x[8 * s + 1]); p.y = epi::cvt_pk_bf16(x[8 * s + 2], x[8 * s + 3]); p.z = epi::cvt_pk_bf16(x[8 * s + 4], x[8 * s + 5]); p.w = epi::cvt_pk_bf16(x[8 * s + 6], x[8 * s + 7]);
    return __builtin_bit_cast(bf16x8, p);
}
__device__ __forceinline__ s16x4 tr_read(const LAS unsigned char* p) { return __builtin_bit_cast(s16x4, __builtin_amdgcn_ds_read_tr16_b64_v4i16((LAS v4i16_t*)p)); }
__device__ __forceinline__ int vimg_off(int key, int piece  ) { return key * 256 + (((piece >> 2) ^ (key & 3)) << 6) + ((piece & 3) << 4); }
__device__ __forceinline__ bf16x8 vt_frag(const LAS unsigned char* img, int key0, int d0, int lane) {
    const int h = lane >> 5, blk = (lane >> 4) & 1, q = (lane & 15) >> 2, pp = lane & 3;
    const int ka = key0 + 4 * h + q, kb = ka + 8;
    const int col = ((d0 ^ q) << 6) + (16 * blk + 4 * pp) * 2;
    const s16x4 lo = tr_read(img + ka * 256 + col), hi = tr_read(img + kb * 256 + col);
    return __builtin_shufflevector(lo, hi, 0, 1, 2, 3, 4, 5, 6, 7);
}
__device__ __forceinline__ int vt_lane_off(int lane, int d0) { const int h = lane >> 5, blk = (lane >> 4) & 1, q = (lane & 15) >> 2, pp = lane & 3; return (4 * h + q) * 256 + ((d0 ^ q) << 6) + (16 * blk + 4 * pp) * 2; }
template <int KEY0> __device__ __forceinline__ bf16x8 vt_frag_o(const LAS unsigned char* img, int voff) {
    const s16x4 lo = tr_read(img + voff + KEY0 * 256), hi = tr_read(img + voff + (KEY0 + 8) * 256);
    return __builtin_shufflevector(lo, hi, 0, 1, 2, 3, 4, 5, 6, 7);
}
__device__ __forceinline__ bf16x8 tr_frag(const LAS unsigned char* img, int ra, int rb, int cb, int lane) {
    const int blk = (lane >> 4) & 1, q = (lane & 15) >> 2, pp = lane & 3;
    const int col = ((cb ^ q) << 6) + (16 * blk + 4 * pp) * 2;
    const s16x4 lo = tr_read(img + (ra + q) * 256 + col), hi = tr_read(img + (rb + q) * 256 + col);
    return __builtin_shufflevector(lo, hi, 0, 1, 2, 3, 4, 5, 6, 7);
}
__device__ __forceinline__ void sgu_mix_mfma(ArgsP A, const Frame& F, int l, int lane) {
    unsigned char* ws = A->ws; const bf16* p = (const bf16*)(ws + WS_P); const bf16* vvn = (const bf16*)(ws + WS_VVN); bf16* z2 = (bf16*)(ws + WS_Z) + (size_t)2 * S * 512;
    const float* sw = A->in[I_SGUW] + (size_t)l * 4 * 128 * 128; const float* sb = A->in[I_SGUB] + (size_t)l * 4 * 128;
    LAS unsigned char* img = F.lds + RING_OFF;
    const int w = F.wave, tid = w * 64 + lane, ql = lane & 31, h = lane >> 5, tb = 32 * (w & 3), cb0 = 2 * (w >> 2);
    for (int unit = F.vcu; unit < 256; unit += F.G) {
        const int n = unit >> 2, g = unit & 3;
#pragma unroll
        for (int i = 0; i < 4; ++i) { const int idx = i * 512 + tid, s = idx >> 4, piece = idx & 15;
            *(LAS v4u*)(img + vimg_off(s, piece)) = *(const v4u*)(vvn + (size_t)(n * 128 + s) * 512 + g * 128 + piece * 8); }
        __syncthreads();
        f32x16 acc0, acc1;
#pragma unroll
        for (int e = 0; e < 16; ++e) { acc0[e] = 0.f; acc1[e] = 0.f; }
        const float* wrow = sw + ((size_t)g * 128 + tb + ql) * 128 + 8 * h;
#pragma unroll
        for (int ks = 0; ks < 8; ++ks) {
            const f32x4 a0 = *(const f32x4*)(wrow + 16 * ks), a1 = *(const f32x4*)(wrow + 16 * ks + 4);
            v4u ap; ap.x = epi::cvt_pk_bf16(a0.x, a0.y); ap.y = epi::cvt_pk_bf16(a0.z, a0.w); ap.z = epi::cvt_pk_bf16(a1.x, a1.y); ap.w = epi::cvt_pk_bf16(a1.z, a1.w);
            const bf16x8 af = __builtin_bit_cast(bf16x8, ap);
            acc0 = MFMA32(af, tr_frag(img, 16 * ks + 8 * h, 16 * ks + 8 * h + 4, cb0, lane), acc0);
            acc1 = MFMA32(af, tr_frag(img, 16 * ks + 8 * h, 16 * ks + 8 * h + 4, cb0 + 1, lane), acc1);
        }
#pragma unroll
        for (int e = 0; e < 16; ++e) { const int tl = tb + crow(e, h), t = n * 128 + tl; const float bias = sb[g * 128 + tl];
            const int c0 = g * 128 + 32 * cb0 + ql;
            const float u0 = bf2f(p[(size_t)t * NINP + PC_SGU + c0]), u1 = bf2f(p[(size_t)t * NINP + PC_SGU + c0 + 32]);
            z2[(size_t)t * 512 + c0] = (bf16)f2bf(u0 * (acc0[e] + bias)); z2[(size_t)t * 512 + c0 + 32] = (bf16)f2bf(u1 * (acc1[e] + bias)); }
        __syncthreads();
    }
}
__device__ __forceinline__ void dil_attention(ArgsP A, const Frame& F, int l, int gw, int lane) {
    unsigned char* ws = A->ws; const bf16* p = (const bf16*)(ws + WS_P);
    float* OP = (float*)(ws + WS_DILO); float* LP = (float*)(ws + WS_DILL);
    LAS unsigned char* img = F.lds + RING_OFF + (gw & 7) * 8192;
    const float* gq = A->in[I_DQN] + l * 128; const float* gk = A->in[I_DKN] + l * 128;
    const float cbound = 11.313708499f * wave_max(fmaxf(fabsf(gq[lane]), fabsf(gq[lane + 64]))) * wave_max(fmaxf(fabsf(gk[lane]), fabsf(gk[lane + 64])));
    const int ql = lane & 31, h = lane >> 5;
    const int nun = ((gw & 7) < 4) ? 2 : 1;
    for (int kk = 0; kk < ((F.G == 256) ? nun : 1 << 30); ++kk) {
        const int unit = (F.G == 256) ? (gw >> 3) * 12 + (gw & 7) + 8 * kk : gw + kk * F.NGW; if (unit >= 12 * 256) break;
        const int hq = unit >> 8, blk = unit & 255, g = hq >> 2, ih = hq & 3, dl = 1 << (2 * g), L = S >> (2 * g), nb = 256 >> (2 * g);
        const int r = blk / nb, b = blk % nb;
        const float slope = __builtin_amdgcn_exp2f(-8.0f * (float)(hq + 1) / 12.0f) * (float)dl;
        const int tq = r + dl * (32 * b + ql);
        bf16x8 qf[8];
        { const v4u* src = (const v4u*)(p + (size_t)tq * NINP + PC_DIL + hq * 128 + 8 * h);
#pragma unroll
          for (int s = 0; s < 8; ++s) qf[s] = __builtin_bit_cast(bf16x8, src[2 * s]); }
        f32x16 o[4]; float lsum = 0.f;
#pragma unroll
        for (int d0 = 0; d0 < 4; ++d0)
#pragma unroll
            for (int e = 0; e < 16; ++e) o[d0][e] = 0.f;
#pragma unroll 1
        for (int c = -2; c <= 2; ++c) {
            const int mb = 32 * (b + c);
            if (mb < 0 || mb >= L) continue;
            f32x16 sacc;
#pragma unroll
            for (int e = 0; e < 16; ++e) sacc[e] = 0.f;
            v4u vreg[8];
#pragma unroll
            for (int i = 0; i < 8; ++i) { const int idx = i * 64 + lane, key = idx >> 4, piece = idx & 15;
                vreg[i] = *(const v4u*)(p + (size_t)(r + dl * (mb + key)) * NINP + PC_DIL + 3072 + hq * 128 + piece * 8); }
            { const int tk = r + dl * (mb + ql);
              const v4u* src = (const v4u*)(p + (size_t)tk * NINP + PC_DIL + 1536 + hq * 128 + 8 * h);
              bf16x8 kf[8];
#pragma unroll
              for (int s = 0; s < 8; ++s) kf[s] = __builtin_bit_cast(bf16x8, src[2 * s]);
#pragma unroll
              for (int s = 0; s < 8; ++s) sacc = MFMA32(kf[s], qf[s], sacc); }
#pragma unroll
            for (int i = 0; i < 8; ++i) { const int idx = i * 64 + lane, key = idx >> 4, piece = idx & 15; *(LAS v4u*)(img + vimg_off(key, piece)) = vreg[i]; }
#pragma unroll
            for (int e = 0; e < 16; ++e) { const int rel = 32 * c + crow(e, h) - ql, arel = rel < 0 ? -rel : rel;
                const float sv = sacc[e] * 0.08838834764831845f - slope * (float)arel - cbound;
                const float pe = (arel <= 64) ? epi::fast_exp(sv) : 0.f; sacc[e] = pe; lsum += pe; }
            const bf16x8 pb0 = pack8(sacc, 0), pb1 = pack8(sacc, 1);
#pragma unroll
            for (int d0 = 0; d0 < 4; ++d0) { o[d0] = MFMA32(vt_frag(img, 0, d0, lane), pb0, o[d0]); o[d0] = MFMA32(vt_frag(img, 16, d0, lane), pb1, o[d0]); }
        }
        lsum += __shfl_xor(lsum, 32);
        float* orow = OP + ((size_t)g * S + tq) * 512 + ih * 128 + 4 * h;
#pragma unroll
        for (int d0 = 0; d0 < 4; ++d0)
#pragma unroll
            for (int k = 0; k < 4; ++k) { f32x4 v; v.x = o[d0][4 * k]; v.y = o[d0][4 * k + 1]; v.z = o[d0][4 * k + 2]; v.w = o[d0][4 * k + 3]; *(f32x4*)(orow + 32 * d0 + 8 * k) = v; }
        if (h == 0) LP[((size_t)g * S + tq) * 4 + ih] = lsum;
    }
}
__device__ __forceinline__ void phase_mix2(ArgsP A, const Frame& F, int l) {
    unsigned char* ws = A->ws; const int lane = opq_lane(); const int gw = opq_s(F.gw); const int gt = gw * 64 + lane;
    const bf16* p = (const bf16*)(ws + WS_P); const float* raw = (const float*)(ws + WS_MLARAW);
    const float* ct = (const float*)(ws + WS_COS); const float* st = (const float*)(ws + WS_SIN);
    const float* gqn = A->in[I_MQN] + l * 192; const float* gkn = A->in[I_MKN] + l * 192;
    const float QSCL = 0.07216878364870322f * 1.4426950408889634f;
    bf16* MQ = (bf16*)(ws + WS_MQ); bf16* MK = (bf16*)(ws + WS_MK); bf16* MV = (bf16*)(ws + WS_MV);
    const int w8 = gw & 7, tok0 = (gw >> 3) * 32 + (w8 < 4 ? 2 * w8 : 8 + 6 * (w8 - 4)), npair = (w8 < 4) ? 1 : 3;
    const float gq0 = gqn[lane], gq1 = gqn[lane + 64], gq2 = gqn[lane + 128], gk0 = gkn[lane], gk1 = gkn[lane + 64], gk2 = gkn[lane + 128];
    for (int jj = 0; jj < ((F.G == 256) ? npair : 1 << 30); ++jj) { const int tb = (F.G == 256) ? tok0 + 2 * jj : 2 * (gw + jj * F.NGW); if (tb >= S) break;
        float cs[2], sn[2], krv[2], q0[2][4], q1[2][4], q2[2][4], k0[2][4], k1[2][4], v0[2][4], v1[2][4], sq[2][4], sk[2][4];
#pragma unroll
        for (int u = 0; u < 2; ++u) { const int t = tb + u; cs[u] = ct[t * 32 + (lane & 31)]; sn[u] = st[t * 32 + (lane & 31)];
            const float* rr = raw + (size_t)t * NMLA; krv[u] = bf2f(p[(size_t)t * NINP + PC_KR + lane]);
#pragma unroll
            for (int h = 0; h < 4; ++h) { q0[u][h] = rr[h * 192 + lane]; q1[u][h] = rr[h * 192 + 64 + lane]; q2[u][h] = rr[h * 192 + 128 + lane];
                k0[u][h] = rr[768 + h * 256 + lane]; k1[u][h] = rr[768 + h * 256 + 64 + lane]; v0[u][h] = rr[768 + h * 256 + 128 + lane]; v1[u][h] = rr[768 + h * 256 + 192 + lane]; } }
#pragma unroll
        for (int u = 0; u < 2; ++u)
#pragma unroll
            for (int h = 0; h < 4; ++h) { sq[u][h] = q0[u][h] * q0[u][h] + q1[u][h] * q1[u][h] + q2[u][h] * q2[u][h]; sk[u][h] = k0[u][h] * k0[u][h] + k1[u][h] * k1[u][h] + krv[u] * krv[u]; }
#pragma unroll
        for (int o = 1; o < 64; o <<= 1) {
#pragma unroll
            for (int u = 0; u < 2; ++u)
#pragma unroll
                for (int h = 0; h < 4; ++h) { sq[u][h] += __shfl_xor(sq[u][h], o); sk[u][h] += __shfl_xor(sk[u][h], o); } }
#pragma unroll
        for (int u = 0; u < 2; ++u) { const int t = tb + u;
#pragma unroll
        for (int h = 0; h < 4; ++h) {
            const float rq = rsq(sq[u][h] * (1.f / 192) + EPS) * QSCL, rk = rsq(sk[u][h] * (1.f / 192) + EPS);
            const float a2 = q2[u][h] * rq * gq2, oa = __shfl_xor(a2, 32), a2r = (lane < 32) ? (a2 * cs[u] - oa * sn[u]) : (oa * sn[u] + a2 * cs[u]);
            const float b2 = krv[u] * rk * gk2, ob = __shfl_xor(b2, 32), b2r = (lane < 32) ? (b2 * cs[u] - ob * sn[u]) : (ob * sn[u] + b2 * cs[u]);
            bf16* qo = MQ + ((size_t)h * S + t) * 192; bf16* ko = MK + ((size_t)h * S + t) * 192; bf16* vo = MV + ((size_t)h * S + t) * 128;
            qo[lane] = (bf16)f2bf(q0[u][h] * rq * gq0); qo[lane + 64] = (bf16)f2bf(q1[u][h] * rq * gq1); qo[lane + 128] = (bf16)f2bf(a2r);
            ko[lane] = (bf16)f2bf(k0[u][h] * rk * gk0); ko[lane + 64] = (bf16)f2bf(k1[u][h] * rk * gk1); ko[lane + 128] = (bf16)f2bf(b2r);
            vo[lane] = (bf16)f2bf(v0[u][h]); vo[lane + 64] = (bf16)f2bf(v1[u][h]); } }
    }
    sgu_mix_mfma(A, F, l, lane);
    dil_attention(A, F, l, gw, lane);
}


#ifndef MLA_SGB
#define MLA_SGB 1
#endif
constexpr int MLA_KROW = 400, MLA_KIMG = 64 * MLA_KROW, MLA_BUF = MLA_KIMG + 64 * 256;
__device__ __forceinline__ void phase_mla_flash(ArgsP A, const Frame& F, int l) {
    unsigned char* ws = A->ws; const int lane = opq_lane();
    const bf16* MQ = (const bf16*)(ws + WS_MQ); const bf16* MK = (const bf16*)(ws + WS_MK); const bf16* MV = (const bf16*)(ws + WS_MV);
    float* OP = (float*)(ws + WS_MOP); float* LP = (float*)(ws + WS_MLP);
    const float* gqn = A->in[I_MQN] + l * 192; const float* gkn = A->in[I_MKN] + l * 192;
    const float c2 = 19.990625f * wave_max(fmaxf(fmaxf(fabsf(gqn[lane]), fabsf(gqn[lane + 64])), fabsf(gqn[lane + 128]))) * wave_max(fmaxf(fmaxf(fabsf(gkn[lane]), fabsf(gkn[lane + 64])), fabsf(gkn[lane + 128])));
    LAS unsigned char* lds = F.lds + RING_OFF;
    const int w = F.wave, tid = w * 64 + lane, ql = lane & 31, hh = lane >> 5;
    int ksrc[3], kdst[3], vsrc[2], vdst[2];
#pragma unroll
    for (int i = 0; i < 3; ++i) { const int idx = i * 512 + tid, row = idx / 24, pc = idx - row * 24; ksrc[i] = row * 192 + pc * 8; kdst[i] = row * MLA_KROW + pc * 16; }
#pragma unroll
    for (int i = 0; i < 2; ++i) { const int idx = i * 512 + tid, row = idx >> 4, pc = idx & 15; vsrc[i] = row * 128 + pc * 8; vdst[i] = MLA_KIMG + vimg_off(row, pc); }
    int voff[4];
#pragma unroll
    for (int d0 = 0; d0 < 4; ++d0) voff[d0] = vt_lane_off(lane, d0);
    for (int unit = F.vcu; unit < 256; unit += F.G) {
        const int kh = unit & 1, qb = (unit >> 1) & 31, h = unit >> 6;
        const bf16* Kg = MK + ((size_t)h * S + kh * 4096) * 192; const bf16* Vg = MV + ((size_t)h * S + kh * 4096) * 128;
        const int tq = qb * 256 + w * 32 + ql;
        bf16x8 qf[12];
        { const v4u* src = (const v4u*)(MQ + ((size_t)h * S + tq) * 192 + 8 * hh);
#pragma unroll
          for (int s = 0; s < 12; ++s) qf[s] = __builtin_bit_cast(bf16x8, src[2 * s]); }
        f32x16 o[4]; float lsum = 0.f;
#pragma unroll
        for (int d0 = 0; d0 < 4; ++d0)
#pragma unroll
            for (int e = 0; e < 16; ++e) o[d0][e] = 0.f;
        v4u kst[3], vst[2];
#pragma unroll
        for (int i = 0; i < 3; ++i) kst[i] = *(const v4u*)(Kg + ksrc[i]);
#pragma unroll
        for (int i = 0; i < 2; ++i) vst[i] = *(const v4u*)(Vg + vsrc[i]);
#pragma unroll
        for (int i = 0; i < 3; ++i) *(LAS v4u*)(lds + kdst[i]) = kst[i];
#pragma unroll
        for (int i = 0; i < 2; ++i) *(LAS v4u*)(lds + vdst[i]) = vst[i];
        __syncthreads();
#pragma unroll 1
        for (int jt = 0; jt < 64; ++jt) {
            const LAS unsigned char* buf = lds + (jt & 1) * MLA_BUF; LAS unsigned char* nbuf = lds + ((jt + 1) & 1) * MLA_BUF;
            const int jn = (jt + 1 < 64) ? jt + 1 : jt;
#pragma unroll
            for (int i = 0; i < 3; ++i) kst[i] = *(const v4u*)(Kg + (size_t)jn * 64 * 192 + ksrc[i]);
#pragma unroll
            for (int i = 0; i < 2; ++i) vst[i] = *(const v4u*)(Vg + (size_t)jn * 64 * 128 + vsrc[i]);
            f32x16 s0, s1;
#pragma unroll
            for (int e = 0; e < 16; ++e) { s0[e] = -c2; s1[e] = -c2; }
            const LAS unsigned char* kr0 = buf + ql * MLA_KROW + 16 * hh;
            const LAS unsigned char* vimg = buf + MLA_KIMG;
#define KFRAG(f) (*(const LAS bf16x8*)(kr0 + ((f) >= 12 ? 32 * MLA_KROW : 0) + 32 * ((f) % 12)))
#define KLOAD(dst, f0) do { _Pragma("unroll") for (int i_ = 0; i_ < 4; ++i_) dst[i_] = KFRAG((f0) + i_); } while (0)
#define KMMA(src, f0) do { _Pragma("unroll") for (int i_ = 0; i_ < 4; ++i_) { if ((f0) + i_ < 12) s0 = MFMA32(src[i_], qf[((f0) + i_) % 12], s0); else s1 = MFMA32(src[i_], qf[((f0) + i_) % 12], s1); } } while (0)
#define SB() __builtin_amdgcn_sched_barrier(0)
            bf16x8 kA[4], kB[4];
            KLOAD(kA, 0);
            KLOAD(kB, 4);  SB(); KMMA(kA, 0);  SB();
            KLOAD(kA, 8);  SB(); KMMA(kB, 4);  SB();
            KLOAD(kB, 12); SB(); KMMA(kA, 8);  SB();
            KLOAD(kA, 16); SB(); KMMA(kB, 12); SB();
            KLOAD(kB, 20); SB(); KMMA(kA, 16); SB();
#define VLOAD(dst, key0, dd) do { dst[0] = vt_frag(vimg, key0, dd, lane); dst[1] = vt_frag(vimg, (key0) + 16, dd, lane); } while (0)
#define VMMA(src, pa, pb_, dd) do { o[dd] = MFMA32(src[0], pa, o[dd]); o[dd] = MFMA32(src[1], pb_, o[dd]); } while (0)
            bf16x8 vA[2], vB[2];
            VLOAD(vA, 0, 0); SB(); KMMA(kB, 20); SB();
#undef KFRAG
#undef KLOAD
#undef KMMA
#pragma unroll
            for (int e = 0; e < 16; ++e) { const float p0 = __builtin_amdgcn_exp2f(s0[e] - c2); s0[e] = p0; lsum += p0; }
            const bf16x8 pb00 = pack8(s0, 0), pb01 = pack8(s0, 1);
#pragma unroll
            for (int e = 0; e < 16; ++e) { const float p1 = __builtin_amdgcn_exp2f(s1[e] - c2); s1[e] = p1; lsum += p1; }
            const bf16x8 pb10 = pack8(s1, 0), pb11 = pack8(s1, 1);
            SB();
            VLOAD(vB, 0, 1);  SB(); VMMA(vA, pb00, pb01, 0); SB();
            VLOAD(vA, 0, 2);  SB(); VMMA(vB, pb00, pb01, 1); SB();
            VLOAD(vB, 0, 3);  SB(); VMMA(vA, pb00, pb01, 2); SB();
            VLOAD(vA, 32, 0); SB(); VMMA(vB, pb00, pb01, 3); SB();
            VLOAD(vB, 32, 1); SB(); VMMA(vA, pb10, pb11, 0); SB();
            VLOAD(vA, 32, 2); SB(); VMMA(vB, pb10, pb11, 1); SB();
            VLOAD(vB, 32, 3); SB(); VMMA(vA, pb10, pb11, 2); SB();
            VMMA(vB, pb10, pb11, 3);
#undef VLOAD
#undef VMMA
#undef SB
#pragma unroll
            for (int i = 0; i < 3; ++i) *(LAS v4u*)(nbuf + kdst[i]) = kst[i];
#pragma unroll
            for (int i = 0; i < 2; ++i) *(LAS v4u*)(nbuf + vdst[i]) = vst[i];
            __syncthreads();
        }
        lsum += __shfl_xor(lsum, 32);
        float* orow = OP + (((size_t)kh * 4 + h) * S + tq) * 128 + 4 * hh;
#pragma unroll
        for (int d0 = 0; d0 < 4; ++d0)
#pragma unroll
            for (int k = 0; k < 4; ++k) { f32x4 v; v.x = o[d0][4 * k]; v.y = o[d0][4 * k + 1]; v.z = o[d0][4 * k + 2]; v.w = o[d0][4 * k + 3]; *(f32x4*)(orow + 32 * d0 + 8 * k) = v; }
        if (hh == 0) LP[((size_t)kh * 4 + h) * S + tq] = lsum;
    }
}
__device__ __forceinline__ void dil_combine(ArgsP A, const Frame& F) {
    unsigned char* ws = A->ws; const int lane = opq_lane(); const int gw = opq_s(F.gw); const int gt = gw * 64 + lane;
    const float* OP = (const float*)(ws + WS_DILO); const float* LP = (const float*)(ws + WS_DILL); bf16* z1 = (bf16*)(ws + WS_Z) + (size_t)1 * S * 512;
    for (int idx = gt; idx < S * 512; idx += F.NGT) { const int t = idx >> 9, c = idx & 511, ih = c >> 7;
        const float num = OP[idx] + OP[(size_t)S * 512 + idx] + OP[(size_t)2 * S * 512 + idx];
        const float den = LP[(size_t)t * 4 + ih] + LP[((size_t)S + t) * 4 + ih] + LP[((size_t)2 * S + t) * 4 + ih];
        z1[idx] = (bf16)f2bf(num / den); }
}
__device__ __forceinline__ void phase_mix3(ArgsP A, const Frame& F) {
    unsigned char* ws = A->ws; const int lane = opq_lane(); const int gw = opq_s(F.gw); const int gt = gw * 64 + lane;
    { const float* MO = (const float*)(ws + WS_MOP); const float* ML = (const float*)(ws + WS_MLP); bf16* z3 = (bf16*)(ws + WS_Z) + (size_t)3 * S * 512;
      for (int idx = gt; idx < S * 512; idx += F.NGT) { const int t = idx >> 9, c = idx & 511, h = c >> 7, d = c & 127;
          const size_t r0 = (size_t)h * S + t, r1 = ((size_t)4 + h) * S + t;
          z3[idx] = (bf16)f2bf((MO[r0 * 128 + d] + MO[r1 * 128 + d]) / (ML[r0] + ML[r1])); } }
}

__global__ void __launch_bounds__(NWAVES * 64, 2) mk_fwd(Args args_unused) {
    extern __shared__ __attribute__((aligned(16))) unsigned char lds[];
    Frame F;
    F.lds = (LAS unsigned char*)lds;
    F.MISC = (volatile LAS unsigned*)(F.lds + MISC_OFF);
    F.wave = __builtin_amdgcn_readfirstlane((int)(threadIdx.x >> 6));
    F.G = gridDim.x; { const int bx = blockIdx.x; F.vcu = (F.G % 8 == 0) ? (bx % 8) * (F.G / 8) + bx / 8 : bx; }
    F.gw = F.vcu * NWAVES + F.wave; F.NGW = F.G * NWAVES; F.NGT = F.NGW * 64;
    for (int u = threadIdx.x; u < (LDS_BYTES - LDSCTL_OFF) / 4; u += NWAVES * 64) ((LAS unsigned*)(F.lds + LDSCTL_OFF))[u] = 0u;
    __syncthreads();
    int l_lo, l_hi; bool multi; XcdBarrier bar;
    { ArgsP A = fresh_args(); l_lo = A->l_lo; l_hi = A->l_hi;
      multi = !((l_hi - l_lo) == 1 && (A->ph_hi - A->ph_lo) == 1);
      unsigned* bw = (unsigned*)((gu32*)(A->ws + WS_CTL) + CW_BAR);
      bar.bar = bw; bar.x = 0; bar.st = F.MISC + 8;
      if (multi) bar = xcd_barrier_post(bw, F.MISC + 8); }
#define SEAM() do { if (multi) xcd_barrier(bar); } while (0)
#ifdef ONLY_PHASE
#define IN(k) ((k) == ONLY_PHASE && lo <= (k) && (k) < hi)
#else
#define IN(k) (lo <= (k) && (k) < hi)
#endif
#ifndef G_ALIGN
#define G_ALIGN true
#endif
#ifndef G_SP2
#define G_SP2 true
#endif
#define GEMM(EPI, ORDER) pg8::gemm_phase<EPI, ORDER, G_ALIGN, G_SP2>(Fl.lds + RING_OFF, g, So, E, Fl.wave)
    { ArgsP A = fresh_args(); if (A->l_lo == 0 && A->ph_lo == 0) phase_rope_tables(A, F); }
    for (int l = l_lo; l < l_hi; ++l) {
        int lo, hi; { ArgsP A = fresh_args(); lo = A->ph_lo; hi = A->ph_hi; }
        if (IN(0)) { ArgsP A = fresh_args(); const Frame Fl = fresh_frame(F); unsigned char* ws = A->ws;
            phase_convert(A, Fl, l, Fl.gw, Fl.NGW, 0, CPARTS);
            if (l == 0) phase_prep(Fl, A->in[I_X], (bf16*)(ws + WS_XN), (float*)(ws + WS_SSP));
            SEAM(); }
        if (IN(1)) { ArgsP A = fresh_args(); const Frame Fl = fresh_frame(F); const int bx = opq_s((int)blockIdx.x); unsigned char* ws = A->ws;
            pg8::Gemm g{(const bf16*)(ws + WS_XN), (const bf16*)(ws + (size_t)(l & 1) * WS_SETD + WS_WGU1), S, NGU, D};
            pg8::StaticOrder So; So.init(S, NGU, Fl.G, bx); epi::fill_rstd_table(So, (const float*)(ws + WS_SSP), (LAS float*)(Fl.lds + RSTD_OFF), Fl.wave); __syncthreads();
            epi::EpiSwiglu E{(bf16*)(ws + WS_HID), (const LAS float*)(Fl.lds + RSTD_OFF)}; GEMM(epi::EpiSwiglu, pg8::StaticOrder); tail_convert(A, Fl, l, bx, (S / 256) * (NGU / 256), 0, 128); SEAM(); }
        if (IN(2)) { ArgsP A = fresh_args(); const Frame Fl = fresh_frame(F); const int bx = opq_s((int)blockIdx.x); unsigned char* ws = A->ws; const float* xin = (l == 0) ? A->in[I_X] : (const float*)(ws + WS_X);
            pg8::Gemm g{(const bf16*)(ws + WS_HID), (const bf16*)(ws + (size_t)(l & 1) * WS_SETD + WS_WD1), S, D, FF}; pg8::StaticOrder So; So.init(S, D, Fl.G, bx);
            epi::EpiResid E{xin, (float*)(ws + WS_X), 0.5f, (bf16*)(ws + WS_XN), (float*)(ws + WS_SSP)}; GEMM(epi::EpiResid, pg8::StaticOrder); SEAM(); }
        if (IN(3)) { ArgsP A = fresh_args(); const Frame Fl = fresh_frame(F); const int bx = opq_s((int)blockIdx.x); unsigned char* ws = A->ws;
            pg8::Gemm g{(const bf16*)(ws + WS_XN), (const bf16*)(ws + (size_t)(l & 1) * WS_SETD + WS_WIN), S, NINP, D};
            pg8::StaticOrder So; So.init(S, NINP, Fl.G, bx); epi::fill_rstd_table(So, (const float*)(ws + WS_SSP), (LAS float*)(Fl.lds + RSTD_OFF), Fl.wave); __syncthreads();
            epi::EpiPin E{(bf16*)(ws + WS_P), (const LAS float*)(Fl.lds + RSTD_OFF)}; GEMM(epi::EpiPin, pg8::StaticOrder); tail_convert(A, Fl, l, bx, (S / 256) * (NINP / 256), 128, 288); SEAM(); }
        if (IN(4)) { ArgsP A = fresh_args(); const Frame Fl = fresh_frame(F); phase_mix1(A, Fl, l); SEAM(); }
        if (IN(5)) { ArgsP A = fresh_args(); const Frame Fl = fresh_frame(F); const int bx = opq_s((int)blockIdx.x); unsigned char* ws = A->ws;
            pg8::Gemm g{(const bf16*)(ws + WS_MLAA), (const bf16*)(ws + (size_t)(l & 1) * WS_SETD + WS_WMLA), S, NMLA, opq_s(512)}; pg8::StaticOrder So; So.init(S, NMLA, Fl.G, bx);
            epi::EpiF32 E{(float*)(ws + WS_MLARAW), NMLA, 1}; GEMM(epi::EpiF32, pg8::StaticOrder); SEAM(); }
        if (IN(6)) { ArgsP A = fresh_args(); const Frame Fl = fresh_frame(F); phase_mix2(A, Fl, l); SEAM(); }
        if (IN(7)) { ArgsP A = fresh_args(); const Frame Fl = fresh_frame(F); phase_mla_flash(A, Fl, l); dil_combine(A, Fl); SEAM(); }
        if (IN(8)) { ArgsP A = fresh_args(); const Frame Fl = fresh_frame(F); phase_mix3(A, Fl); SEAM(); }
        if (IN(9)) { ArgsP A = fresh_args(); const Frame Fl = fresh_frame(F); const int bx = opq_s((int)blockIdx.x); unsigned char* ws = A->ws;
            pg8::Gemm g{(const bf16*)(ws + WS_Z), (const bf16*)(ws + (size_t)(l & 1) * WS_SETD + WS_WBR), 4 * S, 4 * D, opq_s(512)}; epi::BranchOrder So; So.so.init(S, D, Fl.G, bx);
            epi::EpiBranchChain E{(bf16*)(ws + WS_MERGEDB), (const bf16*)(ws + WS_P) + PC_GATE}; GEMM(epi::EpiBranchChain, epi::BranchOrder); SEAM(); }
        if (IN(10)) { ArgsP A = fresh_args(); const Frame Fl = fresh_frame(F); const int bx = opq_s((int)blockIdx.x); unsigned char* ws = A->ws;
            pg8::Gemm g{(const bf16*)(ws + WS_MERGEDB), (const bf16*)(ws + (size_t)(l & 1) * WS_SETD + WS_WOUT), S, D, D}; pg8::StaticOrder So; So.init(S, D, Fl.G, bx);
            epi::EpiResid E{(const float*)(ws + WS_X), (float*)(ws + WS_X), 1.0f, (bf16*)(ws + WS_XN), (float*)(ws + WS_SSP)}; GEMM(epi::EpiResid, pg8::StaticOrder); SEAM(); }
        if (IN(11)) { ArgsP A = fresh_args(); const Frame Fl = fresh_frame(F); const int bx = opq_s((int)blockIdx.x); unsigned char* ws = A->ws;
            pg8::Gemm g{(const bf16*)(ws + WS_XN), (const bf16*)(ws + (size_t)(l & 1) * WS_SETD + WS_WGU2), S, NGU, D};
            pg8::StaticOrder So; So.init(S, NGU, Fl.G, bx); epi::fill_rstd_table(So, (const float*)(ws + WS_SSP), (LAS float*)(Fl.lds + RSTD_OFF), Fl.wave); __syncthreads();
            epi::EpiSwiglu E{(bf16*)(ws + WS_HID), (const LAS float*)(Fl.lds + RSTD_OFF)}; GEMM(epi::EpiSwiglu, pg8::StaticOrder); tail_convert(A, Fl, l, bx, (S / 256) * (NGU / 256), 288, CPARTS); SEAM(); }
        if (IN(12)) { ArgsP A = fresh_args(); const Frame Fl = fresh_frame(F); const int bx = opq_s((int)blockIdx.x); unsigned char* ws = A->ws; const bool lastl = (l == NLAYER - 1);
            pg8::Gemm g{(const bf16*)(ws + WS_HID), (const bf16*)(ws + (size_t)(l & 1) * WS_SETD + WS_WD2), S, D, FF}; pg8::StaticOrder So; So.init(S, D, Fl.G, bx);
            epi::EpiResid E{(const float*)(ws + WS_X), lastl ? A->out : (float*)(ws + WS_X), 0.5f, lastl ? (bf16*)nullptr : (bf16*)(ws + WS_XN), (float*)(ws + WS_SSP)}; GEMM(epi::EpiResid, pg8::StaticOrder);
            SEAM(); }
    }
#undef IN
#undef SEAM
#undef GEMM
}


#ifdef DBG_DUMP_OFF
__global__ void dbg_dump(const unsigned char* ws, float* out, int n) {
    for (int i = blockIdx.x * blockDim.x + threadIdx.x; i < n; i += gridDim.x * blockDim.x) {
        if (i >= DBG_DUMP_N) { out[i] = 0.f; continue; }
#if DBG_DUMP_BF16
        out[i] = __uint_as_float(((unsigned)((const unsigned short*)(ws + DBG_DUMP_OFF))[i]) << 16);
#else
        out[i] = ((const float*)(ws + DBG_DUMP_OFF))[i];
#endif
    }
}
#endif
#ifndef MK_ONE_LAUNCH
#define MK_ONE_LAUNCH 0
#endif
extern "C" void kernel_launch(void* const* d_in, const int* in_sizes, int n_in, void* d_out, int out_size, void* d_ws, size_t ws_size, hipStream_t stream) {
    static int grid = 0;
    if (grid == 0) {
        if (n_in != N_INPUTS || out_size != S * D || ws_size < WS_END) { fprintf(stderr, "kernel_launch: unexpected shapes (n_in %d out %d ws %zu)\n", n_in, out_size, ws_size); grid = -1; return; }
        int dev = 0, cus = 0, per_cu = 0;
        if (hipGetDevice(&dev) != hipSuccess || hipDeviceGetAttribute(&cus, hipDeviceAttributeMultiprocessorCount, dev) != hipSuccess) { grid = -1; return; }
        if (hipFuncSetAttribute((const void*)mk_fwd, hipFuncAttributeMaxDynamicSharedMemorySize, LDS_BYTES) != hipSuccess) { fprintf(stderr, "kernel_launch: hipFuncSetAttribute failed\n"); grid = -1; return; }
        if (hipOccupancyMaxActiveBlocksPerMultiprocessor(&per_cu, (const void*)mk_fwd, NWAVES * 64, LDS_BYTES) != hipSuccess || per_cu < 1) fprintf(stderr, "kernel_launch: occupancy query reports %d\n", per_cu);
        (void)hipGetLastError();
        grid = cus;
    }
    if (grid < 0) return;
    if (hipMemsetAsync((char*)d_ws + WS_CTL, 0, CTL_ZERO_BYTES, stream) != hipSuccess) return;
    Args a{};
    for (int i = 0; i < N_INPUTS; ++i) a.in[i] = (const float*)d_in[i];
    a.out = (float*)d_out; a.ws = (unsigned char*)d_ws;
#if MK_ONE_LAUNCH
    a.l_lo = 0; a.l_hi = NLAYER; a.ph_lo = 0; a.ph_hi = NPHASE;
    hipLaunchKernelGGL(mk_fwd, dim3(grid), dim3(NWAVES * 64), LDS_BYTES, stream, a);
#else
    for (int l = 0; l < NLAYER; ++l)
        for (int ph = 0; ph < NPHASE; ++ph) {
#ifdef DBG_DUMP_OFF
            if (l * NPHASE + ph > DBG_LAST) continue;
#endif
            a.l_lo = l; a.l_hi = l + 1; a.ph_lo = ph; a.ph_hi = ph + 1;
            hipLaunchKernelGGL(mk_fwd, dim3(grid), dim3(NWAVES * 64), LDS_BYTES, stream, a);
#ifdef DUP_MASK
            if ((DUP_MASK >> ph) & 1) hipLaunchKernelGGL(mk_fwd, dim3(grid), dim3(NWAVES * 64), LDS_BYTES, stream, a);
#endif
            }
#ifdef DBG_DUMP_OFF
    hipLaunchKernelGGL(dbg_dump, dim3(2048), dim3(256), 0, stream, (const unsigned char*)d_ws, (float*)d_out, S * D);
#endif
#endif
}
```

```cpp
#define MK_ONE_LAUNCH 1
#include <hip/hip_runtime.h>
#include <cstdio>
#include <cstdint>
namespace pg8 {
#define PG8_LAS __attribute__((address_space(3)))
typedef unsigned short bf16_t;
typedef short bf16x8 __attribute__((ext_vector_type(8)));
typedef float f32x4 __attribute__((ext_vector_type(4)));
typedef unsigned u32x4 __attribute__((ext_vector_type(4)));
constexpr int BM = 256, BK = 64, HALF = 128, HTB = HALF * BK * 2  , STAGE_BYTES = 8 * HTB, NXCD = 8, WGM = 4;

__host__ __device__ __forceinline__ int lds_byte(int r, int c) { const int st = (r >> 4) * 2 + (c >> 5), rr = r & 15, cc = c & 31, ob = rr * 64 + cc * 2; return st * 1024 + (ob ^ (((ob >> 9) & 1) << 5)); }
__host__ __device__ __forceinline__ void stage_rc(int b, int& R, int& C) { const int st = b / 1024, sb = b % 1024, swz = sb ^ (((sb >> 9) & 1) << 5); R = (st >> 1) * 16 + swz / 64; C = (st & 1) * 32 + (swz % 64) / 2; }
__host__ __device__ __forceinline__ int perm32(int rho) { const int n = rho >> 4, i = rho & 15; return 8 * (i >> 2) + 4 * n + (i & 3); }

struct Unit { int pm, pn; };
struct Gemm { const bf16_t* A; const bf16_t* Bt; int M, N, K; };

struct StaticOrder {
    int nM, nN, nwg, G, c;
    __host__ __device__ void init(int M, int N, int G_, int c_) { nM = M / BM; nN = N / BM; nwg = nM * nN; G = G_; c = c_; }
    __host__ __device__ bool next(int i, Unit& u) const {
        const long L = (long)i * G + c; if (L >= nwg) return false;
        int wgid = (int)L; { const int q = nwg / NXCD, r = nwg % NXCD, xcd = wgid % NXCD, off = wgid / NXCD; wgid = (xcd < r ? xcd * (q + 1) : r * (q + 1) + (xcd - r) * q) + off; }
        const int nig = WGM * nN, gid = wgid / nig, fm = gid * WGM, gsz = (nM - fm) < WGM ? (nM - fm) : WGM;
        u.pm = fm + ((wgid % nig) % gsz); u.pn = (wgid % nig) / gsz; return true;
    }
    __device__ __forceinline__ void a_ready(const Unit&, int  ) const {}
    __device__ __forceinline__ void done(const Unit&) const {}
};
__device__ __forceinline__ unsigned cvt_pk_bf16(float lo, float hi) { unsigned r; asm volatile("v_cvt_pk_bf16_f32 %0, %1, %2" : "=v"(r) : "v"(lo), "v"(hi)); return r; }
typedef float f32x2 __attribute__((ext_vector_type(2)));
__device__ __forceinline__ f32x2 gelu_pk(f32x2 v) {
    const f32x2 av = __builtin_elementwise_abs(v), d = av * 0.2316418882f + 1.0f;
    f32x2 t; t.x = __builtin_amdgcn_rcpf(d.x); t.y = __builtin_amdgcn_rcpf(d.y);
    f32x2 q = t * 0.5307027145f + (-0.7265760135f); q = q * t + 0.7107068705f; q = q * t + (-0.142248368f); q = q * t + 0.127414796f; q = q * t;
    const f32x2 s = (v * v) * (-0.72134752044f);
    f32x2 e; e.x = __builtin_amdgcn_exp2f(s.x); e.y = __builtin_amdgcn_exp2f(s.y);
    const f32x2 m = v * (q * e), r = v - m;
    f32x2 o; o.x = v.x < 0.f ? m.x : r.x; o.y = v.y < 0.f ? m.y : r.y; return o;
}
template <class Epi, class Sched, bool ALIGN_EPI = false, bool SP2 = false>
__device__ __forceinline__ void gemm_phase(PG8_LAS unsigned char* lds, const Gemm g, const Sched& S, const Epi& E, int wave_in  ) {
    int tid_ = wave_in * 64 + (int)__builtin_amdgcn_mbcnt_hi(~0u, __builtin_amdgcn_mbcnt_lo(~0u, 0u)); asm volatile("" : "+v"(tid_));
    const int tid = tid_, wid = __builtin_amdgcn_readfirstlane(tid >> 6), lane = tid & 63, wr = wid >> 2, wc = wid & 3, fr = lane & 15, fq = lane >> 4;
    const int K = g.K, nt = K / BK;
    unsigned voffA[2], voffB[2];
#pragma unroll
    for (int i = 0; i < 2; ++i) { int R, C; stage_rc(tid * 16 + i * 8192, R, C); const int Rb = Epi::PERM ? ((R & ~31) + perm32(R & 31)) : R;
        voffA[i] = (unsigned)(R * K + C) * 2u; voffB[i] = (unsigned)(Rb * K + C) * 2u; }
    const size_t kstep = (size_t)(BK * 2);
    const size_t hstep = (size_t)HALF * K * 2;
    const size_t tstep = 2 * hstep;
    const unsigned ldsw = (unsigned)wid * 1024u;
    const int aoff = lds_byte(wr * 64 + fr, fq * 8), boff = lds_byte(wc * 32 + fr, fq * 8);
#define PG8_SA(b, h) (((b) * 2 + (h)) * HTB)
#define PG8_SB(b, h) ((4 + (b) * 2 + (h)) * HTB)
#define PG8_STAGE(bufoff, gbase, voff) do { _Pragma("unroll") for (int _i = 0; _i < 2; ++_i) \
        __builtin_amdgcn_global_load_lds((const unsigned*)((const char*)(gbase) + (voff)[_i]), (PG8_LAS unsigned*)(lds + (bufoff) + ldsw + _i * 8192), 16, 0, 0); } while (0)
#define PG8_LDA(dst, b, h) do { _Pragma("unroll") for (int m = 0; m < 4; ++m) _Pragma("unroll") for (int k = 0; k < 2; ++k) dst[m][k] = *(const PG8_LAS bf16x8*)(lds + PG8_SA(b, h) + aoff + m * 2048 + k * 1024); } while (0)
#define PG8_LDB(dst, b, h) do { _Pragma("unroll") for (int n = 0; n < 2; ++n) _Pragma("unroll") for (int k = 0; k < 2; ++k) dst[n][k] = *(const PG8_LAS bf16x8*)(lds + PG8_SB(b, h) + boff + n * 2048 + k * 1024); } while (0)
#define PG8_MMA(ai, bj, At, Bt) do { __builtin_amdgcn_s_setprio(1); _Pragma("unroll") for (int m = 0; m < 4; ++m) _Pragma("unroll") for (int n = 0; n < 2; ++n) _Pragma("unroll") for (int k = 0; k < 2; ++k) \
        acc[ai][bj][m][n] = __builtin_amdgcn_mfma_f32_16x16x32_bf16(Bt[n][k], At[m][k], acc[ai][bj][m][n], 0, 0, 0); __builtin_amdgcn_s_setprio(0); } while (0)
#define PG8_WAIT_V(n) asm volatile("s_waitcnt vmcnt(" #n ")" ::: "memory")
#define PG8_WAIT_L(n) asm volatile("s_waitcnt lgkmcnt(" #n ")" ::: "memory")
#define PG8_BAR __builtin_amdgcn_s_barrier()
#define PG8_SCHED __builtin_amdgcn_sched_barrier(0)
    Unit cur, nxt; int ui = 0;
    if (!S.next(0, cur)) return;
    f32x4 acc[2][2][4][2];
#pragma unroll
    for (int a = 0; a < 2; ++a)
#pragma unroll
        for (int b = 0; b < 2; ++b)
#pragma unroll
            for (int m = 0; m < 4; ++m)
#pragma unroll
                for (int n = 0; n < 2; ++n) acc[a][b][m][n] = (f32x4){0.f, 0.f, 0.f, 0.f};
    bf16x8 At[4][2], B0[2][2], B1[2][2];
    const char* cA = (const char*)g.A + (size_t)cur.pm * tstep; const char* cB = (const char*)g.Bt + (size_t)cur.pn * tstep;
    S.a_ready(cur, 0);
    if constexpr (SP2) {
        PG8_STAGE(PG8_SB(0, 0), cB, voffB); PG8_STAGE(PG8_SB(0, 1), cB + hstep, voffB); PG8_STAGE(PG8_SA(0, 0), cA, voffA); PG8_STAGE(PG8_SA(0, 1), cA + hstep, voffA);
        if (wr == 1) PG8_BAR;
        PG8_WAIT_V(2); PG8_BAR;
        PG8_STAGE(PG8_SB(1, 0), cB + kstep, voffB); PG8_STAGE(PG8_SA(1, 0), cA + kstep, voffA); PG8_STAGE(PG8_SB(1, 1), cB + hstep + kstep, voffB);
        PG8_WAIT_V(6); PG8_BAR;
    } else {
        PG8_STAGE(PG8_SB(0, 0), cB, voffB); PG8_STAGE(PG8_SA(0, 0), cA, voffA); PG8_STAGE(PG8_SB(0, 1), cB + hstep, voffB); PG8_STAGE(PG8_SA(0, 1), cA + hstep, voffA);
        if (wr == 1) PG8_BAR;
        PG8_WAIT_V(4); PG8_BAR;
        PG8_STAGE(PG8_SB(1, 0), cB + kstep, voffB); PG8_STAGE(PG8_SA(1, 0), cA + kstep, voffA); PG8_STAGE(PG8_SB(1, 1), cB + hstep + kstep, voffB);
        PG8_WAIT_V(6); PG8_BAR;
    }
    for (;;) {
        const bool has_next = S.next(ui + 1, nxt);
        const char* nA = has_next ? (const char*)g.A + (size_t)nxt.pm * tstep : cA; const char* nB = has_next ? (const char*)g.Bt + (size_t)nxt.pn * tstep : cB;
        for (int t = 0; t < nt; t += 2) {
            const bool last = (t == nt - 2);
            const char* a1 = cA + (size_t)(t + 1) * kstep;
            const char* a2 = last ? nA : cA + (size_t)(t + 2) * kstep; const char* b2 = last ? nB : cB + (size_t)(t + 2) * kstep;
            const char* a3 = a2 + kstep; const char* b3 = b2 + kstep;
            if (last && has_next) S.a_ready(nxt, ui + 1);
            if constexpr (SP2) {
            PG8_LDB(B0, 0, 0); PG8_LDB(B1, 0, 1); PG8_SCHED; PG8_LDA(At, 0, 0); PG8_STAGE(PG8_SA(1, 1), a1 + hstep, voffA);
            PG8_WAIT_V(8); PG8_WAIT_L(0); PG8_BAR; PG8_MMA(0, 0, At, B0); PG8_MMA(0, 1, At, B1); PG8_BAR; PG8_SCHED;
            PG8_LDA(At, 0, 1); PG8_STAGE(PG8_SB(0, 0), b2, voffB); PG8_STAGE(PG8_SB(0, 1), b2 + hstep, voffB); PG8_STAGE(PG8_SA(0, 0), a2, voffA);
            PG8_WAIT_V(8); PG8_WAIT_L(0); PG8_BAR; PG8_MMA(1, 0, At, B0); PG8_MMA(1, 1, At, B1); PG8_BAR; PG8_SCHED;
            PG8_LDB(B0, 1, 0); PG8_LDB(B1, 1, 1); PG8_SCHED; PG8_LDA(At, 1, 0); PG8_STAGE(PG8_SA(0, 1), a2 + hstep, voffA);
            PG8_WAIT_V(8); PG8_WAIT_L(0); PG8_BAR; PG8_MMA(0, 0, At, B0); PG8_MMA(0, 1, At, B1); PG8_BAR; PG8_SCHED;
            PG8_LDA(At, 1, 1); PG8_STAGE(PG8_SB(1, 0), b3, voffB); PG8_STAGE(PG8_SB(1, 1), b3 + hstep, voffB); PG8_STAGE(PG8_SA(1, 0), a3, voffA);
            PG8_WAIT_V(8); PG8_WAIT_L(0); PG8_BAR; PG8_MMA(1, 0, At, B0); PG8_MMA(1, 1, At, B1); PG8_BAR; PG8_SCHED;
            } else {
            PG8_LDB(B0, 0, 0); PG8_SCHED; PG8_LDA(At, 0, 0); PG8_STAGE(PG8_SA(1, 1), a1 + hstep, voffA);
            PG8_WAIT_L(8); PG8_BAR; PG8_WAIT_L(0); PG8_MMA(0, 0, At, B0); PG8_BAR; PG8_SCHED;
            PG8_LDB(B1, 0, 1); PG8_STAGE(PG8_SB(0, 0), b2, voffB);
            PG8_BAR; PG8_WAIT_L(0); PG8_MMA(0, 1, At, B1); PG8_BAR;
            PG8_LDA(At, 0, 1); PG8_STAGE(PG8_SA(0, 0), a2, voffA);
            PG8_BAR; PG8_WAIT_L(0); PG8_MMA(1, 0, At, B0); PG8_BAR; PG8_SCHED;
            PG8_STAGE(PG8_SB(0, 1), b2 + hstep, voffB);
            PG8_WAIT_V(6); PG8_BAR; PG8_MMA(1, 1, At, B1); PG8_BAR;
            PG8_LDB(B0, 1, 0); PG8_SCHED; PG8_LDA(At, 1, 0); PG8_STAGE(PG8_SA(0, 1), a2 + hstep, voffA);
            PG8_WAIT_L(8); PG8_BAR; PG8_WAIT_L(0); PG8_MMA(0, 0, At, B0); PG8_BAR; PG8_SCHED;
            PG8_LDB(B1, 1, 1); PG8_STAGE(PG8_SB(1, 0), b3, voffB);
            PG8_BAR; PG8_WAIT_L(0); PG8_MMA(0, 1, At, B1); PG8_BAR;
            PG8_LDA(At, 1, 1); PG8_STAGE(PG8_SA(1, 0), a3, voffA);
            PG8_BAR; PG8_WAIT_L(0); PG8_MMA(1, 0, At, B0); PG8_BAR; PG8_SCHED;
            PG8_STAGE(PG8_SB(1, 1), b3 + hstep, voffB);
            PG8_WAIT_V(6); PG8_BAR; PG8_MMA(1, 1, At, B1); PG8_BAR;
            }
        }
        if constexpr (ALIGN_EPI) { if (wr == 0) PG8_BAR; }
        if constexpr (!Epi::AFTER_DRAIN) { E(acc, cur, wr, wc, fr, fq, ui); S.done(cur); }
        if (!has_next) break;
        if constexpr (!Epi::KEEP_ACC) {
#pragma unroll
        for (int a = 0; a < 2; ++a)
#pragma unroll
            for (int b = 0; b < 2; ++b)
#pragma unroll
                for (int m = 0; m < 4; ++m)
#pragma unroll
                    for (int n = 0; n < 2; ++n) acc[a][b][m][n] = (f32x4){0.f, 0.f, 0.f, 0.f};
        }
        cur = nxt; cA = nA; cB = nB; ++ui;
        if constexpr (ALIGN_EPI) { if (wr == 1) PG8_BAR; }
    }
    PG8_WAIT_V(0);
    if constexpr (!ALIGN_EPI) { if (wr == 0) PG8_BAR; }
    PG8_BAR;
    if constexpr (Epi::AFTER_DRAIN) { E.fused(acc, cur, wr, wc, fr, fq, lds, wid, lane); S.done(cur); }
#undef PG8_SA
#undef PG8_SB
#undef PG8_STAGE
#undef PG8_LDA
#undef PG8_LDB
#undef PG8_MMA
#undef PG8_WAIT_V
#undef PG8_WAIT_L
#undef PG8_BAR
#undef PG8_SCHED
}
}
#define GAS __attribute__((address_space(1)))
#define LAS __attribute__((address_space(3)))
typedef unsigned short bf16;
typedef unsigned v4u __attribute__((ext_vector_type(4)));
typedef float f32x4 __attribute__((ext_vector_type(4)));
typedef short bf16x8 __attribute__((ext_vector_type(8)));
typedef GAS unsigned gu32;
typedef GAS unsigned long long gu64;
#define RLX_AGENT __ATOMIC_RELAXED, __HIP_MEMORY_SCOPE_AGENT
#define LDS_WAIT() asm volatile("s_waitcnt lgkmcnt(0)" ::: "memory")
#define VM_WAIT() asm volatile("s_waitcnt vmcnt(0)" ::: "memory")
__device__ __forceinline__ unsigned long long rt() { return __builtin_amdgcn_s_memrealtime(); }
__device__ __forceinline__ unsigned f2bf(float f) { unsigned u = __builtin_bit_cast(unsigned, f); return (u + 0x7fffu + ((u >> 16) & 1u)) >> 16; }
__device__ __forceinline__ unsigned pk2(float lo, float hi) { return f2bf(lo) | (f2bf(hi) << 16); }
#define XB_TMO      128
#define XB_XCNT(j)  (256  + 64 * (j))
#define XB_XSUB(j)  (1280 + 64 * (j))
#define XB_XGEN(j)  (2304 + 64 * (j))
#define XB_TOP      3328
#define XB_TOPGEN   3392
#define XCD_BAR_WORDS 3456
#define XB_SPIN_CAP (1u << 18)

__device__ __forceinline__ unsigned xb_ld(unsigned* p)              { return __hip_atomic_load(p, __ATOMIC_RELAXED, __HIP_MEMORY_SCOPE_AGENT); }
__device__ __forceinline__ unsigned xb_add(unsigned* p, unsigned v) { return __hip_atomic_fetch_add(p, v, __ATOMIC_RELAXED, __HIP_MEMORY_SCOPE_AGENT); }
__device__ __forceinline__ unsigned xb_xcc_id() { return (unsigned)__builtin_amdgcn_s_getreg((3 << 11) | 20) & 0xFu; }
#define XB_SPIN(cond, bar) do { unsigned _sp = 0; while (cond) { __builtin_amdgcn_s_sleep(1); \
    if ((++_sp & 255u) == 0u) { if (xb_ld(&(bar)[XB_TMO])) break; if (_sp > XB_SPIN_CAP) { atomicAdd(&(bar)[XB_TMO], 1u); break; } } } } while (0)

struct XcdBarrier {
    unsigned* bar; unsigned x;
    volatile LAS unsigned* st;
};

__device__ __forceinline__ XcdBarrier xcd_barrier_post(unsigned* bar, volatile LAS unsigned* st) {
    XcdBarrier b; b.bar = bar; b.x = xb_xcc_id(); b.st = st;
    if (threadIdx.x == 0) (void)xb_add(&bar[XB_XCNT(b.x)], 1u);
    return b;
}
__device__ __forceinline__ void xcd_barrier_complete(unsigned* bar, unsigned x, unsigned& nloc, unsigned& nx) {
    const unsigned G = gridDim.x * gridDim.y * gridDim.z;
    unsigned sum, cnt, mine, sp = 0u;
    for (;;) {
        sum = 0u; cnt = 0u; mine = 0u;
#pragma unroll
        for (unsigned j = 0; j < 16; ++j) { const unsigned c = xb_ld(&bar[XB_XCNT(j)]); sum += c; cnt += (c > 0u) ? 1u : 0u; mine = (j == x) ? c : mine; }
        if (sum == G) break;
        __builtin_amdgcn_s_sleep(1);
        if ((++sp & 255u) == 0u) { if (xb_ld(&bar[XB_TMO])) break; if (sp > XB_SPIN_CAP) { atomicAdd(&bar[XB_TMO], 1u); break; } }
    }
    nloc = mine > 0u ? mine : 1u; nx = cnt > 0u ? cnt : 1u;
}

__device__ __forceinline__ void xcd_barrier(const XcdBarrier& b) {
    asm volatile("s_waitcnt vmcnt(0)" ::: "memory");
    __syncthreads();
    if (threadIdx.x == 0) {
        unsigned* bar = b.bar;
        __builtin_amdgcn_s_waitcnt(0);
        unsigned nloc = b.st[0], nx = b.st[1];
        if (nloc == 0u) { xcd_barrier_complete(bar, b.x, nloc, nx); b.st[0] = nloc; b.st[1] = nx; }
        const unsigned old = xb_add(&bar[XB_XSUB(b.x)], 1u);
        const unsigned gen = old / nloc;
        if (old + 1u == (gen + 1u) * nloc) {
            __builtin_amdgcn_fence(__ATOMIC_RELEASE, "agent");
            asm volatile("s_waitcnt vmcnt(0)" ::: "memory");
            const unsigned og = xb_add(&bar[XB_TOP], 1u);
            const unsigned tg = og / nx;
            if (og + 1u == (tg + 1u) * nx) xb_add(&bar[XB_TOPGEN], 1u);
            else XB_SPIN(xb_ld(&bar[XB_TOPGEN]) == tg, bar);
            __builtin_amdgcn_fence(__ATOMIC_ACQUIRE, "agent");
            xb_add(&bar[XB_XGEN(b.x)], 1u);
            asm volatile("s_waitcnt vmcnt(0)" ::: "memory");
        } else {
            XB_SPIN(xb_ld(&bar[XB_XGEN(b.x)]) == gen, bar);
            __builtin_amdgcn_fence(__ATOMIC_ACQUIRE, "agent");
            asm volatile("s_waitcnt vmcnt(0)" ::: "memory");
        }
    }
    __syncthreads();
}
constexpr int S = 8192, D = 2048, FF = 5632, NLAYER = 4;
constexpr int NIN = 14912, NINP = 15104;
constexpr int NGU = 2 * FF;
constexpr float EPS = 1e-6f;
constexpr int PC_GATE = 0, PC_POOL = 8192, PC_DIL = 8704, PC_SGU = 13312, PC_CQ = 14336, PC_CKV = 14720, PC_KR = 14848;
constexpr int NMLA = 1792;

namespace epi {
using pg8::f32x4; using pg8::u32x4; using pg8::Unit; using pg8::bf16_t;
typedef float f32x2_t __attribute__((ext_vector_type(2))); typedef __bf16 bf16x2_t __attribute__((ext_vector_type(2)));
__device__ __forceinline__ unsigned cvt_pk_bf16(float lo, float hi) { f32x2_t v = {lo, hi}; bf16x2_t b = __builtin_convertvector(v, bf16x2_t); return __builtin_bit_cast(unsigned, b); }
constexpr int BM = 256, HALF = 128;
typedef unsigned u32x2 __attribute__((ext_vector_type(2)));
__device__ __forceinline__ float fast_exp(float x) { return __builtin_amdgcn_exp2f(x * 1.44269504089f); }
__device__ __forceinline__ float sigmoid_f(float x) { return __builtin_amdgcn_rcpf(1.0f + fast_exp(-x)); }

struct EpiSwiglu {
    static constexpr bool PERM = true, AFTER_DRAIN = false, KEEP_ACC = false;
    bf16_t* H; const __attribute__((address_space(3))) float* tab;
    __device__ __forceinline__ void operator()(const f32x4 (&acc)[2][2][4][2], const Unit& u, int wr, int wc, int fr, int fq, int ui) const {
        const int row0 = u.pm * BM + wr * 64 + fr, col0 = u.pn * HALF + wc * 32 + 8 * fq; const __attribute__((address_space(3))) float* tb = tab + ui * 256 + wr * 64 + fr;
#pragma unroll
        for (int ai = 0; ai < 2; ++ai)
#pragma unroll
            for (int m = 0; m < 4; ++m) {
                bf16_t* rowp = H + (size_t)(row0 + ai * HALF + m * 16) * FF + col0; const float rs = tb[ai * HALF + m * 16];
                float o[8];
#pragma unroll
                for (int n = 0; n < 2; ++n)
#pragma unroll
                    for (int j = 0; j < 4; ++j) { const float g = acc[ai][0][m][n][j] * rs, up = acc[ai][1][m][n][j] * rs; o[n * 4 + j] = g * sigmoid_f(g) * up; }
                u32x4 w; w.x = cvt_pk_bf16(o[0], o[1]); w.y = cvt_pk_bf16(o[2], o[3]); w.z = cvt_pk_bf16(o[4], o[5]); w.w = cvt_pk_bf16(o[6], o[7]);
                *(u32x4*)rowp = w;
                asm volatile("" ::: "memory");
            }
    }
};
struct EpiResid {
    static constexpr bool PERM = false, AFTER_DRAIN = false, KEEP_ACC = false;
    const float* base; float* out; float alpha; bf16_t* xb; float* ssp;
    __device__ __forceinline__ void operator()(const f32x4 (&acc)[2][2][4][2], const Unit& u, int wr, int wc, int fr, int fq, int ui) const {
        const int row0 = u.pm * BM + wr * 64 + fr, col0 = u.pn * BM + wc * 32 + 4 * fq;
        f32x4 bb[3][4];
#define ER_LOAD(buf, g) { const size_t off_ = (size_t)(row0 + ((g) >> 2) * HALF + ((g) & 3) * 16) * D + col0; _Pragma("unroll") for (int q_ = 0; q_ < 4; ++q_) bb[buf][q_] = *(const f32x4*)(base + off_ + (q_ >> 1) * HALF + (q_ & 1) * 16); }
        ER_LOAD(0, 0) ER_LOAD(1, 1)
#pragma unroll
        for (int g = 0; g < 8; ++g) { const int ai = g >> 2, m = g & 3;
            if (g + 2 < 8) ER_LOAD((g + 2) % 3, g + 2)
            const int r = row0 + ai * HALF + m * 16; const size_t off = (size_t)r * D + col0; float s = 0.f;
#pragma unroll
            for (int q = 0; q < 4; ++q) { const int bj = q >> 1, n = q & 1; const f32x4 v = bb[g % 3][q] + acc[ai][bj][m][n] * alpha;
                *(f32x4*)(out + off + bj * HALF + n * 16) = v;
                if (xb) { s += (v[0] * v[0] + v[1] * v[1]) + (v[2] * v[2] + v[3] * v[3]); u32x2 w; w.x = cvt_pk_bf16(v[0], v[1]); w.y = cvt_pk_bf16(v[2], v[3]); *(u32x2*)(xb + off + bj * HALF + n * 16) = w; } }
            if (xb) { s += __shfl_xor(s, 16); s += __shfl_xor(s, 32); if (fq == 0) ssp[(size_t)r * 32 + u.pn * 4 + wc] = s; }
            asm volatile("" ::: "memory"); }
#undef ER_LOAD
    }
};
struct EpiPin {
    static constexpr bool PERM = true, AFTER_DRAIN = false, KEEP_ACC = false;
    bf16_t* P; const __attribute__((address_space(3))) float* tab;
    template <int KIND> __device__ __forceinline__ void run(const f32x4 (&acc)[2][2][4][2], const Unit& u, int wr, int wc, int fr, int fq, int ui) const {
        const __attribute__((address_space(3))) float* tb = tab + ui * 256 + wr * 64 + fr;
        const int row0 = u.pm * BM + wr * 64 + fr, col0 = u.pn * BM + wc * 32 + 8 * fq;
#pragma unroll
        for (int ai = 0; ai < 2; ++ai)
#pragma unroll
            for (int m = 0; m < 4; ++m) { bf16_t* rowp = P + (size_t)(row0 + ai * HALF + m * 16) * NINP + col0; const float rs = tb[ai * HALF + m * 16];
#pragma unroll
                for (int bj = 0; bj < 2; ++bj) { float o[8];
#pragma unroll
                    for (int n = 0; n < 2; ++n)
#pragma unroll
                        for (int j = 0; j < 4; ++j) { const float x = acc[ai][bj][m][n][j] * rs;
                            o[n * 4 + j] = (KIND == 0) ? x : ((KIND == 1) ? sigmoid_f(x) : x * sigmoid_f(1.5957691216f * (x + 0.044715f * x * x * x))); }
                    u32x4 w; w.x = cvt_pk_bf16(o[0], o[1]); w.y = cvt_pk_bf16(o[2], o[3]); w.z = cvt_pk_bf16(o[4], o[5]); w.w = cvt_pk_bf16(o[6], o[7]);
                    *(u32x4*)(rowp + bj * HALF) = w; }
                asm volatile("" ::: "memory"); }
    }
    __device__ __forceinline__ void operator()(const f32x4 (&acc)[2][2][4][2], const Unit& u, int wr, int wc, int fr, int fq, int ui) const {
        if (u.pn < 32) run<1>(acc, u, wr, wc, fr, fq, ui); else if (u.pn >= 52 && u.pn < 56) run<2>(acc, u, wr, wc, fr, fq, ui); else run<0>(acc, u, wr, wc, fr, fq, ui);
    }
};
struct EpiF32 {
    static constexpr bool PERM = false, AFTER_DRAIN = false, KEEP_ACC = false;
    float* C; int ldc; int colmul;
    __device__ __forceinline__ void operator()(const f32x4 (&acc)[2][2][4][2], const Unit& u, int wr, int wc, int fr, int fq, int ui) const {
        const int row0 = u.pm * BM + wr * 64 + fr, col0 = colmul * u.pn * BM + wc * 32 + 4 * fq;
#pragma unroll
        for (int ai = 0; ai < 2; ++ai)
#pragma unroll
            for (int m = 0; m < 4; ++m) { float* rowp = C + (size_t)(row0 + ai * HALF + m * 16) * ldc + col0;
#pragma unroll
                for (int bj = 0; bj < 2; ++bj)
#pragma unroll
                    for (int n = 0; n < 2; ++n) *(f32x4*)(rowp + bj * HALF + n * 16) = acc[ai][bj][m][n]; }
    }
};
struct EpiExp {
    static constexpr bool PERM = true, AFTER_DRAIN = false, KEEP_ACC = false;
    bf16_t* P;
    __device__ __forceinline__ void operator()(const f32x4 (&acc)[2][2][4][2], const Unit& u, int wr, int wc, int fr, int fq, int ui) const {
        const int row0 = u.pm * BM + wr * 64 + fr, col0 = (u.pn & 31) * BM + wc * 32 + 8 * fq;
#pragma unroll
        for (int ai = 0; ai < 2; ++ai)
#pragma unroll
            for (int m = 0; m < 4; ++m) { bf16_t* rowp = P + (size_t)(row0 + ai * HALF + m * 16) * S + col0;
#pragma unroll
                for (int bj = 0; bj < 2; ++bj) { float o[8];
#pragma unroll
                    for (int n = 0; n < 2; ++n)
#pragma unroll
                        for (int j = 0; j < 4; ++j) o[n * 4 + j] =
#ifdef DBG_NOEXP
                            acc[ai][bj][m][n][j];
#else
                            fast_exp(acc[ai][bj][m][n][j]);
#endif
                    u32x4 w; w.x = cvt_pk_bf16(o[0], o[1]); w.y = cvt_pk_bf16(o[2], o[3]); w.z = cvt_pk_bf16(o[4], o[5]); w.w = cvt_pk_bf16(o[6], o[7]);
                    *(u32x4*)(rowp + bj * HALF) = w; }
                asm volatile("" ::: "memory"); }
    }
};
struct EpiBranch {
    static constexpr bool PERM = false, AFTER_DRAIN = false, KEEP_ACC = false;
    float* merged; bf16_t* mergedb; const bf16_t* gate; int b;
    __device__ __forceinline__ void operator()(const f32x4 (&acc)[2][2][4][2], const Unit& u, int wr, int wc, int fr, int fq, int ui) const {
        const int row0 = u.pm * BM + wr * 64 + fr, col0 = u.pn * BM + wc * 32 + 4 * fq;
#pragma unroll
        for (int ai = 0; ai < 2; ++ai)
#pragma unroll
            for (int m = 0; m < 4; ++m) { const int r = row0 + ai * HALF + m * 16;
#pragma unroll
                for (int bj = 0; bj < 2; ++bj)
#pragma unroll
                    for (int n = 0; n < 2; ++n) { const int c = col0 + bj * HALF + n * 16;
                        const u32x2 gv = *(const u32x2*)(gate + (size_t)r * NINP + c);
                        f32x4 g; g[0] = __uint_as_float(gv.x << 16); g[1] = __uint_as_float(gv.x & 0xffff0000u); g[2] = __uint_as_float(gv.y << 16); g[3] = __uint_as_float(gv.y & 0xffff0000u);
                        f32x4 v = acc[ai][bj][m][n] * g;
                        float* mp = merged + (size_t)r * D + c;
                        if (b != 0) v += *(const f32x4*)mp;
                        if (b != 3) *(f32x4*)mp = v;
                        else { u32x2 w; w.x = cvt_pk_bf16(v[0], v[1]); w.y = cvt_pk_bf16(v[2], v[3]); *(u32x2*)(mergedb + (size_t)r * D + c) = w; } }
                asm volatile("" ::: "memory"); }
    }
};
struct QKOrder {
    int G, c;
    __device__ bool next(int i, Unit& u) const { const int L = i * G + c; if (L >= 4096) return false; const int h = L >> 10, rem = L & 1023; u.pm = h * 32 + (rem >> 5); u.pn = h * 32 + (rem & 31); return true; }
    __device__ __forceinline__ void a_ready(const Unit&, int) const {}
    __device__ __forceinline__ void done(const Unit&) const {}
};
struct PVOrder {
    int G, c;
    __device__ bool next(int i, Unit& u) const { const int L = i * G + c; if (L >= 128) return false; u.pm = L; u.pn = L >> 5; return true; }
    __device__ __forceinline__ void a_ready(const Unit&, int) const {}
    __device__ __forceinline__ void done(const Unit&) const {}
};
struct EpiBranchChain {
    static constexpr bool PERM = true, AFTER_DRAIN = false, KEEP_ACC = true;
    bf16_t* mergedb; const bf16_t* gate;
    __device__ __forceinline__ void operator()(f32x4 (&acc)[2][2][4][2], const Unit& u, int wr, int wc, int fr, int fq, int ui) const {
        const int b = u.pm >> 5, pm0 = u.pm & 31, pn0 = u.pn & 7;
        const int row0 = pm0 * BM + wr * 64 + fr, col0 = pn0 * BM + wc * 32 + 8 * fq;
        u32x4 gg[3][2][2];
#define BC_LOAD(buf, g) { const bf16_t* gp_ = gate + (size_t)(row0 + ((g) >> 2) * HALF + ((g) & 3) * 16) * NINP + b * D + col0; _Pragma("unroll") for (int bj_ = 0; bj_ < 2; ++bj_) { \
            gg[buf][bj_][0] = *(const u32x4*)(gp_ + bj_ * HALF); if (b != 3) gg[buf][bj_][1] = *(const u32x4*)(gp_ + bj_ * HALF + D); } }
        BC_LOAD(0, 0) BC_LOAD(1, 1)
#pragma unroll
        for (int gi = 0; gi < 8; ++gi) { const int ai = gi >> 2, m = gi & 3; const int r = row0 + ai * HALF + m * 16;
            if (gi + 2 < 8) BC_LOAD((gi + 2) % 3, gi + 2)
#pragma unroll
            for (int bj = 0; bj < 2; ++bj) { const int c = col0 + bj * HALF;
                const u32x4 gv = gg[gi % 3][bj][0];
                float g[8] = {__uint_as_float(gv.x << 16), __uint_as_float(gv.x & 0xffff0000u), __uint_as_float(gv.y << 16), __uint_as_float(gv.y & 0xffff0000u),
                              __uint_as_float(gv.z << 16), __uint_as_float(gv.z & 0xffff0000u), __uint_as_float(gv.w << 16), __uint_as_float(gv.w & 0xffff0000u)};
                if (b != 3) {
                    const u32x4 hv = gg[gi % 3][bj][1];
                    const float gn[8] = {__uint_as_float(hv.x << 16), __uint_as_float(hv.x & 0xffff0000u), __uint_as_float(hv.y << 16), __uint_as_float(hv.y & 0xffff0000u),
                                         __uint_as_float(hv.z << 16), __uint_as_float(hv.z & 0xffff0000u), __uint_as_float(hv.w << 16), __uint_as_float(hv.w & 0xffff0000u)};
#pragma unroll
                    for (int n = 0; n < 2; ++n)
#pragma unroll
                        for (int j = 0; j < 4; ++j) acc[ai][bj][m][n][j] *= fmaxf(g[n * 4 + j], 1e-30f) * __builtin_amdgcn_rcpf(fmaxf(gn[n * 4 + j], 1e-30f));
                } else {
                    float o[8];
#pragma unroll
                    for (int n = 0; n < 2; ++n)
#pragma unroll
                        for (int j = 0; j < 4; ++j) o[n * 4 + j] = acc[ai][bj][m][n][j] * fmaxf(g[n * 4 + j], 1e-30f);
                    u32x4 w; w.x = cvt_pk_bf16(o[0], o[1]); w.y = cvt_pk_bf16(o[2], o[3]); w.z = cvt_pk_bf16(o[4], o[5]); w.w = cvt_pk_bf16(o[6], o[7]);
                    *(u32x4*)(mergedb + (size_t)r * D + c) = w;
                } }
            asm volatile("" ::: "memory"); }
#undef BC_LOAD
    }
};
template <class Sched> __device__ __forceinline__ void fill_rstd_table(const Sched& So, const float* ssp, __attribute__((address_space(3))) float* tab, int wave) {
    int t_ = wave * 64 + (int)__builtin_amdgcn_mbcnt_hi(~0u, __builtin_amdgcn_mbcnt_lo(~0u, 0u)); asm volatile("" : "+v"(t_));
    const int t = t_, row = t >> 1, half = t & 1;
#pragma unroll 1
    for (int ui = 0; ui < 8; ++ui) { Unit u; if (!So.next(ui, u)) break;
        const f32x4* p = (const f32x4*)(ssp + (size_t)(u.pm * BM + row) * 32 + half * 16); const f32x4 a = p[0], b = p[1], c = p[2], d = p[3];
        float s = (((a[0] + a[1]) + (a[2] + a[3])) + ((b[0] + b[1]) + (b[2] + b[3]))) + (((c[0] + c[1]) + (c[2] + c[3])) + ((d[0] + d[1]) + (d[2] + d[3])));
        s += __shfl_xor(s, 1);
        if (half == 0) tab[ui * 256 + row] = 1.0f / sqrtf(s * (1.0f / D) + EPS); }
}
struct BranchOrder {
    pg8::StaticOrder so;
    __device__ bool next(int i, Unit& u) const { if (i >= 4) return false; Unit t; if (!so.next(0, t)) return false; u.pm = i * 32 + t.pm; u.pn = i * 8 + t.pn; return true; }
    __device__ __forceinline__ void a_ready(const Unit&, int) const {}
    __device__ __forceinline__ void done(const Unit&) const {}
};
}
constexpr size_t MiB = 1u << 20;
constexpr size_t WS_CTL = 0, CTL_ZERO_BYTES = 1 * MiB;
constexpr size_t WS_COS = 1 * MiB, WS_SIN = 2 * MiB, WS_SSP = 3 * MiB;
constexpr size_t WS_WGU1 = 4 * MiB, WS_WD1 = 48 * MiB, WS_WGU2 = 70 * MiB, WS_WD2 = 114 * MiB;
constexpr size_t WS_WIN = 136 * MiB, WS_WBR = 195 * MiB, WS_WOUT = 203 * MiB, WS_WMLA = 211 * MiB;
constexpr size_t WS_X = 214 * MiB;
constexpr size_t WS_XN = 278 * MiB;
constexpr size_t WS_HID = 310 * MiB;
constexpr size_t WS_P = 398 * MiB;
constexpr size_t WS_Z = 634 * MiB;
constexpr size_t WS_VVN = 666 * MiB, WS_MLAA = 674 * MiB;
constexpr size_t WS_MLARAW = 682 * MiB;
constexpr size_t WS_QP = 1426 * MiB, WS_KP = 1458 * MiB, WS_VT = 770 * MiB;
constexpr int QKP = 256;
constexpr size_t WS_ORAW = 786 * MiB;
constexpr size_t WS_MERGED = 818 * MiB, WS_MERGEDB = 882 * MiB;
constexpr size_t WS_PEXP = 914 * MiB;
constexpr size_t WS_DILO = 1490 * MiB, WS_DILL = 1540 * MiB;
constexpr size_t WS_MQ = WS_QP, WS_MK = WS_KP, WS_MV = WS_VT, WS_MOP = WS_PEXP, WS_MLP = WS_ORAW;
constexpr size_t WS_END = 1541 * MiB;
static_assert(WS_WGU1 + (size_t)NGU * D * 2 <= WS_WD1 && WS_WD1 + (size_t)D * FF * 2 <= WS_WGU2 && WS_WGU2 + (size_t)NGU * D * 2 <= WS_WD2 && WS_WD2 + (size_t)D * FF * 2 <= WS_WIN, "ws map 1");
static_assert(WS_WIN + (size_t)NINP * D * 2 <= WS_WBR && WS_WBR + (size_t)4 * D * 512 * 2 <= WS_WOUT && WS_WOUT + (size_t)D * D * 2 <= WS_WMLA && WS_WMLA + (size_t)NMLA * 512 * 2 <= WS_X, "ws map 2");
static_assert(WS_X + (size_t)S * D * 4 <= WS_XN && WS_XN + (size_t)S * D * 2 <= WS_HID && WS_HID + (size_t)S * FF * 2 <= WS_P && WS_P + (size_t)S * NINP * 2 <= WS_Z, "ws map 3");
static_assert(WS_Z + (size_t)4 * S * 512 * 2 <= WS_VVN && WS_MLARAW + (size_t)S * NMLA * 4 <= WS_VT && WS_KP + (size_t)4 * S * QKP * 2 <= WS_END && WS_ORAW + (size_t)4 * S * 256 * 4 <= WS_MERGED && WS_MERGED + (size_t)S * D * 4 <= WS_MERGEDB && WS_MERGEDB + (size_t)S * D * 2 <= WS_PEXP && WS_PEXP + (size_t)4 * S * S * 2 <= WS_QP, "ws map 4");
constexpr size_t WS_SETD = 956 * MiB;
static_assert(WS_WGU1 + WS_SETD >= WS_PEXP + (size_t)2 * 4 * S * 128 * 4 && WS_X + WS_SETD <= WS_QP, "second weight set");
#ifndef TAILCONV
#define TAILCONV 0
#endif
constexpr int CPARTS = 416;
constexpr int CW_BAR = 4096;

constexpr int NWAVES = 8;
constexpr int RING_OFF = 0, RING_BYTES = 131072;
constexpr int LDSCTL_OFF = RING_BYTES, MISC_OFF = LDSCTL_OFF + 320;
constexpr int LDS_BYTES = 147456;
constexpr int RSTD_OFF = RING_BYTES + 1024;

enum { I_X = 0, I_F1N, I_F1G, I_F1U, I_F1D, I_MIXN, I_WIN, I_POOLW, I_POOLS, I_DQN, I_DKN, I_SGUN, I_SGUW, I_SGUB, I_MQAN, I_MWUQ, I_MKVAN, I_MWUKV, I_MQN, I_MKN, I_WBR, I_WOUT, I_F2N, I_F2G, I_F2U, I_F2D, N_INPUTS };

struct Frame {
    LAS unsigned char* lds;
    volatile LAS unsigned* MISC;
    int wave, vcu, G;
    int gw, NGW, NGT;
};
constexpr int NPHASE = 13;
struct Args { const float* in[N_INPUTS]; float* out; unsigned char* ws; int l_lo, l_hi, ph_lo, ph_hi; };
typedef const __attribute__((address_space(4))) Args* ArgsP;
__device__ __forceinline__ ArgsP fresh_args() { ArgsP p = (ArgsP)__builtin_amdgcn_kernarg_segment_ptr(); asm volatile("" : "+s"(p)); return p; }
__device__ __forceinline__ int opq_s(int x) { asm volatile("" : "+s"(x)); return x; }
__device__ __forceinline__ Frame fresh_frame(const Frame& F) { Frame R = F; R.wave = opq_s(F.wave); R.vcu = opq_s(F.vcu); R.G = opq_s(F.G); R.gw = opq_s(F.gw); R.NGW = opq_s(F.NGW); R.NGT = opq_s(F.NGT); return R; }
__device__ __forceinline__ int opq_lane() { int l = (int)__builtin_amdgcn_mbcnt_hi(~0u, __builtin_amdgcn_mbcnt_lo(~0u, 0u)); asm volatile("" : "+v"(l)); return l; }
__device__ __forceinline__ float wave_sum(float v) {
#pragma unroll
    for (int o = 1; o < 64; o <<= 1) v += __shfl_xor(v, o);
    return v;
}
__device__ __forceinline__ float wave_max(float v) {
#pragma unroll
    for (int o = 1; o < 64; o <<= 1) v = fmaxf(v, __shfl_xor(v, o));
    return v;
}
__device__ __forceinline__ float bf2f(unsigned short b) { return __uint_as_float(((unsigned)b) << 16); }
__device__ __forceinline__ float bflo(unsigned u) { return __uint_as_float(u << 16); }
__device__ __forceinline__ float bfhi(unsigned u) { return __uint_as_float(u & 0xffff0000u); }
__device__ __forceinline__ float rsq(float x) { return 1.0f / sqrtf(x); }

__device__ __forceinline__ void transpose_load(f32x4 (&v)[8], const float* W, int ldw, int k0, int n0, int lane) {
    const int pc = lane & 7, kr = lane >> 3;
#pragma unroll
    for (int i = 0; i < 8; ++i) v[i] = __builtin_nontemporal_load((const GAS f32x4*)(W + (size_t)(k0 + 8 * i + kr) * ldw + n0 + 4 * pc));
}
__device__ __forceinline__ void transpose_store(const f32x4 (&v)[8], int k0, bf16* WT, int ldt, int drow0, int dk0, LAS float* scr, int lane, const float* kgain) {
    const int pc = lane & 7, kr = lane >> 3;
#pragma unroll
    for (int i = 0; i < 8; ++i) { LAS float* d = scr + (8 * i + kr) * 33 + 4 * pc; const float gk = kgain ? kgain[k0 + 8 * i + kr] : 1.0f;
        d[0] = v[i].x * gk; d[1] = v[i].y * gk; d[2] = v[i].z * gk; d[3] = v[i].w * gk; }
    LDS_WAIT(); asm volatile("" ::: "memory");
    const int c = lane & 7;
#pragma unroll
    for (int j = 0; j < 4; ++j) { const int n = (lane >> 3) + 8 * j; const LAS float* s = scr + (8 * c) * 33 + n;
        v4u o; o.x = pk2(s[0 * 33], s[1 * 33]); o.y = pk2(s[2 * 33], s[3 * 33]); o.z = pk2(s[4 * 33], s[5 * 33]); o.w = pk2(s[6 * 33], s[7 * 33]);
        *(GAS v4u*)(WT + (size_t)(drow0 + n) * ldt + dk0 + k0 + 8 * c) = o; }
    LDS_WAIT(); asm volatile("" ::: "memory");
}
template <int MAP> __device__ __forceinline__ int map_row(int n0, int roff) {
    if (MAP == 0) return n0 + roff;
    if (MAP == 1) return (n0 >> 7) * 256 + roff + (n0 & 127);
    return (n0 < 6720) ? (n0 + 8192) : (n0 - 6720);
}
template <int MAP> __device__ __forceinline__ void transpose_matrix(const Frame& F, int vgw, int vNGW, int p0, int p1, int lane, const float* W, int K, int N, bf16* WT, int ldt, int roff, int dk0, const float* kgain = nullptr) {
    LAS float* scr = (LAS float*)(F.lds + RING_OFF + (vgw & 7) * 16384);
    const int nblk = N / 32, items = (K / 64) * nblk, lo = (int)((long)items * p0 / CPARTS), hi = (int)((long)items * p1 / CPARTS);
    int it = lo + vgw; if (it >= hi) return;
    f32x4 va[8], vb[8]; transpose_load(va, W, N, 64 * (it / nblk), 32 * (it % nblk), lane);
    for (;;) {
        const int itn = it + vNGW; const bool more = itn < hi;
        if (more) transpose_load(vb, W, N, 64 * (itn / nblk), 32 * (itn % nblk), lane);
        transpose_store(va, 64 * (it / nblk), WT, ldt, map_row<MAP>(32 * (it % nblk), roff), dk0, scr, lane, kgain);
        if (!more) break;
#pragma unroll
        for (int i = 0; i < 8; ++i) va[i] = vb[i];
        it = itn;
    }
}

__device__ __forceinline__ void phase_convert(ArgsP A, const Frame& F, int l, int vgw, int vNGW, int p0, int p1) {
    unsigned char* ws = A->ws + (size_t)(l & 1) * WS_SETD; const int lane = opq_lane(); const int vgt = vgw * 64 + lane, vNGT = vNGW * 64;
#define TM(MAP, ...) transpose_matrix<MAP>(F, vgw, vNGW, p0, p1, lane, __VA_ARGS__)
#define PART(n, lo, hi) const int lo = (int)((long)(n) * p0 / CPARTS), hi = (int)((long)(n) * p1 / CPARTS)
    TM(0, A->in[I_F2D] + (size_t)l * FF * D, FF, D, (bf16*)(ws + WS_WD2), FF, 0, 0);
    TM(1, A->in[I_F2G] + (size_t)l * D * FF, D, FF, (bf16*)(ws + WS_WGU2), D, 0, 0, A->in[I_F2N] + (size_t)l * D);
    TM(1, A->in[I_F2U] + (size_t)l * D * FF, D, FF, (bf16*)(ws + WS_WGU2), D, 128, 0, A->in[I_F2N] + (size_t)l * D);
    TM(0, A->in[I_WOUT] + (size_t)l * D * D, D, D, (bf16*)(ws + WS_WOUT), D, 0, 0);
    for (int b = 1; b < 4; ++b) TM(0, A->in[I_WBR] + ((size_t)l * 4 + b) * 512 * D, 512, D, (bf16*)(ws + WS_WBR) + (size_t)b * D * 512, 512, 0, 0);
    TM(0, A->in[I_MWUQ] + (size_t)l * 384 * 768, 384, 768, (bf16*)(ws + WS_WMLA), 512, 0, 0);
    TM(0, A->in[I_MWUKV] + (size_t)l * 128 * 1024, 128, 1024, (bf16*)(ws + WS_WMLA), 512, 768, 384);
    TM(2, A->in[I_WIN] + (size_t)l * D * NIN, D, NIN, (bf16*)(ws + WS_WIN), D, 0, 0, A->in[I_MIXN] + (size_t)l * D);
    TM(0, A->in[I_F1D] + (size_t)l * FF * D, FF, D, (bf16*)(ws + WS_WD1), FF, 0, 0);
    TM(1, A->in[I_F1G] + (size_t)l * D * FF, D, FF, (bf16*)(ws + WS_WGU1), D, 0, 0, A->in[I_F1N] + (size_t)l * D);
    TM(1, A->in[I_F1U] + (size_t)l * D * FF, D, FF, (bf16*)(ws + WS_WGU1), D, 128, 0, A->in[I_F1N] + (size_t)l * D);
    { bf16* wm = (bf16*)(ws + WS_WMLA);
      { PART(768 * 128, lo, hi); for (int i = lo + vgt; i < hi; i += vNGT) wm[(size_t)(i >> 7) * 512 + 384 + (i & 127)] = 0; }
      { PART(1024 * 384, lo, hi); for (int i = lo + vgt; i < hi; i += vNGT) wm[(size_t)(768 + i / 384) * 512 + (i % 384)] = 0; }
      unsigned* wz = (unsigned*)((bf16*)(ws + WS_WIN) + (size_t)NIN * D);
      { PART((NINP - NIN) * D / 2, lo, hi); for (int i = lo + vgt; i < hi; i += vNGT) wz[i] = 0u; } }
    { const float* pw = A->in[I_POOLW] + (size_t)l * 4 * 128 * 128; const float* ps = A->in[I_POOLS] + (size_t)l * 512; const float* wb = A->in[I_WBR] + (size_t)l * 4 * 512 * D;
      bf16* wt = (bf16*)(ws + WS_WBR);
      PART(128 * D, lo, hi);
      for (int i = lo + vgt; i < hi; i += vNGT) { const int r4 = (i >> 11) * 4, n = i & (D - 1), g = r4 >> 7;
          const float* pr = pw + (size_t)r4 * 128; const float* wcol = wb + (size_t)(g * 128) * D + n; const float* psg = ps + g * 128;
          float a0 = 0.f, a1 = 0.f, a2 = 0.f, a3 = 0.f;
#pragma unroll 8
          for (int d = 0; d < 128; ++d) { const float wv = wcol[(size_t)d * D] * psg[d]; a0 += pr[d] * wv; a1 += pr[128 + d] * wv; a2 += pr[256 + d] * wv; a3 += pr[384 + d] * wv; }
          bf16* o = wt + (size_t)n * 512 + r4;
          *(unsigned long long*)o = (unsigned long long)pk2(a0, a1) | ((unsigned long long)pk2(a2, a3) << 32); } }
#undef TM
#undef PART
}
__device__ __forceinline__ void tail_convert(ArgsP A, const Frame& F, int l, int bx, int nunits, int p0, int p1) {
#if !TAILCONV
    return;
#endif
    const int busy = nunits % F.G; if (busy == 0 || l + 1 >= NLAYER) return;
    const int slot = bx - busy; if (slot < 0) return;
    phase_convert(A, F, l + 1, slot * NWAVES + F.wave, (F.G - busy) * NWAVES, p0, p1);
}
__device__ __forceinline__ void phase_rope_tables(ArgsP A, const Frame& F) {
    unsigned char* ws = A->ws; const int lane = opq_lane(); const int gw = opq_s(F.gw); const int gt = gw * 64 + lane;
    {
        float* ct = (float*)(ws + WS_COS); float* st = (float*)(ws + WS_SIN);
        for (int i = gt; i < S * 32; i += F.NGT) { const int pos = i >> 5, k = i & 31;
            double f = 1.0; for (int j = 0; j < k; ++j) f *= 0.74989420933245582730;
            const float ang = (float)pos * (float)f;
            const double a = (double)ang; const double kq = __builtin_rint(a * 0.63661977236758134308); const double r = (a - kq * 1.5707963267948966192) - kq * 6.123233995736766e-17;
            const double r2 = r * r;
            const double sn = r * (1.0 + r2 * (-1.0 / 6 + r2 * (1.0 / 120 + r2 * (-1.0 / 5040 + r2 * (1.0 / 362880 + r2 * (-1.0 / 39916800 + r2 * (1.0 / 6227020800.0)))))));
            const double cs = 1.0 + r2 * (-0.5 + r2 * (1.0 / 24 + r2 * (-1.0 / 720 + r2 * (1.0 / 40320 + r2 * (-1.0 / 3628800 + r2 * (1.0 / 479001600.0 + r2 * (-1.0 / 87178291200.0)))))));
            const int q = ((int)kq) & 3;
            const double sv = (q == 0) ? sn : (q == 1) ? cs : (q == 2) ? -sn : -cs;
            const double cv = (q == 0) ? cs : (q == 1) ? -sn : (q == 2) ? -cs : sn;
            ct[i] = (float)cv; st[i] = (float)sv; }
    }
}
__device__ __forceinline__ void phase_prep(const Frame& F, const float* x, bf16* xb, float* ssp) {
    const int lane = opq_lane(); const int gw = opq_s(F.gw);
    for (int m = gw; m < S; m += F.NGW) {
        const GAS f32x4* xr = (const GAS f32x4*)(x + (size_t)m * D) + lane;
        f32x4 v[8]; float s = 0.f;
#pragma unroll
        for (int j = 0; j < 8; ++j) { v[j] = xr[64 * j]; s += (v[j].x * v[j].x + v[j].y * v[j].y) + (v[j].z * v[j].z + v[j].w * v[j].w); }
        s = wave_sum(s);
        GAS unsigned long long* o8 = (GAS unsigned long long*)(xb + (size_t)m * D) + lane;
#pragma unroll
        for (int j = 0; j < 8; ++j) o8[64 * j] = (unsigned long long)pk2(v[j].x, v[j].y) | ((unsigned long long)pk2(v[j].z, v[j].w) << 32);
        if (lane < 32) ssp[(size_t)m * 32 + lane] = (lane == 0) ? s : 0.f;
    }
}
__device__ __forceinline__ void phase_mix1(ArgsP A, const Frame& F, int l) {
    unsigned char* ws = A->ws; const int lane = opq_lane(); const int gw = opq_s(F.gw); const int gt = gw * 64 + lane;
    bf16* p = (bf16*)(ws + WS_P); bf16* z0 = (bf16*)(ws + WS_Z); bf16* vvn = (bf16*)(ws + WS_VVN); bf16* mlaA = (bf16*)(ws + WS_MLAA);
    for (int item = gt; item < (S / 16) * 256; item += F.NGT) {
        const int cp = item & 255, t0 = (item >> 8) * 16, g = cp >> 6;
        const bf16* col = p + PC_POOL + 2 * cp;
        float va[32], vb[32];
#pragma unroll
        for (int k = 0; k < 32; ++k) { const int tt = t0 - 8 + k; const bool in = (tt >= 0) && (tt < S); const unsigned u = in ? *(const unsigned*)(col + (size_t)(in ? tt : 0) * NINP) : 0u; va[k] = bflo(u); vb[k] = bfhi(u); }
        unsigned* zo = (unsigned*)(z0 + (size_t)t0 * 512 + 2 * cp);
#define POOL_GROUP(HW) do { \
        _Pragma("unroll") for (int i = 0; i < 16; ++i) { float sa = 0.f, sb = 0.f; \
            _Pragma("unroll") for (int k = 8 + i - (HW); k < 8 + i + (HW); ++k) { sa += va[k]; sb += vb[k]; }     \
            const int t = t0 + i, lo = (t - (HW)) < 0 ? 0 : (t - (HW)), hi = (t + (HW)) > S ? S : (t + (HW)); const float inv = 1.0f / (float)(hi - lo); \
            zo[(size_t)i * 256] = pk2(sa * inv - va[8 + i], sb * inv - vb[8 + i]); } } while (0)
        if (g == 0) POOL_GROUP(1); else if (g == 1) POOL_GROUP(2); else if (g == 2) POOL_GROUP(4); else POOL_GROUP(8);
#undef POOL_GROUP
    }
    const float* gq = A->in[I_DQN] + l * 128; const float* gk = A->in[I_DKN] + l * 128; const float* gs = A->in[I_SGUN] + l * 512;
    const float* gqa = A->in[I_MQAN] + l * 384; const float* gkva = A->in[I_MKVAN] + l * 128;
    for (int t = gw; t < S; t += F.NGW) {
        bf16* prow = p + (size_t)t * NINP;
        { unsigned* ptr = (unsigned*)(prow + PC_DIL) + lane; unsigned uu[24]; float ss[24];
#pragma unroll
          for (int hh = 0; hh < 24; ++hh) uu[hh] = ptr[hh * 64];
#pragma unroll
          for (int hh = 0; hh < 24; ++hh) { const float a = bflo(uu[hh]), b = bfhi(uu[hh]); ss[hh] = a * a + b * b; }
#pragma unroll
          for (int o = 1; o < 64; o <<= 1) {
#pragma unroll
              for (int hh = 0; hh < 24; ++hh) ss[hh] += __shfl_xor(ss[hh], o); }
          const float gq0 = gq[2 * lane], gq1 = gq[2 * lane + 1], gk0 = gk[2 * lane], gk1 = gk[2 * lane + 1];
#pragma unroll
          for (int hh = 0; hh < 24; ++hh) { const float rstd = rsq(ss[hh] * (1.f / 128) + EPS);
              ptr[hh * 64] = pk2(bflo(uu[hh]) * rstd * (hh < 12 ? gq0 : gk0), bfhi(uu[hh]) * rstd * (hh < 12 ? gq1 : gk1)); } }
        { const v4u u = *((const v4u*)(prow + PC_SGU + 512) + lane); float x[8] = {bflo(u.x), bfhi(u.x), bflo(u.y), bfhi(u.y), bflo(u.z), bfhi(u.z), bflo(u.w), bfhi(u.w)}; float ss = 0.f;
#pragma unroll
          for (int k = 0; k < 8; ++k) ss += x[k] * x[k];
          const float rstd = rsq(wave_sum(ss) * (1.f / 512) + EPS); const float* gg = gs + 8 * lane;
          v4u o; o.x = pk2(x[0] * rstd * gg[0], x[1] * rstd * gg[1]); o.y = pk2(x[2] * rstd * gg[2], x[3] * rstd * gg[3]); o.z = pk2(x[4] * rstd * gg[4], x[5] * rstd * gg[5]); o.w = pk2(x[6] * rstd * gg[6], x[7] * rstd * gg[7]);
          *((v4u*)(vvn + (size_t)t * 512) + lane) = o; }
        { const unsigned* cq = (const unsigned*)(prow + PC_CQ) + lane; const unsigned u0 = cq[0], u1 = cq[64], u2 = cq[128];
          const float a0 = bflo(u0), b0 = bfhi(u0), a1 = bflo(u1), b1 = bfhi(u1), a2 = bflo(u2), b2 = bfhi(u2);
          const float rstd = rsq(wave_sum((a0 * a0 + b0 * b0) + (a1 * a1 + b1 * b1) + (a2 * a2 + b2 * b2)) * (1.f / 384) + EPS);
          unsigned* o = (unsigned*)(mlaA + (size_t)t * 512) + lane; const float* gg = gqa + 2 * lane;
          o[0] = pk2(a0 * rstd * gg[0], b0 * rstd * gg[1]); o[64] = pk2(a1 * rstd * gg[128], b1 * rstd * gg[129]); o[128] = pk2(a2 * rstd * gg[256], b2 * rstd * gg[257]);
          const unsigned uk = *((const unsigned*)(prow + PC_CKV) + lane); const float ak = bflo(uk), bk = bfhi(uk);
          const float rk = rsq(wave_sum(ak * ak + bk * bk) * (1.f / 128) + EPS);
          o[192] = pk2(ak * rk * gkva[2 * lane], bk * rk * gkva[2 * lane + 1]); }
    }
}
typedef float f32x16 __attribute__((ext_vector_type(16)));
typedef short s16x4 __attribute__((ext_vector_type(4)));
typedef short v4i16_t __attribute__((ext_vector_type(4)));
#define MFMA32(a, b, c) __builtin_amdgcn_mfma_f32_32x32x16_bf16((a), (b), (c), 0, 0, 0)
__device__ __forceinline__ int crow(int reg, int h) { return (reg & 3) + 8 * (reg >> 2) + 4 * h; }
__device__ __forceinline__ bf16x8 pack8(const f32x16& x, int s) {
    v4u p; p.x = epi::cvt_pk_bf16(x[8 * s], x[8 * s + 1]); p.y = epi::cvt_pk_bf16(x[8 * s + 2], x[8 * s + 3]); p.z = epi::cvt_pk_bf16(x[8 * s + 4], x[8 * s + 5]); p.w = epi::cvt_pk_bf16(x[8 * s + 6], x[8 * s + 7]);
    return __builtin_bit_cast(bf16x8, p);
}
__device__ __forceinline__ s16x4 tr_read(const LAS unsigned char* p) { return __builtin_bit_cast(s16x4, __builtin_amdgcn_ds_read_tr16_b64_v4i16((LAS v4i16_t*)p)); }
__device__ __forceinline__ int vimg_off(int key, int piece  ) { return key * 256 + (((piece >> 2) ^ (key & 3)) << 6) + ((piece & 3) << 4); }
__device__ __forceinline__ bf16x8 vt_frag(const LAS unsigned char* img, int key0, int d0, int lane) {
    const int h = lane >> 5, blk = (lane >> 4) & 1, q = (lane & 15) >> 2, pp = lane & 3;
    const int ka = key0 + 4 * h + q, kb = ka + 8;
    const int col = ((d0 ^ q) << 6) + (16 * blk + 4 * pp) * 2;
    const s16x4 lo = tr_read(img + ka * 256 + col), hi = tr_read(img + kb * 256 + col);
    return __builtin_shufflevector(lo, hi, 0, 1, 2, 3, 4, 5, 6, 7);
}
__device__ __forceinline__ int vt_lane_off(int lane, int d0) { const int h = lane >> 5, blk = (lane >> 4) & 1, q = (lane & 15) >> 2, pp = lane & 3; return (4 * h + q) * 256 + ((d0 ^ q) << 6) + (16 * blk + 4 * pp) * 2; }
template <int KEY0> __device__ __forceinline__ bf16x8 vt_frag_o(const LAS unsigned char* img, int voff) {
    const s16x4 lo = tr_read(img + voff + KEY0 * 256), hi = tr_read(img + voff + (KEY0 + 8) * 256);
    return __builtin_shufflevector(lo, hi, 0, 1, 2, 3, 4, 5, 6, 7);
}
__device__ __forceinline__ bf16x8 tr_frag(const LAS unsigned char* img, int ra, int rb, int cb, int lane) {
    const int blk = (lane >> 4) & 1, q = (lane & 15) >> 2, pp = lane & 3;
    const int col = ((cb ^ q) << 6) + (16 * blk + 4 * pp) * 2;
    const s16x4 lo = tr_read(img + (ra + q) * 256 + col), hi = tr_read(img + (rb + q) * 256 + col);
    return __builtin_shufflevector(lo, hi, 0, 1, 2, 3, 4, 5, 6, 7);
}
__device__ __forceinline__ void sgu_mix_mfma(ArgsP A, const Frame& F, int l, int lane) {
    unsigned char* ws = A->ws; const bf16* p = (const bf16*)(ws + WS_P); const bf16* vvn = (const bf16*)(ws + WS_VVN); bf16* z2 = (bf16*)(ws + WS_Z) + (size_t)2 * S * 512;
    const float* sw = A->in[I_SGUW] + (size_t)l * 4 * 128 * 128; const float* sb = A->in[I_SGUB] + (size_t)l * 4 * 128;
    LAS unsigned char* img = F.lds + RING_OFF;
    const int w = F.wave, tid = w * 64 + lane, ql = lane & 31, h = lane >> 5, tb = 32 * (w & 3), cb0 = 2 * (w >> 2);
    for (int unit = F.vcu; unit < 256; unit += F.G) {
        const int n = unit >> 2, g = unit & 3;
#pragma unroll
        for (int i = 0; i < 4; ++i) { const int idx = i * 512 + tid, s = idx >> 4, piece = idx & 15;
            *(LAS v4u*)(img + vimg_off(s, piece)) = *(const v4u*)(vvn + (size_t)(n * 128 + s) * 512 + g * 128 + piece * 8); }
        __syncthreads();
        f32x16 acc0, acc1;
#pragma unroll
        for (int e = 0; e < 16; ++e) { acc0[e] = 0.f; acc1[e] = 0.f; }
        const float* wrow = sw + ((size_t)g * 128 + tb + ql) * 128 + 8 * h;
#pragma unroll
        for (int ks = 0; ks < 8; ++ks) {
            const f32x4 a0 = *(const f32x4*)(wrow + 16 * ks), a1 = *(const f32x4*)(wrow + 16 * ks + 4);
            v4u ap; ap.x = epi::cvt_pk_bf16(a0.x, a0.y); ap.y = epi::cvt_pk_bf16(a0.z, a0.w); ap.z = epi::cvt_pk_bf16(a1.x, a1.y); ap.w = epi::cvt_pk_bf16(a1.z, a1.w);
            const bf16x8 af = __builtin_bit_cast(bf16x8, ap);
            acc0 = MFMA32(af, tr_frag(img, 16 * ks + 8 * h, 16 * ks + 8 * h + 4, cb0, lane), acc0);
            acc1 = MFMA32(af, tr_frag(img, 16 * ks + 8 * h, 16 * ks + 8 * h + 4, cb0 + 1, lane), acc1);
        }
#pragma unroll
        for (int e = 0; e < 16; ++e) { const int tl = tb + crow(e, h), t = n * 128 + tl; const float bias = sb[g * 128 + tl];
            const int c0 = g * 128 + 32 * cb0 + ql;
            const float u0 = bf2f(p[(size_t)t * NINP + PC_SGU + c0]), u1 = bf2f(p[(size_t)t * NINP + PC_SGU + c0 + 32]);
            z2[(size_t)t * 512 + c0] = (bf16)f2bf(u0 * (acc0[e] + bias)); z2[(size_t)t * 512 + c0 + 32] = (bf16)f2bf(u1 * (acc1[e] + bias)); }
        __syncthreads();
    }
}
__device__ __forceinline__ void dil_attention(ArgsP A, const Frame& F, int l, int gw, int lane) {
    unsigned char* ws = A->ws; const bf16* p = (const bf16*)(ws + WS_P);
    float* OP = (float*)(ws + WS_DILO); float* LP = (float*)(ws + WS_DILL);
    LAS unsigned char* img = F.lds + RING_OFF + (gw & 7) * 8192;
    const float* gq = A->in[I_DQN] + l * 128; const float* gk = A->in[I_DKN] + l * 128;
    const float cbound = 11.313708499f * wave_max(fmaxf(fabsf(gq[lane]), fabsf(gq[lane + 64]))) * wave_max(fmaxf(fabsf(gk[lane]), fabsf(gk[lane + 64])));
    const int ql = lane & 31, h = lane >> 5;
    const int nun = ((gw & 7) < 4) ? 2 : 1;
    for (int kk = 0; kk < ((F.G == 256) ? nun : 1 << 30); ++kk) {
        const int unit = (F.G == 256) ? (gw >> 3) * 12 + (gw & 7) + 8 * kk : gw + kk * F.NGW; if (unit >= 12 * 256) break;
        const int hq = unit >> 8, blk = unit & 255, g = hq >> 2, ih = hq & 3, dl = 1 << (2 * g), L = S >> (2 * g), nb = 256 >> (2 * g);
        const int r = blk / nb, b = blk % nb;
        const float slope = __builtin_amdgcn_exp2f(-8.0f * (float)(hq + 1) / 12.0f) * (float)dl;
        const int tq = r + dl * (32 * b + ql);
        bf16x8 qf[8];
        { const v4u* src = (const v4u*)(p + (size_t)tq * NINP + PC_DIL + hq * 128 + 8 * h);
#pragma unroll
          for (int s = 0; s < 8; ++s) qf[s] = __builtin_bit_cast(bf16x8, src[2 * s]); }
        f32x16 o[4]; float lsum = 0.f;
#pragma unroll
        for (int d0 = 0; d0 < 4; ++d0)
#pragma unroll
            for (int e = 0; e < 16; ++e) o[d0][e] = 0.f;
#pragma unroll 1
        for (int c = -2; c <= 2; ++c) {
            const int mb = 32 * (b + c);
            if (mb < 0 || mb >= L) continue;
            f32x16 sacc;
#pragma unroll
            for (int e = 0; e < 16; ++e) sacc[e] = 0.f;
            v4u vreg[8];
#pragma unroll
            for (int i = 0; i < 8; ++i) { const int idx = i * 64 + lane, key = idx >> 4, piece = idx & 15;
                vreg[i] = *(const v4u*)(p + (size_t)(r + dl * (mb + key)) * NINP + PC_DIL + 3072 + hq * 128 + piece * 8); }
            { const int tk = r + dl * (mb + ql);
              const v4u* src = (const v4u*)(p + (size_t)tk * NINP + PC_DIL + 1536 + hq * 128 + 8 * h);
              bf16x8 kf[8];
#pragma unroll
              for (int s = 0; s < 8; ++s) kf[s] = __builtin_bit_cast(bf16x8, src[2 * s]);
#pragma unroll
              for (int s = 0; s < 8; ++s) sacc = MFMA32(kf[s], qf[s], sacc); }
#pragma unroll
            for (int i = 0; i < 8; ++i) { const int idx = i * 64 + lane, key = idx >> 4, piece = idx & 15; *(LAS v4u*)(img + vimg_off(key, piece)) = vreg[i]; }
#pragma unroll
            for (int e = 0; e < 16; ++e) { const int rel = 32 * c + crow(e, h) - ql, arel = rel < 0 ? -rel : rel;
                const float sv = sacc[e] * 0.08838834764831845f - slope * (float)arel - cbound;
                const float pe = (arel <= 64) ? epi::fast_exp(sv) : 0.f; sacc[e] = pe; lsum += pe; }
            const bf16x8 pb0 = pack8(sacc, 0), pb1 = pack8(sacc, 1);
#pragma unroll
            for (int d0 = 0; d0 < 4; ++d0) { o[d0] = MFMA32(vt_frag(img, 0, d0, lane), pb0, o[d0]); o[d0] = MFMA32(vt_frag(img, 16, d0, lane), pb1, o[d0]); }
        }
        lsum += __shfl_xor(lsum, 32);
        float* orow = OP + ((size_t)g * S + tq) * 512 + ih * 128 + 4 * h;
#pragma unroll
        for (int d0 = 0; d0 < 4; ++d0)
#pragma unroll
            for (int k = 0; k < 4; ++k) { f32x4 v; v.x = o[d0][4 * k]; v.y = o[d0][4 * k + 1]; v.z = o[d0][4 * k + 2]; v.w = o[d0][4 * k + 3]; *(f32x4*)(orow + 32 * d0 + 8 * k) = v; }
        if (h == 0) LP[((size_t)g * S + tq) * 4 + ih] = lsum;
    }
}
__device__ __forceinline__ void phase_mix2(ArgsP A, const Frame& F, int l) {
    unsigned char* ws = A->ws; const int lane = opq_lane(); const int gw = opq_s(F.gw); const int gt = gw * 64 + lane;
    const bf16* p = (const bf16*)(ws + WS_P); const float* raw = (const float*)(ws + WS_MLARAW);
    const float* ct = (const float*)(ws + WS_COS); const float* st = (const float*)(ws + WS_SIN);
    const float* gqn = A->in[I_MQN] + l * 192; const float* gkn = A->in[I_MKN] + l * 192;
    const float QSCL = 0.07216878364870322f * 1.4426950408889634f;
    bf16* MQ = (bf16*)(ws + WS_MQ); bf16* MK = (bf16*)(ws + WS_MK); bf16* MV = (bf16*)(ws + WS_MV);
    const int w8 = gw & 7, tok0 = (gw >> 3) * 32 + (w8 < 4 ? 2 * w8 : 8 + 6 * (w8 - 4)), npair = (w8 < 4) ? 1 : 3;
    const float gq0 = gqn[lane], gq1 = gqn[lane + 64], gq2 = gqn[lane + 128], gk0 = gkn[lane], gk1 = gkn[lane + 64], gk2 = gkn[lane + 128];
    for (int jj = 0; jj < ((F.G == 256) ? npair : 1 << 30); ++jj) { const int tb = (F.G == 256) ? tok0 + 2 * jj : 2 * (gw + jj * F.NGW); if (tb >= S) break;
        float cs[2], sn[2], krv[2], q0[2][4], q1[2][4], q2[2][4], k0[2][4], k1[2][4], v0[2][4], v1[2][4], sq[2][4], sk[2][4];
#pragma unroll
        for (int u = 0; u < 2; ++u) { const int t = tb + u; cs[u] = ct[t * 32 + (lane & 31)]; sn[u] = st[t * 32 + (lane & 31)];
            const float* rr = raw + (size_t)t * NMLA; krv[u] = bf2f(p[(size_t)t * NINP + PC_KR + lane]);
#pragma unroll
            for (int h = 0; h < 4; ++h) { q0[u][h] = rr[h * 192 + lane]; q1[u][h] = rr[h * 192 + 64 + lane]; q2[u][h] = rr[h * 192 + 128 + lane];
                k0[u][h] = rr[768 + h * 256 + lane]; k1[u][h] = rr[768 + h * 256 + 64 + lane]; v0[u][h] = rr[768 + h * 256 + 128 + lane]; v1[u][h] = rr[768 + h * 256 + 192 + lane]; } }
#pragma unroll
        for (int u = 0; u < 2; ++u)
#pragma unroll
            for (int h = 0; h < 4; ++h) { sq[u][h] = q0[u][h] * q0[u][h] + q1[u][h] * q1[u][h] + q2[u][h] * q2[u][h]; sk[u][h] = k0[u][h] * k0[u][h] + k1[u][h] * k1[u][h] + krv[u] * krv[u]; }
#pragma unroll
        for (int o = 1; o < 64; o <<= 1) {
#pragma unroll
            for (int u = 0; u < 2; ++u)
#pragma unroll
                for (int h = 0; h < 4; ++h) { sq[u][h] += __shfl_xor(sq[u][h], o); sk[u][h] += __shfl_xor(sk[u][h], o); } }
#pragma unroll
        for (int u = 0; u < 2; ++u) { const int t = tb + u;
#pragma unroll
        for (int h = 0; h < 4; ++h) {
            const float rq = rsq(sq[u][h] * (1.f / 192) + EPS) * QSCL, rk = rsq(sk[u][h] * (1.f / 192) + EPS);
            const float a2 = q2[u][h] * rq * gq2, oa = __shfl_xor(a2, 32), a2r = (lane < 32) ? (a2 * cs[u] - oa * sn[u]) : (oa * sn[u] + a2 * cs[u]);
            const float b2 = krv[u] * rk * gk2, ob = __shfl_xor(b2, 32), b2r = (lane < 32) ? (b2 * cs[u] - ob * sn[u]) : (ob * sn[u] + b2 * cs[u]);
            bf16* qo = MQ + ((size_t)h * S + t) * 192; bf16* ko = MK + ((size_t)h * S + t) * 192; bf16* vo = MV + ((size_t)h * S + t) * 128;
            qo[lane] = (bf16)f2bf(q0[u][h] * rq * gq0); qo[lane + 64] = (bf16)f2bf(q1[u][h] * rq * gq1); qo[lane + 128] = (bf16)f2bf(a2r);
            ko[lane] = (bf16)f2bf(k0[u][h] * rk * gk0); ko[lane + 64] = (bf16)f2bf(k1[u][h] * rk * gk1); ko[lane + 128] = (bf16)f2bf(b2r);
            vo[lane] = (bf16)f2bf(v0[u][h]); vo[lane + 64] = (bf16)f2bf(v1[u][h]); } }
    }
    sgu_mix_mfma(A, F, l, lane);
    dil_attention(A, F, l, gw, lane);
}


#ifndef MLA_SGB
#define MLA_SGB 1
#endif
constexpr int MLA_KROW = 400, MLA_KIMG = 64 * MLA_KROW, MLA_BUF = MLA_KIMG + 64 * 256;
__device__ __forceinline__ void phase_mla_flash(ArgsP A, const Frame& F, int l) {
    unsigned char* ws = A->ws; const int lane = opq_lane();
    const bf16* MQ = (const bf16*)(ws + WS_MQ); const bf16* MK = (const bf16*)(ws + WS_MK); const bf16* MV = (const bf16*)(ws + WS_MV);
    float* OP = (float*)(ws + WS_MOP); float* LP = (float*)(ws + WS_MLP);
    const float* gqn = A->in[I_MQN] + l * 192; const float* gkn = A->in[I_MKN] + l * 192;
    const float c2 = 19.990625f * wave_max(fmaxf(fmaxf(fabsf(gqn[lane]), fabsf(gqn[lane + 64])), fabsf(gqn[lane + 128]))) * wave_max(fmaxf(fmaxf(fabsf(gkn[lane]), fabsf(gkn[lane + 64])), fabsf(gkn[lane + 128])));
    LAS unsigned char* lds = F.lds + RING_OFF;
    const int w = F.wave, tid = w * 64 + lane, ql = lane & 31, hh = lane >> 5;
    int ksrc[3], kdst[3], vsrc[2], vdst[2];
#pragma unroll
    for (int i = 0; i < 3; ++i) { const int idx = i * 512 + tid, row = idx / 24, pc = idx - row * 24; ksrc[i] = row * 192 + pc * 8; kdst[i] = row * MLA_KROW + pc * 16; }
#pragma unroll
    for (int i = 0; i < 2; ++i) { const int idx = i * 512 + tid, row = idx >> 4, pc = idx & 15; vsrc[i] = row * 128 + pc * 8; vdst[i] = MLA_KIMG + vimg_off(row, pc); }
    int voff[4];
#pragma unroll
    for (int d0 = 0; d0 < 4; ++d0) voff[d0] = vt_lane_off(lane, d0);
    for (int unit = F.vcu; unit < 256; unit += F.G) {
        const int kh = unit & 1, qb = (unit >> 1) & 31, h = unit >> 6;
        const bf16* Kg = MK + ((size_t)h * S + kh * 4096) * 192; const bf16* Vg = MV + ((size_t)h * S + kh * 4096) * 128;
        const int tq = qb * 256 + w * 32 + ql;
        bf16x8 qf[12];
        { const v4u* src = (const v4u*)(MQ + ((size_t)h * S + tq) * 192 + 8 * hh);
#pragma unroll
          for (int s = 0; s < 12; ++s) qf[s] = __builtin_bit_cast(bf16x8, src[2 * s]); }
        f32x16 o[4]; float lsum = 0.f;
#pragma unroll
        for (int d0 = 0; d0 < 4; ++d0)
#pragma unroll
            for (int e = 0; e < 16; ++e) o[d0][e] = 0.f;
        v4u kst[3], vst[2];
#pragma unroll
        for (int i = 0; i < 3; ++i) kst[i] = *(const v4u*)(Kg + ksrc[i]);
#pragma unroll
        for (int i = 0; i < 2; ++i) vst[i] = *(const v4u*)(Vg + vsrc[i]);
#pragma unroll
        for (int i = 0; i < 3; ++i) *(LAS v4u*)(lds + kdst[i]) = kst[i];
#pragma unroll
        for (int i = 0; i < 2; ++i) *(LAS v4u*)(lds + vdst[i]) = vst[i];
        __syncthreads();
#pragma unroll 1
        for (int jt = 0; jt < 64; ++jt) {
            const LAS unsigned char* buf = lds + (jt & 1) * MLA_BUF; LAS unsigned char* nbuf = lds + ((jt + 1) & 1) * MLA_BUF;
            const int jn = (jt + 1 < 64) ? jt + 1 : jt;
#pragma unroll
            for (int i = 0; i < 3; ++i) kst[i] = *(const v4u*)(Kg + (size_t)jn * 64 * 192 + ksrc[i]);
#pragma unroll
            for (int i = 0; i < 2; ++i) vst[i] = *(const v4u*)(Vg + (size_t)jn * 64 * 128 + vsrc[i]);
            f32x16 s0, s1;
#pragma unroll
            for (int e = 0; e < 16; ++e) { s0[e] = -c2; s1[e] = -c2; }
            const LAS unsigned char* kr0 = buf + ql * MLA_KROW + 16 * hh;
            const LAS unsigned char* vimg = buf + MLA_KIMG;
#define KFRAG(f) (*(const LAS bf16x8*)(kr0 + ((f) >= 12 ? 32 * MLA_KROW : 0) + 32 * ((f) % 12)))
#define KLOAD(dst, f0) do { _Pragma("unroll") for (int i_ = 0; i_ < 4; ++i_) dst[i_] = KFRAG((f0) + i_); } while (0)
#define KMMA(src, f0) do { _Pragma("unroll") for (int i_ = 0; i_ < 4; ++i_) { if ((f0) + i_ < 12) s0 = MFMA32(src[i_], qf[((f0) + i_) % 12], s0); else s1 = MFMA32(src[i_], qf[((f0) + i_) % 12], s1); } } while (0)
#define SB() __builtin_amdgcn_sched_barrier(0)
            bf16x8 kA[4], kB[4];
            KLOAD(kA, 0);
            KLOAD(kB, 4);  SB(); KMMA(kA, 0);  SB();
            KLOAD(kA, 8);  SB(); KMMA(kB, 4);  SB();
            KLOAD(kB, 12); SB(); KMMA(kA, 8);  SB();
            KLOAD(kA, 16); SB(); KMMA(kB, 12); SB();
            KLOAD(kB, 20); SB(); KMMA(kA, 16); SB();
#define VLOAD(dst, key0, dd) do { dst[0] = vt_frag(vimg, key0, dd, lane); dst[1] = vt_frag(vimg, (key0) + 16, dd, lane); } while (0)
#define VMMA(src, pa, pb_, dd) do { o[dd] = MFMA32(src[0], pa, o[dd]); o[dd] = MFMA32(src[1], pb_, o[dd]); } while (0)
            bf16x8 vA[2], vB[2];
            VLOAD(vA, 0, 0); SB(); KMMA(kB, 20); SB();
#undef KFRAG
#undef KLOAD
#undef KMMA
#pragma unroll
            for (int e = 0; e < 16; ++e) { const float p0 = __builtin_amdgcn_exp2f(s0[e] - c2); s0[e] = p0; lsum += p0; }
            const bf16x8 pb00 = pack8(s0, 0), pb01 = pack8(s0, 1);
#pragma unroll
            for (int e = 0; e < 16; ++e) { const float p1 = __builtin_amdgcn_exp2f(s1[e] - c2); s1[e] = p1; lsum += p1; }
            const bf16x8 pb10 = pack8(s1, 0), pb11 = pack8(s1, 1);
            SB();
            VLOAD(vB, 0, 1);  SB(); VMMA(vA, pb00, pb01, 0); SB();
            VLOAD(vA, 0, 2);  SB(); VMMA(vB, pb00, pb01, 1); SB();
            VLOAD(vB, 0, 3);  SB(); VMMA(vA, pb00, pb01, 2); SB();
            VLOAD(vA, 32, 0); SB(); VMMA(vB, pb00, pb01, 3); SB();
            VLOAD(vB, 32, 1); SB(); VMMA(vA, pb10, pb11, 0); SB();
            VLOAD(vA, 32, 2); SB(); VMMA(vB, pb10, pb11, 1); SB();
            VLOAD(vB, 32, 3); SB(); VMMA(vA, pb10, pb11, 2); SB();
            VMMA(vB, pb10, pb11, 3);
#undef VLOAD
#undef VMMA
#undef SB
#pragma unroll
            for (int i = 0; i < 3; ++i) *(LAS v4u*)(nbuf + kdst[i]) = kst[i];
#pragma unroll
            for (int i = 0; i < 2; ++i) *(LAS v4u*)(nbuf + vdst[i]) = vst[i];
            __syncthreads();
        }
        lsum += __shfl_xor(lsum, 32);
        float* orow = OP + (((size_t)kh * 4 + h) * S + tq) * 128 + 4 * hh;
#pragma unroll
        for (int d0 = 0; d0 < 4; ++d0)
#pragma unroll
            for (int k = 0; k < 4; ++k) { f32x4 v; v.x = o[d0][4 * k]; v.y = o[d0][4 * k + 1]; v.z = o[d0][4 * k + 2]; v.w = o[d0][4 * k + 3]; *(f32x4*)(orow + 32 * d0 + 8 * k) = v; }
        if (hh == 0) LP[((size_t)kh * 4 + h) * S + tq] = lsum;
    }
}
__device__ __forceinline__ void dil_combine(ArgsP A, const Frame& F) {
    unsigned char* ws = A->ws; const int lane = opq_lane(); const int gw = opq_s(F.gw); const int gt = gw * 64 + lane;
    const float* OP = (const float*)(ws + WS_DILO); const float* LP = (const float*)(ws + WS_DILL); bf16* z1 = (bf16*)(ws + WS_Z) + (size_t)1 * S * 512;
    for (int idx = gt; idx < S * 512; idx += F.NGT) { const int t = idx >> 9, c = idx & 511, ih = c >> 7;
        const float num = OP[idx] + OP[(size_t)S * 512 + idx] + OP[(size_t)2 * S * 512 + idx];
        const float den = LP[(size_t)t * 4 + ih] + LP[((size_t)S + t) * 4 + ih] + LP[((size_t)2 * S + t) * 4 + ih];
        z1[idx] = (bf16)f2bf(num / den); }
}
__device__ __forceinline__ void phase_mix3(ArgsP A, const Frame& F) {
    unsigned char* ws = A->ws; const int lane = opq_lane(); const int gw = opq_s(F.gw); const int gt = gw * 64 + lane;
    { const float* MO = (const float*)(ws + WS_MOP); const float* ML = (const float*)(ws + WS_MLP); bf16* z3 = (bf16*)(ws + WS_Z) + (size_t)3 * S * 512;
      for (int idx = gt; idx < S * 512; idx += F.NGT) { const int t = idx >> 9, c = idx & 511, h = c >> 7, d = c & 127;
          const size_t r0 = (size_t)h * S + t, r1 = ((size_t)4 + h) * S + t;
          z3[idx] = (bf16)f2bf((MO[r0 * 128 + d] + MO[r1 * 128 + d]) / (ML[r0] + ML[r1])); } }
}

__global__ void __launch_bounds__(NWAVES * 64, 2) mk_fwd(Args args_unused) {
    extern __shared__ __attribute__((aligned(16))) unsigned char lds[];
    Frame F;
    F.lds = (LAS unsigned char*)lds;
    F.MISC = (volatile LAS unsigned*)(F.lds + MISC_OFF);
    F.wave = __builtin_amdgcn_readfirstlane((int)(threadIdx.x >> 6));
    F.G = gridDim.x; { const int bx = blockIdx.x; F.vcu = (F.G % 8 == 0) ? (bx % 8) * (F.G / 8) + bx / 8 : bx; }
    F.gw = F.vcu * NWAVES + F.wave; F.NGW = F.G * NWAVES; F.NGT = F.NGW * 64;
    for (int u = threadIdx.x; u < (LDS_BYTES - LDSCTL_OFF) / 4; u += NWAVES * 64) ((LAS unsigned*)(F.lds + LDSCTL_OFF))[u] = 0u;
    __syncthreads();
    int l_lo, l_hi; bool multi; XcdBarrier bar;
    { ArgsP A = fresh_args(); l_lo = A->l_lo; l_hi = A->l_hi;
      multi = !((l_hi - l_lo) == 1 && (A->ph_hi - A->ph_lo) == 1);
      unsigned* bw = (unsigned*)((gu32*)(A->ws + WS_CTL) + CW_BAR);
      bar.bar = bw; bar.x = 0; bar.st = F.MISC + 8;
      if (multi) bar = xcd_barrier_post(bw, F.MISC + 8); }
#define SEAM() do { if (multi) xcd_barrier(bar); } while (0)
#ifdef ONLY_PHASE
#define IN(k) ((k) == ONLY_PHASE && lo <= (k) && (k) < hi)
#else
#define IN(k) (lo <= (k) && (k) < hi)
#endif
#ifndef G_ALIGN
#define G_ALIGN true
#endif
#ifndef G_SP2
#define G_SP2 true
#endif
#define GEMM(EPI, ORDER) pg8::gemm_phase<EPI, ORDER, G_ALIGN, G_SP2>(Fl.lds + RING_OFF, g, So, E, Fl.wave)
    { ArgsP A = fresh_args(); if (A->l_lo == 0 && A->ph_lo == 0) phase_rope_tables(A, F); }
    for (int l = l_lo; l < l_hi; ++l) {
        int lo, hi; { ArgsP A = fresh_args(); lo = A->ph_lo; hi = A->ph_hi; }
        if (IN(0)) { ArgsP A = fresh_args(); const Frame Fl = fresh_frame(F); unsigned char* ws = A->ws;
            phase_convert(A, Fl, l, Fl.gw, Fl.NGW, 0, CPARTS);
            if (l == 0) phase_prep(Fl, A->in[I_X], (bf16*)(ws + WS_XN), (float*)(ws + WS_SSP));
            SEAM(); }
        if (IN(1)) { ArgsP A = fresh_args(); const Frame Fl = fresh_frame(F); const int bx = opq_s((int)blockIdx.x); unsigned char* ws = A->ws;
            pg8::Gemm g{(const bf16*)(ws + WS_XN), (const bf16*)(ws + (size_t)(l & 1) * WS_SETD + WS_WGU1), S, NGU, D};
            pg8::StaticOrder So; So.init(S, NGU, Fl.G, bx); epi::fill_rstd_table(So, (const float*)(ws + WS_SSP), (LAS float*)(Fl.lds + RSTD_OFF), Fl.wave); __syncthreads();
            epi::EpiSwiglu E{(bf16*)(ws + WS_HID), (const LAS float*)(Fl.lds + RSTD_OFF)}; GEMM(epi::EpiSwiglu, pg8::StaticOrder); tail_convert(A, Fl, l, bx, (S / 256) * (NGU / 256), 0, 128); SEAM(); }
        if (IN(2)) { ArgsP A = fresh_args(); const Frame Fl = fresh_frame(F); const int bx = opq_s((int)blockIdx.x); unsigned char* ws = A->ws; const float* xin = (l == 0) ? A->in[I_X] : (const float*)(ws + WS_X);
            pg8::Gemm g{(const bf16*)(ws + WS_HID), (const bf16*)(ws + (size_t)(l & 1) * WS_SETD + WS_WD1), S, D, FF}; pg8::StaticOrder So; So.init(S, D, Fl.G, bx);
            epi::EpiResid E{xin, (float*)(ws + WS_X), 0.5f, (bf16*)(ws + WS_XN), (float*)(ws + WS_SSP)}; GEMM(epi::EpiResid, pg8::StaticOrder); SEAM(); }
        if (IN(3)) { ArgsP A = fresh_args(); const Frame Fl = fresh_frame(F); const int bx = opq_s((int)blockIdx.x); unsigned char* ws = A->ws;
            pg8::Gemm g{(const bf16*)(ws + WS_XN), (const bf16*)(ws + (size_t)(l & 1) * WS_SETD + WS_WIN), S, NINP, D};
            pg8::StaticOrder So; So.init(S, NINP, Fl.G, bx); epi::fill_rstd_table(So, (const float*)(ws + WS_SSP), (LAS float*)(Fl.lds + RSTD_OFF), Fl.wave); __syncthreads();
            epi::EpiPin E{(bf16*)(ws + WS_P), (const LAS float*)(Fl.lds + RSTD_OFF)}; GEMM(epi::EpiPin, pg8::StaticOrder); tail_convert(A, Fl, l, bx, (S / 256) * (NINP / 256), 128, 288); SEAM(); }
        if (IN(4)) { ArgsP A = fresh_args(); const Frame Fl = fresh_frame(F); phase_mix1(A, Fl, l); SEAM(); }
        if (IN(5)) { ArgsP A = fresh_args(); const Frame Fl = fresh_frame(F); const int bx = opq_s((int)blockIdx.x); unsigned char* ws = A->ws;
            pg8::Gemm g{(const bf16*)(ws + WS_MLAA), (const bf16*)(ws + (size_t)(l & 1) * WS_SETD + WS_WMLA), S, NMLA, opq_s(512)}; pg8::StaticOrder So; So.init(S, NMLA, Fl.G, bx);
            epi::EpiF32 E{(float*)(ws + WS_MLARAW), NMLA, 1}; GEMM(epi::EpiF32, pg8::StaticOrder); SEAM(); }
        if (IN(6)) { ArgsP A = fresh_args(); const Frame Fl = fresh_frame(F); phase_mix2(A, Fl, l); SEAM(); }
        if (IN(7)) { ArgsP A = fresh_args(); const Frame Fl = fresh_frame(F); phase_mla_flash(A, Fl, l); dil_combine(A, Fl); SEAM(); }
        if (IN(8)) { ArgsP A = fresh_args(); const Frame Fl = fresh_frame(F); phase_mix3(A, Fl); SEAM(); }
        if (IN(9)) { ArgsP A = fresh_args(); const Frame Fl = fresh_frame(F); const int bx = opq_s((int)blockIdx.x); unsigned char* ws = A->ws;
            pg8::Gemm g{(const bf16*)(ws + WS_Z), (const bf16*)(ws + (size_t)(l & 1) * WS_SETD + WS_WBR), 4 * S, 4 * D, opq_s(512)}; epi::BranchOrder So; So.so.init(S, D, Fl.G, bx);
            epi::EpiBranchChain E{(bf16*)(ws + WS_MERGEDB), (const bf16*)(ws + WS_P) + PC_GATE}; GEMM(epi::EpiBranchChain, epi::BranchOrder); SEAM(); }
        if (IN(10)) { ArgsP A = fresh_args(); const Frame Fl = fresh_frame(F); const int bx = opq_s((int)blockIdx.x); unsigned char* ws = A->ws;
            pg8::Gemm g{(const bf16*)(ws + WS_MERGEDB), (const bf16*)(ws + (size_t)(l & 1) * WS_SETD + WS_WOUT), S, D, D}; pg8::StaticOrder So; So.init(S, D, Fl.G, bx);
            epi::EpiResid E{(const float*)(ws + WS_X), (float*)(ws + WS_X), 1.0f, (bf16*)(ws + WS_XN), (float*)(ws + WS_SSP)}; GEMM(epi::EpiResid, pg8::StaticOrder); SEAM(); }
        if (IN(11)) { ArgsP A = fresh_args(); const Frame Fl = fresh_frame(F); const int bx = opq_s((int)blockIdx.x); unsigned char* ws = A->ws;
            pg8::Gemm g{(const bf16*)(ws + WS_XN), (const bf16*)(ws + (size_t)(l & 1) * WS_SETD + WS_WGU2), S, NGU, D};
            pg8::StaticOrder So; So.init(S, NGU, Fl.G, bx); epi::fill_rstd_table(So, (const float*)(ws + WS_SSP), (LAS float*)(Fl.lds + RSTD_OFF), Fl.wave); __syncthreads();
            epi::EpiSwiglu E{(bf16*)(ws + WS_HID), (const LAS float*)(Fl.lds + RSTD_OFF)}; GEMM(epi::EpiSwiglu, pg8::StaticOrder); tail_convert(A, Fl, l, bx, (S / 256) * (NGU / 256), 288, CPARTS); SEAM(); }
        if (IN(12)) { ArgsP A = fresh_args(); const Frame Fl = fresh_frame(F); const int bx = opq_s((int)blockIdx.x); unsigned char* ws = A->ws; const bool lastl = (l == NLAYER - 1);
            pg8::Gemm g{(const bf16*)(ws + WS_HID), (const bf16*)(ws + (size_t)(l & 1) * WS_SETD + WS_WD2), S, D, FF}; pg8::StaticOrder So; So.init(S, D, Fl.G, bx);
            epi::EpiResid E{(const float*)(ws + WS_X), lastl ? A->out : (float*)(ws + WS_X), 0.5f, lastl ? (bf16*)nullptr : (bf16*)(ws + WS_XN), (float*)(ws + WS_SSP)}; GEMM(epi::EpiResid, pg8::StaticOrder);
            SEAM(); }
    }
#undef IN
#undef SEAM
#undef GEMM
}


#ifdef DBG_DUMP_OFF
__global__ void dbg_dump(const unsigned char* ws, float* out, int n) {
    for (int i = blockIdx.x * blockDim.x + threadIdx.x; i < n; i += gridDim.x * blockDim.x) {
        if (i >= DBG_DUMP_N) { out[i] = 0.f; continue; }
#if DBG_DUMP_BF16
        out[i] = __uint_as_float(((unsigned)((const unsigned short*)(ws + DBG_DUMP_OFF))[i]) << 16);
#else
        out[i] = ((const float*)(ws + DBG_DUMP_OFF))[i];
#endif
    }
}
#endif
#ifndef MK_ONE_LAUNCH
#define MK_ONE_LAUNCH 0
#endif
extern "C" void kernel_launch(void* const* d_in, const int* in_sizes, int n_in, void* d_out, int out_size, void* d_ws, size_t ws_size, hipStream_t stream) {
    static int grid = 0;
    if (grid == 0) {
        if (n_in != N_INPUTS || out_size != S * D || ws_size < WS_END) { fprintf(stderr, "kernel_launch: unexpected shapes (n_in %d out %d ws %zu)\n", n_in, out_size, ws_size); grid = -1; return; }
        int dev = 0, cus = 0, per_cu = 0;
        if (hipGetDevice(&dev) != hipSuccess || hipDeviceGetAttribute(&cus, hipDeviceAttributeMultiprocessorCount, dev) != hipSuccess) { grid = -1; return; }
        if (hipFuncSetAttribute((const void*)mk_fwd, hipFuncAttributeMaxDynamicSharedMemorySize, LDS_BYTES) != hipSuccess) { fprintf(stderr, "kernel_launch: hipFuncSetAttribute failed\n"); grid = -1; return; }
        if (hipOccupancyMaxActiveBlocksPerMultiprocessor(&per_cu, (const void*)mk_fwd, NWAVES * 64, LDS_BYTES) != hipSuccess || per_cu < 1) fprintf(stderr, "kernel_launch: occupancy query reports %d\n", per_cu);
        (void)hipGetLastError();
        grid = cus;
    }
    if (grid < 0) return;
    if (hipMemsetAsync((char*)d_ws + WS_CTL, 0, CTL_ZERO_BYTES, stream) != hipSuccess) return;
    Args a{};
    for (int i = 0; i < N_INPUTS; ++i) a.in[i] = (const float*)d_in[i];
    a.out = (float*)d_out; a.ws = (unsigned char*)d_ws;
#if MK_ONE_LAUNCH
    a.l_lo = 0; a.l_hi = NLAYER; a.ph_lo = 0; a.ph_hi = NPHASE;
    hipLaunchKernelGGL(mk_fwd, dim3(grid), dim3(NWAVES * 64), LDS_BYTES, stream, a);
#else
    for (int l = 0; l < NLAYER; ++l)
        for (int ph = 0; ph < NPHASE; ++ph) {
#ifdef DBG_DUMP_OFF
            if (l * NPHASE + ph > DBG_LAST) continue;
#endif
            a.l_lo = l; a.l_hi = l + 1; a.ph_lo = ph; a.ph_hi = ph + 1;
            hipLaunchKernelGGL(mk_fwd, dim3(grid), dim3(NWAVES * 64), LDS_BYTES, stream, a);
#ifdef DUP_MASK
            if ((DUP_MASK >> ph) & 1) hipLaunchKernelGGL(mk_fwd, dim3(grid), dim3(NWAVES * 64), LDS_BYTES, stream, a);
#endif
            }
#ifdef DBG_DUMP_OFF
    hipLaunchKernelGGL(dbg_dump, dim3(2048), dim3(256), 0, stream, (const unsigned char*)d_ws, (float*)d_out, S * D);
#endif
#endif
}
```

```cpp
#define MK_ONE_LAUNCH 1
#include <hip/hip_runtime.h>
#include <cstdio>
#include <cstdint>
namespace pg8 {
#define PG8_LAS __attribute__((address_space(3)))
typedef unsigned short bf16_t;
typedef short bf16x8 __attribute__((ext_vector_type(8)));
typedef float f32x4 __attribute__((ext_vector_type(4)));
typedef unsigned u32x4 __attribute__((ext_vector_type(4)));
constexpr int BM = 256, BK = 64, HALF = 128, HTB = HALF * BK * 2  , STAGE_BYTES = 8 * HTB, NXCD = 8, WGM = 4;

__host__ __device__ __forceinline__ int lds_byte(int r, int c) { const int st = (r >> 4) * 2 + (c >> 5), rr = r & 15, cc = c & 31, ob = rr * 64 + cc * 2; return st * 1024 + (ob ^ (((ob >> 9) & 1) << 5)); }
__host__ __device__ __forceinline__ void stage_rc(int b, int& R, int& C) { const int st = b / 1024, sb = b % 1024, swz = sb ^ (((sb >> 9) & 1) << 5); R = (st >> 1) * 16 + swz / 64; C = (st & 1) * 32 + (swz % 64) / 2; }
__host__ __device__ __forceinline__ int perm32(int rho) { const int n = rho >> 4, i = rho & 15; return 8 * (i >> 2) + 4 * n + (i & 3); }

struct Unit { int pm, pn; };
struct Gemm { const bf16_t* A; const bf16_t* Bt; int M, N, K; };

struct StaticOrder {
    int nM, nN, nwg, G, c;
    __host__ __device__ void init(int M, int N, int G_, int c_) { nM = M / BM; nN = N / BM; nwg = nM * nN; G = G_; c = c_; }
    __host__ __device__ bool next(int i, Unit& u) const {
        const long L = (long)i * G + c; if (L >= nwg) return false;
        int wgid = (int)L; { const int q = nwg / NXCD, r = nwg % NXCD, xcd = wgid % NXCD, off = wgid / NXCD; wgid = (xcd < r ? xcd * (q + 1) : r * (q + 1) + (xcd - r) * q) + off; }
        const int nig = WGM * nN, gid = wgid / nig, fm = gid * WGM, gsz = (nM - fm) < WGM ? (nM - fm) : WGM;
        u.pm = fm + ((wgid % nig) % gsz); u.pn = (wgid % nig) / gsz; return true;
    }
    __device__ __forceinline__ void a_ready(const Unit&, int  ) const {}
    __device__ __forceinline__ void done(const Unit&) const {}
};
__device__ __forceinline__ unsigned cvt_pk_bf16(float lo, float hi) { unsigned r; asm volatile("v_cvt_pk_bf16_f32 %0, %1, %2" : "=v"(r) : "v"(lo), "v"(hi)); return r; }
typedef float f32x2 __attribute__((ext_vector_type(2)));
__device__ __forceinline__ f32x2 gelu_pk(f32x2 v) {
    const f32x2 av = __builtin_elementwise_abs(v), d = av * 0.2316418882f + 1.0f;
    f32x2 t; t.x = __builtin_amdgcn_rcpf(d.x); t.y = __builtin_amdgcn_rcpf(d.y);
    f32x2 q = t * 0.5307027145f + (-0.7265760135f); q = q * t + 0.7107068705f; q = q * t + (-0.142248368f); q = q * t + 0.127414796f; q = q * t;
    const f32x2 s = (v * v) * (-0.72134752044f);
    f32x2 e; e.x = __builtin_amdgcn_exp2f(s.x); e.y = __builtin_amdgcn_exp2f(s.y);
    const f32x2 m = v * (q * e), r = v - m;
    f32x2 o; o.x = v.x < 0.f ? m.x : r.x; o.y = v.y < 0.f ? m.y : r.y; return o;
}
template <class Epi, class Sched, bool ALIGN_EPI = false, bool SP2 = false>
__device__ __forceinline__ void gemm_phase(PG8_LAS unsigned char* lds, const Gemm g, const Sched& S, const Epi& E, int wave_in  ) {
    int tid_ = wave_in * 64 + (int)__builtin_amdgcn_mbcnt_hi(~0u, __builtin_amdgcn_mbcnt_lo(~0u, 0u)); asm volatile("" : "+v"(tid_));
    const int tid = tid_, wid = __builtin_amdgcn_readfirstlane(tid >> 6), lane = tid & 63, wr = wid >> 2, wc = wid & 3, fr = lane & 15, fq = lane >> 4;
    const int K = g.K, nt = K / BK;
    unsigned voffA[2], voffB[2];
#pragma unroll
    for (int i = 0; i < 2; ++i) { int R, C; stage_rc(tid * 16 + i * 8192, R, C); const int Rb = Epi::PERM ? ((R & ~31) + perm32(R & 31)) : R;
        voffA[i] = (unsigned)(R * K + C) * 2u; voffB[i] = (unsigned)(Rb * K + C) * 2u; }
    const size_t kstep = (size_t)(BK * 2);
    const size_t hstep = (size_t)HALF * K * 2;
    const size_t tstep = 2 * hstep;
    const unsigned ldsw = (unsigned)wid * 1024u;
    const int aoff = lds_byte(wr * 64 + fr, fq * 8), boff = lds_byte(wc * 32 + fr, fq * 8);
#define PG8_SA(b, h) (((b) * 2 + (h)) * HTB)
#define PG8_SB(b, h) ((4 + (b) * 2 + (h)) * HTB)
#define PG8_STAGE(bufoff, gbase, voff) do { _Pragma("unroll") for (int _i = 0; _i < 2; ++_i) \
        __builtin_amdgcn_global_load_lds((const unsigned*)((const char*)(gbase) + (voff)[_i]), (PG8_LAS unsigned*)(lds + (bufoff) + ldsw + _i * 8192), 16, 0, 0); } while (0)
#define PG8_LDA(dst, b, h) do { _Pragma("unroll") for (int m = 0; m < 4; ++m) _Pragma("unroll") for (int k = 0; k < 2; ++k) dst[m][k] = *(const PG8_LAS bf16x8*)(lds + PG8_SA(b, h) + aoff + m * 2048 + k * 1024); } while (0)
#define PG8_LDB(dst, b, h) do { _Pragma("unroll") for (int n = 0; n < 2; ++n) _Pragma("unroll") for (int k = 0; k < 2; ++k) dst[n][k] = *(const PG8_LAS bf16x8*)(lds + PG8_SB(b, h) + boff + n * 2048 + k * 1024); } while (0)
#define PG8_MMA(ai, bj, At, Bt) do { __builtin_amdgcn_s_setprio(1); _Pragma("unroll") for (int m = 0; m < 4; ++m) _Pragma("unroll") for (int n = 0; n < 2; ++n) _Pragma("unroll") for (int k = 0; k < 2; ++k) \
        acc[ai][bj][m][n] = __builtin_amdgcn_mfma_f32_16x16x32_bf16(Bt[n][k], At[m][k], acc[ai][bj][m][n], 0, 0, 0); __builtin_amdgcn_s_setprio(0); } while (0)
#define PG8_WAIT_V(n) asm volatile("s_waitcnt vmcnt(" #n ")" ::: "memory")
#define PG8_WAIT_L(n) asm volatile("s_waitcnt lgkmcnt(" #n ")" ::: "memory")
#define PG8_BAR __builtin_amdgcn_s_barrier()
#define PG8_SCHED __builtin_amdgcn_sched_barrier(0)
    Unit cur, nxt; int ui = 0;
    if (!S.next(0, cur)) return;
    f32x4 acc[2][2][4][2];
#pragma unroll
    for (int a = 0; a < 2; ++a)
#pragma unroll
        for (int b = 0; b < 2; ++b)
#pragma unroll
            for (int m = 0; m < 4; ++m)
#pragma unroll
                for (int n = 0; n < 2; ++n) acc[a][b][m][n] = (f32x4){0.f, 0.f, 0.f, 0.f};
    bf16x8 At[4][2], B0[2][2], B1[2][2];
    const char* cA = (const char*)g.A + (size_t)cur.pm * tstep; const char* cB = (const char*)g.Bt + (size_t)cur.pn * tstep;
    S.a_ready(cur, 0);
    if constexpr (SP2) {
        PG8_STAGE(PG8_SB(0, 0), cB, voffB); PG8_STAGE(PG8_SB(0, 1), cB + hstep, voffB); PG8_STAGE(PG8_SA(0, 0), cA, voffA); PG8_STAGE(PG8_SA(0, 1), cA + hstep, voffA);
        if (wr == 1) PG8_BAR;
        PG8_WAIT_V(2); PG8_BAR;
        PG8_STAGE(PG8_SB(1, 0), cB + kstep, voffB); PG8_STAGE(PG8_SA(1, 0), cA + kstep, voffA); PG8_STAGE(PG8_SB(1, 1), cB + hstep + kstep, voffB);
        PG8_WAIT_V(6); PG8_BAR;
    } else {
        PG8_STAGE(PG8_SB(0, 0), cB, voffB); PG8_STAGE(PG8_SA(0, 0), cA, voffA); PG8_STAGE(PG8_SB(0, 1), cB + hstep, voffB); PG8_STAGE(PG8_SA(0, 1), cA + hstep, voffA);
        if (wr == 1) PG8_BAR;
        PG8_WAIT_V(4); PG8_BAR;
        PG8_STAGE(PG8_SB(1, 0), cB + kstep, voffB); PG8_STAGE(PG8_SA(1, 0), cA + kstep, voffA); PG8_STAGE(PG8_SB(1, 1), cB + hstep + kstep, voffB);
        PG8_WAIT_V(6); PG8_BAR;
    }
    for (;;) {
        const bool has_next = S.next(ui + 1, nxt);
        const char* nA = has_next ? (const char*)g.A + (size_t)nxt.pm * tstep : cA; const char* nB = has_next ? (const char*)g.Bt + (size_t)nxt.pn * tstep : cB;
        for (int t = 0; t < nt; t += 2) {
            const bool last = (t == nt - 2);
            const char* a1 = cA + (size_t)(t + 1) * kstep;
            const char* a2 = last ? nA : cA + (size_t)(t + 2) * kstep; const char* b2 = last ? nB : cB + (size_t)(t + 2) * kstep;
            const char* a3 = a2 + kstep; const char* b3 = b2 + kstep;
            if (last && has_next) S.a_ready(nxt, ui + 1);
            if constexpr (SP2) {
            PG8_LDB(B0, 0, 0); PG8_LDB(B1, 0, 1); PG8_SCHED; PG8_LDA(At, 0, 0); PG8_STAGE(PG8_SA(1, 1), a1 + hstep, voffA);
            PG8_WAIT_V(8); PG8_WAIT_L(0); PG8_BAR; PG8_MMA(0, 0, At, B0); PG8_MMA(0, 1, At, B1); PG8_BAR; PG8_SCHED;
            PG8_LDA(At, 0, 1); PG8_STAGE(PG8_SB(0, 0), b2, voffB); PG8_STAGE(PG8_SB(0, 1), b2 + hstep, voffB); PG8_STAGE(PG8_SA(0, 0), a2, voffA);
            PG8_WAIT_V(8); PG8_WAIT_L(0); PG8_BAR; PG8_MMA(1, 0, At, B0); PG8_MMA(1, 1, At, B1); PG8_BAR; PG8_SCHED;
            PG8_LDB(B0, 1, 0); PG8_LDB(B1, 1, 1); PG8_SCHED; PG8_LDA(At, 1, 0); PG8_STAGE(PG8_SA(0, 1), a2 + hstep, voffA);
            PG8_WAIT_V(8); PG8_WAIT_L(0); PG8_BAR; PG8_MMA(0, 0, At, B0); PG8_MMA(0, 1, At, B1); PG8_BAR; PG8_SCHED;
            PG8_LDA(At, 1, 1); PG8_STAGE(PG8_SB(1, 0), b3, voffB); PG8_STAGE(PG8_SB(1, 1), b3 + hstep, voffB); PG8_STAGE(PG8_SA(1, 0), a3, voffA);
            PG8_WAIT_V(8); PG8_WAIT_L(0); PG8_BAR; PG8_MMA(1, 0, At, B0); PG8_MMA(1, 1, At, B1); PG8_BAR; PG8_SCHED;
            } else {
            PG8_LDB(B0, 0, 0); PG8_SCHED; PG8_LDA(At, 0, 0); PG8_STAGE(PG8_SA(1, 1), a1 + hstep, voffA);
            PG8_WAIT_L(8); PG8_BAR; PG8_WAIT_L(0); PG8_MMA(0, 0, At, B0); PG8_BAR; PG8_SCHED;
            PG8_LDB(B1, 0, 1); PG8_STAGE(PG8_SB(0, 0), b2, voffB);
            PG8_BAR; PG8_WAIT_L(0); PG8_MMA(0, 1, At, B1); PG8_BAR;
            PG8_LDA(At, 0, 1); PG8_STAGE(PG8_SA(0, 0), a2, voffA);
            PG8_BAR; PG8_WAIT_L(0); PG8_MMA(1, 0, At, B0); PG8_BAR; PG8_SCHED;
            PG8_STAGE(PG8_SB(0, 1), b2 + hstep, voffB);
            PG8_WAIT_V(6); PG8_BAR; PG8_MMA(1, 1, At, B1); PG8_BAR;
            PG8_LDB(B0, 1, 0); PG8_SCHED; PG8_LDA(At, 1, 0); PG8_STAGE(PG8_SA(0, 1), a2 + hstep, voffA);
            PG8_WAIT_L(8); PG8_BAR; PG8_WAIT_L(0); PG8_MMA(0, 0, At, B0); PG8_BAR; PG8_SCHED;
            PG8_LDB(B1, 1, 1); PG8_STAGE(PG8_SB(1, 0), b3, voffB);
            PG8_BAR; PG8_WAIT_L(0); PG8_MMA(0, 1, At, B1); PG8_BAR;
            PG8_LDA(At, 1, 1); PG8_STAGE(PG8_SA(1, 0), a3, voffA);
            PG8_BAR; PG8_WAIT_L(0); PG8_MMA(1, 0, At, B0); PG8_BAR; PG8_SCHED;
            PG8_STAGE(PG8_SB(1, 1), b3 + hstep, voffB);
            PG8_WAIT_V(6); PG8_BAR; PG8_MMA(1, 1, At, B1); PG8_BAR;
            }
        }
        if constexpr (ALIGN_EPI) { if (wr == 0) PG8_BAR; }
        if constexpr (!Epi::AFTER_DRAIN) { E(acc, cur, wr, wc, fr, fq, ui); S.done(cur); }
        if (!has_next) break;
        if constexpr (!Epi::KEEP_ACC) {
#pragma unroll
        for (int a = 0; a < 2; ++a)
#pragma unroll
            for (int b = 0; b < 2; ++b)
#pragma unroll
                for (int m = 0; m < 4; ++m)
#pragma unroll
                    for (int n = 0; n < 2; ++n) acc[a][b][m][n] = (f32x4){0.f, 0.f, 0.f, 0.f};
        }
        cur = nxt; cA = nA; cB = nB; ++ui;
        if constexpr (ALIGN_EPI) { if (wr == 1) PG8_BAR; }
    }
    PG8_WAIT_V(0);
    if constexpr (!ALIGN_EPI) { if (wr == 0) PG8_BAR; }
    PG8_BAR;
    if constexpr (Epi::AFTER_DRAIN) { E.fused(acc, cur, wr, wc, fr, fq, lds, wid, lane); S.done(cur); }
#undef PG8_SA
#undef PG8_SB
#undef PG8_STAGE
#undef PG8_LDA
#undef PG8_LDB
#undef PG8_MMA
#undef PG8_WAIT_V
#undef PG8_WAIT_L
#undef PG8_BAR
#undef PG8_SCHED
}
}
#define GAS __attribute__((address_space(1)))
#define LAS __attribute__((address_space(3)))
typedef unsigned short bf16;
typedef unsigned v4u __attribute__((ext_vector_type(4)));
typedef float f32x4 __attribute__((ext_vector_type(4)));
typedef short bf16x8 __attribute__((ext_vector_type(8)));
typedef GAS unsigned gu32;
typedef GAS unsigned long long gu64;
#define RLX_AGENT __ATOMIC_RELAXED, __HIP_MEMORY_SCOPE_AGENT
#define LDS_WAIT() asm volatile("s_waitcnt lgkmcnt(0)" ::: "memory")
#define VM_WAIT() asm volatile("s_waitcnt vmcnt(0)" ::: "memory")
__device__ __forceinline__ unsigned long long rt() { return __builtin_amdgcn_s_memrealtime(); }
__device__ __forceinline__ unsigned f2bf(float f) { unsigned u = __builtin_bit_cast(unsigned, f); return (u + 0x7fffu + ((u >> 16) & 1u)) >> 16; }
__device__ __forceinline__ unsigned pk2(float lo, float hi) { return f2bf(lo) | (f2bf(hi) << 16); }
#define XB_TMO      128
#define XB_XCNT(j)  (256  + 64 * (j))
#define XB_XSUB(j)  (1280 + 64 * (j))
#define XB_XGEN(j)  (2304 + 64 * (j))
#define XB_TOP      3328
#define XB_TOPGEN   3392
#define XCD_BAR_WORDS 3456
#define XB_SPIN_CAP (1u << 18)

__device__ __forceinline__ unsigned xb_ld(unsigned* p)              { return __hip_atomic_load(p, __ATOMIC_RELAXED, __HIP_MEMORY_SCOPE_AGENT); }
__device__ __forceinline__ unsigned xb_add(unsigned* p, unsigned v) { return __hip_atomic_fetch_add(p, v, __ATOMIC_RELAXED, __HIP_MEMORY_SCOPE_AGENT); }
__device__ __forceinline__ unsigned xb_xcc_id() { return (unsigned)__builtin_amdgcn_s_getreg((3 << 11) | 20) & 0xFu; }
#define XB_SPIN(cond, bar) do { unsigned _sp = 0; while (cond) { __builtin_amdgcn_s_sleep(1); \
    if ((++_sp & 255u) == 0u) { if (xb_ld(&(bar)[XB_TMO])) break; if (_sp > XB_SPIN_CAP) { atomicAdd(&(bar)[XB_TMO], 1u); break; } } } } while (0)

struct XcdBarrier {
    unsigned* bar; unsigned x;
    volatile LAS unsigned* st;
};

__device__ __forceinline__ XcdBarrier xcd_barrier_post(unsigned* bar, volatile LAS unsigned* st) {
    XcdBarrier b; b.bar = bar; b.x = xb_xcc_id(); b.st = st;
    if (threadIdx.x == 0) (void)xb_add(&bar[XB_XCNT(b.x)], 1u);
    return b;
}
__device__ __forceinline__ void xcd_barrier_complete(unsigned* bar, unsigned x, unsigned& nloc, unsigned& nx) {
    const unsigned G = gridDim.x * gridDim.y * gridDim.z;
    unsigned sum, cnt, mine, sp = 0u;
    for (;;) {
        sum = 0u; cnt = 0u; mine = 0u;
#pragma unroll
        for (unsigned j = 0; j < 16; ++j) { const unsigned c = xb_ld(&bar[XB_XCNT(j)]); sum += c; cnt += (c > 0u) ? 1u : 0u; mine = (j == x) ? c : mine; }
        if (sum == G) break;
        __builtin_amdgcn_s_sleep(1);
        if ((++sp & 255u) == 0u) { if (xb_ld(&bar[XB_TMO])) break; if (sp > XB_SPIN_CAP) { atomicAdd(&bar[XB_TMO], 1u); break; } }
    }
    nloc = mine > 0u ? mine : 1u; nx = cnt > 0u ? cnt : 1u;
}

__device__ __forceinline__ void xcd_barrier(const XcdBarrier& b) {
    asm volatile("s_waitcnt vmcnt(0)" ::: "memory");
    __syncthreads();
    if (threadIdx.x == 0) {
        unsigned* bar = b.bar;
        __builtin_amdgcn_s_waitcnt(0);
        unsigned nloc = b.st[0], nx = b.st[1];
        if (nloc == 0u) { xcd_barrier_complete(bar, b.x, nloc, nx); b.st[0] = nloc; b.st[1] = nx; }
        const unsigned old = xb_add(&bar[XB_XSUB(b.x)], 1u);
        const unsigned gen = old / nloc;
        if (old + 1u == (gen + 1u) * nloc) {
            __builtin_amdgcn_fence(__ATOMIC_RELEASE, "agent");
            asm volatile("s_waitcnt vmcnt(0)" ::: "memory");
            const unsigned og = xb_add(&bar[XB_TOP], 1u);
            const unsigned tg = og / nx;
            if (og + 1u == (tg + 1u) * nx) xb_add(&bar[XB_TOPGEN], 1u);
            else XB_SPIN(xb_ld(&bar[XB_TOPGEN]) == tg, bar);
            __builtin_amdgcn_fence(__ATOMIC_ACQUIRE, "agent");
            xb_add(&bar[XB_XGEN(b.x)], 1u);
            asm volatile("s_waitcnt vmcnt(0)" ::: "memory");
        } else {
            XB_SPIN(xb_ld(&bar[XB_XGEN(b.x)]) == gen, bar);
            __builtin_amdgcn_fence(__ATOMIC_ACQUIRE, "agent");
            asm volatile("s_waitcnt vmcnt(0)" ::: "memory");
        }
    }
    __syncthreads();
}
constexpr int S = 8192, D = 2048, FF = 5632, NLAYER = 4;
constexpr int NIN = 14912, NINP = 15104;
constexpr int NGU = 2 * FF;
constexpr float EPS = 1e-6f;
constexpr int PC_GATE = 0, PC_POOL = 8192, PC_DIL = 8704, PC_SGU = 13312, PC_CQ = 14336, PC_CKV = 14720, PC_KR = 14848;
constexpr int NMLA = 1792;

namespace epi {
using pg8::f32x4; using pg8::u32x4; using pg8::Unit; using pg8::bf16_t;
typedef float f32x2_t __attribute__((ext_vector_type(2))); typedef __bf16 bf16x2_t __attribute__((ext_vector_type(2)));
__device__ __forceinline__ unsigned cvt_pk_bf16(float lo, float hi) { f32x2_t v = {lo, hi}; bf16x2_t b = __builtin_convertvector(v, bf16x2_t); return __builtin_bit_cast(unsigned, b); }
constexpr int BM = 256, HALF = 128;
typedef unsigned u32x2 __attribute__((ext_vector_type(2)));
__device__ __forceinline__ float fast_exp(float x) { return __builtin_amdgcn_exp2f(x * 1.44269504089f); }
__device__ __forceinline__ float sigmoid_f(float x) { return __builtin_amdgcn_rcpf(1.0f + fast_exp(-x)); }

struct EpiSwiglu {
    static constexpr bool PERM = true, AFTER_DRAIN = false, KEEP_ACC = false;
    bf16_t* H; const __attribute__((address_space(3))) float* tab;
    __device__ __forceinline__ void operator()(const f32x4 (&acc)[2][2][4][2], const Unit& u, int wr, int wc, int fr, int fq, int ui) const {
        const int row0 = u.pm * BM + wr * 64 + fr, col0 = u.pn * HALF + wc * 32 + 8 * fq; const __attribute__((address_space(3))) float* tb = tab + ui * 256 + wr * 64 + fr;
#pragma unroll
        for (int ai = 0; ai < 2; ++ai)
#pragma unroll
            for (int m = 0; m < 4; ++m) {
                bf16_t* rowp = H + (size_t)(row0 + ai * HALF + m * 16) * FF + col0; const float rs = tb[ai * HALF + m * 16];
                float o[8];
#pragma unroll
                for (int n = 0; n < 2; ++n)
#pragma unroll
                    for (int j = 0; j < 4; ++j) { const float g = acc[ai][0][m][n][j] * rs, up = acc[ai][1][m][n][j] * rs; o[n * 4 + j] = g * sigmoid_f(g) * up; }
                u32x4 w; w.x = cvt_pk_bf16(o[0], o[1]); w.y = cvt_pk_bf16(o[2], o[3]); w.z = cvt_pk_bf16(o[4], o[5]); w.w = cvt_pk_bf16(o[6], o[7]);
                *(u32x4*)rowp = w;
                asm volatile("" ::: "memory");
            }
    }
};
struct EpiResid {
    static constexpr bool PERM = false, AFTER_DRAIN = false, KEEP_ACC = false;
    const float* base; float* out; float alpha; bf16_t* xb; float* ssp;
    __device__ __forceinline__ void operator()(const f32x4 (&acc)[2][2][4][2], const Unit& u, int wr, int wc, int fr, int fq, int ui) const {
        const int row0 = u.pm * BM + wr * 64 + fr, col0 = u.pn * BM + wc * 32 + 4 * fq;
        f32x4 bb[3][4];
#define ER_LOAD(buf, g) { const size_t off_ = (size_t)(row0 + ((g) >> 2) * HALF + ((g) & 3) * 16) * D + col0; _Pragma("unroll") for (int q_ = 0; q_ < 4; ++q_) bb[buf][q_] = *(const f32x4*)(base + off_ + (q_ >> 1) * HALF + (q_ & 1) * 16); }
        ER_LOAD(0, 0) ER_LOAD(1, 1)
#pragma unroll
        for (int g = 0; g < 8; ++g) { const int ai = g >> 2, m = g & 3;
            if (g + 2 < 8) ER_LOAD((g + 2) % 3, g + 2)
            const int r = row0 + ai * HALF + m * 16; const size_t off = (size_t)r * D + col0; float s = 0.f;
#pragma unroll
            for (int q = 0; q < 4; ++q) { const int bj = q >> 1, n = q & 1; const f32x4 v = bb[g % 3][q] + acc[ai][bj][m][n] * alpha;
                *(f32x4*)(out + off + bj * HALF + n * 16) = v;
                if (xb) { s += (v[0] * v[0] + v[1] * v[1]) + (v[2] * v[2] + v[3] * v[3]); u32x2 w; w.x = cvt_pk_bf16(v[0], v[1]); w.y = cvt_pk_bf16(v[2], v[3]); *(u32x2*)(xb + off + bj * HALF + n * 16) = w; } }
            if (xb) { s += __shfl_xor(s, 16); s += __shfl_xor(s, 32); if (fq == 0) ssp[(size_t)r * 32 + u.pn * 4 + wc] = s; }
            asm volatile("" ::: "memory"); }
#undef ER_LOAD
    }
};
struct EpiPin {
    static constexpr bool PERM = true, AFTER_DRAIN = false, KEEP_ACC = false;
    bf16_t* P; const __attribute__((address_space(3))) float* tab;
    template <int KIND> __device__ __forceinline__ void run(const f32x4 (&acc)[2][2][4][2], const Unit& u, int wr, int wc, int fr, int fq, int ui) const {
        const __attribute__((address_space(3))) float* tb = tab + ui * 256 + wr * 64 + fr;
        const int row0 = u.pm * BM + wr * 64 + fr, col0 = u.pn * BM + wc * 32 + 8 * fq;
#pragma unroll
        for (int ai = 0; ai < 2; ++ai)
#pragma unroll
            for (int m = 0; m < 4; ++m) { bf16_t* rowp = P + (size_t)(row0 + ai * HALF + m * 16) * NINP + col0; const float rs = tb[ai * HALF + m * 16];
#pragma unroll
                for (int bj = 0; bj < 2; ++bj) { float o[8];
#pragma unroll
                    for (int n = 0; n < 2; ++n)
#pragma unroll
                        for (int j = 0; j < 4; ++j) { const float x = acc[ai][bj][m][n][j] * rs;
                            o[n * 4 + j] = (KIND == 0) ? x : ((KIND == 1) ? sigmoid_f(x) : x * sigmoid_f(1.5957691216f * (x + 0.044715f * x * x * x))); }
                    u32x4 w; w.x = cvt_pk_bf16(o[0], o[1]); w.y = cvt_pk_bf16(o[2], o[3]); w.z = cvt_pk_bf16(o[4], o[5]); w.w = cvt_pk_bf16(o[6], o[7]);
                    *(u32x4*)(rowp + bj * HALF) = w; }
                asm volatile("" ::: "memory"); }
    }
    __device__ __forceinline__ void operator()(const f32x4 (&acc)[2][2][4][2], const Unit& u, int wr, int wc, int fr, int fq, int ui) const {
        if (u.pn < 32) run<1>(acc, u, wr, wc, fr, fq, ui); else if (u.pn >= 52 && u.pn < 56) run<2>(acc, u, wr, wc, fr, fq, ui); else run<0>(acc, u, wr, wc, fr, fq, ui);
    }
};
struct EpiF32 {
    static constexpr bool PERM = false, AFTER_DRAIN = false, KEEP_ACC = false;
    float* C; int ldc; int colmul;
    __device__ __forceinline__ void operator()(const f32x4 (&acc)[2][2][4][2], const Unit& u, int wr, int wc, int fr, int fq, int ui) const {
        const int row0 = u.pm * BM + wr * 64 + fr, col0 = colmul * u.pn * BM + wc * 32 + 4 * fq;
#pragma unroll
        for (int ai = 0; ai < 2; ++ai)
#pragma unroll
            for (int m = 0; m < 4; ++m) { float* rowp = C + (size_t)(row0 + ai * HALF + m * 16) * ldc + col0;
#pragma unroll
                for (int bj = 0; bj < 2; ++bj)
#pragma unroll
                    for (int n = 0; n < 2; ++n) *(f32x4*)(rowp + bj * HALF + n * 16) = acc[ai][bj][m][n]; }
    }
};
struct EpiExp {
    static constexpr bool PERM = true, AFTER_DRAIN = false, KEEP_ACC = false;
    bf16_t* P;
    __device__ __forceinline__ void operator()(const f32x4 (&acc)[2][2][4][2], const Unit& u, int wr, int wc, int fr, int fq, int ui) const {
        const int row0 = u.pm * BM + wr * 64 + fr, col0 = (u.pn & 31) * BM + wc * 32 + 8 * fq;
#pragma unroll
        for (int ai = 0; ai < 2; ++ai)
#pragma unroll
            for (int m = 0; m < 4; ++m) { bf16_t* rowp = P + (size_t)(row0 + ai * HALF + m * 16) * S + col0;
#pragma unroll
                for (int bj = 0; bj < 2; ++bj) { float o[8];
#pragma unroll
                    for (int n = 0; n < 2; ++n)
#pragma unroll
                        for (int j = 0; j < 4; ++j) o[n * 4 + j] =
#ifdef DBG_NOEXP
                            acc[ai][bj][m][n][j];
#else
                            fast_exp(acc[ai][bj][m][n][j]);
#endif
                    u32x4 w; w.x = cvt_pk_bf16(o[0], o[1]); w.y = cvt_pk_bf16(o[2], o[3]); w.z = cvt_pk_bf16(o[4], o[5]); w.w = cvt_pk_bf16(o[6], o[7]);
                    *(u32x4*)(rowp + bj * HALF) = w; }
                asm volatile("" ::: "memory"); }
    }
};
struct EpiBranch {
    static constexpr bool PERM = false, AFTER_DRAIN = false, KEEP_ACC = false;
    float* merged; bf16_t* mergedb; const bf16_t* gate; int b;
    __device__ __forceinline__ void operator()(const f32x4 (&acc)[2][2][4][2], const Unit& u, int wr, int wc, int fr, int fq, int ui) const {
        const int row0 = u.pm * BM + wr * 64 + fr, col0 = u.pn * BM + wc * 32 + 4 * fq;
#pragma unroll
        for (int ai = 0; ai < 2; ++ai)
#pragma unroll
            for (int m = 0; m < 4; ++m) { const int r = row0 + ai * HALF + m * 16;
#pragma unroll
                for (int bj = 0; bj < 2; ++bj)
#pragma unroll
                    for (int n = 0; n < 2; ++n) { const int c = col0 + bj * HALF + n * 16;
                        const u32x2 gv = *(const u32x2*)(gate + (size_t)r * NINP + c);
                        f32x4 g; g[0] = __uint_as_float(gv.x << 16); g[1] = __uint_as_float(gv.x & 0xffff0000u); g[2] = __uint_as_float(gv.y << 16); g[3] = __uint_as_float(gv.y & 0xffff0000u);
                        f32x4 v = acc[ai][bj][m][n] * g;
                        float* mp = merged + (size_t)r * D + c;
                        if (b != 0) v += *(const f32x4*)mp;
                        if (b != 3) *(f32x4*)mp = v;
                        else { u32x2 w; w.x = cvt_pk_bf16(v[0], v[1]); w.y = cvt_pk_bf16(v[2], v[3]); *(u32x2*)(mergedb + (size_t)r * D + c) = w; } }
                asm volatile("" ::: "memory"); }
    }
};
struct QKOrder {
    int G, c;
    __device__ bool next(int i, Unit& u) const { const int L = i * G + c; if (L >= 4096) return false; const int h = L >> 10, rem = L & 1023; u.pm = h * 32 + (rem >> 5); u.pn = h * 32 + (rem & 31); return true; }
    __device__ __forceinline__ void a_ready(const Unit&, int) const {}
    __device__ __forceinline__ void done(const Unit&) const {}
};
struct PVOrder {
    int G, c;
    __device__ bool next(int i, Unit& u) const { const int L = i * G + c; if (L >= 128) return false; u.pm = L; u.pn = L >> 5; return true; }
    __device__ __forceinline__ void a_ready(const Unit&, int) const {}
    __device__ __forceinline__ void done(const Unit&) const {}
};
struct EpiBranchChain {
    static constexpr bool PERM = true, AFTER_DRAIN = false, KEEP_ACC = true;
    bf16_t* mergedb; const bf16_t* gate;
    __device__ __forceinline__ void operator()(f32x4 (&acc)[2][2][4][2], const Unit& u, int wr, int wc, int fr, int fq, int ui) const {
        const int b = u.pm >> 5, pm0 = u.pm & 31, pn0 = u.pn & 7;
        const int row0 = pm0 * BM + wr * 64 + fr, col0 = pn0 * BM + wc * 32 + 8 * fq;
        u32x4 gg[3][2][2];
#define BC_LOAD(buf, g) { const bf16_t* gp_ = gate + (size_t)(row0 + ((g) >> 2) * HALF + ((g) & 3) * 16) * NINP + b * D + col0; _Pragma("unroll") for (int bj_ = 0; bj_ < 2; ++bj_) { \
            gg[buf][bj_][0] = *(const u32x4*)(gp_ + bj_ * HALF); if (b != 3) gg[buf][bj_][1] = *(const u32x4*)(gp_ + bj_ * HALF + D); } }
        BC_LOAD(0, 0) BC_LOAD(1, 1)
#pragma unroll
        for (int gi = 0; gi < 8; ++gi) { const int ai = gi >> 2, m = gi & 3; const int r = row0 + ai * HALF + m * 16;
            if (gi + 2 < 8) BC_LOAD((gi + 2) % 3, gi + 2)
#pragma unroll
            for (int bj = 0; bj < 2; ++bj) { const int c = col0 + bj * HALF;
                const u32x4 gv = gg[gi % 3][bj][0];
                float g[8] = {__uint_as_float(gv.x << 16), __uint_as_float(gv.x & 0xffff0000u), __uint_as_float(gv.y << 16), __uint_as_float(gv.y & 0xffff0000u),
                              __uint_as_float(gv.z << 16), __uint_as_float(gv.z & 0xffff0000u), __uint_as_float(gv.w << 16), __uint_as_float(gv.w & 0xffff0000u)};
                if (b != 3) {
                    const u32x4 hv = gg[gi % 3][bj][1];
                    const float gn[8] = {__uint_as_float(hv.x << 16), __uint_as_float(hv.x & 0xffff0000u), __uint_as_float(hv.y << 16), __uint_as_float(hv.y & 0xffff0000u),
                                         __uint_as_float(hv.z << 16), __uint_as_float(hv.z & 0xffff0000u), __uint_as_float(hv.w << 16), __uint_as_float(hv.w & 0xffff0000u)};
#pragma unroll
                    for (int n = 0; n < 2; ++n)
#pragma unroll
                        for (int j = 0; j < 4; ++j) acc[ai][bj][m][n][j] *= fmaxf(g[n * 4 + j], 1e-30f) * __builtin_amdgcn_rcpf(fmaxf(gn[n * 4 + j], 1e-30f));
                } else {
                    float o[8];
#pragma unroll
                    for (int n = 0; n < 2; ++n)
#pragma unroll
                        for (int j = 0; j < 4; ++j) o[n * 4 + j] = acc[ai][bj][m][n][j] * fmaxf(g[n * 4 + j], 1e-30f);
                    u32x4 w; w.x = cvt_pk_bf16(o[0], o[1]); w.y = cvt_pk_bf16(o[2], o[3]); w.z = cvt_pk_bf16(o[4], o[5]); w.w = cvt_pk_bf16(o[6], o[7]);
                    *(u32x4*)(mergedb + (size_t)r * D + c) = w;
                } }
            asm volatile("" ::: "memory"); }
#undef BC_LOAD
    }
};
template <class Sched> __device__ __forceinline__ void fill_rstd_table(const Sched& So, const float* ssp, __attribute__((address_space(3))) float* tab, int wave) {
    int t_ = wave * 64 + (int)__builtin_amdgcn_mbcnt_hi(~0u, __builtin_amdgcn_mbcnt_lo(~0u, 0u)); asm volatile("" : "+v"(t_));
    const int t = t_, row = t >> 1, half = t & 1;
#pragma unroll 1
    for (int ui = 0; ui < 8; ++ui) { Unit u; if (!So.next(ui, u)) break;
        const f32x4* p = (const f32x4*)(ssp + (size_t)(u.pm * BM + row) * 32 + half * 16); const f32x4 a = p[0], b = p[1], c = p[2], d = p[3];
        float s = (((a[0] + a[1]) + (a[2] + a[3])) + ((b[0] + b[1]) + (b[2] + b[3]))) + (((c[0] + c[1]) + (c[2] + c[3])) + ((d[0] + d[1]) + (d[2] + d[3])));
        s += __shfl_xor(s, 1);
        if (half == 0) tab[ui * 256 + row] = 1.0f / sqrtf(s * (1.0f / D) + EPS); }
}
struct BranchOrder {
    pg8::StaticOrder so;
    __device__ bool next(int i, Unit& u) const { if (i >= 4) return false; Unit t; if (!so.next(0, t)) return false; u.pm = i * 32 + t.pm; u.pn = i * 8 + t.pn; return true; }
    __device__ __forceinline__ void a_ready(const Unit&, int) const {}
    __device__ __forceinline__ void done(const Unit&) const {}
};
}
constexpr size_t MiB = 1u << 20;
constexpr size_t WS_CTL = 0, CTL_ZERO_BYTES = 1 * MiB;
constexpr size_t WS_COS = 1 * MiB, WS_SIN = 2 * MiB, WS_SSP = 3 * MiB;
constexpr size_t WS_WGU1 = 4 * MiB, WS_WD1 = 48 * MiB, WS_WGU2 = 70 * MiB, WS_WD2 = 114 * MiB;
constexpr size_t WS_WIN = 136 * MiB, WS_WBR = 195 * MiB, WS_WOUT = 203 * MiB, WS_WMLA = 211 * MiB;
constexpr size_t WS_X = 214 * MiB;
constexpr size_t WS_XN = 278 * MiB;
constexpr size_t WS_HID = 310 * MiB;
constexpr size_t WS_P = 398 * MiB;
constexpr size_t WS_Z = 634 * MiB;
constexpr size_t WS_VVN = 666 * MiB, WS_MLAA = 674 * MiB;
constexpr size_t WS_MLARAW = 682 * MiB;
constexpr size_t WS_QP = 1426 * MiB, WS_KP = 1458 * MiB, WS_VT = 770 * MiB;
constexpr int QKP = 256;
constexpr size_t WS_ORAW = 786 * MiB;
constexpr size_t WS_MERGED = 818 * MiB, WS_MERGEDB = 882 * MiB;
constexpr size_t WS_PEXP = 914 * MiB;
constexpr size_t WS_DILO = 1490 * MiB, WS_DILL = 1540 * MiB;
constexpr size_t WS_MQ = WS_QP, WS_MK = WS_KP, WS_MV = WS_VT, WS_MOP = WS_PEXP, WS_MLP = WS_ORAW;
constexpr size_t WS_END = 1541 * MiB;
static_assert(WS_WGU1 + (size_t)NGU * D * 2 <= WS_WD1 && WS_WD1 + (size_t)D * FF * 2 <= WS_WGU2 && WS_WGU2 + (size_t)NGU * D * 2 <= WS_WD2 && WS_WD2 + (size_t)D * FF * 2 <= WS_WIN, "ws map 1");
static_assert(WS_WIN + (size_t)NINP * D * 2 <= WS_WBR && WS_WBR + (size_t)4 * D * 512 * 2 <= WS_WOUT && WS_WOUT + (size_t)D * D * 2 <= WS_WMLA && WS_WMLA + (size_t)NMLA * 512 * 2 <= WS_X, "ws map 2");
static_assert(WS_X + (size_t)S * D * 4 <= WS_XN && WS_XN + (size_t)S * D * 2 <= WS_HID && WS_HID + (size_t)S * FF * 2 <= WS_P && WS_P + (size_t)S * NINP * 2 <= WS_Z, "ws map 3");
static_assert(WS_Z + (size_t)4 * S * 512 * 2 <= WS_VVN && WS_MLARAW + (size_t)S * NMLA * 4 <= WS_VT && WS_KP + (size_t)4 * S * QKP * 2 <= WS_END && WS_ORAW + (size_t)4 * S * 256 * 4 <= WS_MERGED && WS_MERGED + (size_t)S * D * 4 <= WS_MERGEDB && WS_MERGEDB + (size_t)S * D * 2 <= WS_PEXP && WS_PEXP + (size_t)4 * S * S * 2 <= WS_QP, "ws map 4");
constexpr size_t WS_SETD = 956 * MiB;
static_assert(WS_WGU1 + WS_SETD >= WS_PEXP + (size_t)2 * 4 * S * 128 * 4 && WS_X + WS_SETD <= WS_QP, "second weight set");
#ifndef TAILCONV
#define TAILCONV 0
#endif
constexpr int CPARTS = 416;
constexpr int CW_BAR = 4096;

constexpr int NWAVES = 8;
constexpr int RING_OFF = 0, RING_BYTES = 131072;
constexpr int LDS_BYTES = 163840;
constexpr int LDSCTL_OFF = LDS_BYTES - 1024, MISC_OFF = LDSCTL_OFF + 320;
constexpr int RSTD_OFF = RING_BYTES + 1024;

enum { I_X = 0, I_F1N, I_F1G, I_F1U, I_F1D, I_MIXN, I_WIN, I_POOLW, I_POOLS, I_DQN, I_DKN, I_SGUN, I_SGUW, I_SGUB, I_MQAN, I_MWUQ, I_MKVAN, I_MWUKV, I_MQN, I_MKN, I_WBR, I_WOUT, I_F2N, I_F2G, I_F2U, I_F2D, N_INPUTS };

struct Frame {
    LAS unsigned char* lds;
    volatile LAS unsigned* MISC;
    int wave, vcu, G;
    int gw, NGW, NGT;
};
constexpr int NPHASE = 13;
struct Args { const float* in[N_INPUTS]; float* out; unsigned char* ws; int l_lo, l_hi, ph_lo, ph_hi; };
typedef const __attribute__((address_space(4))) Args* ArgsP;
__device__ __forceinline__ ArgsP fresh_args() { ArgsP p = (ArgsP)__builtin_amdgcn_kernarg_segment_ptr(); asm volatile("" : "+s"(p)); return p; }
__device__ __forceinline__ int opq_s(int x) { asm volatile("" : "+s"(x)); return x; }
__device__ __forceinline__ Frame fresh_frame(const Frame& F) { Frame R = F; R.wave = opq_s(F.wave); R.vcu = opq_s(F.vcu); R.G = opq_s(F.G); R.gw = opq_s(F.gw); R.NGW = opq_s(F.NGW); R.NGT = opq_s(F.NGT); return R; }
__device__ __forceinline__ int opq_lane() { int l = (int)__builtin_amdgcn_mbcnt_hi(~0u, __builtin_amdgcn_mbcnt_lo(~0u, 0u)); asm volatile("" : "+v"(l)); return l; }
__device__ __forceinline__ float wave_sum(float v) {
#pragma unroll
    for (int o = 1; o < 64; o <<= 1) v += __shfl_xor(v, o);
    return v;
}
__device__ __forceinline__ float wave_max(float v) {
#pragma unroll
    for (int o = 1; o < 64; o <<= 1) v = fmaxf(v, __shfl_xor(v, o));
    return v;
}
__device__ __forceinline__ float bf2f(unsigned short b) { return __uint_as_float(((unsigned)b) << 16); }
__device__ __forceinline__ float bflo(unsigned u) { return __uint_as_float(u << 16); }
__device__ __forceinline__ float bfhi(unsigned u) { return __uint_as_float(u & 0xffff0000u); }
__device__ __forceinline__ float rsq(float x) { return 1.0f / sqrtf(x); }

__device__ __forceinline__ void transpose_load(f32x4 (&v)[8], const float* W, int ldw, int k0, int n0, int lane) {
    const int pc = lane & 7, kr = lane >> 3;
#pragma unroll
    for (int i = 0; i < 8; ++i) v[i] = __builtin_nontemporal_load((const GAS f32x4*)(W + (size_t)(k0 + 8 * i + kr) * ldw + n0 + 4 * pc));
}
__device__ __forceinline__ void transpose_store(const f32x4 (&v)[8], int k0, bf16* WT, int ldt, int drow0, int dk0, LAS float* scr, int lane, const float* kgain) {
    const int pc = lane & 7, kr = lane >> 3;
#pragma unroll
    for (int i = 0; i < 8; ++i) { LAS float* d = scr + (8 * i + kr) * 33 + 4 * pc; const float gk = kgain ? kgain[k0 + 8 * i + kr] : 1.0f;
        d[0] = v[i].x * gk; d[1] = v[i].y * gk; d[2] = v[i].z * gk; d[3] = v[i].w * gk; }
    LDS_WAIT(); asm volatile("" ::: "memory");
    const int c = lane & 7;
#pragma unroll
    for (int j = 0; j < 4; ++j) { const int n = (lane >> 3) + 8 * j; const LAS float* s = scr + (8 * c) * 33 + n;
        v4u o; o.x = pk2(s[0 * 33], s[1 * 33]); o.y = pk2(s[2 * 33], s[3 * 33]); o.z = pk2(s[4 * 33], s[5 * 33]); o.w = pk2(s[6 * 33], s[7 * 33]);
        *(GAS v4u*)(WT + (size_t)(drow0 + n) * ldt + dk0 + k0 + 8 * c) = o; }
    LDS_WAIT(); asm volatile("" ::: "memory");
}
template <int MAP> __device__ __forceinline__ int map_row(int n0, int roff) {
    if (MAP == 0) return n0 + roff;
    if (MAP == 1) return (n0 >> 7) * 256 + roff + (n0 & 127);
    return (n0 < 6720) ? (n0 + 8192) : (n0 - 6720);
}
template <int MAP> __device__ __forceinline__ void transpose_matrix(const Frame& F, int vgw, int vNGW, int p0, int p1, int lane, const float* W, int K, int N, bf16* WT, int ldt, int roff, int dk0, const float* kgain = nullptr) {
    LAS float* scr = (LAS float*)(F.lds + RING_OFF + (vgw & 7) * 16384);
    const int nblk = N / 32, items = (K / 64) * nblk, lo = (int)((long)items * p0 / CPARTS), hi = (int)((long)items * p1 / CPARTS);
    int it = lo + vgw; if (it >= hi) return;
    f32x4 va[8], vb[8]; transpose_load(va, W, N, 64 * (it / nblk), 32 * (it % nblk), lane);
    for (;;) {
        const int itn = it + vNGW; const bool more = itn < hi;
        if (more) transpose_load(vb, W, N, 64 * (itn / nblk), 32 * (itn % nblk), lane);
        transpose_store(va, 64 * (it / nblk), WT, ldt, map_row<MAP>(32 * (it % nblk), roff), dk0, scr, lane, kgain);
        if (!more) break;
#pragma unroll
        for (int i = 0; i < 8; ++i) va[i] = vb[i];
        it = itn;
    }
}

__device__ __forceinline__ void phase_convert(ArgsP A, const Frame& F, int l, int vgw, int vNGW, int p0, int p1) {
    unsigned char* ws = A->ws + (size_t)(l & 1) * WS_SETD; const int lane = opq_lane(); const int vgt = vgw * 64 + lane, vNGT = vNGW * 64;
#define TM(MAP, ...) transpose_matrix<MAP>(F, vgw, vNGW, p0, p1, lane, __VA_ARGS__)
#define PART(n, lo, hi) const int lo = (int)((long)(n) * p0 / CPARTS), hi = (int)((long)(n) * p1 / CPARTS)
    TM(0, A->in[I_F2D] + (size_t)l * FF * D, FF, D, (bf16*)(ws + WS_WD2), FF, 0, 0);
    TM(1, A->in[I_F2G] + (size_t)l * D * FF, D, FF, (bf16*)(ws + WS_WGU2), D, 0, 0, A->in[I_F2N] + (size_t)l * D);
    TM(1, A->in[I_F2U] + (size_t)l * D * FF, D, FF, (bf16*)(ws + WS_WGU2), D, 128, 0, A->in[I_F2N] + (size_t)l * D);
    TM(0, A->in[I_WOUT] + (size_t)l * D * D, D, D, (bf16*)(ws + WS_WOUT), D, 0, 0);
    for (int b = 1; b < 4; ++b) TM(0, A->in[I_WBR] + ((size_t)l * 4 + b) * 512 * D, 512, D, (bf16*)(ws + WS_WBR) + (size_t)b * D * 512, 512, 0, 0);
    TM(0, A->in[I_MWUQ] + (size_t)l * 384 * 768, 384, 768, (bf16*)(ws + WS_WMLA), 512, 0, 0);
    TM(0, A->in[I_MWUKV] + (size_t)l * 128 * 1024, 128, 1024, (bf16*)(ws + WS_WMLA), 512, 768, 384);
    TM(2, A->in[I_WIN] + (size_t)l * D * NIN, D, NIN, (bf16*)(ws + WS_WIN), D, 0, 0, A->in[I_MIXN] + (size_t)l * D);
    TM(0, A->in[I_F1D] + (size_t)l * FF * D, FF, D, (bf16*)(ws + WS_WD1), FF, 0, 0);
    TM(1, A->in[I_F1G] + (size_t)l * D * FF, D, FF, (bf16*)(ws + WS_WGU1), D, 0, 0, A->in[I_F1N] + (size_t)l * D);
    TM(1, A->in[I_F1U] + (size_t)l * D * FF, D, FF, (bf16*)(ws + WS_WGU1), D, 128, 0, A->in[I_F1N] + (size_t)l * D);
    { bf16* wm = (bf16*)(ws + WS_WMLA);
      { PART(768 * 128, lo, hi); for (int i = lo + vgt; i < hi; i += vNGT) wm[(size_t)(i >> 7) * 512 + 384 + (i & 127)] = 0; }
      { PART(1024 * 384, lo, hi); for (int i = lo + vgt; i < hi; i += vNGT) wm[(size_t)(768 + i / 384) * 512 + (i % 384)] = 0; }
      unsigned* wz = (unsigned*)((bf16*)(ws + WS_WIN) + (size_t)NIN * D);
      { PART((NINP - NIN) * D / 2, lo, hi); for (int i = lo + vgt; i < hi; i += vNGT) wz[i] = 0u; } }
    { const float* pw = A->in[I_POOLW] + (size_t)l * 4 * 128 * 128; const float* ps = A->in[I_POOLS] + (size_t)l * 512; const float* wb = A->in[I_WBR] + (size_t)l * 4 * 512 * D;
      bf16* wt = (bf16*)(ws + WS_WBR);
      PART(128 * D, lo, hi);
      for (int i = lo + vgt; i < hi; i += vNGT) { const int r4 = (i >> 11) * 4, n = i & (D - 1), g = r4 >> 7;
          const float* pr = pw + (size_t)r4 * 128; const float* wcol = wb + (size_t)(g * 128) * D + n; const float* psg = ps + g * 128;
          float a0 = 0.f, a1 = 0.f, a2 = 0.f, a3 = 0.f;
#pragma unroll 8
          for (int d = 0; d < 128; ++d) { const float wv = wcol[(size_t)d * D] * psg[d]; a0 += pr[d] * wv; a1 += pr[128 + d] * wv; a2 += pr[256 + d] * wv; a3 += pr[384 + d] * wv; }
          bf16* o = wt + (size_t)n * 512 + r4;
          *(unsigned long long*)o = (unsigned long long)pk2(a0, a1) | ((unsigned long long)pk2(a2, a3) << 32); } }
#undef TM
#undef PART
}
__device__ __forceinline__ void tail_convert(ArgsP A, const Frame& F, int l, int bx, int nunits, int p0, int p1) {
#if !TAILCONV
    return;
#endif
    const int busy = nunits % F.G; if (busy == 0 || l + 1 >= NLAYER) return;
    const int slot = bx - busy; if (slot < 0) return;
    phase_convert(A, F, l + 1, slot * NWAVES + F.wave, (F.G - busy) * NWAVES, p0, p1);
}
__device__ __forceinline__ void phase_rope_tables(ArgsP A, const Frame& F) {
    unsigned char* ws = A->ws; const int lane = opq_lane(); const int gw = opq_s(F.gw); const int gt = gw * 64 + lane;
    {
        float* ct = (float*)(ws + WS_COS); float* st = (float*)(ws + WS_SIN);
        for (int i = gt; i < S * 32; i += F.NGT) { const int pos = i >> 5, k = i & 31;
            double f = 1.0; for (int j = 0; j < k; ++j) f *= 0.74989420933245582730;
            const float ang = (float)pos * (float)f;
            const double a = (double)ang; const double kq = __builtin_rint(a * 0.63661977236758134308); const double r = (a - kq * 1.5707963267948966192) - kq * 6.123233995736766e-17;
            const double r2 = r * r;
            const double sn = r * (1.0 + r2 * (-1.0 / 6 + r2 * (1.0 / 120 + r2 * (-1.0 / 5040 + r2 * (1.0 / 362880 + r2 * (-1.0 / 39916800 + r2 * (1.0 / 6227020800.0)))))));
            const double cs = 1.0 + r2 * (-0.5 + r2 * (1.0 / 24 + r2 * (-1.0 / 720 + r2 * (1.0 / 40320 + r2 * (-1.0 / 3628800 + r2 * (1.0 / 479001600.0 + r2 * (-1.0 / 87178291200.0)))))));
            const int q = ((int)kq) & 3;
            const double sv = (q == 0) ? sn : (q == 1) ? cs : (q == 2) ? -sn : -cs;
            const double cv = (q == 0) ? cs : (q == 1) ? -sn : (q == 2) ? -cs : sn;
            ct[i] = (float)cv; st[i] = (float)sv; }
    }
}
__device__ __forceinline__ void phase_prep(const Frame& F, const float* x, bf16* xb, float* ssp) {
    const int lane = opq_lane(); const int gw = opq_s(F.gw);
    for (int m = gw; m < S; m += F.NGW) {
        const GAS f32x4* xr = (const GAS f32x4*)(x + (size_t)m * D) + lane;
        f32x4 v[8]; float s = 0.f;
#pragma unroll
        for (int j = 0; j < 8; ++j) { v[j] = xr[64 * j]; s += (v[j].x * v[j].x + v[j].y * v[j].y) + (v[j].z * v[j].z + v[j].w * v[j].w); }
        s = wave_sum(s);
        GAS unsigned long long* o8 = (GAS unsigned long long*)(xb + (size_t)m * D) + lane;
#pragma unroll
        for (int j = 0; j < 8; ++j) o8[64 * j] = (unsigned long long)pk2(v[j].x, v[j].y) | ((unsigned long long)pk2(v[j].z, v[j].w) << 32);
        if (lane < 32) ssp[(size_t)m * 32 + lane] = (lane == 0) ? s : 0.f;
    }
}
__device__ __forceinline__ void phase_mix1(ArgsP A, const Frame& F, int l) {
    unsigned char* ws = A->ws; const int lane = opq_lane(); const int gw = opq_s(F.gw); const int gt = gw * 64 + lane;
    bf16* p = (bf16*)(ws + WS_P); bf16* z0 = (bf16*)(ws + WS_Z); bf16* vvn = (bf16*)(ws + WS_VVN); bf16* mlaA = (bf16*)(ws + WS_MLAA);
    for (int item = gt; item < (S / 16) * 256; item += F.NGT) {
        const int cp = item & 255, t0 = (item >> 8) * 16, g = cp >> 6;
        const bf16* col = p + PC_POOL + 2 * cp;
        float va[32], vb[32];
#pragma unroll
        for (int k = 0; k < 32; ++k) { const int tt = t0 - 8 + k; const bool in = (tt >= 0) && (tt < S); const unsigned u = in ? *(const unsigned*)(col + (size_t)(in ? tt : 0) * NINP) : 0u; va[k] = bflo(u); vb[k] = bfhi(u); }
        unsigned* zo = (unsigned*)(z0 + (size_t)t0 * 512 + 2 * cp);
#define POOL_GROUP(HW) do { \
        _Pragma("unroll") for (int i = 0; i < 16; ++i) { float sa = 0.f, sb = 0.f; \
            _Pragma("unroll") for (int k = 8 + i - (HW); k < 8 + i + (HW); ++k) { sa += va[k]; sb += vb[k]; }     \
            const int t = t0 + i, lo = (t - (HW)) < 0 ? 0 : (t - (HW)), hi = (t + (HW)) > S ? S : (t + (HW)); const float inv = 1.0f / (float)(hi - lo); \
            zo[(size_t)i * 256] = pk2(sa * inv - va[8 + i], sb * inv - vb[8 + i]); } } while (0)
        if (g == 0) POOL_GROUP(1); else if (g == 1) POOL_GROUP(2); else if (g == 2) POOL_GROUP(4); else POOL_GROUP(8);
#undef POOL_GROUP
    }
    const float* gq = A->in[I_DQN] + l * 128; const float* gk = A->in[I_DKN] + l * 128; const float* gs = A->in[I_SGUN] + l * 512;
    const float* gqa = A->in[I_MQAN] + l * 384; const float* gkva = A->in[I_MKVAN] + l * 128;
    for (int t = gw; t < S; t += F.NGW) {
        bf16* prow = p + (size_t)t * NINP;
        { unsigned* ptr = (unsigned*)(prow + PC_DIL) + lane; unsigned uu[24]; float ss[24];
#pragma unroll
          for (int hh = 0; hh < 24; ++hh) uu[hh] = ptr[hh * 64];
#pragma unroll
          for (int hh = 0; hh < 24; ++hh) { const float a = bflo(uu[hh]), b = bfhi(uu[hh]); ss[hh] = a * a + b * b; }
#pragma unroll
          for (int o = 1; o < 64; o <<= 1) {
#pragma unroll
              for (int hh = 0; hh < 24; ++hh) ss[hh] += __shfl_xor(ss[hh], o); }
          const float gq0 = gq[2 * lane], gq1 = gq[2 * lane + 1], gk0 = gk[2 * lane], gk1 = gk[2 * lane + 1];
#pragma unroll
          for (int hh = 0; hh < 24; ++hh) { const float rstd = rsq(ss[hh] * (1.f / 128) + EPS);
              ptr[hh * 64] = pk2(bflo(uu[hh]) * rstd * (hh < 12 ? gq0 : gk0), bfhi(uu[hh]) * rstd * (hh < 12 ? gq1 : gk1)); } }
        { const v4u u = *((const v4u*)(prow + PC_SGU + 512) + lane); float x[8] = {bflo(u.x), bfhi(u.x), bflo(u.y), bfhi(u.y), bflo(u.z), bfhi(u.z), bflo(u.w), bfhi(u.w)}; float ss = 0.f;
#pragma unroll
          for (int k = 0; k < 8; ++k) ss += x[k] * x[k];
          const float rstd = rsq(wave_sum(ss) * (1.f / 512) + EPS); const float* gg = gs + 8 * lane;
          v4u o; o.x = pk2(x[0] * rstd * gg[0], x[1] * rstd * gg[1]); o.y = pk2(x[2] * rstd * gg[2], x[3] * rstd * gg[3]); o.z = pk2(x[4] * rstd * gg[4], x[5] * rstd * gg[5]); o.w = pk2(x[6] * rstd * gg[6], x[7] * rstd * gg[7]);
          *((v4u*)(vvn + (size_t)t * 512) + lane) = o; }
        { const unsigned* cq = (const unsigned*)(prow + PC_CQ) + lane; const unsigned u0 = cq[0], u1 = cq[64], u2 = cq[128];
          const float a0 = bflo(u0), b0 = bfhi(u0), a1 = bflo(u1), b1 = bfhi(u1), a2 = bflo(u2), b2 = bfhi(u2);
          const float rstd = rsq(wave_sum((a0 * a0 + b0 * b0) + (a1 * a1 + b1 * b1) + (a2 * a2 + b2 * b2)) * (1.f / 384) + EPS);
          unsigned* o = (unsigned*)(mlaA + (size_t)t * 512) + lane; const float* gg = gqa + 2 * lane;
          o[0] = pk2(a0 * rstd * gg[0], b0 * rstd * gg[1]); o[64] = pk2(a1 * rstd * gg[128], b1 * rstd * gg[129]); o[128] = pk2(a2 * rstd * gg[256], b2 * rstd * gg[257]);
          const unsigned uk = *((const unsigned*)(prow + PC_CKV) + lane); const float ak = bflo(uk), bk = bfhi(uk);
          const float rk = rsq(wave_sum(ak * ak + bk * bk) * (1.f / 128) + EPS);
          o[192] = pk2(ak * rk * gkva[2 * lane], bk * rk * gkva[2 * lane + 1]); }
    }
}
typedef float f32x16 __attribute__((ext_vector_type(16)));
typedef short s16x4 __attribute__((ext_vector_type(4)));
typedef short v4i16_t __attribute__((ext_vector_type(4)));
#define MFMA32(a, b, c) __builtin_amdgcn_mfma_f32_32x32x16_bf16((a), (b), (c), 0, 0, 0)
__device__ __forceinline__ int crow(int reg, int h) { return (reg & 3) + 8 * (reg >> 2) + 4 * h; }
__device__ __forceinline__ bf16x8 pack8(const f32x16& x, int s) {
    v4u p; p.x = epi::cvt_pk_bf16(x[8 * s], x[8 * s + 1]); p.y = epi::cvt_pk_bf16(x[8 * s + 2], x[8 * s + 3]); p.z = epi::cvt_pk_bf16(x[8 * s + 4], x[8 * s + 5]); p.w = epi::cvt_pk_bf16(x[8 * s + 6], x[8 * s + 7]);
    return __builtin_bit_cast(bf16x8, p);
}
__device__ __forceinline__ s16x4 tr_read(const LAS unsigned char* p) { return __builtin_bit_cast(s16x4, __builtin_amdgcn_ds_read_tr16_b64_v4i16((LAS v4i16_t*)p)); }
__device__ __forceinline__ int vimg_off(int key, int piece  ) { return key * 256 + (((piece >> 2) ^ (key & 3)) << 6) + ((piece & 3) << 4); }
__device__ __forceinline__ bf16x8 vt_frag(const LAS unsigned char* img, int key0, int d0, int lane) {
    const int h = lane >> 5, blk = (lane >> 4) & 1, q = (lane & 15) >> 2, pp = lane & 3;
    const int ka = key0 + 4 * h + q, kb = ka + 8;
    const int col = ((d0 ^ q) << 6) + (16 * blk + 4 * pp) * 2;
    const s16x4 lo = tr_read(img + ka * 256 + col), hi = tr_read(img + kb * 256 + col);
    return __builtin_shufflevector(lo, hi, 0, 1, 2, 3, 4, 5, 6, 7);
}
__device__ __forceinline__ int vt_lane_off(int lane, int d0) { const int h = lane >> 5, blk = (lane >> 4) & 1, q = (lane & 15) >> 2, pp = lane & 3; return (4 * h + q) * 256 + ((d0 ^ q) << 6) + (16 * blk + 4 * pp) * 2; }
template <int KEY0> __device__ __forceinline__ bf16x8 vt_frag_o(const LAS unsigned char* img, int voff) {
    const s16x4 lo = tr_read(img + voff + KEY0 * 256), hi = tr_read(img + voff + (KEY0 + 8) * 256);
    return __builtin_shufflevector(lo, hi, 0, 1, 2, 3, 4, 5, 6, 7);
}
__device__ __forceinline__ bf16x8 tr_frag(const LAS unsigned char* img, int ra, int rb, int cb, int lane) {
    const int blk = (lane >> 4) & 1, q = (lane & 15) >> 2, pp = lane & 3;
    const int col = ((cb ^ q) << 6) + (16 * blk + 4 * pp) * 2;
    const s16x4 lo = tr_read(img + (ra + q) * 256 + col), hi = tr_read(img + (rb + q) * 256 + col);
    return __builtin_shufflevector(lo, hi, 0, 1, 2, 3, 4, 5, 6, 7);
}
__device__ __forceinline__ void sgu_mix_mfma(ArgsP A, const Frame& F, int l, int lane) {
    unsigned char* ws = A->ws; const bf16* p = (const bf16*)(ws + WS_P); const bf16* vvn = (const bf16*)(ws + WS_VVN); bf16* z2 = (bf16*)(ws + WS_Z) + (size_t)2 * S * 512;
    const float* sw = A->in[I_SGUW] + (size_t)l * 4 * 128 * 128; const float* sb = A->in[I_SGUB] + (size_t)l * 4 * 128;
    LAS unsigned char* img = F.lds + RING_OFF;
    const int w = F.wave, tid = w * 64 + lane, ql = lane & 31, h = lane >> 5, tb = 32 * (w & 3), cb0 = 2 * (w >> 2);
    for (int unit = F.vcu; unit < 256; unit += F.G) {
        const int n = unit >> 2, g = unit & 3;
#pragma unroll
        for (int i = 0; i < 4; ++i) { const int idx = i * 512 + tid, s = idx >> 4, piece = idx & 15;
            *(LAS v4u*)(img + vimg_off(s, piece)) = *(const v4u*)(vvn + (size_t)(n * 128 + s) * 512 + g * 128 + piece * 8); }
        __syncthreads();
        f32x16 acc0, acc1;
#pragma unroll
        for (int e = 0; e < 16; ++e) { acc0[e] = 0.f; acc1[e] = 0.f; }
        const float* wrow = sw + ((size_t)g * 128 + tb + ql) * 128 + 8 * h;
#pragma unroll
        for (int ks = 0; ks < 8; ++ks) {
            const f32x4 a0 = *(const f32x4*)(wrow + 16 * ks), a1 = *(const f32x4*)(wrow + 16 * ks + 4);
            v4u ap; ap.x = epi::cvt_pk_bf16(a0.x, a0.y); ap.y = epi::cvt_pk_bf16(a0.z, a0.w); ap.z = epi::cvt_pk_bf16(a1.x, a1.y); ap.w = epi::cvt_pk_bf16(a1.z, a1.w);
            const bf16x8 af = __builtin_bit_cast(bf16x8, ap);
            acc0 = MFMA32(af, tr_frag(img, 16 * ks + 8 * h, 16 * ks + 8 * h + 4, cb0, lane), acc0);
            acc1 = MFMA32(af, tr_frag(img, 16 * ks + 8 * h, 16 * ks + 8 * h + 4, cb0 + 1, lane), acc1);
        }
#pragma unroll
        for (int e = 0; e < 16; ++e) { const int tl = tb + crow(e, h), t = n * 128 + tl; const float bias = sb[g * 128 + tl];
            const int c0 = g * 128 + 32 * cb0 + ql;
            const float u0 = bf2f(p[(size_t)t * NINP + PC_SGU + c0]), u1 = bf2f(p[(size_t)t * NINP + PC_SGU + c0 + 32]);
            z2[(size_t)t * 512 + c0] = (bf16)f2bf(u0 * (acc0[e] + bias)); z2[(size_t)t * 512 + c0 + 32] = (bf16)f2bf(u1 * (acc1[e] + bias)); }
        __syncthreads();
    }
}
__device__ __forceinline__ void dil_attention(ArgsP A, const Frame& F, int l, int gw, int lane) {
    unsigned char* ws = A->ws; const bf16* p = (const bf16*)(ws + WS_P);
    float* OP = (float*)(ws + WS_DILO); float* LP = (float*)(ws + WS_DILL);
    LAS unsigned char* img = F.lds + RING_OFF + (gw & 7) * 8192;
    const float* gq = A->in[I_DQN] + l * 128; const float* gk = A->in[I_DKN] + l * 128;
    const float cbound = 11.313708499f * wave_max(fmaxf(fabsf(gq[lane]), fabsf(gq[lane + 64]))) * wave_max(fmaxf(fabsf(gk[lane]), fabsf(gk[lane + 64])));
    const int ql = lane & 31, h = lane >> 5;
    const int nun = ((gw & 7) < 4) ? 2 : 1;
    for (int kk = 0; kk < ((F.G == 256) ? nun : 1 << 30); ++kk) {
        const int unit = (F.G == 256) ? (gw >> 3) * 12 + (gw & 7) + 8 * kk : gw + kk * F.NGW; if (unit >= 12 * 256) break;
        const int hq = unit >> 8, blk = unit & 255, g = hq >> 2, ih = hq & 3, dl = 1 << (2 * g), L = S >> (2 * g), nb = 256 >> (2 * g);
        const int r = blk / nb, b = blk % nb;
        const float slope = __builtin_amdgcn_exp2f(-8.0f * (float)(hq + 1) / 12.0f) * (float)dl;
        const int tq = r + dl * (32 * b + ql);
        bf16x8 qf[8];
        { const v4u* src = (const v4u*)(p + (size_t)tq * NINP + PC_DIL + hq * 128 + 8 * h);
#pragma unroll
          for (int s = 0; s < 8; ++s) qf[s] = __builtin_bit_cast(bf16x8, src[2 * s]); }
        f32x16 o[4]; float lsum = 0.f;
#pragma unroll
        for (int d0 = 0; d0 < 4; ++d0)
#pragma unroll
            for (int e = 0; e < 16; ++e) o[d0][e] = 0.f;
#pragma unroll 1
        for (int c = -2; c <= 2; ++c) {
            const int mb = 32 * (b + c);
            if (mb < 0 || mb >= L) continue;
            f32x16 sacc;
#pragma unroll
            for (int e = 0; e < 16; ++e) sacc[e] = 0.f;
            v4u vreg[8];
#pragma unroll
            for (int i = 0; i < 8; ++i) { const int idx = i * 64 + lane, key = idx >> 4, piece = idx & 15;
                vreg[i] = *(const v4u*)(p + (size_t)(r + dl * (mb + key)) * NINP + PC_DIL + 3072 + hq * 128 + piece * 8); }
            { const int tk = r + dl * (mb + ql);
              const v4u* src = (const v4u*)(p + (size_t)tk * NINP + PC_DIL + 1536 + hq * 128 + 8 * h);
              bf16x8 kf[8];
#pragma unroll
              for (int s = 0; s < 8; ++s) kf[s] = __builtin_bit_cast(bf16x8, src[2 * s]);
#pragma unroll
              for (int s = 0; s < 8; ++s) sacc = MFMA32(kf[s], qf[s], sacc); }
#pragma unroll
            for (int i = 0; i < 8; ++i) { const int idx = i * 64 + lane, key = idx >> 4, piece = idx & 15; *(LAS v4u*)(img + vimg_off(key, piece)) = vreg[i]; }
#pragma unroll
            for (int e = 0; e < 16; ++e) { const int rel = 32 * c + crow(e, h) - ql, arel = rel < 0 ? -rel : rel;
                const float sv = sacc[e] * 0.08838834764831845f - slope * (float)arel - cbound;
                const float pe = (arel <= 64) ? epi::fast_exp(sv) : 0.f; sacc[e] = pe; lsum += pe; }
            const bf16x8 pb0 = pack8(sacc, 0), pb1 = pack8(sacc, 1);
#pragma unroll
            for (int d0 = 0; d0 < 4; ++d0) { o[d0] = MFMA32(vt_frag(img, 0, d0, lane), pb0, o[d0]); o[d0] = MFMA32(vt_frag(img, 16, d0, lane), pb1, o[d0]); }
        }
        lsum += __shfl_xor(lsum, 32);
        float* orow = OP + ((size_t)g * S + tq) * 512 + ih * 128 + 4 * h;
#pragma unroll
        for (int d0 = 0; d0 < 4; ++d0)
#pragma unroll
            for (int k = 0; k < 4; ++k) { f32x4 v; v.x = o[d0][4 * k]; v.y = o[d0][4 * k + 1]; v.z = o[d0][4 * k + 2]; v.w = o[d0][4 * k + 3]; *(f32x4*)(orow + 32 * d0 + 8 * k) = v; }
        if (h == 0) LP[((size_t)g * S + tq) * 4 + ih] = lsum;
    }
}
__device__ __forceinline__ void phase_mix2(ArgsP A, const Frame& F, int l) {
    unsigned char* ws = A->ws; const int lane = opq_lane(); const int gw = opq_s(F.gw); const int gt = gw * 64 + lane;
    const bf16* p = (const bf16*)(ws + WS_P); const float* raw = (const float*)(ws + WS_MLARAW);
    const float* ct = (const float*)(ws + WS_COS); const float* st = (const float*)(ws + WS_SIN);
    const float* gqn = A->in[I_MQN] + l * 192; const float* gkn = A->in[I_MKN] + l * 192;
    const float QSCL = 0.07216878364870322f * 1.4426950408889634f;
    bf16* MQ = (bf16*)(ws + WS_MQ); bf16* MK = (bf16*)(ws + WS_MK); bf16* MV = (bf16*)(ws + WS_MV);
    const int w8 = gw & 7, tok0 = (gw >> 3) * 32 + (w8 < 4 ? 2 * w8 : 8 + 6 * (w8 - 4)), npair = (w8 < 4) ? 1 : 3;
    const float gq0 = gqn[lane], gq1 = gqn[lane + 64], gq2 = gqn[lane + 128], gk0 = gkn[lane], gk1 = gkn[lane + 64], gk2 = gkn[lane + 128];
    for (int jj = 0; jj < ((F.G == 256) ? npair : 1 << 30); ++jj) { const int tb = (F.G == 256) ? tok0 + 2 * jj : 2 * (gw + jj * F.NGW); if (tb >= S) break;
        float cs[2], sn[2], krv[2], q0[2][4], q1[2][4], q2[2][4], k0[2][4], k1[2][4], v0[2][4], v1[2][4], sq[2][4], sk[2][4];
#pragma unroll
        for (int u = 0; u < 2; ++u) { const int t = tb + u; cs[u] = ct[t * 32 + (lane & 31)]; sn[u] = st[t * 32 + (lane & 31)];
            const float* rr = raw + (size_t)t * NMLA; krv[u] = bf2f(p[(size_t)t * NINP + PC_KR + lane]);
#pragma unroll
            for (int h = 0; h < 4; ++h) { q0[u][h] = rr[h * 192 + lane]; q1[u][h] = rr[h * 192 + 64 + lane]; q2[u][h] = rr[h * 192 + 128 + lane];
                k0[u][h] = rr[768 + h * 256 + lane]; k1[u][h] = rr[768 + h * 256 + 64 + lane]; v0[u][h] = rr[768 + h * 256 + 128 + lane]; v1[u][h] = rr[768 + h * 256 + 192 + lane]; } }
#pragma unroll
        for (int u = 0; u < 2; ++u)
#pragma unroll
            for (int h = 0; h < 4; ++h) { sq[u][h] = q0[u][h] * q0[u][h] + q1[u][h] * q1[u][h] + q2[u][h] * q2[u][h]; sk[u][h] = k0[u][h] * k0[u][h] + k1[u][h] * k1[u][h] + krv[u] * krv[u]; }
#pragma unroll
        for (int o = 1; o < 64; o <<= 1) {
#pragma unroll
            for (int u = 0; u < 2; ++u)
#pragma unroll
                for (int h = 0; h < 4; ++h) { sq[u][h] += __shfl_xor(sq[u][h], o); sk[u][h] += __shfl_xor(sk[u][h], o); } }
#pragma unroll
        for (int u = 0; u < 2; ++u) { const int t = tb + u;
#pragma unroll
        for (int h = 0; h < 4; ++h) {
            const float rq = rsq(sq[u][h] * (1.f / 192) + EPS) * QSCL, rk = rsq(sk[u][h] * (1.f / 192) + EPS);
            const float a2 = q2[u][h] * rq * gq2, oa = __shfl_xor(a2, 32), a2r = (lane < 32) ? (a2 * cs[u] - oa * sn[u]) : (oa * sn[u] + a2 * cs[u]);
            const float b2 = krv[u] * rk * gk2, ob = __shfl_xor(b2, 32), b2r = (lane < 32) ? (b2 * cs[u] - ob * sn[u]) : (ob * sn[u] + b2 * cs[u]);
            bf16* qo = MQ + ((size_t)h * S + t) * 192; bf16* ko = MK + ((size_t)h * S + t) * 192; bf16* vo = MV + ((size_t)h * S + t) * 128;
            qo[lane] = (bf16)f2bf(q0[u][h] * rq * gq0); qo[lane + 64] = (bf16)f2bf(q1[u][h] * rq * gq1); qo[lane + 128] = (bf16)f2bf(a2r);
            ko[lane] = (bf16)f2bf(k0[u][h] * rk * gk0); ko[lane + 64] = (bf16)f2bf(k1[u][h] * rk * gk1); ko[lane + 128] = (bf16)f2bf(b2r);
            vo[lane] = (bf16)f2bf(v0[u][h]); vo[lane + 64] = (bf16)f2bf(v1[u][h]); } }
    }
    sgu_mix_mfma(A, F, l, lane);
    dil_attention(A, F, l, gw, lane);
}


constexpr int MLA_KROW = 400, MLA_KIMG = 64 * MLA_KROW, MLA_VIMG = 64 * 256;
constexpr int FL_V0 = 2 * MLA_KIMG, FL_P0 = FL_V0 + 2 * MLA_VIMG, FL_PBUF = 8 * 1024, FL_END = FL_P0 + 4 * 2 * FL_PBUF;
constexpr int FL_FLAG = FL_END;
static_assert(FL_FLAG + 64 <= LDSCTL_OFF, "flash LDS map");
#define FL_SB() __builtin_amdgcn_sched_barrier(0)
__device__ __forceinline__ void flash_scores(LAS unsigned char* lds, const bf16* MQ, const bf16* MK, const bf16* MV, float* LP, float c2, int vcu, int G, int w, int lane) {
    const int ql = lane & 31, hh = lane >> 5;
    LAS unsigned char* pw = lds + FL_P0 + w * 2 * FL_PBUF + lane * 16;
    volatile LAS unsigned* flag = (volatile LAS unsigned*)(lds + FL_FLAG + 16 * w); unsigned gen = 0u;
    for (int unit = vcu; unit < 256; unit += G) {
        const int kh = unit & 1, qb = (unit >> 1) & 31, h = unit >> 6;
        const bf16* Kg = MK + ((size_t)h * S + kh * 4096) * 192; const bf16* Vg = MV + ((size_t)h * S + kh * 4096) * 128;
        const int tq = qb * 256 + w * 64 + ql;
        bf16x8 qf0[12], qf1[12];
        { const v4u* src = (const v4u*)(MQ + ((size_t)h * S + tq) * 192 + 8 * hh);
#pragma unroll
          for (int s = 0; s < 12; ++s) { qf0[s] = __builtin_bit_cast(bf16x8, src[2 * s]); qf1[s] = __builtin_bit_cast(bf16x8, src[2 * s + 32 * 24]); } }
        float lsum0 = 0.f, lsum1 = 0.f;
        if (unit == vcu) *flag = 0u;
        __syncthreads();
#pragma unroll 1
        for (int jt = 0; jt < 64; ++jt) {
            const LAS unsigned char* kr0 = lds + (jt & 1) * MLA_KIMG + ql * MLA_KROW + 16 * hh;
            f32x16 s00, s01, s10, s11;
#pragma unroll
            for (int e = 0; e < 16; ++e) { s00[e] = -c2; s01[e] = -c2; s10[e] = -c2; s11[e] = -c2; }
#define KFRAG(f) (*(const LAS bf16x8*)(kr0 + ((f) >= 12 ? 32 * MLA_KROW : 0) + 32 * ((f) % 12)))
#define KLOAD(dst, f0) do { _Pragma("unroll") for (int i_ = 0; i_ < 4; ++i_) dst[i_] = KFRAG((f0) + i_); } while (0)
#define KMMA(src, f0) do { _Pragma("unroll") for (int i_ = 0; i_ < 4; ++i_) { if ((f0) + i_ < 12) { s00 = MFMA32(src[i_], qf0[((f0) + i_) % 12], s00); s10 = MFMA32(src[i_], qf1[((f0) + i_) % 12], s10); } \
                                                                               else { s01 = MFMA32(src[i_], qf0[((f0) + i_) % 12], s01); s11 = MFMA32(src[i_], qf1[((f0) + i_) % 12], s11); } } } while (0)
            bf16x8 kA[4], kB[4];
            KLOAD(kA, 0);
            KLOAD(kB, 4);  FL_SB(); KMMA(kA, 0);  FL_SB();
            KLOAD(kA, 8);  FL_SB(); KMMA(kB, 4);  FL_SB();
            KLOAD(kB, 12); FL_SB(); KMMA(kA, 8);  FL_SB();
            KLOAD(kA, 16); FL_SB(); KMMA(kB, 12); FL_SB();
            KLOAD(kB, 20); FL_SB(); KMMA(kA, 16); FL_SB();
            KMMA(kB, 20); FL_SB();
            *flag = ++gen; FL_SB();
#undef KFRAG
#undef KLOAD
#undef KMMA
            LAS unsigned char* pb = pw + (jt & 1) * FL_PBUF;
#define EXPW(sx, ls, f0) { _Pragma("unroll") for (int e = 0; e < 16; ++e) { const float p_ = __builtin_amdgcn_exp2f(sx[e]); sx[e] = p_; ls += p_; } \
                           *(LAS bf16x8*)(pb + (f0) * 1024) = pack8(sx, 0); *(LAS bf16x8*)(pb + ((f0) + 1) * 1024) = pack8(sx, 1); }
            EXPW(s00, lsum0, 0) EXPW(s01, lsum0, 2) EXPW(s10, lsum1, 4) EXPW(s11, lsum1, 6)
#undef EXPW
            __syncthreads();
        }
        lsum0 += __shfl_xor(lsum0, 32); lsum1 += __shfl_xor(lsum1, 32);
        if (hh == 0) { LP[((size_t)kh * 4 + h) * S + tq] = lsum0; LP[((size_t)kh * 4 + h) * S + tq + 32] = lsum1; }
    }
}
__device__ __forceinline__ void flash_pv(LAS unsigned char* lds, const bf16* MK, const bf16* MV, float* OP, int vcu, int G, int pw, int lane) {
    const int ql = lane & 31, hh = lane >> 5;
    int ksrc[7], vsrc[4];
#pragma unroll
    for (int i = 0; i < 7; ++i) { const int L = (pw + 4 * i) * 1024 + 16 * lane, row = L / MLA_KROW, within = L - row * MLA_KROW; ksrc[i] = (row < 64 ? row : 0) * 192 + (within < 384 ? within / 2 : 0); }
#pragma unroll
    for (int i = 0; i < 4; ++i) { const int L = (pw + 4 * i) * 1024 + 16 * lane, key = L >> 8, pos = (L & 255) >> 4; vsrc[i] = key * 128 + ((((pos >> 2) ^ (key & 3)) << 2) | (pos & 3)) * 8; }
#define FL_DMAK(jt_) { const bf16* kg_ = Kg + (size_t)(jt_) * 64 * 192; LAS unsigned char* kd_ = lds + ((jt_) & 1) * MLA_KIMG; \
        _Pragma("unroll") for (int i_ = 0; i_ < 6; ++i_) __builtin_amdgcn_global_load_lds((const unsigned*)(kg_ + ksrc[i_]), (LAS unsigned*)(kd_ + (pw + 4 * i_) * 1024), 16, 0, 0); \
        if (pw == 0) __builtin_amdgcn_global_load_lds((const unsigned*)(kg_ + ksrc[6]), (LAS unsigned*)(kd_ + 24 * 1024), 16, 0, 0); }
#define FL_DMAV(jt_) { const bf16* vg_ = Vg + (size_t)(jt_) * 64 * 128; LAS unsigned char* vd_ = lds + FL_V0 + ((jt_) & 1) * MLA_VIMG; \
        _Pragma("unroll") for (int i_ = 0; i_ < 4; ++i_) __builtin_amdgcn_global_load_lds((const unsigned*)(vg_ + vsrc[i_]), (LAS unsigned*)(vd_ + (pw + 4 * i_) * 1024), 16, 0, 0); }
    int voff[4];
#pragma unroll
    for (int d0 = 0; d0 < 4; ++d0) voff[d0] = vt_lane_off(lane, d0);
    const LAS unsigned char* pr = lds + FL_P0 + pw * 2 * FL_PBUF + lane * 16;
    volatile LAS unsigned* flag = (volatile LAS unsigned*)(lds + FL_FLAG + 16 * pw); unsigned gen = 0u;
    for (int unit = vcu; unit < 256; unit += G) {
        const int kh = unit & 1, qb = (unit >> 1) & 31, h = unit >> 6;
        const bf16* Kg = MK + ((size_t)h * S + kh * 4096) * 192; const bf16* Vg = MV + ((size_t)h * S + kh * 4096) * 128;
        const int tq = qb * 256 + pw * 64 + ql;
        f32x16 o0[4], o1[4];
#pragma unroll
        for (int d0 = 0; d0 < 4; ++d0)
#pragma unroll
            for (int e = 0; e < 16; ++e) { o0[d0][e] = 0.f; o1[d0][e] = 0.f; }
        FL_DMAK(0) VM_WAIT();
        __syncthreads();
#define PV_TILE(t_, WAITGEN) { const LAS unsigned char* pb = pr + ((t_) & 1) * FL_PBUF; const LAS unsigned char* vimg = lds + FL_V0 + ((t_) & 1) * MLA_VIMG; \
            bf16x8 pf[8]; _Pragma("unroll") for (int f = 0; f < 8; ++f) pf[f] = *(const LAS bf16x8*)(pb + f * 1024); \
            if (WAITGEN) { while (*flag < gen) __builtin_amdgcn_s_sleep(1); } \
            _Pragma("unroll") for (int dd = 0; dd < 4; ++dd) { bf16x8 vf[4]; \
                vf[0] = vt_frag_o<0>(vimg, voff[dd]); vf[1] = vt_frag_o<16>(vimg, voff[dd]); vf[2] = vt_frag_o<32>(vimg, voff[dd]); vf[3] = vt_frag_o<48>(vimg, voff[dd]); \
                _Pragma("unroll") for (int ks = 0; ks < 4; ++ks) { o0[dd] = MFMA32(vf[ks], pf[ks], o0[dd]); o1[dd] = MFMA32(vf[ks], pf[4 + ks], o1[dd]); } } }
#pragma unroll 1
        for (int jt = 0; jt < 64; ++jt) {
            if (jt + 1 < 64) FL_DMAK(jt + 1)
            FL_DMAV(jt)
            ++gen;
            if (jt > 0) PV_TILE(jt - 1, true)
            VM_WAIT();
            __syncthreads();
        }
        PV_TILE(63, false)
#undef PV_TILE
#pragma unroll
        for (int b = 0; b < 2; ++b) { float* orow = OP + (((size_t)kh * 4 + h) * S + tq + 32 * b) * 128 + 4 * hh;
#pragma unroll
            for (int d0 = 0; d0 < 4; ++d0)
#pragma unroll
                for (int k = 0; k < 4; ++k) { const f32x16& oo = b ? o1[d0] : o0[d0]; f32x4 v; v.x = oo[4 * k]; v.y = oo[4 * k + 1]; v.z = oo[4 * k + 2]; v.w = oo[4 * k + 3]; *(f32x4*)(orow + 32 * d0 + 8 * k) = v; } }
    }
}
__device__ __forceinline__ void phase_mla_flash(ArgsP A, const Frame& F, int l) {
    unsigned char* ws = A->ws; const int lane = opq_lane();
    const bf16* MQ = (const bf16*)(ws + WS_MQ); const bf16* MK = (const bf16*)(ws + WS_MK); const bf16* MV = (const bf16*)(ws + WS_MV);
    float* OP = (float*)(ws + WS_MOP); float* LP = (float*)(ws + WS_MLP);
    const float* gqn = A->in[I_MQN] + l * 192; const float* gkn = A->in[I_MKN] + l * 192;
    const float c2 = 19.990625f * wave_max(fmaxf(fmaxf(fabsf(gqn[lane]), fabsf(gqn[lane + 64])), fabsf(gqn[lane + 128]))) * wave_max(fmaxf(fmaxf(fabsf(gkn[lane]), fabsf(gkn[lane + 64])), fabsf(gkn[lane + 128])));
    if (F.wave < 4) flash_scores(F.lds, MQ, MK, MV, LP, c2, F.vcu, F.G, F.wave, lane);
    else flash_pv(F.lds, MK, MV, OP, F.vcu, F.G, F.wave - 4, lane);
    __syncthreads();
}
#undef FL_SB
#undef FL_DMAK
#undef FL_DMAV
__device__ __forceinline__ void dil_combine(ArgsP A, const Frame& F) {
    unsigned char* ws = A->ws; const int lane = opq_lane(); const int gw = opq_s(F.gw); const int gt = gw * 64 + lane;
    const float* OP = (const float*)(ws + WS_DILO); const float* LP = (const float*)(ws + WS_DILL); bf16* z1 = (bf16*)(ws + WS_Z) + (size_t)1 * S * 512;
    for (int idx = gt; idx < S * 512; idx += F.NGT) { const int t = idx >> 9, c = idx & 511, ih = c >> 7;
        const float num = OP[idx] + OP[(size_t)S * 512 + idx] + OP[(size_t)2 * S * 512 + idx];
        const float den = LP[(size_t)t * 4 + ih] + LP[((size_t)S + t) * 4 + ih] + LP[((size_t)2 * S + t) * 4 + ih];
        z1[idx] = (bf16)f2bf(num / den); }
}
__device__ __forceinline__ void phase_mix3(ArgsP A, const Frame& F) {
    unsigned char* ws = A->ws; const int lane = opq_lane(); const int gw = opq_s(F.gw); const int gt = gw * 64 + lane;
    { const float* MO = (const float*)(ws + WS_MOP); const float* ML = (const float*)(ws + WS_MLP); bf16* z3 = (bf16*)(ws + WS_Z) + (size_t)3 * S * 512;
      for (int idx = gt; idx < S * 512; idx += F.NGT) { const int t = idx >> 9, c = idx & 511, h = c >> 7, d = c & 127;
          const size_t r0 = (size_t)h * S + t, r1 = ((size_t)4 + h) * S + t;
          z3[idx] = (bf16)f2bf((MO[r0 * 128 + d] + MO[r1 * 128 + d]) / (ML[r0] + ML[r1])); } }
}

__global__ void __launch_bounds__(NWAVES * 64, 2) mk_fwd(Args args_unused) {
    extern __shared__ __attribute__((aligned(16))) unsigned char lds[];
    Frame F;
    F.lds = (LAS unsigned char*)lds;
    F.MISC = (volatile LAS unsigned*)(F.lds + MISC_OFF);
    F.wave = __builtin_amdgcn_readfirstlane((int)(threadIdx.x >> 6));
    F.G = gridDim.x; { const int bx = blockIdx.x; F.vcu = (F.G % 8 == 0) ? (bx % 8) * (F.G / 8) + bx / 8 : bx; }
    F.gw = F.vcu * NWAVES + F.wave; F.NGW = F.G * NWAVES; F.NGT = F.NGW * 64;
    for (int u = threadIdx.x; u < (LDS_BYTES - LDSCTL_OFF) / 4; u += NWAVES * 64) ((LAS unsigned*)(F.lds + LDSCTL_OFF))[u] = 0u;
    __syncthreads();
    int l_lo, l_hi; bool multi; XcdBarrier bar;
    { ArgsP A = fresh_args(); l_lo = A->l_lo; l_hi = A->l_hi;
      multi = !((l_hi - l_lo) == 1 && (A->ph_hi - A->ph_lo) == 1);
      unsigned* bw = (unsigned*)((gu32*)(A->ws + WS_CTL) + CW_BAR);
      bar.bar = bw; bar.x = 0; bar.st = F.MISC + 8;
      if (multi) bar = xcd_barrier_post(bw, F.MISC + 8); }
#define SEAM() do { if (multi) xcd_barrier(bar); } while (0)
#ifdef ONLY_PHASE
#define IN(k) ((k) == ONLY_PHASE && lo <= (k) && (k) < hi)
#else
#define IN(k) (lo <= (k) && (k) < hi)
#endif
#ifndef G_ALIGN
#define G_ALIGN true
#endif
#ifndef G_SP2
#define G_SP2 true
#endif
#define GEMM(EPI, ORDER) pg8::gemm_phase<EPI, ORDER, G_ALIGN, G_SP2>(Fl.lds + RING_OFF, g, So, E, Fl.wave)
    { ArgsP A = fresh_args(); if (A->l_lo == 0 && A->ph_lo == 0) phase_rope_tables(A, F); }
    for (int l = l_lo; l < l_hi; ++l) {
        int lo, hi; { ArgsP A = fresh_args(); lo = A->ph_lo; hi = A->ph_hi; }
        if (IN(0)) { ArgsP A = fresh_args(); const Frame Fl = fresh_frame(F); unsigned char* ws = A->ws;
            phase_convert(A, Fl, l, Fl.gw, Fl.NGW, 0, CPARTS);
            if (l == 0) phase_prep(Fl, A->in[I_X], (bf16*)(ws + WS_XN), (float*)(ws + WS_SSP));
            SEAM(); }
        if (IN(1)) { ArgsP A = fresh_args(); const Frame Fl = fresh_frame(F); const int bx = opq_s((int)blockIdx.x); unsigned char* ws = A->ws;
            pg8::Gemm g{(const bf16*)(ws + WS_XN), (const bf16*)(ws + (size_t)(l & 1) * WS_SETD + WS_WGU1), S, NGU, D};
            pg8::StaticOrder So; So.init(S, NGU, Fl.G, bx); epi::fill_rstd_table(So, (const float*)(ws + WS_SSP), (LAS float*)(Fl.lds + RSTD_OFF), Fl.wave); __syncthreads();
            epi::EpiSwiglu E{(bf16*)(ws + WS_HID), (const LAS float*)(Fl.lds + RSTD_OFF)}; GEMM(epi::EpiSwiglu, pg8::StaticOrder); tail_convert(A, Fl, l, bx, (S / 256) * (NGU / 256), 0, 128); SEAM(); }
        if (IN(2)) { ArgsP A = fresh_args(); const Frame Fl = fresh_frame(F); const int bx = opq_s((int)blockIdx.x); unsigned char* ws = A->ws; const float* xin = (l == 0) ? A->in[I_X] : (const float*)(ws + WS_X);
            pg8::Gemm g{(const bf16*)(ws + WS_HID), (const bf16*)(ws + (size_t)(l & 1) * WS_SETD + WS_WD1), S, D, FF}; pg8::StaticOrder So; So.init(S, D, Fl.G, bx);
            epi::EpiResid E{xin, (float*)(ws + WS_X), 0.5f, (bf16*)(ws + WS_XN), (float*)(ws + WS_SSP)}; GEMM(epi::EpiResid, pg8::StaticOrder); SEAM(); }
        if (IN(3)) { ArgsP A = fresh_args(); const Frame Fl = fresh_frame(F); const int bx = opq_s((int)blockIdx.x); unsigned char* ws = A->ws;
            pg8::Gemm g{(const bf16*)(ws + WS_XN), (const bf16*)(ws + (size_t)(l & 1) * WS_SETD + WS_WIN), S, NINP, D};
            pg8::StaticOrder So; So.init(S, NINP, Fl.G, bx); epi::fill_rstd_table(So, (const float*)(ws + WS_SSP), (LAS float*)(Fl.lds + RSTD_OFF), Fl.wave); __syncthreads();
            epi::EpiPin E{(bf16*)(ws + WS_P), (const LAS float*)(Fl.lds + RSTD_OFF)}; GEMM(epi::EpiPin, pg8::StaticOrder); tail_convert(A, Fl, l, bx, (S / 256) * (NINP / 256), 128, 288); SEAM(); }
        if (IN(4)) { ArgsP A = fresh_args(); const Frame Fl = fresh_frame(F); phase_mix1(A, Fl, l); SEAM(); }
        if (IN(5)) { ArgsP A = fresh_args(); const Frame Fl = fresh_frame(F); const int bx = opq_s((int)blockIdx.x); unsigned char* ws = A->ws;
            pg8::Gemm g{(const bf16*)(ws + WS_MLAA), (const bf16*)(ws + (size_t)(l & 1) * WS_SETD + WS_WMLA), S, NMLA, opq_s(512)}; pg8::StaticOrder So; So.init(S, NMLA, Fl.G, bx);
            epi::EpiF32 E{(float*)(ws + WS_MLARAW), NMLA, 1}; GEMM(epi::EpiF32, pg8::StaticOrder); SEAM(); }
        if (IN(6)) { ArgsP A = fresh_args(); const Frame Fl = fresh_frame(F); phase_mix2(A, Fl, l); SEAM(); }
        if (IN(7)) { ArgsP A = fresh_args(); const Frame Fl = fresh_frame(F); phase_mla_flash(A, Fl, l); dil_combine(A, Fl); SEAM(); }
        if (IN(8)) { ArgsP A = fresh_args(); const Frame Fl = fresh_frame(F); phase_mix3(A, Fl); SEAM(); }
        if (IN(9)) { ArgsP A = fresh_args(); const Frame Fl = fresh_frame(F); const int bx = opq_s((int)blockIdx.x); unsigned char* ws = A->ws;
            pg8::Gemm g{(const bf16*)(ws + WS_Z), (const bf16*)(ws + (size_t)(l & 1) * WS_SETD + WS_WBR), 4 * S, 4 * D, opq_s(512)}; epi::BranchOrder So; So.so.init(S, D, Fl.G, bx);
            epi::EpiBranchChain E{(bf16*)(ws + WS_MERGEDB), (const bf16*)(ws + WS_P) + PC_GATE}; GEMM(epi::EpiBranchChain, epi::BranchOrder); SEAM(); }
        if (IN(10)) { ArgsP A = fresh_args(); const Frame Fl = fresh_frame(F); const int bx = opq_s((int)blockIdx.x); unsigned char* ws = A->ws;
            pg8::Gemm g{(const bf16*)(ws + WS_MERGEDB), (const bf16*)(ws + (size_t)(l & 1) * WS_SETD + WS_WOUT), S, D, D}; pg8::StaticOrder So; So.init(S, D, Fl.G, bx);
            epi::EpiResid E{(const float*)(ws + WS_X), (float*)(ws + WS_X), 1.0f, (bf16*)(ws + WS_XN), (float*)(ws + WS_SSP)}; GEMM(epi::EpiResid, pg8::StaticOrder); SEAM(); }
        if (IN(11)) { ArgsP A = fresh_args(); const Frame Fl = fresh_frame(F); const int bx = opq_s((int)blockIdx.x); unsigned char* ws = A->ws;
            pg8::Gemm g{(const bf16*)(ws + WS_XN), (const bf16*)(ws + (size_t)(l & 1) * WS_SETD + WS_WGU2), S, NGU, D};
            pg8::StaticOrder So; So.init(S, NGU, Fl.G, bx); epi::fill_rstd_table(So, (const float*)(ws + WS_SSP), (LAS float*)(Fl.lds + RSTD_OFF), Fl.wave); __syncthreads();
            epi::EpiSwiglu E{(bf16*)(ws + WS_HID), (const LAS float*)(Fl.lds + RSTD_OFF)}; GEMM(epi::EpiSwiglu, pg8::StaticOrder); tail_convert(A, Fl, l, bx, (S / 256) * (NGU / 256), 288, CPARTS); SEAM(); }
        if (IN(12)) { ArgsP A = fresh_args(); const Frame Fl = fresh_frame(F); const int bx = opq_s((int)blockIdx.x); unsigned char* ws = A->ws; const bool lastl = (l == NLAYER - 1);
            pg8::Gemm g{(const bf16*)(ws + WS_HID), (const bf16*)(ws + (size_t)(l & 1) * WS_SETD + WS_WD2), S, D, FF}; pg8::StaticOrder So; So.init(S, D, Fl.G, bx);
            epi::EpiResid E{(const float*)(ws + WS_X), lastl ? A->out : (float*)(ws + WS_X), 0.5f, lastl ? (bf16*)nullptr : (bf16*)(ws + WS_XN), (float*)(ws + WS_SSP)}; GEMM(epi::EpiResid, pg8::StaticOrder);
            SEAM(); }
    }
#undef IN
#undef SEAM
#undef GEMM
}


#ifdef DBG_DUMP_OFF
__global__ void dbg_dump(const unsigned char* ws, float* out, int n) {
    for (int i = blockIdx.x * blockDim.x + threadIdx.x; i < n; i += gridDim.x * blockDim.x) {
        if (i >= DBG_DUMP_N) { out[i] = 0.f; continue; }
#if DBG_DUMP_BF16
        out[i] = __uint_as_float(((unsigned)((const unsigned short*)(ws + DBG_DUMP_OFF))[i]) << 16);
#else
        out[i] = ((const float*)(ws + DBG_DUMP_OFF))[i];
#endif
    }
}
#endif
#ifndef MK_ONE_LAUNCH
#define MK_ONE_LAUNCH 0
#endif
extern "C" void kernel_launch(void* const* d_in, const int* in_sizes, int n_in, void* d_out, int out_size, void* d_ws, size_t ws_size, hipStream_t stream) {
    static int grid = 0;
    if (grid == 0) {
        if (n_in != N_INPUTS || out_size != S * D || ws_size < WS_END) { fprintf(stderr, "kernel_launch: unexpected shapes (n_in %d out %d ws %zu)\n", n_in, out_size, ws_size); grid = -1; return; }
        int dev = 0, cus = 0, per_cu = 0;
        if (hipGetDevice(&dev) != hipSuccess || hipDeviceGetAttribute(&cus, hipDeviceAttributeMultiprocessorCount, dev) != hipSuccess) { grid = -1; return; }
        if (hipFuncSetAttribute((const void*)mk_fwd, hipFuncAttributeMaxDynamicSharedMemorySize, LDS_BYTES) != hipSuccess) { fprintf(stderr, "kernel_launch: hipFuncSetAttribute failed\n"); grid = -1; return; }
        if (hipOccupancyMaxActiveBlocksPerMultiprocessor(&per_cu, (const void*)mk_fwd, NWAVES * 64, LDS_BYTES) != hipSuccess || per_cu < 1) fprintf(stderr, "kernel_launch: occupancy query reports %d\n", per_cu);
        (void)hipGetLastError();
        grid = cus;
    }
    if (grid < 0) return;
    if (hipMemsetAsync((char*)d_ws + WS_CTL, 0, CTL_ZERO_BYTES, stream) != hipSuccess) return;
    Args a{};
    for (int i = 0; i < N_INPUTS; ++i) a.in[i] = (const float*)d_in[i];
    a.out = (float*)d_out; a.ws = (unsigned char*)d_ws;
#if MK_ONE_LAUNCH
    a.l_lo = 0; a.l_hi = NLAYER; a.ph_lo = 0; a.ph_hi = NPHASE;
    hipLaunchKernelGGL(mk_fwd, dim3(grid), dim3(NWAVES * 64), LDS_BYTES, stream, a);
#else
    for (int l = 0; l < NLAYER; ++l)
        for (int ph = 0; ph < NPHASE; ++ph) {
#ifdef DBG_DUMP_OFF
            if (l * NPHASE + ph > DBG_LAST) continue;
#endif
            a.l_lo = l; a.l_hi = l + 1; a.ph_lo = ph; a.ph_hi = ph + 1;
            hipLaunchKernelGGL(mk_fwd, dim3(grid), dim3(NWAVES * 64), LDS_BYTES, stream, a);
#ifdef DUP_MASK
            if ((DUP_MASK >> ph) & 1) hipLaunchKernelGGL(mk_fwd, dim3(grid), dim3(NWAVES * 64), LDS_BYTES, stream, a);
#endif
            }
#ifdef DBG_DUMP_OFF
    hipLaunchKernelGGL(dbg_dump, dim3(2048), dim3(256), 0, stream, (const unsigned char*)d_ws, (float*)d_out, S * D);
#endif
#endif
}
```

```cpp
#define MK_ONE_LAUNCH 1
#include <hip/hip_runtime.h>
#include <cstdio>
#include <cstdint>
namespace pg8 {
#define PG8_LAS __attribute__((address_space(3)))
typedef unsigned short bf16_t;
typedef short bf16x8 __attribute__((ext_vector_type(8)));
typedef float f32x4 __attribute__((ext_vector_type(4)));
typedef unsigned u32x4 __attribute__((ext_vector_type(4)));
constexpr int BM = 256, BK = 64, HALF = 128, HTB = HALF * BK * 2  , STAGE_BYTES = 8 * HTB, NXCD = 8, WGM = 4;

__host__ __device__ __forceinline__ int lds_byte(int r, int c) { const int st = (r >> 4) * 2 + (c >> 5), rr = r & 15, cc = c & 31, ob = rr * 64 + cc * 2; return st * 1024 + (ob ^ (((ob >> 9) & 1) << 5)); }
__host__ __device__ __forceinline__ void stage_rc(int b, int& R, int& C) { const int st = b / 1024, sb = b % 1024, swz = sb ^ (((sb >> 9) & 1) << 5); R = (st >> 1) * 16 + swz / 64; C = (st & 1) * 32 + (swz % 64) / 2; }
__host__ __device__ __forceinline__ int perm32(int rho) { const int n = rho >> 4, i = rho & 15; return 8 * (i >> 2) + 4 * n + (i & 3); }

struct Unit { int pm, pn; };
struct Gemm { const bf16_t* A; const bf16_t* Bt; int M, N, K; };

struct StaticOrder {
    int nM, nN, nwg, G, c;
    __host__ __device__ void init(int M, int N, int G_, int c_) { nM = M / BM; nN = N / BM; nwg = nM * nN; G = G_; c = c_; }
    __host__ __device__ bool next(int i, Unit& u) const {
        const long L = (long)i * G + c; if (L >= nwg) return false;
        int wgid = (int)L; { const int q = nwg / NXCD, r = nwg % NXCD, xcd = wgid % NXCD, off = wgid / NXCD; wgid = (xcd < r ? xcd * (q + 1) : r * (q + 1) + (xcd - r) * q) + off; }
        const int nig = WGM * nN, gid = wgid / nig, fm = gid * WGM, gsz = (nM - fm) < WGM ? (nM - fm) : WGM;
        u.pm = fm + ((wgid % nig) % gsz); u.pn = (wgid % nig) / gsz; return true;
    }
    __device__ __forceinline__ void a_ready(const Unit&, int  ) const {}
    __device__ __forceinline__ void done(const Unit&) const {}
};
__device__ __forceinline__ unsigned cvt_pk_bf16(float lo, float hi) { unsigned r; asm volatile("v_cvt_pk_bf16_f32 %0, %1, %2" : "=v"(r) : "v"(lo), "v"(hi)); return r; }
typedef float f32x2 __attribute__((ext_vector_type(2)));
__device__ __forceinline__ f32x2 gelu_pk(f32x2 v) {
    const f32x2 av = __builtin_elementwise_abs(v), d = av * 0.2316418882f + 1.0f;
    f32x2 t; t.x = __builtin_amdgcn_rcpf(d.x); t.y = __builtin_amdgcn_rcpf(d.y);
    f32x2 q = t * 0.5307027145f + (-0.7265760135f); q = q * t + 0.7107068705f; q = q * t + (-0.142248368f); q = q * t + 0.127414796f; q = q * t;
    const f32x2 s = (v * v) * (-0.72134752044f);
    f32x2 e; e.x = __builtin_amdgcn_exp2f(s.x); e.y = __builtin_amdgcn_exp2f(s.y);
    const f32x2 m = v * (q * e), r = v - m;
    f32x2 o; o.x = v.x < 0.f ? m.x : r.x; o.y = v.y < 0.f ? m.y : r.y; return o;
}
template <class Epi, class Sched, bool ALIGN_EPI = false, bool SP2 = false>
__device__ __forceinline__ void gemm_phase(PG8_LAS unsigned char* lds, const Gemm g, const Sched& S, const Epi& E, int wave_in  ) {
    int tid_ = wave_in * 64 + (int)__builtin_amdgcn_mbcnt_hi(~0u, __builtin_amdgcn_mbcnt_lo(~0u, 0u)); asm volatile("" : "+v"(tid_));
    const int tid = tid_, wid = __builtin_amdgcn_readfirstlane(tid >> 6), lane = tid & 63, wr = wid >> 2, wc = wid & 3, fr = lane & 15, fq = lane >> 4;
    const int K = g.K, nt = K / BK;
    unsigned voffA[2], voffB[2];
#pragma unroll
    for (int i = 0; i < 2; ++i) { int R, C; stage_rc(tid * 16 + i * 8192, R, C); const int Rb = Epi::PERM ? ((R & ~31) + perm32(R & 31)) : R;
        voffA[i] = (unsigned)(R * K + C) * 2u; voffB[i] = (unsigned)(Rb * K + C) * 2u; }
    const size_t kstep = (size_t)(BK * 2);
    const size_t hstep = (size_t)HALF * K * 2;
    const size_t tstep = 2 * hstep;
    const unsigned ldsw = (unsigned)wid * 1024u;
    const int aoff = lds_byte(wr * 64 + fr, fq * 8), boff = lds_byte(wc * 32 + fr, fq * 8);
#define PG8_SA(b, h) (((b) * 2 + (h)) * HTB)
#define PG8_SB(b, h) ((4 + (b) * 2 + (h)) * HTB)
#define PG8_STAGE(bufoff, gbase, voff) do { _Pragma("unroll") for (int _i = 0; _i < 2; ++_i) \
        __builtin_amdgcn_global_load_lds((const unsigned*)((const char*)(gbase) + (voff)[_i]), (PG8_LAS unsigned*)(lds + (bufoff) + ldsw + _i * 8192), 16, 0, 0); } while (0)
#define PG8_LDA(dst, b, h) do { _Pragma("unroll") for (int m = 0; m < 4; ++m) _Pragma("unroll") for (int k = 0; k < 2; ++k) dst[m][k] = *(const PG8_LAS bf16x8*)(lds + PG8_SA(b, h) + aoff + m * 2048 + k * 1024); } while (0)
#define PG8_LDB(dst, b, h) do { _Pragma("unroll") for (int n = 0; n < 2; ++n) _Pragma("unroll") for (int k = 0; k < 2; ++k) dst[n][k] = *(const PG8_LAS bf16x8*)(lds + PG8_SB(b, h) + boff + n * 2048 + k * 1024); } while (0)
#define PG8_MMA(ai, bj, At, Bt) do { __builtin_amdgcn_s_setprio(1); _Pragma("unroll") for (int m = 0; m < 4; ++m) _Pragma("unroll") for (int n = 0; n < 2; ++n) _Pragma("unroll") for (int k = 0; k < 2; ++k) \
        acc[ai][bj][m][n] = __builtin_amdgcn_mfma_f32_16x16x32_bf16(Bt[n][k], At[m][k], acc[ai][bj][m][n], 0, 0, 0); __builtin_amdgcn_s_setprio(0); } while (0)
#define PG8_WAIT_V(n) asm volatile("s_waitcnt vmcnt(" #n ")" ::: "memory")
#define PG8_WAIT_L(n) asm volatile("s_waitcnt lgkmcnt(" #n ")" ::: "memory")
#define PG8_BAR __builtin_amdgcn_s_barrier()
#define PG8_SCHED __builtin_amdgcn_sched_barrier(0)
    Unit cur, nxt; int ui = 0;
    if (!S.next(0, cur)) return;
    f32x4 acc[2][2][4][2];
#pragma unroll
    for (int a = 0; a < 2; ++a)
#pragma unroll
        for (int b = 0; b < 2; ++b)
#pragma unroll
            for (int m = 0; m < 4; ++m)
#pragma unroll
                for (int n = 0; n < 2; ++n) acc[a][b][m][n] = (f32x4){0.f, 0.f, 0.f, 0.f};
    bf16x8 At[4][2], B0[2][2], B1[2][2];
    const char* cA = (const char*)g.A + (size_t)cur.pm * tstep; const char* cB = (const char*)g.Bt + (size_t)cur.pn * tstep;
    S.a_ready(cur, 0);
    if constexpr (SP2) {
        PG8_STAGE(PG8_SB(0, 0), cB, voffB); PG8_STAGE(PG8_SB(0, 1), cB + hstep, voffB); PG8_STAGE(PG8_SA(0, 0), cA, voffA); PG8_STAGE(PG8_SA(0, 1), cA + hstep, voffA);
        if (wr == 1) PG8_BAR;
        PG8_WAIT_V(2); PG8_BAR;
        PG8_STAGE(PG8_SB(1, 0), cB + kstep, voffB); PG8_STAGE(PG8_SA(1, 0), cA + kstep, voffA); PG8_STAGE(PG8_SB(1, 1), cB + hstep + kstep, voffB);
        PG8_WAIT_V(6); PG8_BAR;
    } else {
        PG8_STAGE(PG8_SB(0, 0), cB, voffB); PG8_STAGE(PG8_SA(0, 0), cA, voffA); PG8_STAGE(PG8_SB(0, 1), cB + hstep, voffB); PG8_STAGE(PG8_SA(0, 1), cA + hstep, voffA);
        if (wr == 1) PG8_BAR;
        PG8_WAIT_V(4); PG8_BAR;
        PG8_STAGE(PG8_SB(1, 0), cB + kstep, voffB); PG8_STAGE(PG8_SA(1, 0), cA + kstep, voffA); PG8_STAGE(PG8_SB(1, 1), cB + hstep + kstep, voffB);
        PG8_WAIT_V(6); PG8_BAR;
    }
    for (;;) {
        const bool has_next = S.next(ui + 1, nxt);
        const char* nA = has_next ? (const char*)g.A + (size_t)nxt.pm * tstep : cA; const char* nB = has_next ? (const char*)g.Bt + (size_t)nxt.pn * tstep : cB;
        for (int t = 0; t < nt; t += 2) {
            const bool last = (t == nt - 2);
            const char* a1 = cA + (size_t)(t + 1) * kstep;
            const char* a2 = last ? nA : cA + (size_t)(t + 2) * kstep; const char* b2 = last ? nB : cB + (size_t)(t + 2) * kstep;
            const char* a3 = a2 + kstep; const char* b3 = b2 + kstep;
            if (last && has_next) S.a_ready(nxt, ui + 1);
            if constexpr (SP2) {
            PG8_LDB(B0, 0, 0); PG8_LDB(B1, 0, 1); PG8_SCHED; PG8_LDA(At, 0, 0); PG8_STAGE(PG8_SA(1, 1), a1 + hstep, voffA);
            PG8_WAIT_V(8); PG8_WAIT_L(0); PG8_BAR; PG8_MMA(0, 0, At, B0); PG8_MMA(0, 1, At, B1); PG8_BAR; PG8_SCHED;
            PG8_LDA(At, 0, 1); PG8_STAGE(PG8_SB(0, 0), b2, voffB); PG8_STAGE(PG8_SB(0, 1), b2 + hstep, voffB); PG8_STAGE(PG8_SA(0, 0), a2, voffA);
            PG8_WAIT_V(8); PG8_WAIT_L(0); PG8_BAR; PG8_MMA(1, 0, At, B0); PG8_MMA(1, 1, At, B1); PG8_BAR; PG8_SCHED;
            PG8_LDB(B0, 1, 0); PG8_LDB(B1, 1, 1); PG8_SCHED; PG8_LDA(At, 1, 0); PG8_STAGE(PG8_SA(0, 1), a2 + hstep, voffA);
            PG8_WAIT_V(8); PG8_WAIT_L(0); PG8_BAR; PG8_MMA(0, 0, At, B0); PG8_MMA(0, 1, At, B1); PG8_BAR; PG8_SCHED;
            PG8_LDA(At, 1, 1); PG8_STAGE(PG8_SB(1, 0), b3, voffB); PG8_STAGE(PG8_SB(1, 1), b3 + hstep, voffB); PG8_STAGE(PG8_SA(1, 0), a3, voffA);
            PG8_WAIT_V(8); PG8_WAIT_L(0); PG8_BAR; PG8_MMA(1, 0, At, B0); PG8_MMA(1, 1, At, B1); PG8_BAR; PG8_SCHED;
            } else {
            PG8_LDB(B0, 0, 0); PG8_SCHED; PG8_LDA(At, 0, 0); PG8_STAGE(PG8_SA(1, 1), a1 + hstep, voffA);
            PG8_WAIT_L(8); PG8_BAR; PG8_WAIT_L(0); PG8_MMA(0, 0, At, B0); PG8_BAR; PG8_SCHED;
            PG8_LDB(B1, 0, 1); PG8_STAGE(PG8_SB(0, 0), b2, voffB);
            PG8_BAR; PG8_WAIT_L(0); PG8_MMA(0, 1, At, B1); PG8_BAR;
            PG8_LDA(At, 0, 1); PG8_STAGE(PG8_SA(0, 0), a2, voffA);
            PG8_BAR; PG8_WAIT_L(0); PG8_MMA(1, 0, At, B0); PG8_BAR; PG8_SCHED;
            PG8_STAGE(PG8_SB(0, 1), b2 + hstep, voffB);
            PG8_WAIT_V(6); PG8_BAR; PG8_MMA(1, 1, At, B1); PG8_BAR;
            PG8_LDB(B0, 1, 0); PG8_SCHED; PG8_LDA(At, 1, 0); PG8_STAGE(PG8_SA(0, 1), a2 + hstep, voffA);
            PG8_WAIT_L(8); PG8_BAR; PG8_WAIT_L(0); PG8_MMA(0, 0, At, B0); PG8_BAR; PG8_SCHED;
            PG8_LDB(B1, 1, 1); PG8_STAGE(PG8_SB(1, 0), b3, voffB);
            PG8_BAR; PG8_WAIT_L(0); PG8_MMA(0, 1, At, B1); PG8_BAR;
            PG8_LDA(At, 1, 1); PG8_STAGE(PG8_SA(1, 0), a3, voffA);
            PG8_BAR; PG8_WAIT_L(0); PG8_MMA(1, 0, At, B0); PG8_BAR; PG8_SCHED;
            PG8_STAGE(PG8_SB(1, 1), b3 + hstep, voffB);
            PG8_WAIT_V(6); PG8_BAR; PG8_MMA(1, 1, At, B1); PG8_BAR;
            }
        }
        if constexpr (ALIGN_EPI) { if (wr == 0) PG8_BAR; }
        if constexpr (!Epi::AFTER_DRAIN) { E(acc, cur, wr, wc, fr, fq, ui); S.done(cur); }
        if (!has_next) break;
        if constexpr (!Epi::KEEP_ACC) {
#pragma unroll
        for (int a = 0; a < 2; ++a)
#pragma unroll
            for (int b = 0; b < 2; ++b)
#pragma unroll
                for (int m = 0; m < 4; ++m)
#pragma unroll
                    for (int n = 0; n < 2; ++n) acc[a][b][m][n] = (f32x4){0.f, 0.f, 0.f, 0.f};
        }
        cur = nxt; cA = nA; cB = nB; ++ui;
        if constexpr (ALIGN_EPI) { if (wr == 1) PG8_BAR; }
    }
    PG8_WAIT_V(0);
    if constexpr (!ALIGN_EPI) { if (wr == 0) PG8_BAR; }
    PG8_BAR;
    if constexpr (Epi::AFTER_DRAIN) { E.fused(acc, cur, wr, wc, fr, fq, lds, wid, lane); S.done(cur); }
#undef PG8_SA
#undef PG8_SB
#undef PG8_STAGE
#undef PG8_LDA
#undef PG8_LDB
#undef PG8_MMA
#undef PG8_WAIT_V
#undef PG8_WAIT_L
#undef PG8_BAR
#undef PG8_SCHED
}
}
#define GAS __attribute__((address_space(1)))
#define LAS __attribute__((address_space(3)))
typedef unsigned short bf16;
typedef unsigned v4u __attribute__((ext_vector_type(4)));
typedef float f32x4 __attribute__((ext_vector_type(4)));
typedef short bf16x8 __attribute__((ext_vector_type(8)));
typedef GAS unsigned gu32;
typedef GAS unsigned long long gu64;
#define RLX_AGENT __ATOMIC_RELAXED, __HIP_MEMORY_SCOPE_AGENT
#define LDS_WAIT() asm volatile("s_waitcnt lgkmcnt(0)" ::: "memory")
#define VM_WAIT() asm volatile("s_waitcnt vmcnt(0)" ::: "memory")
__device__ __forceinline__ unsigned long long rt() { return __builtin_amdgcn_s_memrealtime(); }
__device__ __forceinline__ unsigned f2bf(float f) { unsigned u = __builtin_bit_cast(unsigned, f); return (u + 0x7fffu + ((u >> 16) & 1u)) >> 16; }
__device__ __forceinline__ unsigned pk2(float lo, float hi) { return f2bf(lo) | (f2bf(hi) << 16); }
#define XB_TMO      128
#define XB_XCNT(j)  (256  + 64 * (j))
#define XB_XSUB(j)  (1280 + 64 * (j))
#define XB_XGEN(j)  (2304 + 64 * (j))
#define XB_TOP      3328
#define XB_TOPGEN   3392
#define XCD_BAR_WORDS 3456
#define XB_SPIN_CAP (1u << 18)

__device__ __forceinline__ unsigned xb_ld(unsigned* p)              { return __hip_atomic_load(p, __ATOMIC_RELAXED, __HIP_MEMORY_SCOPE_AGENT); }
__device__ __forceinline__ unsigned xb_add(unsigned* p, unsigned v) { return __hip_atomic_fetch_add(p, v, __ATOMIC_RELAXED, __HIP_MEMORY_SCOPE_AGENT); }
__device__ __forceinline__ unsigned xb_xcc_id() { return (unsigned)__builtin_amdgcn_s_getreg((3 << 11) | 20) & 0xFu; }
#define XB_SPIN(cond, bar) do { unsigned _sp = 0; while (cond) { __builtin_amdgcn_s_sleep(1); \
    if ((++_sp & 255u) == 0u) { if (xb_ld(&(bar)[XB_TMO])) break; if (_sp > XB_SPIN_CAP) { atomicAdd(&(bar)[XB_TMO], 1u); break; } } } } while (0)

struct XcdBarrier {
    unsigned* bar; unsigned x;
    volatile LAS unsigned* st;
};

__device__ __forceinline__ XcdBarrier xcd_barrier_post(unsigned* bar, volatile LAS unsigned* st) {
    XcdBarrier b; b.bar = bar; b.x = xb_xcc_id(); b.st = st;
    if (threadIdx.x == 0) (void)xb_add(&bar[XB_XCNT(b.x)], 1u);
    return b;
}
__device__ __forceinline__ void xcd_barrier_complete(unsigned* bar, unsigned x, unsigned& nloc, unsigned& nx) {
    const unsigned G = gridDim.x * gridDim.y * gridDim.z;
    unsigned sum, cnt, mine, sp = 0u;
    for (;;) {
        sum = 0u; cnt = 0u; mine = 0u;
#pragma unroll
        for (unsigned j = 0; j < 16; ++j) { const unsigned c = xb_ld(&bar[XB_XCNT(j)]); sum += c; cnt += (c > 0u) ? 1u : 0u; mine = (j == x) ? c : mine; }
        if (sum == G) break;
        __builtin_amdgcn_s_sleep(1);
        if ((++sp & 255u) == 0u) { if (xb_ld(&bar[XB_TMO])) break; if (sp > XB_SPIN_CAP) { atomicAdd(&bar[XB_TMO], 1u); break; } }
    }
    nloc = mine > 0u ? mine : 1u; nx = cnt > 0u ? cnt : 1u;
}

__device__ __forceinline__ void xcd_barrier(const XcdBarrier& b) {
    asm volatile("s_waitcnt vmcnt(0)" ::: "memory");
    __syncthreads();
    if (threadIdx.x == 0) {
        unsigned* bar = b.bar;
        __builtin_amdgcn_s_waitcnt(0);
        unsigned nloc = b.st[0], nx = b.st[1];
        if (nloc == 0u) { xcd_barrier_complete(bar, b.x, nloc, nx); b.st[0] = nloc; b.st[1] = nx; }
        const unsigned old = xb_add(&bar[XB_XSUB(b.x)], 1u);
        const unsigned gen = old / nloc;
        if (old + 1u == (gen + 1u) * nloc) {
            __builtin_amdgcn_fence(__ATOMIC_RELEASE, "agent");
            asm volatile("s_waitcnt vmcnt(0)" ::: "memory");
            const unsigned og = xb_add(&bar[XB_TOP], 1u);
            const unsigned tg = og / nx;
            if (og + 1u == (tg + 1u) * nx) xb_add(&bar[XB_TOPGEN], 1u);
            else XB_SPIN(xb_ld(&bar[XB_TOPGEN]) == tg, bar);
            __builtin_amdgcn_fence(__ATOMIC_ACQUIRE, "agent");
            xb_add(&bar[XB_XGEN(b.x)], 1u);
            asm volatile("s_waitcnt vmcnt(0)" ::: "memory");
        } else {
            XB_SPIN(xb_ld(&bar[XB_XGEN(b.x)]) == gen, bar);
            __builtin_amdgcn_fence(__ATOMIC_ACQUIRE, "agent");
            asm volatile("s_waitcnt vmcnt(0)" ::: "memory");
        }
    }
    __syncthreads();
}
constexpr int S = 8192, D = 2048, FF = 5632, NLAYER = 4;
constexpr int NIN = 14912, NINP = 15104;
constexpr int NGU = 2 * FF;
constexpr float EPS = 1e-6f;
constexpr int PC_GATE = 0, PC_POOL = 8192, PC_DIL = 8704, PC_SGU = 13312, PC_CQ = 14336, PC_CKV = 14720, PC_KR = 14848;
constexpr int NMLA = 1792;

namespace epi {
using pg8::f32x4; using pg8::u32x4; using pg8::Unit; using pg8::bf16_t;
typedef float f32x2_t __attribute__((ext_vector_type(2))); typedef __bf16 bf16x2_t __attribute__((ext_vector_type(2)));
__device__ __forceinline__ unsigned cvt_pk_bf16(float lo, float hi) { f32x2_t v = {lo, hi}; bf16x2_t b = __builtin_convertvector(v, bf16x2_t); return __builtin_bit_cast(unsigned, b); }
constexpr int BM = 256, HALF = 128;
typedef unsigned u32x2 __attribute__((ext_vector_type(2)));
__device__ __forceinline__ float fast_exp(float x) { return __builtin_amdgcn_exp2f(x * 1.44269504089f); }
__device__ __forceinline__ float sigmoid_f(float x) { return __builtin_amdgcn_rcpf(1.0f + fast_exp(-x)); }

struct EpiSwiglu {
    static constexpr bool PERM = true, AFTER_DRAIN = false, KEEP_ACC = false;
    bf16_t* H; const __attribute__((address_space(3))) float* tab;
    __device__ __forceinline__ void operator()(const f32x4 (&acc)[2][2][4][2], const Unit& u, int wr, int wc, int fr, int fq, int ui) const {
        const int row0 = u.pm * BM + wr * 64 + fr, col0 = u.pn * HALF + wc * 32 + 8 * fq; const __attribute__((address_space(3))) float* tb = tab + ui * 256 + wr * 64 + fr;
#pragma unroll
        for (int ai = 0; ai < 2; ++ai)
#pragma unroll
            for (int m = 0; m < 4; ++m) {
                bf16_t* rowp = H + (size_t)(row0 + ai * HALF + m * 16) * FF + col0; const float rs = tb[ai * HALF + m * 16];
                float o[8];
#pragma unroll
                for (int n = 0; n < 2; ++n)
#pragma unroll
                    for (int j = 0; j < 4; ++j) { const float g = acc[ai][0][m][n][j] * rs, up = acc[ai][1][m][n][j] * rs; o[n * 4 + j] = g * sigmoid_f(g) * up; }
                u32x4 w; w.x = cvt_pk_bf16(o[0], o[1]); w.y = cvt_pk_bf16(o[2], o[3]); w.z = cvt_pk_bf16(o[4], o[5]); w.w = cvt_pk_bf16(o[6], o[7]);
                *(u32x4*)rowp = w;
                asm volatile("" ::: "memory");
            }
    }
};
struct EpiResid {
    static constexpr bool PERM = false, AFTER_DRAIN = false, KEEP_ACC = false;
    const float* base; float* out; float alpha; bf16_t* xb; float* ssp;
    __device__ __forceinline__ void operator()(const f32x4 (&acc)[2][2][4][2], const Unit& u, int wr, int wc, int fr, int fq, int ui) const {
        const int row0 = u.pm * BM + wr * 64 + fr, col0 = u.pn * BM + wc * 32 + 4 * fq;
        f32x4 bb[3][4];
#define ER_LOAD(buf, g) { const size_t off_ = (size_t)(row0 + ((g) >> 2) * HALF + ((g) & 3) * 16) * D + col0; _Pragma("unroll") for (int q_ = 0; q_ < 4; ++q_) bb[buf][q_] = *(const f32x4*)(base + off_ + (q_ >> 1) * HALF + (q_ & 1) * 16); }
        ER_LOAD(0, 0) ER_LOAD(1, 1)
#pragma unroll
        for (int g = 0; g < 8; ++g) { const int ai = g >> 2, m = g & 3;
            if (g + 2 < 8) ER_LOAD((g + 2) % 3, g + 2)
            const int r = row0 + ai * HALF + m * 16; const size_t off = (size_t)r * D + col0; float s = 0.f;
#pragma unroll
            for (int q = 0; q < 4; ++q) { const int bj = q >> 1, n = q & 1; const f32x4 v = bb[g % 3][q] + acc[ai][bj][m][n] * alpha;
                *(f32x4*)(out + off + bj * HALF + n * 16) = v;
                if (xb) { s += (v[0] * v[0] + v[1] * v[1]) + (v[2] * v[2] + v[3] * v[3]); u32x2 w; w.x = cvt_pk_bf16(v[0], v[1]); w.y = cvt_pk_bf16(v[2], v[3]); *(u32x2*)(xb + off + bj * HALF + n * 16) = w; } }
            if (xb) { s += __shfl_xor(s, 16); s += __shfl_xor(s, 32); if (fq == 0) ssp[(size_t)r * 32 + u.pn * 4 + wc] = s; }
            asm volatile("" ::: "memory"); }
#undef ER_LOAD
    }
};
struct EpiPin {
    static constexpr bool PERM = true, AFTER_DRAIN = false, KEEP_ACC = false;
    bf16_t* P; const __attribute__((address_space(3))) float* tab;
    template <int KIND> __device__ __forceinline__ void run(const f32x4 (&acc)[2][2][4][2], const Unit& u, int wr, int wc, int fr, int fq, int ui) const {
        const __attribute__((address_space(3))) float* tb = tab + ui * 256 + wr * 64 + fr;
        const int row0 = u.pm * BM + wr * 64 + fr, col0 = u.pn * BM + wc * 32 + 8 * fq;
#pragma unroll
        for (int ai = 0; ai < 2; ++ai)
#pragma unroll
            for (int m = 0; m < 4; ++m) { bf16_t* rowp = P + (size_t)(row0 + ai * HALF + m * 16) * NINP + col0; const float rs = tb[ai * HALF + m * 16];
#pragma unroll
                for (int bj = 0; bj < 2; ++bj) { float o[8];
#pragma unroll
                    for (int n = 0; n < 2; ++n)
#pragma unroll
                        for (int j = 0; j < 4; ++j) { const float x = acc[ai][bj][m][n][j] * rs;
                            o[n * 4 + j] = (KIND == 0) ? x : ((KIND == 1) ? sigmoid_f(x) : x * sigmoid_f(1.5957691216f * (x + 0.044715f * x * x * x))); }
                    u32x4 w; w.x = cvt_pk_bf16(o[0], o[1]); w.y = cvt_pk_bf16(o[2], o[3]); w.z = cvt_pk_bf16(o[4], o[5]); w.w = cvt_pk_bf16(o[6], o[7]);
                    *(u32x4*)(rowp + bj * HALF) = w; }
                asm volatile("" ::: "memory"); }
    }
    __device__ __forceinline__ void operator()(const f32x4 (&acc)[2][2][4][2], const Unit& u, int wr, int wc, int fr, int fq, int ui) const {
        if (u.pn < 32) run<1>(acc, u, wr, wc, fr, fq, ui); else if (u.pn >= 52 && u.pn < 56) run<2>(acc, u, wr, wc, fr, fq, ui); else run<0>(acc, u, wr, wc, fr, fq, ui);
    }
};
struct EpiF32 {
    static constexpr bool PERM = false, AFTER_DRAIN = false, KEEP_ACC = false;
    float* C; int ldc; int colmul;
    __device__ __forceinline__ void operator()(const f32x4 (&acc)[2][2][4][2], const Unit& u, int wr, int wc, int fr, int fq, int ui) const {
        const int row0 = u.pm * BM + wr * 64 + fr, col0 = colmul * u.pn * BM + wc * 32 + 4 * fq;
#pragma unroll
        for (int ai = 0; ai < 2; ++ai)
#pragma unroll
            for (int m = 0; m < 4; ++m) { float* rowp = C + (size_t)(row0 + ai * HALF + m * 16) * ldc + col0;
#pragma unroll
                for (int bj = 0; bj < 2; ++bj)
#pragma unroll
                    for (int n = 0; n < 2; ++n) *(f32x4*)(rowp + bj * HALF + n * 16) = acc[ai][bj][m][n]; }
    }
};
struct EpiExp {
    static constexpr bool PERM = true, AFTER_DRAIN = false, KEEP_ACC = false;
    bf16_t* P;
    __device__ __forceinline__ void operator()(const f32x4 (&acc)[2][2][4][2], const Unit& u, int wr, int wc, int fr, int fq, int ui) const {
        const int row0 = u.pm * BM + wr * 64 + fr, col0 = (u.pn & 31) * BM + wc * 32 + 8 * fq;
#pragma unroll
        for (int ai = 0; ai < 2; ++ai)
#pragma unroll
            for (int m = 0; m < 4; ++m) { bf16_t* rowp = P + (size_t)(row0 + ai * HALF + m * 16) * S + col0;
#pragma unroll
                for (int bj = 0; bj < 2; ++bj) { float o[8];
#pragma unroll
                    for (int n = 0; n < 2; ++n)
#pragma unroll
                        for (int j = 0; j < 4; ++j) o[n * 4 + j] =
#ifdef DBG_NOEXP
                            acc[ai][bj][m][n][j];
#else
                            fast_exp(acc[ai][bj][m][n][j]);
#endif
                    u32x4 w; w.x = cvt_pk_bf16(o[0], o[1]); w.y = cvt_pk_bf16(o[2], o[3]); w.z = cvt_pk_bf16(o[4], o[5]); w.w = cvt_pk_bf16(o[6], o[7]);
                    *(u32x4*)(rowp + bj * HALF) = w; }
                asm volatile("" ::: "memory"); }
    }
};
struct EpiBranch {
    static constexpr bool PERM = false, AFTER_DRAIN = false, KEEP_ACC = false;
    float* merged; bf16_t* mergedb; const bf16_t* gate; int b;
    __device__ __forceinline__ void operator()(const f32x4 (&acc)[2][2][4][2], const Unit& u, int wr, int wc, int fr, int fq, int ui) const {
        const int row0 = u.pm * BM + wr * 64 + fr, col0 = u.pn * BM + wc * 32 + 4 * fq;
#pragma unroll
        for (int ai = 0; ai < 2; ++ai)
#pragma unroll
            for (int m = 0; m < 4; ++m) { const int r = row0 + ai * HALF + m * 16;
#pragma unroll
                for (int bj = 0; bj < 2; ++bj)
#pragma unroll
                    for (int n = 0; n < 2; ++n) { const int c = col0 + bj * HALF + n * 16;
                        const u32x2 gv = *(const u32x2*)(gate + (size_t)r * NINP + c);
                        f32x4 g; g[0] = __uint_as_float(gv.x << 16); g[1] = __uint_as_float(gv.x & 0xffff0000u); g[2] = __uint_as_float(gv.y << 16); g[3] = __uint_as_float(gv.y & 0xffff0000u);
                        f32x4 v = acc[ai][bj][m][n] * g;
                        float* mp = merged + (size_t)r * D + c;
                        if (b != 0) v += *(const f32x4*)mp;
                        if (b != 3) *(f32x4*)mp = v;
                        else { u32x2 w; w.x = cvt_pk_bf16(v[0], v[1]); w.y = cvt_pk_bf16(v[2], v[3]); *(u32x2*)(mergedb + (size_t)r * D + c) = w; } }
                asm volatile("" ::: "memory"); }
    }
};
struct QKOrder {
    int G, c;
    __device__ bool next(int i, Unit& u) const { const int L = i * G + c; if (L >= 4096) return false; const int h = L >> 10, rem = L & 1023; u.pm = h * 32 + (rem >> 5); u.pn = h * 32 + (rem & 31); return true; }
    __device__ __forceinline__ void a_ready(const Unit&, int) const {}
    __device__ __forceinline__ void done(const Unit&) const {}
};
struct PVOrder {
    int G, c;
    __device__ bool next(int i, Unit& u) const { const int L = i * G + c; if (L >= 128) return false; u.pm = L; u.pn = L >> 5; return true; }
    __device__ __forceinline__ void a_ready(const Unit&, int) const {}
    __device__ __forceinline__ void done(const Unit&) const {}
};
struct EpiBranchChain {
    static constexpr bool PERM = true, AFTER_DRAIN = false, KEEP_ACC = true;
    bf16_t* mergedb; const bf16_t* gate;
    __device__ __forceinline__ void operator()(f32x4 (&acc)[2][2][4][2], const Unit& u, int wr, int wc, int fr, int fq, int ui) const {
        const int b = u.pm >> 5, pm0 = u.pm & 31, pn0 = u.pn & 7;
        const int row0 = pm0 * BM + wr * 64 + fr, col0 = pn0 * BM + wc * 32 + 8 * fq;
        u32x4 gg[3][2][2];
#define BC_LOAD(buf, g) { const bf16_t* gp_ = gate + (size_t)(row0 + ((g) >> 2) * HALF + ((g) & 3) * 16) * NINP + b * D + col0; _Pragma("unroll") for (int bj_ = 0; bj_ < 2; ++bj_) { \
            gg[buf][bj_][0] = *(const u32x4*)(gp_ + bj_ * HALF); if (b != 3) gg[buf][bj_][1] = *(const u32x4*)(gp_ + bj_ * HALF + D); } }
        BC_LOAD(0, 0) BC_LOAD(1, 1)
#pragma unroll
        for (int gi = 0; gi < 8; ++gi) { const int ai = gi >> 2, m = gi & 3; const int r = row0 + ai * HALF + m * 16;
            if (gi + 2 < 8) BC_LOAD((gi + 2) % 3, gi + 2)
#pragma unroll
            for (int bj = 0; bj < 2; ++bj) { const int c = col0 + bj * HALF;
                const u32x4 gv = gg[gi % 3][bj][0];
                float g[8] = {__uint_as_float(gv.x << 16), __uint_as_float(gv.x & 0xffff0000u), __uint_as_float(gv.y << 16), __uint_as_float(gv.y & 0xffff0000u),
                              __uint_as_float(gv.z << 16), __uint_as_float(gv.z & 0xffff0000u), __uint_as_float(gv.w << 16), __uint_as_float(gv.w & 0xffff0000u)};
                if (b != 3) {
                    const u32x4 hv = gg[gi % 3][bj][1];
                    const float gn[8] = {__uint_as_float(hv.x << 16), __uint_as_float(hv.x & 0xffff0000u), __uint_as_float(hv.y << 16), __uint_as_float(hv.y & 0xffff0000u),
                                         __uint_as_float(hv.z << 16), __uint_as_float(hv.z & 0xffff0000u), __uint_as_float(hv.w << 16), __uint_as_float(hv.w & 0xffff0000u)};
#pragma unroll
                    for (int n = 0; n < 2; ++n)
#pragma unroll
                        for (int j = 0; j < 4; ++j) acc[ai][bj][m][n][j] *= fmaxf(g[n * 4 + j], 1e-30f) * __builtin_amdgcn_rcpf(fmaxf(gn[n * 4 + j], 1e-30f));
                } else {
                    float o[8];
#pragma unroll
                    for (int n = 0; n < 2; ++n)
#pragma unroll
                        for (int j = 0; j < 4; ++j) o[n * 4 + j] = acc[ai][bj][m][n][j] * fmaxf(g[n * 4 + j], 1e-30f);
                    u32x4 w; w.x = cvt_pk_bf16(o[0], o[1]); w.y = cvt_pk_bf16(o[2], o[3]); w.z = cvt_pk_bf16(o[4], o[5]); w.w = cvt_pk_bf16(o[6], o[7]);
                    *(u32x4*)(mergedb + (size_t)r * D + c) = w;
                } }
            asm volatile("" ::: "memory"); }
#undef BC_LOAD
    }
};
template <class Sched> __device__ __forceinline__ void fill_rstd_table(const Sched& So, const float* ssp, __attribute__((address_space(3))) float* tab, int wave) {
    int t_ = wave * 64 + (int)__builtin_amdgcn_mbcnt_hi(~0u, __builtin_amdgcn_mbcnt_lo(~0u, 0u)); asm volatile("" : "+v"(t_));
    const int t = t_, row = t >> 1, half = t & 1;
#pragma unroll 1
    for (int ui = 0; ui < 8; ++ui) { Unit u; if (!So.next(ui, u)) break;
        const f32x4* p = (const f32x4*)(ssp + (size_t)(u.pm * BM + row) * 32 + half * 16); const f32x4 a = p[0], b = p[1], c = p[2], d = p[3];
        float s = (((a[0] + a[1]) + (a[2] + a[3])) + ((b[0] + b[1]) + (b[2] + b[3]))) + (((c[0] + c[1]) + (c[2] + c[3])) + ((d[0] + d[1]) + (d[2] + d[3])));
        s += __shfl_xor(s, 1);
        if (half == 0) tab[ui * 256 + row] = 1.0f / sqrtf(s * (1.0f / D) + EPS); }
}
struct BranchOrder {
    pg8::StaticOrder so;
    __device__ bool next(int i, Unit& u) const { if (i >= 4) return false; Unit t; if (!so.next(0, t)) return false; u.pm = i * 32 + t.pm; u.pn = i * 8 + t.pn; return true; }
    __device__ __forceinline__ void a_ready(const Unit&, int) const {}
    __device__ __forceinline__ void done(const Unit&) const {}
};
}
constexpr size_t MiB = 1u << 20;
constexpr size_t WS_CTL = 0, CTL_ZERO_BYTES = 1 * MiB;
constexpr size_t WS_COS = 1 * MiB, WS_SIN = 2 * MiB, WS_SSP = 3 * MiB;
constexpr size_t WS_WGU1 = 4 * MiB, WS_WD1 = 48 * MiB, WS_WGU2 = 70 * MiB, WS_WD2 = 114 * MiB;
constexpr size_t WS_WIN = 136 * MiB, WS_WBR = 195 * MiB, WS_WOUT = 203 * MiB, WS_WMLA = 211 * MiB;
constexpr size_t WS_X = 214 * MiB;
constexpr size_t WS_XN = 278 * MiB;
constexpr size_t WS_HID = 310 * MiB;
constexpr size_t WS_P = 398 * MiB;
constexpr size_t WS_Z = 634 * MiB;
constexpr size_t WS_VVN = 666 * MiB, WS_MLAA = 674 * MiB;
constexpr size_t WS_MLARAW = 682 * MiB;
constexpr size_t WS_QP = 1426 * MiB, WS_KP = 1458 * MiB, WS_VT = 770 * MiB;
constexpr int QKP = 256;
constexpr size_t WS_ORAW = 786 * MiB;
constexpr size_t WS_MERGED = 818 * MiB, WS_MERGEDB = 882 * MiB;
constexpr size_t WS_PEXP = 914 * MiB;
constexpr size_t WS_DILO = 1490 * MiB, WS_DILL = 1540 * MiB;
constexpr size_t WS_MQ = WS_QP, WS_MK = WS_KP, WS_MV = WS_VT, WS_MOP = WS_PEXP, WS_MLP = WS_ORAW;
constexpr size_t WS_END = 1541 * MiB;
static_assert(WS_WGU1 + (size_t)NGU * D * 2 <= WS_WD1 && WS_WD1 + (size_t)D * FF * 2 <= WS_WGU2 && WS_WGU2 + (size_t)NGU * D * 2 <= WS_WD2 && WS_WD2 + (size_t)D * FF * 2 <= WS_WIN, "ws map 1");
static_assert(WS_WIN + (size_t)NINP * D * 2 <= WS_WBR && WS_WBR + (size_t)4 * D * 512 * 2 <= WS_WOUT && WS_WOUT + (size_t)D * D * 2 <= WS_WMLA && WS_WMLA + (size_t)NMLA * 512 * 2 <= WS_X, "ws map 2");
static_assert(WS_X + (size_t)S * D * 4 <= WS_XN && WS_XN + (size_t)S * D * 2 <= WS_HID && WS_HID + (size_t)S * FF * 2 <= WS_P && WS_P + (size_t)S * NINP * 2 <= WS_Z, "ws map 3");
static_assert(WS_Z + (size_t)4 * S * 512 * 2 <= WS_VVN && WS_MLARAW + (size_t)S * NMLA * 4 <= WS_VT && WS_KP + (size_t)4 * S * QKP * 2 <= WS_END && WS_ORAW + (size_t)4 * S * 256 * 4 <= WS_MERGED && WS_MERGED + (size_t)S * D * 4 <= WS_MERGEDB && WS_MERGEDB + (size_t)S * D * 2 <= WS_PEXP && WS_PEXP + (size_t)4 * S * S * 2 <= WS_QP, "ws map 4");
constexpr size_t WS_SETD = 956 * MiB;
static_assert(WS_WGU1 + WS_SETD >= WS_PEXP + (size_t)2 * 4 * S * 128 * 4 && WS_X + WS_SETD <= WS_QP, "second weight set");
#ifndef TAILCONV
#define TAILCONV 0
#endif
constexpr int CPARTS = 416;
constexpr int CW_BAR = 4096;

constexpr int NWAVES = 8;
constexpr int RING_OFF = 0, RING_BYTES = 131072;
constexpr int LDS_BYTES = 163840;
constexpr int LDSCTL_OFF = LDS_BYTES - 1024, MISC_OFF = LDSCTL_OFF + 320;
constexpr int RSTD_OFF = RING_BYTES + 1024;

enum { I_X = 0, I_F1N, I_F1G, I_F1U, I_F1D, I_MIXN, I_WIN, I_POOLW, I_POOLS, I_DQN, I_DKN, I_SGUN, I_SGUW, I_SGUB, I_MQAN, I_MWUQ, I_MKVAN, I_MWUKV, I_MQN, I_MKN, I_WBR, I_WOUT, I_F2N, I_F2G, I_F2U, I_F2D, N_INPUTS };

struct Frame {
    LAS unsigned char* lds;
    volatile LAS unsigned* MISC;
    int wave, vcu, G;
    int gw, NGW, NGT;
};
constexpr int NPHASE = 13;
struct Args { const float* in[N_INPUTS]; float* out; unsigned char* ws; int l_lo, l_hi, ph_lo, ph_hi; };
typedef const __attribute__((address_space(4))) Args* ArgsP;
__device__ __forceinline__ ArgsP fresh_args() { ArgsP p = (ArgsP)__builtin_amdgcn_kernarg_segment_ptr(); asm volatile("" : "+s"(p)); return p; }
__device__ __forceinline__ int opq_s(int x) { asm volatile("" : "+s"(x)); return x; }
__device__ __forceinline__ Frame fresh_frame(const Frame& F) { Frame R = F; R.wave = opq_s(F.wave); R.vcu = opq_s(F.vcu); R.G = opq_s(F.G); R.gw = opq_s(F.gw); R.NGW = opq_s(F.NGW); R.NGT = opq_s(F.NGT); return R; }
__device__ __forceinline__ int opq_lane() { int l = (int)__builtin_amdgcn_mbcnt_hi(~0u, __builtin_amdgcn_mbcnt_lo(~0u, 0u)); asm volatile("" : "+v"(l)); return l; }
__device__ __forceinline__ float wave_sum(float v) {
#pragma unroll
    for (int o = 1; o < 64; o <<= 1) v += __shfl_xor(v, o);
    return v;
}
__device__ __forceinline__ float wave_max(float v) {
#pragma unroll
    for (int o = 1; o < 64; o <<= 1) v = fmaxf(v, __shfl_xor(v, o));
    return v;
}
__device__ __forceinline__ float bf2f(unsigned short b) { return __uint_as_float(((unsigned)b) << 16); }
__device__ __forceinline__ float bflo(unsigned u) { return __uint_as_float(u << 16); }
__device__ __forceinline__ float bfhi(unsigned u) { return __uint_as_float(u & 0xffff0000u); }
__device__ __forceinline__ float rsq(float x) { return 1.0f / sqrtf(x); }

__device__ __forceinline__ void transpose_load(f32x4 (&v)[8], const float* W, int ldw, int k0, int n0, int lane) {
    const int pc = lane & 7, kr = lane >> 3;
#pragma unroll
    for (int i = 0; i < 8; ++i) v[i] = __builtin_nontemporal_load((const GAS f32x4*)(W + (size_t)(k0 + 8 * i + kr) * ldw + n0 + 4 * pc));
}
__device__ __forceinline__ void transpose_store(const f32x4 (&v)[8], int k0, bf16* WT, int ldt, int drow0, int dk0, LAS float* scr, int lane, const float* kgain) {
    const int pc = lane & 7, kr = lane >> 3;
#pragma unroll
    for (int i = 0; i < 8; ++i) { LAS float* d = scr + (8 * i + kr) * 33 + 4 * pc; const float gk = kgain ? kgain[k0 + 8 * i + kr] : 1.0f;
        d[0] = v[i].x * gk; d[1] = v[i].y * gk; d[2] = v[i].z * gk; d[3] = v[i].w * gk; }
    LDS_WAIT(); asm volatile("" ::: "memory");
    const int c = lane & 7;
#pragma unroll
    for (int j = 0; j < 4; ++j) { const int n = (lane >> 3) + 8 * j; const LAS float* s = scr + (8 * c) * 33 + n;
        v4u o; o.x = pk2(s[0 * 33], s[1 * 33]); o.y = pk2(s[2 * 33], s[3 * 33]); o.z = pk2(s[4 * 33], s[5 * 33]); o.w = pk2(s[6 * 33], s[7 * 33]);
        *(GAS v4u*)(WT + (size_t)(drow0 + n) * ldt + dk0 + k0 + 8 * c) = o; }
    LDS_WAIT(); asm volatile("" ::: "memory");
}
template <int MAP> __device__ __forceinline__ int map_row(int n0, int roff) {
    if (MAP == 0) return n0 + roff;
    if (MAP == 1) return (n0 >> 7) * 256 + roff + (n0 & 127);
    return (n0 < 6720) ? (n0 + 8192) : (n0 - 6720);
}
template <int MAP> __device__ __forceinline__ void transpose_matrix(const Frame& F, int vgw, int vNGW, int p0, int p1, int lane, const float* W, int K, int N, bf16* WT, int ldt, int roff, int dk0, const float* kgain = nullptr) {
    LAS float* scr = (LAS float*)(F.lds + RING_OFF + (vgw & 7) * 16384);
    const int nblk = N / 32, items = (K / 64) * nblk, lo = (int)((long)items * p0 / CPARTS), hi = (int)((long)items * p1 / CPARTS);
    int it = lo + vgw; if (it >= hi) return;
    f32x4 va[8], vb[8]; transpose_load(va, W, N, 64 * (it / nblk), 32 * (it % nblk), lane);
    for (;;) {
        const int itn = it + vNGW; const bool more = itn < hi;
        if (more) transpose_load(vb, W, N, 64 * (itn / nblk), 32 * (itn % nblk), lane);
        transpose_store(va, 64 * (it / nblk), WT, ldt, map_row<MAP>(32 * (it % nblk), roff), dk0, scr, lane, kgain);
        if (!more) break;
#pragma unroll
        for (int i = 0; i < 8; ++i) va[i] = vb[i];
        it = itn;
    }
}

__device__ __forceinline__ void phase_convert(ArgsP A, const Frame& F, int l, int vgw, int vNGW, int p0, int p1) {
    unsigned char* ws = A->ws + (size_t)(l & 1) * WS_SETD; const int lane = opq_lane(); const int vgt = vgw * 64 + lane, vNGT = vNGW * 64;
#define TM(MAP, ...) transpose_matrix<MAP>(F, vgw, vNGW, p0, p1, lane, __VA_ARGS__)
#define PART(n, lo, hi) const int lo = (int)((long)(n) * p0 / CPARTS), hi = (int)((long)(n) * p1 / CPARTS)
    TM(0, A->in[I_F2D] + (size_t)l * FF * D, FF, D, (bf16*)(ws + WS_WD2), FF, 0, 0);
    TM(1, A->in[I_F2G] + (size_t)l * D * FF, D, FF, (bf16*)(ws + WS_WGU2), D, 0, 0, A->in[I_F2N] + (size_t)l * D);
    TM(1, A->in[I_F2U] + (size_t)l * D * FF, D, FF, (bf16*)(ws + WS_WGU2), D, 128, 0, A->in[I_F2N] + (size_t)l * D);
    TM(0, A->in[I_WOUT] + (size_t)l * D * D, D, D, (bf16*)(ws + WS_WOUT), D, 0, 0);
    for (int b = 1; b < 4; ++b) TM(0, A->in[I_WBR] + ((size_t)l * 4 + b) * 512 * D, 512, D, (bf16*)(ws + WS_WBR) + (size_t)b * D * 512, 512, 0, 0);
    TM(0, A->in[I_MWUQ] + (size_t)l * 384 * 768, 384, 768, (bf16*)(ws + WS_WMLA), 512, 0, 0);
    TM(0, A->in[I_MWUKV] + (size_t)l * 128 * 1024, 128, 1024, (bf16*)(ws + WS_WMLA), 512, 768, 384);
    TM(2, A->in[I_WIN] + (size_t)l * D * NIN, D, NIN, (bf16*)(ws + WS_WIN), D, 0, 0, A->in[I_MIXN] + (size_t)l * D);
    TM(0, A->in[I_F1D] + (size_t)l * FF * D, FF, D, (bf16*)(ws + WS_WD1), FF, 0, 0);
    TM(1, A->in[I_F1G] + (size_t)l * D * FF, D, FF, (bf16*)(ws + WS_WGU1), D, 0, 0, A->in[I_F1N] + (size_t)l * D);
    TM(1, A->in[I_F1U] + (size_t)l * D * FF, D, FF, (bf16*)(ws + WS_WGU1), D, 128, 0, A->in[I_F1N] + (size_t)l * D);
    { bf16* wm = (bf16*)(ws + WS_WMLA);
      { PART(768 * 128, lo, hi); for (int i = lo + vgt; i < hi; i += vNGT) wm[(size_t)(i >> 7) * 512 + 384 + (i & 127)] = 0; }
      { PART(1024 * 384, lo, hi); for (int i = lo + vgt; i < hi; i += vNGT) wm[(size_t)(768 + i / 384) * 512 + (i % 384)] = 0; }
      unsigned* wz = (unsigned*)((bf16*)(ws + WS_WIN) + (size_t)NIN * D);
      { PART((NINP - NIN) * D / 2, lo, hi); for (int i = lo + vgt; i < hi; i += vNGT) wz[i] = 0u; } }
    { const float* pw = A->in[I_POOLW] + (size_t)l * 4 * 128 * 128; const float* ps = A->in[I_POOLS] + (size_t)l * 512; const float* wb = A->in[I_WBR] + (size_t)l * 4 * 512 * D;
      bf16* wt = (bf16*)(ws + WS_WBR);
      PART(128 * D, lo, hi);
      for (int i = lo + vgt; i < hi; i += vNGT) { const int r4 = (i >> 11) * 4, n = i & (D - 1), g = r4 >> 7;
          const float* pr = pw + (size_t)r4 * 128; const float* wcol = wb + (size_t)(g * 128) * D + n; const float* psg = ps + g * 128;
          float a0 = 0.f, a1 = 0.f, a2 = 0.f, a3 = 0.f;
#pragma unroll 8
          for (int d = 0; d < 128; ++d) { const float wv = wcol[(size_t)d * D] * psg[d]; a0 += pr[d] * wv; a1 += pr[128 + d] * wv; a2 += pr[256 + d] * wv; a3 += pr[384 + d] * wv; }
          bf16* o = wt + (size_t)n * 512 + r4;
          *(unsigned long long*)o = (unsigned long long)pk2(a0, a1) | ((unsigned long long)pk2(a2, a3) << 32); } }
#undef TM
#undef PART
}
__device__ __forceinline__ void tail_convert(ArgsP A, const Frame& F, int l, int bx, int nunits, int p0, int p1) {
#if !TAILCONV
    return;
#endif
    const int busy = nunits % F.G; if (busy == 0 || l + 1 >= NLAYER) return;
    const int slot = bx - busy; if (slot < 0) return;
    phase_convert(A, F, l + 1, slot * NWAVES + F.wave, (F.G - busy) * NWAVES, p0, p1);
}
__device__ __forceinline__ void phase_rope_tables(ArgsP A, const Frame& F) {
    unsigned char* ws = A->ws; const int lane = opq_lane(); const int gw = opq_s(F.gw); const int gt = gw * 64 + lane;
    {
        float* ct = (float*)(ws + WS_COS); float* st = (float*)(ws + WS_SIN);
        for (int i = gt; i < S * 32; i += F.NGT) { const int pos = i >> 5, k = i & 31;
            double f = 1.0; for (int j = 0; j < k; ++j) f *= 0.74989420933245582730;
            const float ang = (float)pos * (float)f;
            const double a = (double)ang; const double kq = __builtin_rint(a * 0.63661977236758134308); const double r = (a - kq * 1.5707963267948966192) - kq * 6.123233995736766e-17;
            const double r2 = r * r;
            const double sn = r * (1.0 + r2 * (-1.0 / 6 + r2 * (1.0 / 120 + r2 * (-1.0 / 5040 + r2 * (1.0 / 362880 + r2 * (-1.0 / 39916800 + r2 * (1.0 / 6227020800.0)))))));
            const double cs = 1.0 + r2 * (-0.5 + r2 * (1.0 / 24 + r2 * (-1.0 / 720 + r2 * (1.0 / 40320 + r2 * (-1.0 / 3628800 + r2 * (1.0 / 479001600.0 + r2 * (-1.0 / 87178291200.0)))))));
            const int q = ((int)kq) & 3;
            const double sv = (q == 0) ? sn : (q == 1) ? cs : (q == 2) ? -sn : -cs;
            const double cv = (q == 0) ? cs : (q == 1) ? -sn : (q == 2) ? -cs : sn;
            ct[i] = (float)cv; st[i] = (float)sv; }
    }
}
__device__ __forceinline__ void phase_prep(const Frame& F, const float* x, bf16* xb, float* ssp) {
    const int lane = opq_lane(); const int gw = opq_s(F.gw);
    for (int m = gw; m < S; m += F.NGW) {
        const GAS f32x4* xr = (const GAS f32x4*)(x + (size_t)m * D) + lane;
        f32x4 v[8]; float s = 0.f;
#pragma unroll
        for (int j = 0; j < 8; ++j) { v[j] = xr[64 * j]; s += (v[j].x * v[j].x + v[j].y * v[j].y) + (v[j].z * v[j].z + v[j].w * v[j].w); }
        s = wave_sum(s);
        GAS unsigned long long* o8 = (GAS unsigned long long*)(xb + (size_t)m * D) + lane;
#pragma unroll
        for (int j = 0; j < 8; ++j) o8[64 * j] = (unsigned long long)pk2(v[j].x, v[j].y) | ((unsigned long long)pk2(v[j].z, v[j].w) << 32);
        if (lane < 32) ssp[(size_t)m * 32 + lane] = (lane == 0) ? s : 0.f;
    }
}
__device__ __forceinline__ void phase_mix1(ArgsP A, const Frame& F, int l) {
    unsigned char* ws = A->ws; const int lane = opq_lane(); const int gw = opq_s(F.gw); const int gt = gw * 64 + lane;
    bf16* p = (bf16*)(ws + WS_P); bf16* z0 = (bf16*)(ws + WS_Z); bf16* vvn = (bf16*)(ws + WS_VVN); bf16* mlaA = (bf16*)(ws + WS_MLAA);
    for (int item = gt; item < (S / 16) * 256; item += F.NGT) {
        const int cp = item & 255, t0 = (item >> 8) * 16, g = cp >> 6;
        const bf16* col = p + PC_POOL + 2 * cp;
        float va[32], vb[32];
#pragma unroll
        for (int k = 0; k < 32; ++k) { const int tt = t0 - 8 + k; const bool in = (tt >= 0) && (tt < S); const unsigned u = in ? *(const unsigned*)(col + (size_t)(in ? tt : 0) * NINP) : 0u; va[k] = bflo(u); vb[k] = bfhi(u); }
        unsigned* zo = (unsigned*)(z0 + (size_t)t0 * 512 + 2 * cp);
#define POOL_GROUP(HW) do { \
        _Pragma("unroll") for (int i = 0; i < 16; ++i) { float sa = 0.f, sb = 0.f; \
            _Pragma("unroll") for (int k = 8 + i - (HW); k < 8 + i + (HW); ++k) { sa += va[k]; sb += vb[k]; }     \
            const int t = t0 + i, lo = (t - (HW)) < 0 ? 0 : (t - (HW)), hi = (t + (HW)) > S ? S : (t + (HW)); const float inv = 1.0f / (float)(hi - lo); \
            zo[(size_t)i * 256] = pk2(sa * inv - va[8 + i], sb * inv - vb[8 + i]); } } while (0)
        if (g == 0) POOL_GROUP(1); else if (g == 1) POOL_GROUP(2); else if (g == 2) POOL_GROUP(4); else POOL_GROUP(8);
#undef POOL_GROUP
    }
    const float* gq = A->in[I_DQN] + l * 128; const float* gk = A->in[I_DKN] + l * 128; const float* gs = A->in[I_SGUN] + l * 512;
    const float* gqa = A->in[I_MQAN] + l * 384; const float* gkva = A->in[I_MKVAN] + l * 128;
    const float gq0 = gq[2 * lane], gq1 = gq[2 * lane + 1], gk0 = gk[2 * lane], gk1 = gk[2 * lane + 1];
    float gsv[8];
#pragma unroll
    for (int k = 0; k < 8; ++k) gsv[k] = gs[8 * lane + k];
    const float ga0 = gqa[2 * lane], ga1 = gqa[2 * lane + 1], ga2 = gqa[128 + 2 * lane], ga3 = gqa[129 + 2 * lane], ga4 = gqa[256 + 2 * lane], ga5 = gqa[257 + 2 * lane];
    const float gv0 = gkva[2 * lane], gv1 = gkva[2 * lane + 1];
    for (int t = gw; t < S; t += F.NGW) {
        bf16* prow = p + (size_t)t * NINP;
        unsigned* ptr = (unsigned*)(prow + PC_DIL) + lane; unsigned uu[24]; float ss[24];
#pragma unroll
        for (int hh = 0; hh < 24; ++hh) uu[hh] = ptr[hh * 64];
        const v4u u = *((const v4u*)(prow + PC_SGU + 512) + lane);
        const unsigned* cq = (const unsigned*)(prow + PC_CQ) + lane; const unsigned u0 = cq[0], u1 = cq[64], u2 = cq[128];
        const unsigned uk = *((const unsigned*)(prow + PC_CKV) + lane);
        asm volatile("" ::: "memory");
        {
#pragma unroll
          for (int hh = 0; hh < 24; ++hh) { const float a = bflo(uu[hh]), b = bfhi(uu[hh]); ss[hh] = a * a + b * b; }
#pragma unroll
          for (int o = 1; o < 64; o <<= 1) {
#pragma unroll
              for (int hh = 0; hh < 24; ++hh) ss[hh] += __shfl_xor(ss[hh], o); }
#pragma unroll
          for (int hh = 0; hh < 24; ++hh) { const float rstd = __builtin_amdgcn_rsqf(ss[hh] * (1.f / 128) + EPS);
              ptr[hh * 64] = pk2(bflo(uu[hh]) * rstd * (hh < 12 ? gq0 : gk0), bfhi(uu[hh]) * rstd * (hh < 12 ? gq1 : gk1)); } }
        { float x[8] = {bflo(u.x), bfhi(u.x), bflo(u.y), bfhi(u.y), bflo(u.z), bfhi(u.z), bflo(u.w), bfhi(u.w)}; float s2 = 0.f;
#pragma unroll
          for (int k = 0; k < 8; ++k) s2 += x[k] * x[k];
          const float a0 = bflo(u0), b0 = bfhi(u0), a1 = bflo(u1), b1 = bfhi(u1), a2 = bflo(u2), b2 = bfhi(u2); const float ak = bflo(uk), bk = bfhi(uk);
          float sq = (a0 * a0 + b0 * b0) + (a1 * a1 + b1 * b1) + (a2 * a2 + b2 * b2), sk = ak * ak + bk * bk;
#pragma unroll
          for (int o = 1; o < 64; o <<= 1) { s2 += __shfl_xor(s2, o); sq += __shfl_xor(sq, o); sk += __shfl_xor(sk, o); }
          const float rstd = __builtin_amdgcn_rsqf(s2 * (1.f / 512) + EPS), rq = __builtin_amdgcn_rsqf(sq * (1.f / 384) + EPS), rk = __builtin_amdgcn_rsqf(sk * (1.f / 128) + EPS);
          v4u o; o.x = pk2(x[0] * rstd * gsv[0], x[1] * rstd * gsv[1]); o.y = pk2(x[2] * rstd * gsv[2], x[3] * rstd * gsv[3]); o.z = pk2(x[4] * rstd * gsv[4], x[5] * rstd * gsv[5]); o.w = pk2(x[6] * rstd * gsv[6], x[7] * rstd * gsv[7]);
          *((v4u*)(vvn + (size_t)t * 512) + lane) = o;
          unsigned* om = (unsigned*)(mlaA + (size_t)t * 512) + lane;
          om[0] = pk2(a0 * rq * ga0, b0 * rq * ga1); om[64] = pk2(a1 * rq * ga2, b1 * rq * ga3); om[128] = pk2(a2 * rq * ga4, b2 * rq * ga5);
          om[192] = pk2(ak * rk * gv0, bk * rk * gv1); }
    }
}
typedef float f32x16 __attribute__((ext_vector_type(16)));
typedef short s16x4 __attribute__((ext_vector_type(4)));
typedef short v4i16_t __attribute__((ext_vector_type(4)));
#define MFMA32(a, b, c) __builtin_amdgcn_mfma_f32_32x32x16_bf16((a), (b), (c), 0, 0, 0)
__device__ __forceinline__ int crow(int reg, int h) { return (reg & 3) + 8 * (reg >> 2) + 4 * h; }
__device__ __forceinline__ bf16x8 pack8(const f32x16& x, int s) {
    v4u p; p.x = epi::cvt_pk_bf16(x[8 * s], x[8 * s + 1]); p.y = epi::cvt_pk_bf16(x[8 * s + 2], x[8 * s + 3]); p.z = epi::cvt_pk_bf16(x[8 * s + 4], x[8 * s + 5]); p.w = epi::cvt_pk_bf16(x[8 * s + 6], x[8 * s + 7]);
    return __builtin_bit_cast(bf16x8, p);
}
__device__ __forceinline__ s16x4 tr_read(const LAS unsigned char* p) { return __builtin_bit_cast(s16x4, __builtin_amdgcn_ds_read_tr16_b64_v4i16((LAS v4i16_t*)p)); }
__device__ __forceinline__ int vimg_off(int key, int piece  ) { return key * 256 + (((piece >> 2) ^ (key & 3)) << 6) + ((piece & 3) << 4); }
__device__ __forceinline__ bf16x8 vt_frag(const LAS unsigned char* img, int key0, int d0, int lane) {
    const int h = lane >> 5, blk = (lane >> 4) & 1, q = (lane & 15) >> 2, pp = lane & 3;
    const int ka = key0 + 4 * h + q, kb = ka + 8;
    const int col = ((d0 ^ q) << 6) + (16 * blk + 4 * pp) * 2;
    const s16x4 lo = tr_read(img + ka * 256 + col), hi = tr_read(img + kb * 256 + col);
    return __builtin_shufflevector(lo, hi, 0, 1, 2, 3, 4, 5, 6, 7);
}
__device__ __forceinline__ int vt_lane_off(int lane, int d0) { const int h = lane >> 5, blk = (lane >> 4) & 1, q = (lane & 15) >> 2, pp = lane & 3; return (4 * h + q) * 256 + ((d0 ^ q) << 6) + (16 * blk + 4 * pp) * 2; }
template <int KEY0> __device__ __forceinline__ bf16x8 vt_frag_o(const LAS unsigned char* img, int voff) {
    const s16x4 lo = tr_read(img + voff + KEY0 * 256), hi = tr_read(img + voff + (KEY0 + 8) * 256);
    return __builtin_shufflevector(lo, hi, 0, 1, 2, 3, 4, 5, 6, 7);
}
__device__ __forceinline__ bf16x8 tr_frag(const LAS unsigned char* img, int ra, int rb, int cb, int lane) {
    const int blk = (lane >> 4) & 1, q = (lane & 15) >> 2, pp = lane & 3;
    const int col = ((cb ^ q) << 6) + (16 * blk + 4 * pp) * 2;
    const s16x4 lo = tr_read(img + (ra + q) * 256 + col), hi = tr_read(img + (rb + q) * 256 + col);
    return __builtin_shufflevector(lo, hi, 0, 1, 2, 3, 4, 5, 6, 7);
}
__device__ __forceinline__ void sgu_mix_mfma(ArgsP A, const Frame& F, int l, int lane) {
    unsigned char* ws = A->ws; const bf16* p = (const bf16*)(ws + WS_P); const bf16* vvn = (const bf16*)(ws + WS_VVN); bf16* z2 = (bf16*)(ws + WS_Z) + (size_t)2 * S * 512;
    const float* sw = A->in[I_SGUW] + (size_t)l * 4 * 128 * 128; const float* sb = A->in[I_SGUB] + (size_t)l * 4 * 128;
    LAS unsigned char* img = F.lds + RING_OFF;
    const int w = F.wave, tid = w * 64 + lane, ql = lane & 31, h = lane >> 5, tb = 32 * (w & 3), cb0 = 2 * (w >> 2);
    for (int unit = F.vcu; unit < 256; unit += F.G) {
        const int n = unit >> 2, g = unit & 3;
#pragma unroll
        for (int i = 0; i < 4; ++i) { const int idx = i * 512 + tid, s = idx >> 4, piece = idx & 15;
            *(LAS v4u*)(img + vimg_off(s, piece)) = *(const v4u*)(vvn + (size_t)(n * 128 + s) * 512 + g * 128 + piece * 8); }
        __syncthreads();
        f32x16 acc0, acc1;
#pragma unroll
        for (int e = 0; e < 16; ++e) { acc0[e] = 0.f; acc1[e] = 0.f; }
        const float* wrow = sw + ((size_t)g * 128 + tb + ql) * 128 + 8 * h;
#pragma unroll
        for (int ks = 0; ks < 8; ++ks) {
            const f32x4 a0 = *(const f32x4*)(wrow + 16 * ks), a1 = *(const f32x4*)(wrow + 16 * ks + 4);
            v4u ap; ap.x = epi::cvt_pk_bf16(a0.x, a0.y); ap.y = epi::cvt_pk_bf16(a0.z, a0.w); ap.z = epi::cvt_pk_bf16(a1.x, a1.y); ap.w = epi::cvt_pk_bf16(a1.z, a1.w);
            const bf16x8 af = __builtin_bit_cast(bf16x8, ap);
            acc0 = MFMA32(af, tr_frag(img, 16 * ks + 8 * h, 16 * ks + 8 * h + 4, cb0, lane), acc0);
            acc1 = MFMA32(af, tr_frag(img, 16 * ks + 8 * h, 16 * ks + 8 * h + 4, cb0 + 1, lane), acc1);
        }
        { const int c0 = g * 128 + 32 * cb0 + ql; float bias[16], u0[16], u1[16];
#pragma unroll
          for (int e = 0; e < 16; ++e) { const int tl = tb + crow(e, h), t = n * 128 + tl; bias[e] = sb[g * 128 + tl];
              u0[e] = bf2f(p[(size_t)t * NINP + PC_SGU + c0]); u1[e] = bf2f(p[(size_t)t * NINP + PC_SGU + c0 + 32]); }
#pragma unroll
          for (int e = 0; e < 16; ++e) { const int tl = tb + crow(e, h), t = n * 128 + tl;
              z2[(size_t)t * 512 + c0] = (bf16)f2bf(u0[e] * (acc0[e] + bias[e])); z2[(size_t)t * 512 + c0 + 32] = (bf16)f2bf(u1[e] * (acc1[e] + bias[e])); } }
        __syncthreads();
    }
}
__device__ __forceinline__ void dil_attention(ArgsP A, const Frame& F, int l, int gw, int lane) {
    unsigned char* ws = A->ws; const bf16* p = (const bf16*)(ws + WS_P);
    float* OP = (float*)(ws + WS_DILO); float* LP = (float*)(ws + WS_DILL);
    LAS unsigned char* img = F.lds + RING_OFF + (gw & 7) * 8192;
    const float* gq = A->in[I_DQN] + l * 128; const float* gk = A->in[I_DKN] + l * 128;
    const float cbound = 11.313708499f * wave_max(fmaxf(fabsf(gq[lane]), fabsf(gq[lane + 64]))) * wave_max(fmaxf(fabsf(gk[lane]), fabsf(gk[lane + 64])));
    const int ql = lane & 31, h = lane >> 5;
    const int nun = ((gw & 7) < 4) ? 2 : 1;
    for (int kk = 0; kk < ((F.G == 256) ? nun : 1 << 30); ++kk) {
        const int unit = (F.G == 256) ? (gw >> 3) * 12 + (gw & 7) + 8 * kk : gw + kk * F.NGW; if (unit >= 12 * 256) break;
        const int hq = unit >> 8, blk = unit & 255, g = hq >> 2, ih = hq & 3, dl = 1 << (2 * g), L = S >> (2 * g), nb = 256 >> (2 * g);
        const int r = blk / nb, b = blk % nb;
        const float slope = __builtin_amdgcn_exp2f(-8.0f * (float)(hq + 1) / 12.0f) * (float)dl;
        const int tq = r + dl * (32 * b + ql);
        bf16x8 qf[8];
        { const v4u* src = (const v4u*)(p + (size_t)tq * NINP + PC_DIL + hq * 128 + 8 * h);
#pragma unroll
          for (int s = 0; s < 8; ++s) qf[s] = __builtin_bit_cast(bf16x8, src[2 * s]); }
        f32x16 o[4]; float lsum = 0.f;
#pragma unroll
        for (int d0 = 0; d0 < 4; ++d0)
#pragma unroll
            for (int e = 0; e < 16; ++e) o[d0][e] = 0.f;
#pragma unroll 1
        for (int c = -2; c <= 2; ++c) {
            const int mb = 32 * (b + c);
            if (mb < 0 || mb >= L) continue;
            f32x16 sacc;
#pragma unroll
            for (int e = 0; e < 16; ++e) sacc[e] = 0.f;
            v4u vreg[8];
#pragma unroll
            for (int i = 0; i < 8; ++i) { const int idx = i * 64 + lane, key = idx >> 4, piece = idx & 15;
                vreg[i] = *(const v4u*)(p + (size_t)(r + dl * (mb + key)) * NINP + PC_DIL + 3072 + hq * 128 + piece * 8); }
            { const int tk = r + dl * (mb + ql);
              const v4u* src = (const v4u*)(p + (size_t)tk * NINP + PC_DIL + 1536 + hq * 128 + 8 * h);
              bf16x8 kf[8];
#pragma unroll
              for (int s = 0; s < 8; ++s) kf[s] = __builtin_bit_cast(bf16x8, src[2 * s]);
#pragma unroll
              for (int s = 0; s < 8; ++s) sacc = MFMA32(kf[s], qf[s], sacc); }
#pragma unroll
            for (int i = 0; i < 8; ++i) { const int idx = i * 64 + lane, key = idx >> 4, piece = idx & 15; *(LAS v4u*)(img + vimg_off(key, piece)) = vreg[i]; }
#pragma unroll
            for (int e = 0; e < 16; ++e) { const int rel = 32 * c + crow(e, h) - ql, arel = rel < 0 ? -rel : rel;
                const float sv = sacc[e] * 0.08838834764831845f - slope * (float)arel - cbound;
                const float pe = (arel <= 64) ? epi::fast_exp(sv) : 0.f; sacc[e] = pe; lsum += pe; }
            const bf16x8 pb0 = pack8(sacc, 0), pb1 = pack8(sacc, 1);
#pragma unroll
            for (int d0 = 0; d0 < 4; ++d0) { o[d0] = MFMA32(vt_frag(img, 0, d0, lane), pb0, o[d0]); o[d0] = MFMA32(vt_frag(img, 16, d0, lane), pb1, o[d0]); }
        }
        lsum += __shfl_xor(lsum, 32);
        float* orow = OP + ((size_t)g * S + tq) * 512 + ih * 128 + 4 * h;
#pragma unroll
        for (int d0 = 0; d0 < 4; ++d0)
#pragma unroll
            for (int k = 0; k < 4; ++k) { f32x4 v; v.x = o[d0][4 * k]; v.y = o[d0][4 * k + 1]; v.z = o[d0][4 * k + 2]; v.w = o[d0][4 * k + 3]; *(f32x4*)(orow + 32 * d0 + 8 * k) = v; }
        if (h == 0) LP[((size_t)g * S + tq) * 4 + ih] = lsum;
    }
}
__device__ __forceinline__ void phase_mix2(ArgsP A, const Frame& F, int l) {
    unsigned char* ws = A->ws; const int lane = opq_lane(); const int gw = opq_s(F.gw); const int gt = gw * 64 + lane;
    const bf16* p = (const bf16*)(ws + WS_P); const float* raw = (const float*)(ws + WS_MLARAW);
    const float* ct = (const float*)(ws + WS_COS); const float* st = (const float*)(ws + WS_SIN);
    const float* gqn = A->in[I_MQN] + l * 192; const float* gkn = A->in[I_MKN] + l * 192;
    const float QSCL = 0.07216878364870322f * 1.4426950408889634f;
    bf16* MQ = (bf16*)(ws + WS_MQ); bf16* MK = (bf16*)(ws + WS_MK); bf16* MV = (bf16*)(ws + WS_MV);
    const int w8 = gw & 7, tok0 = (gw >> 3) * 32 + (w8 < 4 ? 2 * w8 : 8 + 6 * (w8 - 4)), npair = (w8 < 4) ? 1 : 3;
    const float gq0 = gqn[lane], gq1 = gqn[lane + 64], gq2 = gqn[lane + 128], gk0 = gkn[lane], gk1 = gkn[lane + 64], gk2 = gkn[lane + 128];
    for (int jj = 0; jj < ((F.G == 256) ? npair : 1 << 30); ++jj) { const int tb = (F.G == 256) ? tok0 + 2 * jj : 2 * (gw + jj * F.NGW); if (tb >= S) break;
        float cs[2], sn[2], krv[2], q0[2][4], q1[2][4], q2[2][4], k0[2][4], k1[2][4], v0[2][4], v1[2][4], sq[2][4], sk[2][4];
#pragma unroll
        for (int u = 0; u < 2; ++u) { const int t = tb + u; cs[u] = ct[t * 32 + (lane & 31)]; sn[u] = st[t * 32 + (lane & 31)];
            const float* rr = raw + (size_t)t * NMLA; krv[u] = bf2f(p[(size_t)t * NINP + PC_KR + lane]);
#pragma unroll
            for (int h = 0; h < 4; ++h) { q0[u][h] = rr[h * 192 + lane]; q1[u][h] = rr[h * 192 + 64 + lane]; q2[u][h] = rr[h * 192 + 128 + lane];
                k0[u][h] = rr[768 + h * 256 + lane]; k1[u][h] = rr[768 + h * 256 + 64 + lane]; v0[u][h] = rr[768 + h * 256 + 128 + lane]; v1[u][h] = rr[768 + h * 256 + 192 + lane]; } }
#pragma unroll
        for (int u = 0; u < 2; ++u)
#pragma unroll
            for (int h = 0; h < 4; ++h) { sq[u][h] = q0[u][h] * q0[u][h] + q1[u][h] * q1[u][h] + q2[u][h] * q2[u][h]; sk[u][h] = k0[u][h] * k0[u][h] + k1[u][h] * k1[u][h] + krv[u] * krv[u]; }
#pragma unroll
        for (int o = 1; o < 64; o <<= 1) {
#pragma unroll
            for (int u = 0; u < 2; ++u)
#pragma unroll
                for (int h = 0; h < 4; ++h) { sq[u][h] += __shfl_xor(sq[u][h], o); sk[u][h] += __shfl_xor(sk[u][h], o); } }
#pragma unroll
        for (int u = 0; u < 2; ++u) { const int t = tb + u;
#pragma unroll
        for (int h = 0; h < 4; ++h) {
            const float rq = rsq(sq[u][h] * (1.f / 192) + EPS) * QSCL, rk = rsq(sk[u][h] * (1.f / 192) + EPS);
            const float a2 = q2[u][h] * rq * gq2, oa = __shfl_xor(a2, 32), a2r = (lane < 32) ? (a2 * cs[u] - oa * sn[u]) : (oa * sn[u] + a2 * cs[u]);
            const float b2 = krv[u] * rk * gk2, ob = __shfl_xor(b2, 32), b2r = (lane < 32) ? (b2 * cs[u] - ob * sn[u]) : (ob * sn[u] + b2 * cs[u]);
            bf16* qo = MQ + ((size_t)h * S + t) * 192; bf16* ko = MK + ((size_t)h * S + t) * 192; bf16* vo = MV + ((size_t)h * S + t) * 128;
            qo[lane] = (bf16)f2bf(q0[u][h] * rq * gq0); qo[lane + 64] = (bf16)f2bf(q1[u][h] * rq * gq1); qo[lane + 128] = (bf16)f2bf(a2r);
            ko[lane] = (bf16)f2bf(k0[u][h] * rk * gk0); ko[lane + 64] = (bf16)f2bf(k1[u][h] * rk * gk1); ko[lane + 128] = (bf16)f2bf(b2r);
            vo[lane] = (bf16)f2bf(v0[u][h]); vo[lane + 64] = (bf16)f2bf(v1[u][h]); } }
    }
    sgu_mix_mfma(A, F, l, lane);
    dil_attention(A, F, l, gw, lane);
}


constexpr int MLA_KROW = 400, MLA_KIMG = 64 * MLA_KROW, MLA_VIMG = 64 * 256;
constexpr int FL_V0 = 2 * MLA_KIMG, FL_P0 = FL_V0 + 2 * MLA_VIMG, FL_PBUF = 8 * 1024, FL_END = FL_P0 + 4 * 2 * FL_PBUF;
constexpr int FL_FLAG = FL_END;
static_assert(FL_FLAG + 64 <= LDSCTL_OFF, "flash LDS map");
#define FL_SB() __builtin_amdgcn_sched_barrier(0)
__device__ __forceinline__ void flash_scores(LAS unsigned char* lds, const bf16* MQ, const bf16* MK, const bf16* MV, float* LP, float c2, int vcu, int G, int w, int lane) {
    const int ql = lane & 31, hh = lane >> 5;
    LAS unsigned char* pw = lds + FL_P0 + w * 2 * FL_PBUF + lane * 16;
    volatile LAS unsigned* flag = (volatile LAS unsigned*)(lds + FL_FLAG + 16 * w); unsigned gen = 0u;
    for (int unit = vcu; unit < 256; unit += G) {
        const int kh = unit & 1, qb = (unit >> 1) & 31, h = unit >> 6;
        const bf16* Kg = MK + ((size_t)h * S + kh * 4096) * 192; const bf16* Vg = MV + ((size_t)h * S + kh * 4096) * 128;
        const int tq = qb * 256 + w * 64 + ql;
        bf16x8 qf0[12], qf1[12];
        { const v4u* src = (const v4u*)(MQ + ((size_t)h * S + tq) * 192 + 8 * hh);
#pragma unroll
          for (int s = 0; s < 12; ++s) { qf0[s] = __builtin_bit_cast(bf16x8, src[2 * s]); qf1[s] = __builtin_bit_cast(bf16x8, src[2 * s + 32 * 24]); } }
        float lsum0 = 0.f, lsum1 = 0.f;
        if (unit == vcu) *flag = 0u;
        __syncthreads();
#pragma unroll 1
        for (int jt = 0; jt < 64; ++jt) {
            const LAS unsigned char* kr0 = lds + (jt & 1) * MLA_KIMG + ql * MLA_KROW + 16 * hh;
            f32x16 s00, s01, s10, s11;
#pragma unroll
            for (int e = 0; e < 16; ++e) { s00[e] = -c2; s01[e] = -c2; s10[e] = -c2; s11[e] = -c2; }
#define KFRAG(f) (*(const LAS bf16x8*)(kr0 + ((f) >= 12 ? 32 * MLA_KROW : 0) + 32 * ((f) % 12)))
#define KLOAD(dst, f0) do { _Pragma("unroll") for (int i_ = 0; i_ < 4; ++i_) dst[i_] = KFRAG((f0) + i_); } while (0)
#define KMMA(src, f0) do { _Pragma("unroll") for (int i_ = 0; i_ < 4; ++i_) { if ((f0) + i_ < 12) { s00 = MFMA32(src[i_], qf0[((f0) + i_) % 12], s00); s10 = MFMA32(src[i_], qf1[((f0) + i_) % 12], s10); } \
                                                                               else { s01 = MFMA32(src[i_], qf0[((f0) + i_) % 12], s01); s11 = MFMA32(src[i_], qf1[((f0) + i_) % 12], s11); } } } while (0)
            bf16x8 kA[4], kB[4];
            KLOAD(kA, 0);
            KLOAD(kB, 4);  FL_SB(); KMMA(kA, 0);  FL_SB();
            KLOAD(kA, 8);  FL_SB(); KMMA(kB, 4);  FL_SB();
            KLOAD(kB, 12); FL_SB(); KMMA(kA, 8);  FL_SB();
            KLOAD(kA, 16); FL_SB(); KMMA(kB, 12); FL_SB();
            KLOAD(kB, 20); FL_SB(); KMMA(kA, 16); FL_SB();
            KMMA(kB, 20); FL_SB();
            *flag = ++gen; FL_SB();
#undef KFRAG
#undef KLOAD
#undef KMMA
            LAS unsigned char* pb = pw + (jt & 1) * FL_PBUF;
#define EXPW(sx, ls, f0) { _Pragma("unroll") for (int e = 0; e < 16; ++e) { const float p_ = __builtin_amdgcn_exp2f(sx[e]); sx[e] = p_; ls += p_; } \
                           *(LAS bf16x8*)(pb + (f0) * 1024) = pack8(sx, 0); *(LAS bf16x8*)(pb + ((f0) + 1) * 1024) = pack8(sx, 1); }
            EXPW(s00, lsum0, 0) EXPW(s01, lsum0, 2) EXPW(s10, lsum1, 4) EXPW(s11, lsum1, 6)
#undef EXPW
            __syncthreads();
        }
        lsum0 += __shfl_xor(lsum0, 32); lsum1 += __shfl_xor(lsum1, 32);
        if (hh == 0) { LP[((size_t)kh * 4 + h) * S + tq] = lsum0; LP[((size_t)kh * 4 + h) * S + tq + 32] = lsum1; }
    }
}
__device__ __forceinline__ void flash_pv(LAS unsigned char* lds, const bf16* MK, const bf16* MV, float* OP, int vcu, int G, int pw, int lane) {
    const int ql = lane & 31, hh = lane >> 5;
    int ksrc[7], vsrc[4];
#pragma unroll
    for (int i = 0; i < 7; ++i) { const int L = (pw + 4 * i) * 1024 + 16 * lane, row = L / MLA_KROW, within = L - row * MLA_KROW; ksrc[i] = (row < 64 ? row : 0) * 192 + (within < 384 ? within / 2 : 0); }
#pragma unroll
    for (int i = 0; i < 4; ++i) { const int L = (pw + 4 * i) * 1024 + 16 * lane, key = L >> 8, pos = (L & 255) >> 4; vsrc[i] = key * 128 + ((((pos >> 2) ^ (key & 3)) << 2) | (pos & 3)) * 8; }
#define FL_DMAK(jt_) { const bf16* kg_ = Kg + (size_t)(jt_) * 64 * 192; LAS unsigned char* kd_ = lds + ((jt_) & 1) * MLA_KIMG; \
        _Pragma("unroll") for (int i_ = 0; i_ < 6; ++i_) __builtin_amdgcn_global_load_lds((const unsigned*)(kg_ + ksrc[i_]), (LAS unsigned*)(kd_ + (pw + 4 * i_) * 1024), 16, 0, 0); \
        if (pw == 0) __builtin_amdgcn_global_load_lds((const unsigned*)(kg_ + ksrc[6]), (LAS unsigned*)(kd_ + 24 * 1024), 16, 0, 0); }
#define FL_DMAV(jt_) { const bf16* vg_ = Vg + (size_t)(jt_) * 64 * 128; LAS unsigned char* vd_ = lds + FL_V0 + ((jt_) & 1) * MLA_VIMG; \
        _Pragma("unroll") for (int i_ = 0; i_ < 4; ++i_) __builtin_amdgcn_global_load_lds((const unsigned*)(vg_ + vsrc[i_]), (LAS unsigned*)(vd_ + (pw + 4 * i_) * 1024), 16, 0, 0); }
    int voff[4];
#pragma unroll
    for (int d0 = 0; d0 < 4; ++d0) voff[d0] = vt_lane_off(lane, d0);
    const LAS unsigned char* pr = lds + FL_P0 + pw * 2 * FL_PBUF + lane * 16;
    volatile LAS unsigned* flag = (volatile LAS unsigned*)(lds + FL_FLAG + 16 * pw); unsigned gen = 0u;
    for (int unit = vcu; unit < 256; unit += G) {
        const int kh = unit & 1, qb = (unit >> 1) & 31, h = unit >> 6;
        const bf16* Kg = MK + ((size_t)h * S + kh * 4096) * 192; const bf16* Vg = MV + ((size_t)h * S + kh * 4096) * 128;
        const int tq = qb * 256 + pw * 64 + ql;
        f32x16 o0[4], o1[4];
#pragma unroll
        for (int d0 = 0; d0 < 4; ++d0)
#pragma unroll
            for (int e = 0; e < 16; ++e) { o0[d0][e] = 0.f; o1[d0][e] = 0.f; }
        FL_DMAK(0) VM_WAIT();
        __syncthreads();
#define PV_TILE(t_, WAITGEN) { const LAS unsigned char* pb = pr + ((t_) & 1) * FL_PBUF; const LAS unsigned char* vimg = lds + FL_V0 + ((t_) & 1) * MLA_VIMG; \
            bf16x8 pf[8]; _Pragma("unroll") for (int f = 0; f < 8; ++f) pf[f] = *(const LAS bf16x8*)(pb + f * 1024); \
            if (WAITGEN) { while (*flag < gen) __builtin_amdgcn_s_sleep(1); } \
            _Pragma("unroll") for (int dd = 0; dd < 4; ++dd) { bf16x8 vf[4]; \
                vf[0] = vt_frag_o<0>(vimg, voff[dd]); vf[1] = vt_frag_o<16>(vimg, voff[dd]); vf[2] = vt_frag_o<32>(vimg, voff[dd]); vf[3] = vt_frag_o<48>(vimg, voff[dd]); \
                _Pragma("unroll") for (int ks = 0; ks < 4; ++ks) { o0[dd] = MFMA32(vf[ks], pf[ks], o0[dd]); o1[dd] = MFMA32(vf[ks], pf[4 + ks], o1[dd]); } } }
#pragma unroll 1
        for (int jt = 0; jt < 64; ++jt) {
            if (jt + 1 < 64) FL_DMAK(jt + 1)
            FL_DMAV(jt)
            ++gen;
            if (jt > 0) PV_TILE(jt - 1, true)
            VM_WAIT();
            __syncthreads();
        }
        PV_TILE(63, false)
#undef PV_TILE
#pragma unroll
        for (int b = 0; b < 2; ++b) { float* orow = OP + (((size_t)kh * 4 + h) * S + tq + 32 * b) * 128 + 4 * hh;
#pragma unroll
            for (int d0 = 0; d0 < 4; ++d0)
#pragma unroll
                for (int k = 0; k < 4; ++k) { const f32x16& oo = b ? o1[d0] : o0[d0]; f32x4 v; v.x = oo[4 * k]; v.y = oo[4 * k + 1]; v.z = oo[4 * k + 2]; v.w = oo[4 * k + 3]; *(f32x4*)(orow + 32 * d0 + 8 * k) = v; } }
    }
}
__device__ __forceinline__ void phase_mla_flash(ArgsP A, const Frame& F, int l) {
    unsigned char* ws = A->ws; const int lane = opq_lane();
    const bf16* MQ = (const bf16*)(ws + WS_MQ); const bf16* MK = (const bf16*)(ws + WS_MK); const bf16* MV = (const bf16*)(ws + WS_MV);
    float* OP = (float*)(ws + WS_MOP); float* LP = (float*)(ws + WS_MLP);
    const float* gqn = A->in[I_MQN] + l * 192; const float* gkn = A->in[I_MKN] + l * 192;
    const float c2 = 19.990625f * wave_max(fmaxf(fmaxf(fabsf(gqn[lane]), fabsf(gqn[lane + 64])), fabsf(gqn[lane + 128]))) * wave_max(fmaxf(fmaxf(fabsf(gkn[lane]), fabsf(gkn[lane + 64])), fabsf(gkn[lane + 128])));
    if (F.wave < 4) flash_scores(F.lds, MQ, MK, MV, LP, c2, F.vcu, F.G, F.wave, lane);
    else flash_pv(F.lds, MK, MV, OP, F.vcu, F.G, F.wave - 4, lane);
    __syncthreads();
}
#undef FL_SB
#undef FL_DMAK
#undef FL_DMAV
__device__ __forceinline__ void dil_combine(ArgsP A, const Frame& F) {
    unsigned char* ws = A->ws; const int lane = opq_lane(); const int gw = opq_s(F.gw); const int gt = gw * 64 + lane;
    const float* OP = (const float*)(ws + WS_DILO); const float* LP = (const float*)(ws + WS_DILL); bf16* z1 = (bf16*)(ws + WS_Z) + (size_t)1 * S * 512;
    for (int base = gt; base < S * 64; base += 2 * F.NGT) {
        f32x4 a[2][6]; float den[2][3];
#pragma unroll
        for (int k = 0; k < 2; ++k) { const int it = base + k * F.NGT, itc = it < S * 64 ? it : gt, t = itc >> 6, ih = (itc & 63) >> 4; const size_t idx = (size_t)itc * 8;
#pragma unroll
            for (int g = 0; g < 3; ++g) { a[k][2 * g] = *(const f32x4*)(OP + (size_t)g * S * 512 + idx); a[k][2 * g + 1] = *(const f32x4*)(OP + (size_t)g * S * 512 + idx + 4); den[k][g] = LP[((size_t)g * S + t) * 4 + ih]; } }
#pragma unroll
        for (int k = 0; k < 2; ++k) { const int it = base + k * F.NGT; if (it >= S * 64) break;
            const float inv = 1.0f / ((den[k][0] + den[k][1]) + den[k][2]); const f32x4 lo = ((a[k][0] + a[k][2]) + a[k][4]) * inv, hi = ((a[k][1] + a[k][3]) + a[k][5]) * inv;
            v4u o; o.x = pk2(lo[0], lo[1]); o.y = pk2(lo[2], lo[3]); o.z = pk2(hi[0], hi[1]); o.w = pk2(hi[2], hi[3]);
            *(v4u*)(z1 + (size_t)it * 8) = o; }
    }
}
__device__ __forceinline__ void phase_mix3(ArgsP A, const Frame& F) {
    unsigned char* ws = A->ws; const int lane = opq_lane(); const int gw = opq_s(F.gw); const int gt = gw * 64 + lane;
    const float* MO = (const float*)(ws + WS_MOP); const float* ML = (const float*)(ws + WS_MLP); bf16* z3 = (bf16*)(ws + WS_Z) + (size_t)3 * S * 512;
    for (int base = gt; base < S * 64; base += 4 * F.NGT) {
        f32x4 a[4][4]; float den[4][2];
#pragma unroll
        for (int k = 0; k < 4; ++k) { const int it = base + k * F.NGT, itc = it < S * 64 ? it : gt, t = itc >> 6, c8 = (itc & 63) * 8, h = c8 >> 7, d = c8 & 127;
            const size_t r0 = (size_t)h * S + t, r1 = ((size_t)4 + h) * S + t;
            a[k][0] = *(const f32x4*)(MO + r0 * 128 + d); a[k][1] = *(const f32x4*)(MO + r0 * 128 + d + 4); a[k][2] = *(const f32x4*)(MO + r1 * 128 + d); a[k][3] = *(const f32x4*)(MO + r1 * 128 + d + 4);
            den[k][0] = ML[r0]; den[k][1] = ML[r1]; }
#pragma unroll
        for (int k = 0; k < 4; ++k) { const int it = base + k * F.NGT; if (it >= S * 64) break;
            const float inv = 1.0f / (den[k][0] + den[k][1]); const f32x4 lo = (a[k][0] + a[k][2]) * inv, hi = (a[k][1] + a[k][3]) * inv;
            v4u o; o.x = pk2(lo[0], lo[1]); o.y = pk2(lo[2], lo[3]); o.z = pk2(hi[0], hi[1]); o.w = pk2(hi[2], hi[3]);
            *(v4u*)(z3 + (size_t)it * 8) = o; }
    }
}

__global__ void __launch_bounds__(NWAVES * 64, 2) mk_fwd(Args args_unused) {
    extern __shared__ __attribute__((aligned(16))) unsigned char lds[];
    Frame F;
    F.lds = (LAS unsigned char*)lds;
    F.MISC = (volatile LAS unsigned*)(F.lds + MISC_OFF);
    F.wave = __builtin_amdgcn_readfirstlane((int)(threadIdx.x >> 6));
    F.G = gridDim.x; { const int bx = blockIdx.x; F.vcu = (F.G % 8 == 0) ? (bx % 8) * (F.G / 8) + bx / 8 : bx; }
    F.gw = F.vcu * NWAVES + F.wave; F.NGW = F.G * NWAVES; F.NGT = F.NGW * 64;
    for (int u = threadIdx.x; u < (LDS_BYTES - LDSCTL_OFF) / 4; u += NWAVES * 64) ((LAS unsigned*)(F.lds + LDSCTL_OFF))[u] = 0u;
    __syncthreads();
    int l_lo, l_hi; bool multi; XcdBarrier bar;
    { ArgsP A = fresh_args(); l_lo = A->l_lo; l_hi = A->l_hi;
      multi = !((l_hi - l_lo) == 1 && (A->ph_hi - A->ph_lo) == 1);
      unsigned* bw = (unsigned*)((gu32*)(A->ws + WS_CTL) + CW_BAR);
      bar.bar = bw; bar.x = 0; bar.st = F.MISC + 8;
      if (multi) bar = xcd_barrier_post(bw, F.MISC + 8); }
#define SEAM() do { if (multi) xcd_barrier(bar); } while (0)
#ifdef ONLY_PHASE
#define IN(k) ((k) == ONLY_PHASE && lo <= (k) && (k) < hi)
#else
#define IN(k) (lo <= (k) && (k) < hi)
#endif
#ifndef G_ALIGN
#define G_ALIGN true
#endif
#ifndef G_SP2
#define G_SP2 true
#endif
#define GEMM(EPI, ORDER) pg8::gemm_phase<EPI, ORDER, G_ALIGN, G_SP2>(Fl.lds + RING_OFF, g, So, E, Fl.wave)
    { ArgsP A = fresh_args(); if (A->l_lo == 0 && A->ph_lo == 0) phase_rope_tables(A, F); }
    for (int l = l_lo; l < l_hi; ++l) {
        int lo, hi; { ArgsP A = fresh_args(); lo = A->ph_lo; hi = A->ph_hi; }
        if (IN(0)) { ArgsP A = fresh_args(); const Frame Fl = fresh_frame(F); unsigned char* ws = A->ws;
            phase_convert(A, Fl, l, Fl.gw, Fl.NGW, 0, CPARTS);
            if (l == 0) phase_prep(Fl, A->in[I_X], (bf16*)(ws + WS_XN), (float*)(ws + WS_SSP));
            SEAM(); }
        if (IN(1)) { ArgsP A = fresh_args(); const Frame Fl = fresh_frame(F); const int bx = opq_s((int)blockIdx.x); unsigned char* ws = A->ws;
            pg8::Gemm g{(const bf16*)(ws + WS_XN), (const bf16*)(ws + (size_t)(l & 1) * WS_SETD + WS_WGU1), S, NGU, D};
            pg8::StaticOrder So; So.init(S, NGU, Fl.G, bx); epi::fill_rstd_table(So, (const float*)(ws + WS_SSP), (LAS float*)(Fl.lds + RSTD_OFF), Fl.wave); __syncthreads();
            epi::EpiSwiglu E{(bf16*)(ws + WS_HID), (const LAS float*)(Fl.lds + RSTD_OFF)}; GEMM(epi::EpiSwiglu, pg8::StaticOrder); tail_convert(A, Fl, l, bx, (S / 256) * (NGU / 256), 0, 128); SEAM(); }
        if (IN(2)) { ArgsP A = fresh_args(); const Frame Fl = fresh_frame(F); const int bx = opq_s((int)blockIdx.x); unsigned char* ws = A->ws; const float* xin = (l == 0) ? A->in[I_X] : (const float*)(ws + WS_X);
            pg8::Gemm g{(const bf16*)(ws + WS_HID), (const bf16*)(ws + (size_t)(l & 1) * WS_SETD + WS_WD1), S, D, FF}; pg8::StaticOrder So; So.init(S, D, Fl.G, bx);
            epi::EpiResid E{xin, (float*)(ws + WS_X), 0.5f, (bf16*)(ws + WS_XN), (float*)(ws + WS_SSP)}; GEMM(epi::EpiResid, pg8::StaticOrder); SEAM(); }
        if (IN(3)) { ArgsP A = fresh_args(); const Frame Fl = fresh_frame(F); const int bx = opq_s((int)blockIdx.x); unsigned char* ws = A->ws;
            pg8::Gemm g{(const bf16*)(ws + WS_XN), (const bf16*)(ws + (size_t)(l & 1) * WS_SETD + WS_WIN), S, NINP, D};
            pg8::StaticOrder So; So.init(S, NINP, Fl.G, bx); epi::fill_rstd_table(So, (const float*)(ws + WS_SSP), (LAS float*)(Fl.lds + RSTD_OFF), Fl.wave); __syncthreads();
            epi::EpiPin E{(bf16*)(ws + WS_P), (const LAS float*)(Fl.lds + RSTD_OFF)}; GEMM(epi::EpiPin, pg8::StaticOrder); tail_convert(A, Fl, l, bx, (S / 256) * (NINP / 256), 128, 288); SEAM(); }
        if (IN(4)) { ArgsP A = fresh_args(); const Frame Fl = fresh_frame(F); phase_mix1(A, Fl, l); SEAM(); }
        if (IN(5)) { ArgsP A = fresh_args(); const Frame Fl = fresh_frame(F); const int bx = opq_s((int)blockIdx.x); unsigned char* ws = A->ws;
            pg8::Gemm g{(const bf16*)(ws + WS_MLAA), (const bf16*)(ws + (size_t)(l & 1) * WS_SETD + WS_WMLA), S, NMLA, opq_s(512)}; pg8::StaticOrder So; So.init(S, NMLA, Fl.G, bx);
            epi::EpiF32 E{(float*)(ws + WS_MLARAW), NMLA, 1}; GEMM(epi::EpiF32, pg8::StaticOrder); SEAM(); }
        if (IN(6)) { ArgsP A = fresh_args(); const Frame Fl = fresh_frame(F); phase_mix2(A, Fl, l); SEAM(); }
        if (IN(7)) { ArgsP A = fresh_args(); const Frame Fl = fresh_frame(F); phase_mla_flash(A, Fl, l); dil_combine(A, Fl); SEAM(); }
        if (IN(8)) { ArgsP A = fresh_args(); const Frame Fl = fresh_frame(F); phase_mix3(A, Fl); SEAM(); }
        if (IN(9)) { ArgsP A = fresh_args(); const Frame Fl = fresh_frame(F); const int bx = opq_s((int)blockIdx.x); unsigned char* ws = A->ws;
            pg8::Gemm g{(const bf16*)(ws + WS_Z), (const bf16*)(ws + (size_t)(l & 1) * WS_SETD + WS_WBR), 4 * S, 4 * D, opq_s(512)}; epi::BranchOrder So; So.so.init(S, D, Fl.G, bx);
            epi::EpiBranchChain E{(bf16*)(ws + WS_MERGEDB), (const bf16*)(ws + WS_P) + PC_GATE}; GEMM(epi::EpiBranchChain, epi::BranchOrder); SEAM(); }
        if (IN(10)) { ArgsP A = fresh_args(); const Frame Fl = fresh_frame(F); const int bx = opq_s((int)blockIdx.x); unsigned char* ws = A->ws;
            pg8::Gemm g{(const bf16*)(ws + WS_MERGEDB), (const bf16*)(ws + (size_t)(l & 1) * WS_SETD + WS_WOUT), S, D, D}; pg8::StaticOrder So; So.init(S, D, Fl.G, bx);
            epi::EpiResid E{(const float*)(ws + WS_X), (float*)(ws + WS_X), 1.0f, (bf16*)(ws + WS_XN), (float*)(ws + WS_SSP)}; GEMM(epi::EpiResid, pg8::StaticOrder); SEAM(); }
        if (IN(11)) { ArgsP A = fresh_args(); const Frame Fl = fresh_frame(F); const int bx = opq_s((int)blockIdx.x); unsigned char* ws = A->ws;
            pg8::Gemm g{(const bf16*)(ws + WS_XN), (const bf16*)(ws + (size_t)(l & 1) * WS_SETD + WS_WGU2), S, NGU, D};
            pg8::StaticOrder So; So.init(S, NGU, Fl.G, bx); epi::fill_rstd_table(So, (const float*)(ws + WS_SSP), (LAS float*)(Fl.lds + RSTD_OFF), Fl.wave); __syncthreads();
            epi::EpiSwiglu E{(bf16*)(ws + WS_HID), (const LAS float*)(Fl.lds + RSTD_OFF)}; GEMM(epi::EpiSwiglu, pg8::StaticOrder); tail_convert(A, Fl, l, bx, (S / 256) * (NGU / 256), 288, CPARTS); SEAM(); }
        if (IN(12)) { ArgsP A = fresh_args(); const Frame Fl = fresh_frame(F); const int bx = opq_s((int)blockIdx.x); unsigned char* ws = A->ws; const bool lastl = (l == NLAYER - 1);
            pg8::Gemm g{(const bf16*)(ws + WS_HID), (const bf16*)(ws + (size_t)(l & 1) * WS_SETD + WS_WD2), S, D, FF}; pg8::StaticOrder So; So.init(S, D, Fl.G, bx);
            epi::EpiResid E{(const float*)(ws + WS_X), lastl ? A->out : (float*)(ws + WS_X), 0.5f, lastl ? (bf16*)nullptr : (bf16*)(ws + WS_XN), (float*)(ws + WS_SSP)}; GEMM(epi::EpiResid, pg8::StaticOrder);
            SEAM(); }
    }
#undef IN
#undef SEAM
#undef GEMM
}


#ifdef DBG_DUMP_OFF
__global__ void dbg_dump(const unsigned char* ws, float* out, int n) {
    for (int i = blockIdx.x * blockDim.x + threadIdx.x; i < n; i += gridDim.x * blockDim.x) {
        if (i >= DBG_DUMP_N) { out[i] = 0.f; continue; }
#if DBG_DUMP_BF16
        out[i] = __uint_as_float(((unsigned)((const unsigned short*)(ws + DBG_DUMP_OFF))[i]) << 16);
#else
        out[i] = ((const float*)(ws + DBG_DUMP_OFF))[i];
#endif
    }
}
#endif
#ifndef MK_ONE_LAUNCH
#define MK_ONE_LAUNCH 0
#endif
extern "C" void kernel_launch(void* const* d_in, const int* in_sizes, int n_in, void* d_out, int out_size, void* d_ws, size_t ws_size, hipStream_t stream) {
    static int grid = 0;
    if (grid == 0) {
        if (n_in != N_INPUTS || out_size != S * D || ws_size < WS_END) { fprintf(stderr, "kernel_launch: unexpected shapes (n_in %d out %d ws %zu)\n", n_in, out_size, ws_size); grid = -1; return; }
        int dev = 0, cus = 0, per_cu = 0;
        if (hipGetDevice(&dev) != hipSuccess || hipDeviceGetAttribute(&cus, hipDeviceAttributeMultiprocessorCount, dev) != hipSuccess) { grid = -1; return; }
        if (hipFuncSetAttribute((const void*)mk_fwd, hipFuncAttributeMaxDynamicSharedMemorySize, LDS_BYTES) != hipSuccess) { fprintf(stderr, "kernel_launch: hipFuncSetAttribute failed\n"); grid = -1; return; }
        if (hipOccupancyMaxActiveBlocksPerMultiprocessor(&per_cu, (const void*)mk_fwd, NWAVES * 64, LDS_BYTES) != hipSuccess || per_cu < 1) fprintf(stderr, "kernel_launch: occupancy query reports %d\n", per_cu);
        (void)hipGetLastError();
        grid = cus;
    }
    if (grid < 0) return;
    if (hipMemsetAsync((char*)d_ws + WS_CTL, 0, CTL_ZERO_BYTES, stream) != hipSuccess) return;
    Args a{};
    for (int i = 0; i < N_INPUTS; ++i) a.in[i] = (const float*)d_in[i];
    a.out = (float*)d_out; a.ws = (unsigned char*)d_ws;
#if MK_ONE_LAUNCH
    a.l_lo = 0; a.l_hi = NLAYER; a.ph_lo = 0; a.ph_hi = NPHASE;
    hipLaunchKernelGGL(mk_fwd, dim3(grid), dim3(NWAVES * 64), LDS_BYTES, stream, a);
#else
    for (int l = 0; l < NLAYER; ++l)
        for (int ph = 0; ph < NPHASE; ++ph) {
#ifdef DBG_DUMP_OFF
            if (l * NPHASE + ph > DBG_LAST) continue;
#endif
            a.l_lo = l; a.l_hi = l + 1; a.ph_lo = ph; a.ph_hi = ph + 1;
            hipLaunchKernelGGL(mk_fwd, dim3(grid), dim3(NWAVES * 64), LDS_BYTES, stream, a);
#ifdef DUP_MASK
            if ((DUP_MASK >> ph) & 1) hipLaunchKernelGGL(mk_fwd, dim3(grid), dim3(NWAVES * 64), LDS_BYTES, stream, a);
#endif
            }
#ifdef DBG_DUMP_OFF
    hipLaunchKernelGGL(dbg_dump, dim3(2048), dim3(256), 0, stream, (const unsigned char*)d_ws, (float*)d_out, S * D);
#endif
#endif
}
```

```cpp
#define MK_ONE_LAUNCH 1
#include <hip/hip_runtime.h>
#include <cstdio>
#include <cstdint>
namespace pg8 {
#define PG8_LAS __attribute__((address_space(3)))
typedef unsigned short bf16_t;
typedef short bf16x8 __attribute__((ext_vector_type(8)));
typedef float f32x4 __attribute__((ext_vector_type(4)));
typedef unsigned u32x4 __attribute__((ext_vector_type(4)));
constexpr int BM = 256, BK = 64, HALF = 128, HTB = HALF * BK * 2  , STAGE_BYTES = 8 * HTB, NXCD = 8, WGM = 4;

__host__ __device__ __forceinline__ int lds_byte(int r, int c) { const int st = (r >> 4) * 2 + (c >> 5), rr = r & 15, cc = c & 31, ob = rr * 64 + cc * 2; return st * 1024 + (ob ^ (((ob >> 9) & 1) << 5)); }
__host__ __device__ __forceinline__ void stage_rc(int b, int& R, int& C) { const int st = b / 1024, sb = b % 1024, swz = sb ^ (((sb >> 9) & 1) << 5); R = (st >> 1) * 16 + swz / 64; C = (st & 1) * 32 + (swz % 64) / 2; }
__host__ __device__ __forceinline__ int perm32(int rho) { const int n = rho >> 4, i = rho & 15; return 8 * (i >> 2) + 4 * n + (i & 3); }

struct Unit { int pm, pn; };
struct Gemm { const bf16_t* A; const bf16_t* Bt; int M, N, K; };

struct StaticOrder {
    int nM, nN, nwg, G, c;
    __host__ __device__ void init(int M, int N, int G_, int c_) { nM = M / BM; nN = N / BM; nwg = nM * nN; G = G_; c = c_; }
    __host__ __device__ bool next(int i, Unit& u) const {
        const long L = (long)i * G + c; if (L >= nwg) return false;
        int wgid = (int)L; { const int q = nwg / NXCD, r = nwg % NXCD, xcd = wgid % NXCD, off = wgid / NXCD; wgid = (xcd < r ? xcd * (q + 1) : r * (q + 1) + (xcd - r) * q) + off; }
        const int nig = WGM * nN, gid = wgid / nig, fm = gid * WGM, gsz = (nM - fm) < WGM ? (nM - fm) : WGM;
        u.pm = fm + ((wgid % nig) % gsz); u.pn = (wgid % nig) / gsz; return true;
    }
    __device__ __forceinline__ void a_ready(const Unit&, int  ) const {}
    __device__ __forceinline__ void done(const Unit&) const {}
};
__device__ __forceinline__ unsigned cvt_pk_bf16(float lo, float hi) { unsigned r; asm volatile("v_cvt_pk_bf16_f32 %0, %1, %2" : "=v"(r) : "v"(lo), "v"(hi)); return r; }
typedef float f32x2 __attribute__((ext_vector_type(2)));
__device__ __forceinline__ f32x2 gelu_pk(f32x2 v) {
    const f32x2 av = __builtin_elementwise_abs(v), d = av * 0.2316418882f + 1.0f;
    f32x2 t; t.x = __builtin_amdgcn_rcpf(d.x); t.y = __builtin_amdgcn_rcpf(d.y);
    f32x2 q = t * 0.5307027145f + (-0.7265760135f); q = q * t + 0.7107068705f; q = q * t + (-0.142248368f); q = q * t + 0.127414796f; q = q * t;
    const f32x2 s = (v * v) * (-0.72134752044f);
    f32x2 e; e.x = __builtin_amdgcn_exp2f(s.x); e.y = __builtin_amdgcn_exp2f(s.y);
    const f32x2 m = v * (q * e), r = v - m;
    f32x2 o; o.x = v.x < 0.f ? m.x : r.x; o.y = v.y < 0.f ? m.y : r.y; return o;
}
template <class Epi, class Sched, bool ALIGN_EPI = false, bool SP2 = false>
__device__ __forceinline__ void gemm_phase(PG8_LAS unsigned char* lds, const Gemm g, const Sched& S, const Epi& E, int wave_in  ) {
    int tid_ = wave_in * 64 + (int)__builtin_amdgcn_mbcnt_hi(~0u, __builtin_amdgcn_mbcnt_lo(~0u, 0u)); asm volatile("" : "+v"(tid_));
    const int tid = tid_, wid = __builtin_amdgcn_readfirstlane(tid >> 6), lane = tid & 63, wr = wid >> 2, wc = wid & 3, fr = lane & 15, fq = lane >> 4;
    const int K = g.K, nt = K / BK;
    unsigned voffA[2], voffB[2];
#pragma unroll
    for (int i = 0; i < 2; ++i) { int R, C; stage_rc(tid * 16 + i * 8192, R, C); const int Rb = Epi::PERM ? ((R & ~31) + perm32(R & 31)) : R;
        voffA[i] = (unsigned)(R * K + C) * 2u; voffB[i] = (unsigned)(Rb * K + C) * 2u; }
    const size_t kstep = (size_t)(BK * 2);
    const size_t hstep = (size_t)HALF * K * 2;
    const size_t tstep = 2 * hstep;
    const unsigned ldsw = (unsigned)wid * 1024u;
    const int aoff = lds_byte(wr * 64 + fr, fq * 8), boff = lds_byte(wc * 32 + fr, fq * 8);
#define PG8_SA(b, h) (((b) * 2 + (h)) * HTB)
#define PG8_SB(b, h) ((4 + (b) * 2 + (h)) * HTB)
#define PG8_STAGE(bufoff, gbase, voff) do { _Pragma("unroll") for (int _i = 0; _i < 2; ++_i) \
        __builtin_amdgcn_global_load_lds((const unsigned*)((const char*)(gbase) + (voff)[_i]), (PG8_LAS unsigned*)(lds + (bufoff) + ldsw + _i * 8192), 16, 0, 0); } while (0)
#define PG8_LDA(dst, b, h) do { _Pragma("unroll") for (int m = 0; m < 4; ++m) _Pragma("unroll") for (int k = 0; k < 2; ++k) dst[m][k] = *(const PG8_LAS bf16x8*)(lds + PG8_SA(b, h) + aoff + m * 2048 + k * 1024); } while (0)
#define PG8_LDB(dst, b, h) do { _Pragma("unroll") for (int n = 0; n < 2; ++n) _Pragma("unroll") for (int k = 0; k < 2; ++k) dst[n][k] = *(const PG8_LAS bf16x8*)(lds + PG8_SB(b, h) + boff + n * 2048 + k * 1024); } while (0)
#define PG8_MMA(ai, bj, At, Bt) do { __builtin_amdgcn_s_setprio(1); _Pragma("unroll") for (int m = 0; m < 4; ++m) _Pragma("unroll") for (int n = 0; n < 2; ++n) _Pragma("unroll") for (int k = 0; k < 2; ++k) \
        acc[ai][bj][m][n] = __builtin_amdgcn_mfma_f32_16x16x32_bf16(Bt[n][k], At[m][k], acc[ai][bj][m][n], 0, 0, 0); __builtin_amdgcn_s_setprio(0); } while (0)
#define PG8_WAIT_V(n) asm volatile("s_waitcnt vmcnt(" #n ")" ::: "memory")
#define PG8_WAIT_L(n) asm volatile("s_waitcnt lgkmcnt(" #n ")" ::: "memory")
#define PG8_BAR __builtin_amdgcn_s_barrier()
#define PG8_SCHED __builtin_amdgcn_sched_barrier(0)
    Unit cur, nxt; int ui = 0;
    if (!S.next(0, cur)) return;
    f32x4 acc[2][2][4][2];
#pragma unroll
    for (int a = 0; a < 2; ++a)
#pragma unroll
        for (int b = 0; b < 2; ++b)
#pragma unroll
            for (int m = 0; m < 4; ++m)
#pragma unroll
                for (int n = 0; n < 2; ++n) acc[a][b][m][n] = (f32x4){0.f, 0.f, 0.f, 0.f};
    bf16x8 At[4][2], B0[2][2], B1[2][2];
    const char* cA = (const char*)g.A + (size_t)cur.pm * tstep; const char* cB = (const char*)g.Bt + (size_t)cur.pn * tstep;
    S.a_ready(cur, 0);
    if constexpr (SP2) {
        PG8_STAGE(PG8_SB(0, 0), cB, voffB); PG8_STAGE(PG8_SB(0, 1), cB + hstep, voffB); PG8_STAGE(PG8_SA(0, 0), cA, voffA); PG8_STAGE(PG8_SA(0, 1), cA + hstep, voffA);
        if (wr == 1) PG8_BAR;
        PG8_WAIT_V(2); PG8_BAR;
        PG8_STAGE(PG8_SB(1, 0), cB + kstep, voffB); PG8_STAGE(PG8_SA(1, 0), cA + kstep, voffA); PG8_STAGE(PG8_SB(1, 1), cB + hstep + kstep, voffB);
        PG8_WAIT_V(6); PG8_BAR;
    } else {
        PG8_STAGE(PG8_SB(0, 0), cB, voffB); PG8_STAGE(PG8_SA(0, 0), cA, voffA); PG8_STAGE(PG8_SB(0, 1), cB + hstep, voffB); PG8_STAGE(PG8_SA(0, 1), cA + hstep, voffA);
        if (wr == 1) PG8_BAR;
        PG8_WAIT_V(4); PG8_BAR;
        PG8_STAGE(PG8_SB(1, 0), cB + kstep, voffB); PG8_STAGE(PG8_SA(1, 0), cA + kstep, voffA); PG8_STAGE(PG8_SB(1, 1), cB + hstep + kstep, voffB);
        PG8_WAIT_V(6); PG8_BAR;
    }
    for (;;) {
        const bool has_next = S.next(ui + 1, nxt);
        const char* nA = has_next ? (const char*)g.A + (size_t)nxt.pm * tstep : cA; const char* nB = has_next ? (const char*)g.Bt + (size_t)nxt.pn * tstep : cB;
        for (int t = 0; t < nt; t += 2) {
            const bool last = (t == nt - 2);
            const char* a1 = cA + (size_t)(t + 1) * kstep;
            const char* a2 = last ? nA : cA + (size_t)(t + 2) * kstep; const char* b2 = last ? nB : cB + (size_t)(t + 2) * kstep;
            const char* a3 = a2 + kstep; const char* b3 = b2 + kstep;
            if (last && has_next) S.a_ready(nxt, ui + 1);
            if constexpr (SP2) {
            PG8_LDB(B0, 0, 0); PG8_LDB(B1, 0, 1); PG8_SCHED; PG8_LDA(At, 0, 0); PG8_STAGE(PG8_SA(1, 1), a1 + hstep, voffA);
            PG8_WAIT_V(8); PG8_WAIT_L(0); PG8_BAR; PG8_MMA(0, 0, At, B0); PG8_MMA(0, 1, At, B1); PG8_BAR; PG8_SCHED;
            PG8_LDA(At, 0, 1); PG8_STAGE(PG8_SB(0, 0), b2, voffB); PG8_STAGE(PG8_SB(0, 1), b2 + hstep, voffB); PG8_STAGE(PG8_SA(0, 0), a2, voffA);
            PG8_WAIT_V(8); PG8_WAIT_L(0); PG8_BAR; PG8_MMA(1, 0, At, B0); PG8_MMA(1, 1, At, B1); PG8_BAR; PG8_SCHED;
            PG8_LDB(B0, 1, 0); PG8_LDB(B1, 1, 1); PG8_SCHED; PG8_LDA(At, 1, 0); PG8_STAGE(PG8_SA(0, 1), a2 + hstep, voffA);
            PG8_WAIT_V(8); PG8_WAIT_L(0); PG8_BAR; PG8_MMA(0, 0, At, B0); PG8_MMA(0, 1, At, B1); PG8_BAR; PG8_SCHED;
            PG8_LDA(At, 1, 1); PG8_STAGE(PG8_SB(1, 0), b3, voffB); PG8_STAGE(PG8_SB(1, 1), b3 + hstep, voffB); PG8_STAGE(PG8_SA(1, 0), a3, voffA);
            PG8_WAIT_V(8); PG8_WAIT_L(0); PG8_BAR; PG8_MMA(1, 0, At, B0); PG8_MMA(1, 1, At, B1); PG8_BAR; PG8_SCHED;
            } else {
            PG8_LDB(B0, 0, 0); PG8_SCHED; PG8_LDA(At, 0, 0); PG8_STAGE(PG8_SA(1, 1), a1 + hstep, voffA);
            PG8_WAIT_L(8); PG8_BAR; PG8_WAIT_L(0); PG8_MMA(0, 0, At, B0); PG8_BAR; PG8_SCHED;
            PG8_LDB(B1, 0, 1); PG8_STAGE(PG8_SB(0, 0), b2, voffB);
            PG8_BAR; PG8_WAIT_L(0); PG8_MMA(0, 1, At, B1); PG8_BAR;
            PG8_LDA(At, 0, 1); PG8_STAGE(PG8_SA(0, 0), a2, voffA);
            PG8_BAR; PG8_WAIT_L(0); PG8_MMA(1, 0, At, B0); PG8_BAR; PG8_SCHED;
            PG8_STAGE(PG8_SB(0, 1), b2 + hstep, voffB);
            PG8_WAIT_V(6); PG8_BAR; PG8_MMA(1, 1, At, B1); PG8_BAR;
            PG8_LDB(B0, 1, 0); PG8_SCHED; PG8_LDA(At, 1, 0); PG8_STAGE(PG8_SA(0, 1), a2 + hstep, voffA);
            PG8_WAIT_L(8); PG8_BAR; PG8_WAIT_L(0); PG8_MMA(0, 0, At, B0); PG8_BAR; PG8_SCHED;
            PG8_LDB(B1, 1, 1); PG8_STAGE(PG8_SB(1, 0), b3, voffB);
            PG8_BAR; PG8_WAIT_L(0); PG8_MMA(0, 1, At, B1); PG8_BAR;
            PG8_LDA(At, 1, 1); PG8_STAGE(PG8_SA(1, 0), a3, voffA);
            PG8_BAR; PG8_WAIT_L(0); PG8_MMA(1, 0, At, B0); PG8_BAR; PG8_SCHED;
            PG8_STAGE(PG8_SB(1, 1), b3 + hstep, voffB);
            PG8_WAIT_V(6); PG8_BAR; PG8_MMA(1, 1, At, B1); PG8_BAR;
            }
        }
        if constexpr (ALIGN_EPI) { if (wr == 0) PG8_BAR; }
        if constexpr (!Epi::AFTER_DRAIN) { E(acc, cur, wr, wc, fr, fq, ui); S.done(cur); }
        if (!has_next) break;
        if constexpr (!Epi::KEEP_ACC) {
#pragma unroll
        for (int a = 0; a < 2; ++a)
#pragma unroll
            for (int b = 0; b < 2; ++b)
#pragma unroll
                for (int m = 0; m < 4; ++m)
#pragma unroll
                    for (int n = 0; n < 2; ++n) acc[a][b][m][n] = (f32x4){0.f, 0.f, 0.f, 0.f};
        }
        cur = nxt; cA = nA; cB = nB; ++ui;
        if constexpr (ALIGN_EPI) { if (wr == 1) PG8_BAR; }
    }
    PG8_WAIT_V(0);
    if constexpr (!ALIGN_EPI) { if (wr == 0) PG8_BAR; }
    PG8_BAR;
    if constexpr (Epi::AFTER_DRAIN) { E.fused(acc, cur, wr, wc, fr, fq, lds, wid, lane); S.done(cur); }
#undef PG8_SA
#undef PG8_SB
#undef PG8_STAGE
#undef PG8_LDA
#undef PG8_LDB
#undef PG8_MMA
#undef PG8_WAIT_V
#undef PG8_WAIT_L
#undef PG8_BAR
#undef PG8_SCHED
}
}
#define GAS __attribute__((address_space(1)))
#define LAS __attribute__((address_space(3)))
typedef unsigned short bf16;
typedef unsigned v4u __attribute__((ext_vector_type(4)));
typedef float f32x4 __attribute__((ext_vector_type(4)));
typedef short bf16x8 __attribute__((ext_vector_type(8)));
typedef GAS unsigned gu32;
typedef GAS unsigned long long gu64;
#define RLX_AGENT __ATOMIC_RELAXED, __HIP_MEMORY_SCOPE_AGENT
#define LDS_WAIT() asm volatile("s_waitcnt lgkmcnt(0)" ::: "memory")
#define VM_WAIT() asm volatile("s_waitcnt vmcnt(0)" ::: "memory")
__device__ __forceinline__ unsigned long long rt() { return __builtin_amdgcn_s_memrealtime(); }
__device__ __forceinline__ unsigned f2bf(float f) { unsigned u = __builtin_bit_cast(unsigned, f); return (u + 0x7fffu + ((u >> 16) & 1u)) >> 16; }
__device__ __forceinline__ unsigned pk2(float lo, float hi) { return f2bf(lo) | (f2bf(hi) << 16); }
#define XB_TMO      128
#define XB_XCNT(j)  (256  + 64 * (j))
#define XB_XSUB(j)  (1280 + 64 * (j))
#define XB_XGEN(j)  (2304 + 64 * (j))
#define XB_TOP      3328
#define XB_TOPGEN   3392
#define XCD_BAR_WORDS 3456
#define XB_SPIN_CAP (1u << 18)

__device__ __forceinline__ unsigned xb_ld(unsigned* p)              { return __hip_atomic_load(p, __ATOMIC_RELAXED, __HIP_MEMORY_SCOPE_AGENT); }
__device__ __forceinline__ unsigned xb_add(unsigned* p, unsigned v) { return __hip_atomic_fetch_add(p, v, __ATOMIC_RELAXED, __HIP_MEMORY_SCOPE_AGENT); }
__device__ __forceinline__ unsigned xb_xcc_id() { return (unsigned)__builtin_amdgcn_s_getreg((3 << 11) | 20) & 0xFu; }
#define XB_SPIN(cond, bar) do { unsigned _sp = 0; while (cond) { __builtin_amdgcn_s_sleep(1); \
    if ((++_sp & 255u) == 0u) { if (xb_ld(&(bar)[XB_TMO])) break; if (_sp > XB_SPIN_CAP) { atomicAdd(&(bar)[XB_TMO], 1u); break; } } } } while (0)

struct XcdBarrier {
    unsigned* bar; unsigned x;
    volatile LAS unsigned* st;
};

__device__ __forceinline__ XcdBarrier xcd_barrier_post(unsigned* bar, volatile LAS unsigned* st) {
    XcdBarrier b; b.bar = bar; b.x = xb_xcc_id(); b.st = st;
    if (threadIdx.x == 0) (void)xb_add(&bar[XB_XCNT(b.x)], 1u);
    return b;
}
__device__ __forceinline__ void xcd_barrier_complete(unsigned* bar, unsigned x, unsigned& nloc, unsigned& nx) {
    const unsigned G = gridDim.x * gridDim.y * gridDim.z;
    unsigned sum, cnt, mine, sp = 0u;
    for (;;) {
        sum = 0u; cnt = 0u; mine = 0u;
#pragma unroll
        for (unsigned j = 0; j < 16; ++j) { const unsigned c = xb_ld(&bar[XB_XCNT(j)]); sum += c; cnt += (c > 0u) ? 1u : 0u; mine = (j == x) ? c : mine; }
        if (sum == G) break;
        __builtin_amdgcn_s_sleep(1);
        if ((++sp & 255u) == 0u) { if (xb_ld(&bar[XB_TMO])) break; if (sp > XB_SPIN_CAP) { atomicAdd(&bar[XB_TMO], 1u); break; } }
    }
    nloc = mine > 0u ? mine : 1u; nx = cnt > 0u ? cnt : 1u;
}

__device__ __forceinline__ void xcd_barrier(const XcdBarrier& b) {
    asm volatile("s_waitcnt vmcnt(0)" ::: "memory");
    __syncthreads();
    if (threadIdx.x == 0) {
        unsigned* bar = b.bar;
        __builtin_amdgcn_s_waitcnt(0);
        unsigned nloc = b.st[0], nx = b.st[1];
        if (nloc == 0u) { xcd_barrier_complete(bar, b.x, nloc, nx); b.st[0] = nloc; b.st[1] = nx; }
        const unsigned old = xb_add(&bar[XB_XSUB(b.x)], 1u);
        const unsigned gen = old / nloc;
        if (old + 1u == (gen + 1u) * nloc) {
            __builtin_amdgcn_fence(__ATOMIC_RELEASE, "agent");
            asm volatile("s_waitcnt vmcnt(0)" ::: "memory");
            const unsigned og = xb_add(&bar[XB_TOP], 1u);
            const unsigned tg = og / nx;
            if (og + 1u == (tg + 1u) * nx) xb_add(&bar[XB_TOPGEN], 1u);
            else XB_SPIN(xb_ld(&bar[XB_TOPGEN]) == tg, bar);
            __builtin_amdgcn_fence(__ATOMIC_ACQUIRE, "agent");
            xb_add(&bar[XB_XGEN(b.x)], 1u);
            asm volatile("s_waitcnt vmcnt(0)" ::: "memory");
        } else {
            XB_SPIN(xb_ld(&bar[XB_XGEN(b.x)]) == gen, bar);
            __builtin_amdgcn_fence(__ATOMIC_ACQUIRE, "agent");
            asm volatile("s_waitcnt vmcnt(0)" ::: "memory");
        }
    }
    __syncthreads();
}
constexpr int S = 8192, D = 2048, FF = 5632, NLAYER = 4;
constexpr int NIN = 14912, NINP = 15104;
constexpr int NGU = 2 * FF;
constexpr float EPS = 1e-6f;
constexpr int PC_GATE = 0, PC_POOL = 8192, PC_DIL = 8704, PC_SGU = 13312, PC_CQ = 14336, PC_CKV = 14720, PC_KR = 14848;
constexpr int NMLA = 1792;

namespace epi {
using pg8::f32x4; using pg8::u32x4; using pg8::Unit; using pg8::bf16_t;
typedef float f32x2_t __attribute__((ext_vector_type(2))); typedef __bf16 bf16x2_t __attribute__((ext_vector_type(2)));
__device__ __forceinline__ unsigned cvt_pk_bf16(float lo, float hi) { f32x2_t v = {lo, hi}; bf16x2_t b = __builtin_convertvector(v, bf16x2_t); return __builtin_bit_cast(unsigned, b); }
constexpr int BM = 256, HALF = 128;
typedef unsigned u32x2 __attribute__((ext_vector_type(2)));
__device__ __forceinline__ float fast_exp(float x) { return __builtin_amdgcn_exp2f(x * 1.44269504089f); }
__device__ __forceinline__ float sigmoid_f(float x) { return __builtin_amdgcn_rcpf(1.0f + fast_exp(-x)); }

struct EpiSwiglu {
    static constexpr bool PERM = true, AFTER_DRAIN = false, KEEP_ACC = false;
    bf16_t* H; const __attribute__((address_space(3))) float* tab;
    __device__ __forceinline__ void operator()(const f32x4 (&acc)[2][2][4][2], const Unit& u, int wr, int wc, int fr, int fq, int ui) const {
        const int row0 = u.pm * BM + wr * 64 + fr, col0 = u.pn * HALF + wc * 32 + 8 * fq; const __attribute__((address_space(3))) float* tb = tab + ui * 256 + wr * 64 + fr;
#pragma unroll
        for (int ai = 0; ai < 2; ++ai)
#pragma unroll
            for (int m = 0; m < 4; ++m) {
                bf16_t* rowp = H + (size_t)(row0 + ai * HALF + m * 16) * FF + col0; const float rs = tb[ai * HALF + m * 16];
                float o[8];
#pragma unroll
                for (int n = 0; n < 2; ++n)
#pragma unroll
                    for (int j = 0; j < 4; ++j) { const float g = acc[ai][0][m][n][j] * rs, up = acc[ai][1][m][n][j] * rs; o[n * 4 + j] = g * sigmoid_f(g) * up; }
                u32x4 w; w.x = cvt_pk_bf16(o[0], o[1]); w.y = cvt_pk_bf16(o[2], o[3]); w.z = cvt_pk_bf16(o[4], o[5]); w.w = cvt_pk_bf16(o[6], o[7]);
                *(u32x4*)rowp = w;
                asm volatile("" ::: "memory");
            }
    }
};
struct EpiResid {
    static constexpr bool PERM = false, AFTER_DRAIN = false, KEEP_ACC = false;
    const float* base; float* out; float alpha; bf16_t* xb; float* ssp;
    __device__ __forceinline__ void operator()(const f32x4 (&acc)[2][2][4][2], const Unit& u, int wr, int wc, int fr, int fq, int ui) const {
        const int row0 = u.pm * BM + wr * 64 + fr, col0 = u.pn * BM + wc * 32 + 4 * fq;
        f32x4 bb[3][4];
#define ER_LOAD(buf, g) { const size_t off_ = (size_t)(row0 + ((g) >> 2) * HALF + ((g) & 3) * 16) * D + col0; _Pragma("unroll") for (int q_ = 0; q_ < 4; ++q_) bb[buf][q_] = *(const f32x4*)(base + off_ + (q_ >> 1) * HALF + (q_ & 1) * 16); }
        ER_LOAD(0, 0) ER_LOAD(1, 1)
#pragma unroll
        for (int g = 0; g < 8; ++g) { const int ai = g >> 2, m = g & 3;
            if (g + 2 < 8) ER_LOAD((g + 2) % 3, g + 2)
            const int r = row0 + ai * HALF + m * 16; const size_t off = (size_t)r * D + col0; float s = 0.f;
#pragma unroll
            for (int q = 0; q < 4; ++q) { const int bj = q >> 1, n = q & 1; const f32x4 v = bb[g % 3][q] + acc[ai][bj][m][n] * alpha;
                *(f32x4*)(out + off + bj * HALF + n * 16) = v;
                if (xb) { s += (v[0] * v[0] + v[1] * v[1]) + (v[2] * v[2] + v[3] * v[3]); u32x2 w; w.x = cvt_pk_bf16(v[0], v[1]); w.y = cvt_pk_bf16(v[2], v[3]); *(u32x2*)(xb + off + bj * HALF + n * 16) = w; } }
            if (xb) { s += __shfl_xor(s, 16); s += __shfl_xor(s, 32); if (fq == 0) ssp[(size_t)r * 32 + u.pn * 4 + wc] = s; }
            asm volatile("" ::: "memory"); }
#undef ER_LOAD
    }
};
struct EpiPin {
    static constexpr bool PERM = true, AFTER_DRAIN = false, KEEP_ACC = false;
    bf16_t* P; const __attribute__((address_space(3))) float* tab;
    template <int KIND> __device__ __forceinline__ void run(const f32x4 (&acc)[2][2][4][2], const Unit& u, int wr, int wc, int fr, int fq, int ui) const {
        const __attribute__((address_space(3))) float* tb = tab + ui * 256 + wr * 64 + fr;
        const int row0 = u.pm * BM + wr * 64 + fr, col0 = u.pn * BM + wc * 32 + 8 * fq;
#pragma unroll
        for (int ai = 0; ai < 2; ++ai)
#pragma unroll
            for (int m = 0; m < 4; ++m) { bf16_t* rowp = P + (size_t)(row0 + ai * HALF + m * 16) * NINP + col0; const float rs = tb[ai * HALF + m * 16];
#pragma unroll
                for (int bj = 0; bj < 2; ++bj) { float o[8];
#pragma unroll
                    for (int n = 0; n < 2; ++n)
#pragma unroll
                        for (int j = 0; j < 4; ++j) { const float x = acc[ai][bj][m][n][j] * rs;
                            o[n * 4 + j] = (KIND == 0) ? x : ((KIND == 1) ? sigmoid_f(x) : x * sigmoid_f(1.5957691216f * (x + 0.044715f * x * x * x))); }
                    u32x4 w; w.x = cvt_pk_bf16(o[0], o[1]); w.y = cvt_pk_bf16(o[2], o[3]); w.z = cvt_pk_bf16(o[4], o[5]); w.w = cvt_pk_bf16(o[6], o[7]);
                    *(u32x4*)(rowp + bj * HALF) = w; }
                asm volatile("" ::: "memory"); }
    }
    __device__ __forceinline__ void operator()(const f32x4 (&acc)[2][2][4][2], const Unit& u, int wr, int wc, int fr, int fq, int ui) const {
        if (u.pn < 32) run<1>(acc, u, wr, wc, fr, fq, ui); else if (u.pn >= 52 && u.pn < 56) run<2>(acc, u, wr, wc, fr, fq, ui); else run<0>(acc, u, wr, wc, fr, fq, ui);
    }
};
struct EpiF32 {
    static constexpr bool PERM = false, AFTER_DRAIN = false, KEEP_ACC = false;
    float* C; int ldc; int colmul;
    __device__ __forceinline__ void operator()(const f32x4 (&acc)[2][2][4][2], const Unit& u, int wr, int wc, int fr, int fq, int ui) const {
        const int row0 = u.pm * BM + wr * 64 + fr, col0 = colmul * u.pn * BM + wc * 32 + 4 * fq;
#pragma unroll
        for (int ai = 0; ai < 2; ++ai)
#pragma unroll
            for (int m = 0; m < 4; ++m) { float* rowp = C + (size_t)(row0 + ai * HALF + m * 16) * ldc + col0;
#pragma unroll
                for (int bj = 0; bj < 2; ++bj)
#pragma unroll
                    for (int n = 0; n < 2; ++n) *(f32x4*)(rowp + bj * HALF + n * 16) = acc[ai][bj][m][n]; }
    }
};
struct EpiExp {
    static constexpr bool PERM = true, AFTER_DRAIN = false, KEEP_ACC = false;
    bf16_t* P;
    __device__ __forceinline__ void operator()(const f32x4 (&acc)[2][2][4][2], const Unit& u, int wr, int wc, int fr, int fq, int ui) const {
        const int row0 = u.pm * BM + wr * 64 + fr, col0 = (u.pn & 31) * BM + wc * 32 + 8 * fq;
#pragma unroll
        for (int ai = 0; ai < 2; ++ai)
#pragma unroll
            for (int m = 0; m < 4; ++m) { bf16_t* rowp = P + (size_t)(row0 + ai * HALF + m * 16) * S + col0;
#pragma unroll
                for (int bj = 0; bj < 2; ++bj) { float o[8];
#pragma unroll
                    for (int n = 0; n < 2; ++n)
#pragma unroll
                        for (int j = 0; j < 4; ++j) o[n * 4 + j] =
#ifdef DBG_NOEXP
                            acc[ai][bj][m][n][j];
#else
                            fast_exp(acc[ai][bj][m][n][j]);
#endif
                    u32x4 w; w.x = cvt_pk_bf16(o[0], o[1]); w.y = cvt_pk_bf16(o[2], o[3]); w.z = cvt_pk_bf16(o[4], o[5]); w.w = cvt_pk_bf16(o[6], o[7]);
                    *(u32x4*)(rowp + bj * HALF) = w; }
                asm volatile("" ::: "memory"); }
    }
};
struct EpiBranch {
    static constexpr bool PERM = false, AFTER_DRAIN = false, KEEP_ACC = false;
    float* merged; bf16_t* mergedb; const bf16_t* gate; int b;
    __device__ __forceinline__ void operator()(const f32x4 (&acc)[2][2][4][2], const Unit& u, int wr, int wc, int fr, int fq, int ui) const {
        const int row0 = u.pm * BM + wr * 64 + fr, col0 = u.pn * BM + wc * 32 + 4 * fq;
#pragma unroll
        for (int ai = 0; ai < 2; ++ai)
#pragma unroll
            for (int m = 0; m < 4; ++m) { const int r = row0 + ai * HALF + m * 16;
#pragma unroll
                for (int bj = 0; bj < 2; ++bj)
#pragma unroll
                    for (int n = 0; n < 2; ++n) { const int c = col0 + bj * HALF + n * 16;
                        const u32x2 gv = *(const u32x2*)(gate + (size_t)r * NINP + c);
                        f32x4 g; g[0] = __uint_as_float(gv.x << 16); g[1] = __uint_as_float(gv.x & 0xffff0000u); g[2] = __uint_as_float(gv.y << 16); g[3] = __uint_as_float(gv.y & 0xffff0000u);
                        f32x4 v = acc[ai][bj][m][n] * g;
                        float* mp = merged + (size_t)r * D + c;
                        if (b != 0) v += *(const f32x4*)mp;
                        if (b != 3) *(f32x4*)mp = v;
                        else { u32x2 w; w.x = cvt_pk_bf16(v[0], v[1]); w.y = cvt_pk_bf16(v[2], v[3]); *(u32x2*)(mergedb + (size_t)r * D + c) = w; } }
                asm volatile("" ::: "memory"); }
    }
};
struct QKOrder {
    int G, c;
    __device__ bool next(int i, Unit& u) const { const int L = i * G + c; if (L >= 4096) return false; const int h = L >> 10, rem = L & 1023; u.pm = h * 32 + (rem >> 5); u.pn = h * 32 + (rem & 31); return true; }
    __device__ __forceinline__ void a_ready(const Unit&, int) const {}
    __device__ __forceinline__ void done(const Unit&) const {}
};
struct PVOrder {
    int G, c;
    __device__ bool next(int i, Unit& u) const { const int L = i * G + c; if (L >= 128) return false; u.pm = L; u.pn = L >> 5; return true; }
    __device__ __forceinline__ void a_ready(const Unit&, int) const {}
    __device__ __forceinline__ void done(const Unit&) const {}
};
struct EpiBranchChain {
    static constexpr bool PERM = true, AFTER_DRAIN = false, KEEP_ACC = true;
    bf16_t* mergedb; const bf16_t* gate;
    __device__ __forceinline__ void operator()(f32x4 (&acc)[2][2][4][2], const Unit& u, int wr, int wc, int fr, int fq, int ui) const {
        const int b = u.pm >> 5, pm0 = u.pm & 31, pn0 = u.pn & 7;
        const int row0 = pm0 * BM + wr * 64 + fr, col0 = pn0 * BM + wc * 32 + 8 * fq;
        u32x4 gg[3][2][2];
#define BC_LOAD(buf, g) { const bf16_t* gp_ = gate + (size_t)(row0 + ((g) >> 2) * HALF + ((g) & 3) * 16) * NINP + b * D + col0; _Pragma("unroll") for (int bj_ = 0; bj_ < 2; ++bj_) { \
            gg[buf][bj_][0] = *(const u32x4*)(gp_ + bj_ * HALF); if (b != 3) gg[buf][bj_][1] = *(const u32x4*)(gp_ + bj_ * HALF + D); } }
        BC_LOAD(0, 0) BC_LOAD(1, 1)
#pragma unroll
        for (int gi = 0; gi < 8; ++gi) { const int ai = gi >> 2, m = gi & 3; const int r = row0 + ai * HALF + m * 16;
            if (gi + 2 < 8) BC_LOAD((gi + 2) % 3, gi + 2)
#pragma unroll
            for (int bj = 0; bj < 2; ++bj) { const int c = col0 + bj * HALF;
                const u32x4 gv = gg[gi % 3][bj][0];
                float g[8] = {__uint_as_float(gv.x << 16), __uint_as_float(gv.x & 0xffff0000u), __uint_as_float(gv.y << 16), __uint_as_float(gv.y & 0xffff0000u),
                              __uint_as_float(gv.z << 16), __uint_as_float(gv.z & 0xffff0000u), __uint_as_float(gv.w << 16), __uint_as_float(gv.w & 0xffff0000u)};
                if (b != 3) {
                    const u32x4 hv = gg[gi % 3][bj][1];
                    const float gn[8] = {__uint_as_float(hv.x << 16), __uint_as_float(hv.x & 0xffff0000u), __uint_as_float(hv.y << 16), __uint_as_float(hv.y & 0xffff0000u),
                                         __uint_as_float(hv.z << 16), __uint_as_float(hv.z & 0xffff0000u), __uint_as_float(hv.w << 16), __uint_as_float(hv.w & 0xffff0000u)};
#pragma unroll
                    for (int n = 0; n < 2; ++n)
#pragma unroll
                        for (int j = 0; j < 4; ++j) acc[ai][bj][m][n][j] *= fmaxf(g[n * 4 + j], 1e-30f) * __builtin_amdgcn_rcpf(fmaxf(gn[n * 4 + j], 1e-30f));
                } else {
                    float o[8];
#pragma unroll
                    for (int n = 0; n < 2; ++n)
#pragma unroll
                        for (int j = 0; j < 4; ++j) o[n * 4 + j] = acc[ai][bj][m][n][j] * fmaxf(g[n * 4 + j], 1e-30f);
                    u32x4 w; w.x = cvt_pk_bf16(o[0], o[1]); w.y = cvt_pk_bf16(o[2], o[3]); w.z = cvt_pk_bf16(o[4], o[5]); w.w = cvt_pk_bf16(o[6], o[7]);
                    *(u32x4*)(mergedb + (size_t)r * D + c) = w;
                } }
            asm volatile("" ::: "memory"); }
#undef BC_LOAD
    }
};
template <class Sched> __device__ __forceinline__ void fill_rstd_table(const Sched& So, const float* ssp, __attribute__((address_space(3))) float* tab, int wave) {
    int t_ = wave * 64 + (int)__builtin_amdgcn_mbcnt_hi(~0u, __builtin_amdgcn_mbcnt_lo(~0u, 0u)); asm volatile("" : "+v"(t_));
    const int t = t_, row = t >> 1, half = t & 1;
#pragma unroll 1
    for (int ui = 0; ui < 8; ++ui) { Unit u; if (!So.next(ui, u)) break;
        const f32x4* p = (const f32x4*)(ssp + (size_t)(u.pm * BM + row) * 32 + half * 16); const f32x4 a = p[0], b = p[1], c = p[2], d = p[3];
        float s = (((a[0] + a[1]) + (a[2] + a[3])) + ((b[0] + b[1]) + (b[2] + b[3]))) + (((c[0] + c[1]) + (c[2] + c[3])) + ((d[0] + d[1]) + (d[2] + d[3])));
        s += __shfl_xor(s, 1);
        if (half == 0) tab[ui * 256 + row] = 1.0f / sqrtf(s * (1.0f / D) + EPS); }
}
struct BranchOrder {
    pg8::StaticOrder so;
    __device__ bool next(int i, Unit& u) const { if (i >= 4) return false; Unit t; if (!so.next(0, t)) return false; u.pm = i * 32 + t.pm; u.pn = i * 8 + t.pn; return true; }
    __device__ __forceinline__ void a_ready(const Unit&, int) const {}
    __device__ __forceinline__ void done(const Unit&) const {}
};
}
constexpr size_t MiB = 1u << 20;
constexpr size_t WS_CTL = 0, CTL_ZERO_BYTES = 1 * MiB;
constexpr size_t WS_COS = 1 * MiB, WS_SIN = 2 * MiB, WS_SSP = 3 * MiB;
constexpr size_t WS_WGU1 = 4 * MiB, WS_WD1 = 48 * MiB, WS_WGU2 = 70 * MiB, WS_WD2 = 114 * MiB;
constexpr size_t WS_WIN = 136 * MiB, WS_WBR = 195 * MiB, WS_WOUT = 203 * MiB, WS_WMLA = 211 * MiB;
constexpr size_t WS_X = 214 * MiB;
constexpr size_t WS_XN = 278 * MiB;
constexpr size_t WS_HID = 310 * MiB;
constexpr size_t WS_P = 398 * MiB;
constexpr size_t WS_Z = 634 * MiB;
constexpr size_t WS_VVN = 666 * MiB, WS_MLAA = 674 * MiB;
constexpr size_t WS_MLARAW = 682 * MiB;
constexpr size_t WS_QP = 1426 * MiB, WS_KP = 1458 * MiB, WS_VT = 770 * MiB;
constexpr int QKP = 256;
constexpr size_t WS_ORAW = 786 * MiB;
constexpr size_t WS_MERGED = 818 * MiB, WS_MERGEDB = 882 * MiB;
constexpr size_t WS_PEXP = 914 * MiB;
constexpr size_t WS_DILO = 1490 * MiB, WS_DILL = 1540 * MiB;
constexpr size_t WS_MQ = WS_QP, WS_MK = WS_KP, WS_MV = WS_VT, WS_MOP = WS_PEXP, WS_MLP = WS_ORAW;
constexpr size_t WS_END = 1541 * MiB;
static_assert(WS_WGU1 + (size_t)NGU * D * 2 <= WS_WD1 && WS_WD1 + (size_t)D * FF * 2 <= WS_WGU2 && WS_WGU2 + (size_t)NGU * D * 2 <= WS_WD2 && WS_WD2 + (size_t)D * FF * 2 <= WS_WIN, "ws map 1");
static_assert(WS_WIN + (size_t)NINP * D * 2 <= WS_WBR && WS_WBR + (size_t)4 * D * 512 * 2 <= WS_WOUT && WS_WOUT + (size_t)D * D * 2 <= WS_WMLA && WS_WMLA + (size_t)NMLA * 512 * 2 <= WS_X, "ws map 2");
static_assert(WS_X + (size_t)S * D * 4 <= WS_XN && WS_XN + (size_t)S * D * 2 <= WS_HID && WS_HID + (size_t)S * FF * 2 <= WS_P && WS_P + (size_t)S * NINP * 2 <= WS_Z, "ws map 3");
static_assert(WS_Z + (size_t)4 * S * 512 * 2 <= WS_VVN && WS_MLARAW + (size_t)S * NMLA * 4 <= WS_VT && WS_KP + (size_t)4 * S * QKP * 2 <= WS_END && WS_ORAW + (size_t)4 * S * 256 * 4 <= WS_MERGED && WS_MERGED + (size_t)S * D * 4 <= WS_MERGEDB && WS_MERGEDB + (size_t)S * D * 2 <= WS_PEXP && WS_PEXP + (size_t)4 * S * S * 2 <= WS_QP, "ws map 4");
constexpr size_t WS_SETD = 956 * MiB;
static_assert(WS_WGU1 + WS_SETD >= WS_PEXP + (size_t)2 * 4 * S * 128 * 4 && WS_X + WS_SETD <= WS_QP, "second weight set");
#ifndef TAILCONV
#define TAILCONV 0
#endif
constexpr int CPARTS = 416;
constexpr int CW_BAR = 4096;

constexpr int NWAVES = 8;
constexpr int RING_OFF = 0, RING_BYTES = 131072;
constexpr int LDS_BYTES = 163840;
constexpr int LDSCTL_OFF = LDS_BYTES - 1024, MISC_OFF = LDSCTL_OFF + 320;
constexpr int RSTD_OFF = RING_BYTES + 1024;

enum { I_X = 0, I_F1N, I_F1G, I_F1U, I_F1D, I_MIXN, I_WIN, I_POOLW, I_POOLS, I_DQN, I_DKN, I_SGUN, I_SGUW, I_SGUB, I_MQAN, I_MWUQ, I_MKVAN, I_MWUKV, I_MQN, I_MKN, I_WBR, I_WOUT, I_F2N, I_F2G, I_F2U, I_F2D, N_INPUTS };

struct Frame {
    LAS unsigned char* lds;
    volatile LAS unsigned* MISC;
    int wave, vcu, G;
    int gw, NGW, NGT;
};
constexpr int NPHASE = 13;
struct Args { const float* in[N_INPUTS]; float* out; unsigned char* ws; int l_lo, l_hi, ph_lo, ph_hi; };
typedef const __attribute__((address_space(4))) Args* ArgsP;
__device__ __forceinline__ ArgsP fresh_args() { ArgsP p = (ArgsP)__builtin_amdgcn_kernarg_segment_ptr(); asm volatile("" : "+s"(p)); return p; }
__device__ __forceinline__ int opq_s(int x) { asm volatile("" : "+s"(x)); return x; }
__device__ __forceinline__ Frame fresh_frame(const Frame& F) { Frame R = F; R.wave = opq_s(F.wave); R.vcu = opq_s(F.vcu); R.G = opq_s(F.G); R.gw = opq_s(F.gw); R.NGW = opq_s(F.NGW); R.NGT = opq_s(F.NGT); return R; }
__device__ __forceinline__ int opq_lane() { int l = (int)__builtin_amdgcn_mbcnt_hi(~0u, __builtin_amdgcn_mbcnt_lo(~0u, 0u)); asm volatile("" : "+v"(l)); return l; }
__device__ __forceinline__ float wave_sum(float v) {
#pragma unroll
    for (int o = 1; o < 64; o <<= 1) v += __shfl_xor(v, o);
    return v;
}
__device__ __forceinline__ float wave_max(float v) {
#pragma unroll
    for (int o = 1; o < 64; o <<= 1) v = fmaxf(v, __shfl_xor(v, o));
    return v;
}
__device__ __forceinline__ float bf2f(unsigned short b) { return __uint_as_float(((unsigned)b) << 16); }
__device__ __forceinline__ float bflo(unsigned u) { return __uint_as_float(u << 16); }
__device__ __forceinline__ float bfhi(unsigned u) { return __uint_as_float(u & 0xffff0000u); }
__device__ __forceinline__ float rsq(float x) { return 1.0f / sqrtf(x); }

typedef float f32x16 __attribute__((ext_vector_type(16)));
#define MFMA32(a, b, c) __builtin_amdgcn_mfma_f32_32x32x16_bf16((a), (b), (c), 0, 0, 0)
__device__ __forceinline__ void transpose_load(f32x4 (&v)[8], const float* W, int ldw, int k0, int n0, int lane) {
    const int pc = lane & 7, kr = lane >> 3;
#pragma unroll
    for (int i = 0; i < 8; ++i) v[i] = __builtin_nontemporal_load((const GAS f32x4*)(W + (size_t)(k0 + 8 * i + kr) * ldw + n0 + 4 * pc));
}
__device__ __forceinline__ void transpose_store(const f32x4 (&v)[8], int k0, bf16* WT, int ldt, int drow0, int dk0, LAS float* scr, int lane, const float* kgain) {
    const int pc = lane & 7, kr = lane >> 3;
#pragma unroll
    for (int i = 0; i < 8; ++i) { LAS float* d = scr + (8 * i + kr) * 33 + 4 * pc; const float gk = kgain ? kgain[k0 + 8 * i + kr] : 1.0f;
        d[0] = v[i].x * gk; d[1] = v[i].y * gk; d[2] = v[i].z * gk; d[3] = v[i].w * gk; }
    LDS_WAIT(); asm volatile("" ::: "memory");
    const int c = lane & 7;
#pragma unroll
    for (int j = 0; j < 4; ++j) { const int n = (lane >> 3) + 8 * j; const LAS float* s = scr + (8 * c) * 33 + n;
        v4u o; o.x = pk2(s[0 * 33], s[1 * 33]); o.y = pk2(s[2 * 33], s[3 * 33]); o.z = pk2(s[4 * 33], s[5 * 33]); o.w = pk2(s[6 * 33], s[7 * 33]);
        *(GAS v4u*)(WT + (size_t)(drow0 + n) * ldt + dk0 + k0 + 8 * c) = o; }
    LDS_WAIT(); asm volatile("" ::: "memory");
}
template <int MAP> __device__ __forceinline__ int map_row(int n0, int roff) {
    if (MAP == 0) return n0 + roff;
    if (MAP == 1) return (n0 >> 7) * 256 + roff + (n0 & 127);
    return (n0 < 6720) ? (n0 + 8192) : (n0 - 6720);
}
template <int MAP> __device__ __forceinline__ void transpose_matrix(const Frame& F, int vgw, int vNGW, int p0, int p1, int lane, const float* W, int K, int N, bf16* WT, int ldt, int roff, int dk0, const float* kgain = nullptr) {
    LAS float* scr = (LAS float*)(F.lds + RING_OFF + (vgw & 7) * 16384);
    const int nblk = N / 32, items = (K / 64) * nblk, lo = (int)((long)items * p0 / CPARTS), hi = (int)((long)items * p1 / CPARTS);
    int it = lo + vgw; if (it >= hi) return;
    f32x4 va[8], vb[8]; transpose_load(va, W, N, 64 * (it / nblk), 32 * (it % nblk), lane);
    for (;;) {
        const int itn = it + vNGW; const bool more = itn < hi;
        if (more) transpose_load(vb, W, N, 64 * (itn / nblk), 32 * (itn % nblk), lane);
        transpose_store(va, 64 * (it / nblk), WT, ldt, map_row<MAP>(32 * (it % nblk), roff), dk0, scr, lane, kgain);
        if (!more) break;
#pragma unroll
        for (int i = 0; i < 8; ++i) va[i] = vb[i];
        it = itn;
    }
}

struct TDesc { const float* W; const float* kgain; bf16* WT; int N, nblk, ldt, roff, dk0, map, first; };
constexpr int TI_FD = (FF / 64) * (D / 32), TI_FG = (D / 64) * (FF / 32), TI_WO = (D / 64) * (D / 32), TI_BR = (512 / 64) * (D / 32), TI_UQ = (384 / 64) * (768 / 32), TI_UKV = (128 / 64) * (1024 / 32), TI_WIN = (D / 64) * (NIN / 32);
constexpr int TS1 = TI_FD, TS2 = TS1 + TI_FG, TS3 = TS2 + TI_FG, TS4 = TS3 + TI_WO, TS5 = TS4 + TI_BR, TS6 = TS5 + TI_BR, TS7 = TS6 + TI_BR, TS8 = TS7 + TI_UQ, TS9 = TS8 + TI_UKV, TS10 = TS9 + TI_WIN, TS11 = TS10 + TI_FD, TS12 = TS11 + TI_FG, TS_ALL = TS12 + TI_FG;
__device__ __forceinline__ TDesc conv_desc(ArgsP A, unsigned char* ws, int l, int it) {
    TDesc d; d.kgain = nullptr; d.roff = 0; d.dk0 = 0; d.map = 0;
    if (it < TS1)       { d.W = A->in[I_F2D] + (size_t)l * FF * D; d.N = D; d.WT = (bf16*)(ws + WS_WD2); d.ldt = FF; d.first = 0; }
    else if (it < TS2)  { d.W = A->in[I_F2G] + (size_t)l * D * FF; d.N = FF; d.WT = (bf16*)(ws + WS_WGU2); d.ldt = D; d.map = 1; d.kgain = A->in[I_F2N] + (size_t)l * D; d.first = TS1; }
    else if (it < TS3)  { d.W = A->in[I_F2U] + (size_t)l * D * FF; d.N = FF; d.WT = (bf16*)(ws + WS_WGU2); d.ldt = D; d.map = 1; d.roff = 128; d.kgain = A->in[I_F2N] + (size_t)l * D; d.first = TS2; }
    else if (it < TS4)  { d.W = A->in[I_WOUT] + (size_t)l * D * D; d.N = D; d.WT = (bf16*)(ws + WS_WOUT); d.ldt = D; d.first = TS3; }
    else if (it < TS7)  { const int b = (it < TS5) ? 1 : (it < TS6) ? 2 : 3; d.W = A->in[I_WBR] + ((size_t)l * 4 + b) * 512 * D; d.N = D; d.WT = (bf16*)(ws + WS_WBR) + (size_t)b * D * 512; d.ldt = 512; d.first = TS4 + (b - 1) * TI_BR; }
    else if (it < TS8)  { d.W = A->in[I_MWUQ] + (size_t)l * 384 * 768; d.N = 768; d.WT = (bf16*)(ws + WS_WMLA); d.ldt = 512; d.first = TS7; }
    else if (it < TS9)  { d.W = A->in[I_MWUKV] + (size_t)l * 128 * 1024; d.N = 1024; d.WT = (bf16*)(ws + WS_WMLA); d.ldt = 512; d.roff = 768; d.dk0 = 384; d.first = TS8; }
    else if (it < TS10) { d.W = A->in[I_WIN] + (size_t)l * D * NIN; d.N = NIN; d.WT = (bf16*)(ws + WS_WIN); d.ldt = D; d.map = 2; d.kgain = A->in[I_MIXN] + (size_t)l * D; d.first = TS9; }
    else if (it < TS11) { d.W = A->in[I_F1D] + (size_t)l * FF * D; d.N = D; d.WT = (bf16*)(ws + WS_WD1); d.ldt = FF; d.first = TS10; }
    else if (it < TS12) { d.W = A->in[I_F1G] + (size_t)l * D * FF; d.N = FF; d.WT = (bf16*)(ws + WS_WGU1); d.ldt = D; d.map = 1; d.kgain = A->in[I_F1N] + (size_t)l * D; d.first = TS11; }
    else                { d.W = A->in[I_F1U] + (size_t)l * D * FF; d.N = FF; d.WT = (bf16*)(ws + WS_WGU1); d.ldt = D; d.map = 1; d.roff = 128; d.kgain = A->in[I_F1N] + (size_t)l * D; d.first = TS12; }
    d.nblk = d.N / 32;
    return d;
}
__device__ __forceinline__ int map_row_rt(int map, int n0, int roff) { return (map == 0) ? n0 + roff : (map == 1) ? (n0 >> 7) * 256 + roff + (n0 & 127) : ((n0 < 6720) ? (n0 + 8192) : (n0 - 6720)); }
__device__ __forceinline__ void transpose_all(ArgsP A, const Frame& F, unsigned char* ws, int l, int vgw, int vNGW, int p0, int p1, int lane) {
    LAS float* scr = (LAS float*)(F.lds + RING_OFF + (vgw & 7) * 16384);
    const int lo = (int)((long)TS_ALL * p0 / CPARTS), hi = (int)((long)TS_ALL * p1 / CPARTS);
    int it = lo + vgw; if (it >= hi) return;
    TDesc dc = conv_desc(A, ws, l, it); int loc = it - dc.first, kb = loc / dc.nblk, nbk = loc - kb * dc.nblk;
    f32x4 va[8], vb[8]; transpose_load(va, dc.W, dc.N, 64 * kb, 32 * nbk, lane);
    for (;;) {
        const int itn = it + vNGW; const bool more = itn < hi;
        TDesc dn = dc; int kbn = 0, nbn = 0;
        if (more) { dn = conv_desc(A, ws, l, itn); const int ln = itn - dn.first; kbn = ln / dn.nblk; nbn = ln - kbn * dn.nblk; transpose_load(vb, dn.W, dn.N, 64 * kbn, 32 * nbn, lane); }
        transpose_store(va, 64 * kb, dc.WT, dc.ldt, map_row_rt(dc.map, 32 * nbk, dc.roff), dc.dk0, scr, lane, dc.kgain);
        if (!more) break;
#pragma unroll
        for (int i = 0; i < 8; ++i) va[i] = vb[i];
        it = itn; dc = dn; kb = kbn; nbk = nbn;
    }
}

__device__ __forceinline__ void phase_convert(ArgsP A, const Frame& F, int l, int vgw, int vNGW, int p0, int p1) {
    unsigned char* ws = A->ws + (size_t)(l & 1) * WS_SETD; const int lane = opq_lane(); const int vgt = vgw * 64 + lane, vNGT = vNGW * 64;
#define TM(MAP, ...) transpose_matrix<MAP>(F, vgw, vNGW, p0, p1, lane, __VA_ARGS__)
#define PART(n, lo, hi) const int lo = (int)((long)(n) * p0 / CPARTS), hi = (int)((long)(n) * p1 / CPARTS)
    transpose_all(A, F, ws, l, vgw, vNGW, p0, p1, lane);
    { bf16* wm = (bf16*)(ws + WS_WMLA);
      { PART(768 * 128, lo, hi); for (int i = lo + vgt; i < hi; i += vNGT) wm[(size_t)(i >> 7) * 512 + 384 + (i & 127)] = 0; }
      { PART(1024 * 384, lo, hi); for (int i = lo + vgt; i < hi; i += vNGT) wm[(size_t)(768 + i / 384) * 512 + (i % 384)] = 0; }
      unsigned* wz = (unsigned*)((bf16*)(ws + WS_WIN) + (size_t)NIN * D);
      { PART((NINP - NIN) * D / 2, lo, hi); for (int i = lo + vgt; i < hi; i += vNGT) wz[i] = 0u; } }
    { const float* pw = A->in[I_POOLW] + (size_t)l * 4 * 128 * 128; const float* ps = A->in[I_POOLS] + (size_t)l * 512; const float* wb = A->in[I_WBR] + (size_t)l * 4 * 512 * D;
      bf16* wt = (bf16*)(ws + WS_WBR);
      PART(1024, lo, hi);
      if ((vgw & 1) == 0)
      for (int blk = lo + (vgw >> 1); blk < hi; blk += (vNGW >> 1)) {
          const int rb = blk >> 6, nb = blk & 63, g = rb >> 2, ql = lane & 31, h = lane >> 5;
          const float* arow = pw + (size_t)(32 * rb + ql) * 128 + 8 * h;
          const float* bcol = wb + (size_t)(g * 128 + 8 * h) * D + 32 * nb + ql;
          const float* psr = ps + g * 128 + 8 * h;
          f32x16 acc;
#pragma unroll
          for (int e = 0; e < 16; ++e) acc[e] = 0.f;
#pragma unroll
          for (int half = 0; half < 2; ++half) {
              f32x4 av[4][2], pv[4][2]; float bv[4][8];
#pragma unroll
              for (int k4 = 0; k4 < 4; ++k4) { const int ks = 4 * half + k4;
                  av[k4][0] = *(const f32x4*)(arow + 16 * ks); av[k4][1] = *(const f32x4*)(arow + 16 * ks + 4); pv[k4][0] = *(const f32x4*)(psr + 16 * ks); pv[k4][1] = *(const f32x4*)(psr + 16 * ks + 4);
#pragma unroll
                  for (int j = 0; j < 8; ++j) bv[k4][j] = bcol[(size_t)(16 * ks + j) * D]; }
#pragma unroll
              for (int k4 = 0; k4 < 4; ++k4) { v4u ah, al, bh, bl;
#define SPLIT2(x0, x1, HI, LO) { const unsigned h0_ = f2bf(x0), h1_ = f2bf(x1); HI = h0_ | (h1_ << 16); LO = f2bf((x0) - __uint_as_float(h0_ << 16)) | (f2bf((x1) - __uint_as_float(h1_ << 16)) << 16); }
                  SPLIT2(av[k4][0][0], av[k4][0][1], ah.x, al.x) SPLIT2(av[k4][0][2], av[k4][0][3], ah.y, al.y) SPLIT2(av[k4][1][0], av[k4][1][1], ah.z, al.z) SPLIT2(av[k4][1][2], av[k4][1][3], ah.w, al.w)
                  const float b0 = bv[k4][0] * pv[k4][0][0], b1 = bv[k4][1] * pv[k4][0][1], b2 = bv[k4][2] * pv[k4][0][2], b3 = bv[k4][3] * pv[k4][0][3];
                  const float b4 = bv[k4][4] * pv[k4][1][0], b5 = bv[k4][5] * pv[k4][1][1], b6 = bv[k4][6] * pv[k4][1][2], b7 = bv[k4][7] * pv[k4][1][3];
                  SPLIT2(b0, b1, bh.x, bl.x) SPLIT2(b2, b3, bh.y, bl.y) SPLIT2(b4, b5, bh.z, bl.z) SPLIT2(b6, b7, bh.w, bl.w)
#undef SPLIT2
                  const bf16x8 Ah = __builtin_bit_cast(bf16x8, ah), Al = __builtin_bit_cast(bf16x8, al), Bh = __builtin_bit_cast(bf16x8, bh), Bl = __builtin_bit_cast(bf16x8, bl);
                  acc = MFMA32(Al, Bh, acc); acc = MFMA32(Ah, Bl, acc); acc = MFMA32(Ah, Bh, acc); } }
          bf16* o = wt + (size_t)(32 * nb + ql) * 512 + 32 * rb + 4 * h;
#pragma unroll
          for (int q = 0; q < 4; ++q) *(unsigned long long*)(o + 8 * q) = (unsigned long long)pk2(acc[4 * q], acc[4 * q + 1]) | ((unsigned long long)pk2(acc[4 * q + 2], acc[4 * q + 3]) << 32);
      } }
#undef TM
#undef PART
}
__device__ __forceinline__ void tail_convert(ArgsP A, const Frame& F, int l, int bx, int nunits, int p0, int p1) {
#if !TAILCONV
    return;
#endif
    const int busy = nunits % F.G; if (busy == 0 || l + 1 >= NLAYER) return;
    const int slot = bx - busy; if (slot < 0) return;
    phase_convert(A, F, l + 1, slot * NWAVES + F.wave, (F.G - busy) * NWAVES, p0, p1);
}
__device__ __forceinline__ void phase_rope_tables(ArgsP A, const Frame& F) {
    unsigned char* ws = A->ws; const int lane = opq_lane(); const int gw = opq_s(F.gw); const int gt = gw * 64 + lane;
    {
        float* ct = (float*)(ws + WS_COS); float* st = (float*)(ws + WS_SIN);
        for (int i = gt; i < S * 32; i += F.NGT) { const int pos = i >> 5, k = i & 31;
            double f = 1.0; for (int j = 0; j < k; ++j) f *= 0.74989420933245582730;
            const float ang = (float)pos * (float)f;
            const double a = (double)ang; const double kq = __builtin_rint(a * 0.63661977236758134308); const double r = (a - kq * 1.5707963267948966192) - kq * 6.123233995736766e-17;
            const double r2 = r * r;
            const double sn = r * (1.0 + r2 * (-1.0 / 6 + r2 * (1.0 / 120 + r2 * (-1.0 / 5040 + r2 * (1.0 / 362880 + r2 * (-1.0 / 39916800 + r2 * (1.0 / 6227020800.0)))))));
            const double cs = 1.0 + r2 * (-0.5 + r2 * (1.0 / 24 + r2 * (-1.0 / 720 + r2 * (1.0 / 40320 + r2 * (-1.0 / 3628800 + r2 * (1.0 / 479001600.0 + r2 * (-1.0 / 87178291200.0)))))));
            const int q = ((int)kq) & 3;
            const double sv = (q == 0) ? sn : (q == 1) ? cs : (q == 2) ? -sn : -cs;
            const double cv = (q == 0) ? cs : (q == 1) ? -sn : (q == 2) ? -cs : sn;
            ct[i] = (float)cv; st[i] = (float)sv; }
    }
}
__device__ __forceinline__ void phase_prep(const Frame& F, const float* x, bf16* xb, float* ssp) {
    const int lane = opq_lane(); const int gw = opq_s(F.gw);
    for (int m = gw; m < S; m += F.NGW) {
        const GAS f32x4* xr = (const GAS f32x4*)(x + (size_t)m * D) + lane;
        f32x4 v[8]; float s = 0.f;
#pragma unroll
        for (int j = 0; j < 8; ++j) { v[j] = xr[64 * j]; s += (v[j].x * v[j].x + v[j].y * v[j].y) + (v[j].z * v[j].z + v[j].w * v[j].w); }
        s = wave_sum(s);
        GAS unsigned long long* o8 = (GAS unsigned long long*)(xb + (size_t)m * D) + lane;
#pragma unroll
        for (int j = 0; j < 8; ++j) o8[64 * j] = (unsigned long long)pk2(v[j].x, v[j].y) | ((unsigned long long)pk2(v[j].z, v[j].w) << 32);
        if (lane < 32) ssp[(size_t)m * 32 + lane] = (lane == 0) ? s : 0.f;
    }
}
__device__ __forceinline__ void phase_mix1(ArgsP A, const Frame& F, int l) {
    unsigned char* ws = A->ws; const int lane = opq_lane(); const int gw = opq_s(F.gw); const int gt = gw * 64 + lane;
    bf16* p = (bf16*)(ws + WS_P); bf16* z0 = (bf16*)(ws + WS_Z); bf16* vvn = (bf16*)(ws + WS_VVN); bf16* mlaA = (bf16*)(ws + WS_MLAA);
    for (int item = gt; item < (S / 16) * 256; item += F.NGT) {
        const int cp = item & 255, t0 = (item >> 8) * 16, g = cp >> 6;
        const bf16* col = p + PC_POOL + 2 * cp;
        float va[32], vb[32];
#pragma unroll
        for (int k = 0; k < 32; ++k) { const int tt = t0 - 8 + k; const bool in = (tt >= 0) && (tt < S); const unsigned u = in ? *(const unsigned*)(col + (size_t)(in ? tt : 0) * NINP) : 0u; va[k] = bflo(u); vb[k] = bfhi(u); }
        unsigned* zo = (unsigned*)(z0 + (size_t)t0 * 512 + 2 * cp);
#define POOL_GROUP(HW) do { \
        _Pragma("unroll") for (int i = 0; i < 16; ++i) { float sa = 0.f, sb = 0.f; \
            _Pragma("unroll") for (int k = 8 + i - (HW); k < 8 + i + (HW); ++k) { sa += va[k]; sb += vb[k]; }     \
            const int t = t0 + i, lo = (t - (HW)) < 0 ? 0 : (t - (HW)), hi = (t + (HW)) > S ? S : (t + (HW)); const float inv = 1.0f / (float)(hi - lo); \
            zo[(size_t)i * 256] = pk2(sa * inv - va[8 + i], sb * inv - vb[8 + i]); } } while (0)
        if (g == 0) POOL_GROUP(1); else if (g == 1) POOL_GROUP(2); else if (g == 2) POOL_GROUP(4); else POOL_GROUP(8);
#undef POOL_GROUP
    }
    const float* gq = A->in[I_DQN] + l * 128; const float* gk = A->in[I_DKN] + l * 128; const float* gs = A->in[I_SGUN] + l * 512;
    const float* gqa = A->in[I_MQAN] + l * 384; const float* gkva = A->in[I_MKVAN] + l * 128;
    const float gq0 = gq[2 * lane], gq1 = gq[2 * lane + 1], gk0 = gk[2 * lane], gk1 = gk[2 * lane + 1];
    float gsv[8];
#pragma unroll
    for (int k = 0; k < 8; ++k) gsv[k] = gs[8 * lane + k];
    const float ga0 = gqa[2 * lane], ga1 = gqa[2 * lane + 1], ga2 = gqa[128 + 2 * lane], ga3 = gqa[129 + 2 * lane], ga4 = gqa[256 + 2 * lane], ga5 = gqa[257 + 2 * lane];
    const float gv0 = gkva[2 * lane], gv1 = gkva[2 * lane + 1];
    for (int t = gw; t < S; t += F.NGW) {
        bf16* prow = p + (size_t)t * NINP;
        unsigned* ptr = (unsigned*)(prow + PC_DIL) + lane; unsigned uu[24]; float ss[24];
#pragma unroll
        for (int hh = 0; hh < 24; ++hh) uu[hh] = ptr[hh * 64];
        const v4u u = *((const v4u*)(prow + PC_SGU + 512) + lane);
        const unsigned* cq = (const unsigned*)(prow + PC_CQ) + lane; const unsigned u0 = cq[0], u1 = cq[64], u2 = cq[128];
        const unsigned uk = *((const unsigned*)(prow + PC_CKV) + lane);
        asm volatile("" ::: "memory");
        {
#pragma unroll
          for (int hh = 0; hh < 24; ++hh) { const float a = bflo(uu[hh]), b = bfhi(uu[hh]); ss[hh] = a * a + b * b; }
#pragma unroll
          for (int o = 1; o < 64; o <<= 1) {
#pragma unroll
              for (int hh = 0; hh < 24; ++hh) ss[hh] += __shfl_xor(ss[hh], o); }
#pragma unroll
          for (int hh = 0; hh < 24; ++hh) { const float rstd = __builtin_amdgcn_rsqf(ss[hh] * (1.f / 128) + EPS);
              ptr[hh * 64] = pk2(bflo(uu[hh]) * rstd * (hh < 12 ? gq0 : gk0), bfhi(uu[hh]) * rstd * (hh < 12 ? gq1 : gk1)); } }
        { float x[8] = {bflo(u.x), bfhi(u.x), bflo(u.y), bfhi(u.y), bflo(u.z), bfhi(u.z), bflo(u.w), bfhi(u.w)}; float s2 = 0.f;
#pragma unroll
          for (int k = 0; k < 8; ++k) s2 += x[k] * x[k];
          const float a0 = bflo(u0), b0 = bfhi(u0), a1 = bflo(u1), b1 = bfhi(u1), a2 = bflo(u2), b2 = bfhi(u2); const float ak = bflo(uk), bk = bfhi(uk);
          float sq = (a0 * a0 + b0 * b0) + (a1 * a1 + b1 * b1) + (a2 * a2 + b2 * b2), sk = ak * ak + bk * bk;
#pragma unroll
          for (int o = 1; o < 64; o <<= 1) { s2 += __shfl_xor(s2, o); sq += __shfl_xor(sq, o); sk += __shfl_xor(sk, o); }
          const float rstd = __builtin_amdgcn_rsqf(s2 * (1.f / 512) + EPS), rq = __builtin_amdgcn_rsqf(sq * (1.f / 384) + EPS), rk = __builtin_amdgcn_rsqf(sk * (1.f / 128) + EPS);
          v4u o; o.x = pk2(x[0] * rstd * gsv[0], x[1] * rstd * gsv[1]); o.y = pk2(x[2] * rstd * gsv[2], x[3] * rstd * gsv[3]); o.z = pk2(x[4] * rstd * gsv[4], x[5] * rstd * gsv[5]); o.w = pk2(x[6] * rstd * gsv[6], x[7] * rstd * gsv[7]);
          *((v4u*)(vvn + (size_t)t * 512) + lane) = o;
          unsigned* om = (unsigned*)(mlaA + (size_t)t * 512) + lane;
          om[0] = pk2(a0 * rq * ga0, b0 * rq * ga1); om[64] = pk2(a1 * rq * ga2, b1 * rq * ga3); om[128] = pk2(a2 * rq * ga4, b2 * rq * ga5);
          om[192] = pk2(ak * rk * gv0, bk * rk * gv1); }
    }
}
typedef short s16x4 __attribute__((ext_vector_type(4)));
typedef short v4i16_t __attribute__((ext_vector_type(4)));
__device__ __forceinline__ int crow(int reg, int h) { return (reg & 3) + 8 * (reg >> 2) + 4 * h; }
__device__ __forceinline__ bf16x8 pack8(const f32x16& x, int s) {
    v4u p; p.x = epi::cvt_pk_bf16(x[8 * s], x[8 * s + 1]); p.y = epi::cvt_pk_bf16(x[8 * s + 2], x[8 * s + 3]); p.z = epi::cvt_pk_bf16(x[8 * s + 4], x[8 * s + 5]); p.w = epi::cvt_pk_bf16(x[8 * s + 6], x[8 * s + 7]);
    return __builtin_bit_cast(bf16x8, p);
}
__device__ __forceinline__ s16x4 tr_read(const LAS unsigned char* p) { return __builtin_bit_cast(s16x4, __builtin_amdgcn_ds_read_tr16_b64_v4i16((LAS v4i16_t*)p)); }
__device__ __forceinline__ int vimg_off(int key, int piece  ) { return key * 256 + (((piece >> 2) ^ (key & 3)) << 6) + ((piece & 3) << 4); }
__device__ __forceinline__ bf16x8 vt_frag(const LAS unsigned char* img, int key0, int d0, int lane) {
    const int h = lane >> 5, blk = (lane >> 4) & 1, q = (lane & 15) >> 2, pp = lane & 3;
    const int ka = key0 + 4 * h + q, kb = ka + 8;
    const int col = ((d0 ^ q) << 6) + (16 * blk + 4 * pp) * 2;
    const s16x4 lo = tr_read(img + ka * 256 + col), hi = tr_read(img + kb * 256 + col);
    return __builtin_shufflevector(lo, hi, 0, 1, 2, 3, 4, 5, 6, 7);
}
__device__ __forceinline__ int vt_lane_off(int lane, int d0) { const int h = lane >> 5, blk = (lane >> 4) & 1, q = (lane & 15) >> 2, pp = lane & 3; return (4 * h + q) * 256 + ((d0 ^ q) << 6) + (16 * blk + 4 * pp) * 2; }
template <int KEY0> __device__ __forceinline__ bf16x8 vt_frag_o(const LAS unsigned char* img, int voff) {
    const s16x4 lo = tr_read(img + voff + KEY0 * 256), hi = tr_read(img + voff + (KEY0 + 8) * 256);
    return __builtin_shufflevector(lo, hi, 0, 1, 2, 3, 4, 5, 6, 7);
}
__device__ __forceinline__ bf16x8 tr_frag(const LAS unsigned char* img, int ra, int rb, int cb, int lane) {
    const int blk = (lane >> 4) & 1, q = (lane & 15) >> 2, pp = lane & 3;
    const int col = ((cb ^ q) << 6) + (16 * blk + 4 * pp) * 2;
    const s16x4 lo = tr_read(img + (ra + q) * 256 + col), hi = tr_read(img + (rb + q) * 256 + col);
    return __builtin_shufflevector(lo, hi, 0, 1, 2, 3, 4, 5, 6, 7);
}
__device__ __forceinline__ void sgu_mix_mfma(ArgsP A, const Frame& F, int l, int lane) {
    unsigned char* ws = A->ws; const bf16* p = (const bf16*)(ws + WS_P); const bf16* vvn = (const bf16*)(ws + WS_VVN); bf16* z2 = (bf16*)(ws + WS_Z) + (size_t)2 * S * 512;
    const float* sw = A->in[I_SGUW] + (size_t)l * 4 * 128 * 128; const float* sb = A->in[I_SGUB] + (size_t)l * 4 * 128;
    LAS unsigned char* img = F.lds + RING_OFF;
    const int w = F.wave, tid = w * 64 + lane, ql = lane & 31, h = lane >> 5, tb = 32 * (w & 3), cb0 = 2 * (w >> 2);
    for (int unit = F.vcu; unit < 256; unit += F.G) {
        const int n = unit >> 2, g = unit & 3;
#pragma unroll
        for (int i = 0; i < 4; ++i) { const int idx = i * 512 + tid, s = idx >> 4, piece = idx & 15;
            *(LAS v4u*)(img + vimg_off(s, piece)) = *(const v4u*)(vvn + (size_t)(n * 128 + s) * 512 + g * 128 + piece * 8); }
        __syncthreads();
        f32x16 acc0, acc1;
#pragma unroll
        for (int e = 0; e < 16; ++e) { acc0[e] = 0.f; acc1[e] = 0.f; }
        const float* wrow = sw + ((size_t)g * 128 + tb + ql) * 128 + 8 * h;
#pragma unroll
        for (int ks = 0; ks < 8; ++ks) {
            const f32x4 a0 = *(const f32x4*)(wrow + 16 * ks), a1 = *(const f32x4*)(wrow + 16 * ks + 4);
            v4u ap; ap.x = epi::cvt_pk_bf16(a0.x, a0.y); ap.y = epi::cvt_pk_bf16(a0.z, a0.w); ap.z = epi::cvt_pk_bf16(a1.x, a1.y); ap.w = epi::cvt_pk_bf16(a1.z, a1.w);
            const bf16x8 af = __builtin_bit_cast(bf16x8, ap);
            acc0 = MFMA32(af, tr_frag(img, 16 * ks + 8 * h, 16 * ks + 8 * h + 4, cb0, lane), acc0);
            acc1 = MFMA32(af, tr_frag(img, 16 * ks + 8 * h, 16 * ks + 8 * h + 4, cb0 + 1, lane), acc1);
        }
        { const int c0 = g * 128 + 32 * cb0 + ql; float bias[16], u0[16], u1[16];
#pragma unroll
          for (int e = 0; e < 16; ++e) { const int tl = tb + crow(e, h), t = n * 128 + tl; bias[e] = sb[g * 128 + tl];
              u0[e] = bf2f(p[(size_t)t * NINP + PC_SGU + c0]); u1[e] = bf2f(p[(size_t)t * NINP + PC_SGU + c0 + 32]); }
#pragma unroll
          for (int e = 0; e < 16; ++e) { const int tl = tb + crow(e, h), t = n * 128 + tl;
              z2[(size_t)t * 512 + c0] = (bf16)f2bf(u0[e] * (acc0[e] + bias[e])); z2[(size_t)t * 512 + c0 + 32] = (bf16)f2bf(u1[e] * (acc1[e] + bias[e])); } }
        __syncthreads();
    }
}
__device__ __forceinline__ void dil_attention(ArgsP A, const Frame& F, int l, int gw, int lane) {
    unsigned char* ws = A->ws; const bf16* p = (const bf16*)(ws + WS_P);
    float* OP = (float*)(ws + WS_DILO); float* LP = (float*)(ws + WS_DILL);
    LAS unsigned char* img = F.lds + RING_OFF + (gw & 7) * 8192;
    const float* gq = A->in[I_DQN] + l * 128; const float* gk = A->in[I_DKN] + l * 128;
    const float cbound = 11.313708499f * wave_max(fmaxf(fabsf(gq[lane]), fabsf(gq[lane + 64]))) * wave_max(fmaxf(fabsf(gk[lane]), fabsf(gk[lane + 64])));
    const int ql = lane & 31, h = lane >> 5;
    const int nun = ((gw & 7) < 4) ? 2 : 1;
    for (int kk = 0; kk < ((F.G == 256) ? nun : 1 << 30); ++kk) {
        const int unit = (F.G == 256) ? (gw >> 3) * 12 + (gw & 7) + 8 * kk : gw + kk * F.NGW; if (unit >= 12 * 256) break;
        const int hq = unit >> 8, blk = unit & 255, g = hq >> 2, ih = hq & 3, dl = 1 << (2 * g), L = S >> (2 * g), nb = 256 >> (2 * g);
        const int r = blk / nb, b = blk % nb;
        const float slope = __builtin_amdgcn_exp2f(-8.0f * (float)(hq + 1) / 12.0f) * (float)dl;
        const int tq = r + dl * (32 * b + ql);
        bf16x8 qf[8];
        { const v4u* src = (const v4u*)(p + (size_t)tq * NINP + PC_DIL + hq * 128 + 8 * h);
#pragma unroll
          for (int s = 0; s < 8; ++s) qf[s] = __builtin_bit_cast(bf16x8, src[2 * s]); }
        f32x16 o[4]; float lsum = 0.f;
#pragma unroll
        for (int d0 = 0; d0 < 4; ++d0)
#pragma unroll
            for (int e = 0; e < 16; ++e) o[d0][e] = 0.f;
#pragma unroll 1
        for (int c = -2; c <= 2; ++c) {
            const int mb = 32 * (b + c);
            if (mb < 0 || mb >= L) continue;
            f32x16 sacc;
#pragma unroll
            for (int e = 0; e < 16; ++e) sacc[e] = 0.f;
            v4u vreg[8];
#pragma unroll
            for (int i = 0; i < 8; ++i) { const int idx = i * 64 + lane, key = idx >> 4, piece = idx & 15;
                vreg[i] = *(const v4u*)(p + (size_t)(r + dl * (mb + key)) * NINP + PC_DIL + 3072 + hq * 128 + piece * 8); }
            { const int tk = r + dl * (mb + ql);
              const v4u* src = (const v4u*)(p + (size_t)tk * NINP + PC_DIL + 1536 + hq * 128 + 8 * h);
              bf16x8 kf[8];
#pragma unroll
              for (int s = 0; s < 8; ++s) kf[s] = __builtin_bit_cast(bf16x8, src[2 * s]);
#pragma unroll
              for (int s = 0; s < 8; ++s) sacc = MFMA32(kf[s], qf[s], sacc); }
#pragma unroll
            for (int i = 0; i < 8; ++i) { const int idx = i * 64 + lane, key = idx >> 4, piece = idx & 15; *(LAS v4u*)(img + vimg_off(key, piece)) = vreg[i]; }
#pragma unroll
            for (int e = 0; e < 16; ++e) { const int rel = 32 * c + crow(e, h) - ql, arel = rel < 0 ? -rel : rel;
                const float sv = sacc[e] * 0.08838834764831845f - slope * (float)arel - cbound;
                const float pe = (arel <= 64) ? epi::fast_exp(sv) : 0.f; sacc[e] = pe; lsum += pe; }
            const bf16x8 pb0 = pack8(sacc, 0), pb1 = pack8(sacc, 1);
#pragma unroll
            for (int d0 = 0; d0 < 4; ++d0) { o[d0] = MFMA32(vt_frag(img, 0, d0, lane), pb0, o[d0]); o[d0] = MFMA32(vt_frag(img, 16, d0, lane), pb1, o[d0]); }
        }
        lsum += __shfl_xor(lsum, 32);
        float* orow = OP + ((size_t)g * S + tq) * 512 + ih * 128 + 4 * h;
#pragma unroll
        for (int d0 = 0; d0 < 4; ++d0)
#pragma unroll
            for (int k = 0; k < 4; ++k) { f32x4 v; v.x = o[d0][4 * k]; v.y = o[d0][4 * k + 1]; v.z = o[d0][4 * k + 2]; v.w = o[d0][4 * k + 3]; *(f32x4*)(orow + 32 * d0 + 8 * k) = v; }
        if (h == 0) LP[((size_t)g * S + tq) * 4 + ih] = lsum;
    }
}
__device__ __forceinline__ void phase_mix2(ArgsP A, const Frame& F, int l) {
    unsigned char* ws = A->ws; const int lane = opq_lane(); const int gw = opq_s(F.gw); const int gt = gw * 64 + lane;
    const bf16* p = (const bf16*)(ws + WS_P); const float* raw = (const float*)(ws + WS_MLARAW);
    const float* ct = (const float*)(ws + WS_COS); const float* st = (const float*)(ws + WS_SIN);
    const float* gqn = A->in[I_MQN] + l * 192; const float* gkn = A->in[I_MKN] + l * 192;
    const float QSCL = 0.07216878364870322f * 1.4426950408889634f;
    bf16* MQ = (bf16*)(ws + WS_MQ); bf16* MK = (bf16*)(ws + WS_MK); bf16* MV = (bf16*)(ws + WS_MV);
    sgu_mix_mfma(A, F, l, lane);
    const int w8 = gw & 7, tok0 = (gw >> 3) * 32 + (w8 < 4 ? 2 * w8 : 8 + 6 * (w8 - 4)), npair = (w8 < 4) ? 1 : 3;
    const float gq0 = gqn[lane], gq1 = gqn[lane + 64], gq2 = gqn[lane + 128], gk0 = gkn[lane], gk1 = gkn[lane + 64], gk2 = gkn[lane + 128];
    for (int jj = 0; jj < ((F.G == 256) ? npair : 1 << 30); ++jj) { const int tb = (F.G == 256) ? tok0 + 2 * jj : 2 * (gw + jj * F.NGW); if (tb >= S) break;
        float cs[2], sn[2], krv[2], q0[2][4], q1[2][4], q2[2][4], k0[2][4], k1[2][4], v0[2][4], v1[2][4], sq[2][4], sk[2][4];
#pragma unroll
        for (int u = 0; u < 2; ++u) { const int t = tb + u; cs[u] = ct[t * 32 + (lane & 31)]; sn[u] = st[t * 32 + (lane & 31)];
            const float* rr = raw + (size_t)t * NMLA; krv[u] = bf2f(p[(size_t)t * NINP + PC_KR + lane]);
#pragma unroll
            for (int h = 0; h < 4; ++h) { q0[u][h] = rr[h * 192 + lane]; q1[u][h] = rr[h * 192 + 64 + lane]; q2[u][h] = rr[h * 192 + 128 + lane];
                k0[u][h] = rr[768 + h * 256 + lane]; k1[u][h] = rr[768 + h * 256 + 64 + lane]; v0[u][h] = rr[768 + h * 256 + 128 + lane]; v1[u][h] = rr[768 + h * 256 + 192 + lane]; } }
#pragma unroll
        for (int u = 0; u < 2; ++u)
#pragma unroll
            for (int h = 0; h < 4; ++h) { sq[u][h] = q0[u][h] * q0[u][h] + q1[u][h] * q1[u][h] + q2[u][h] * q2[u][h]; sk[u][h] = k0[u][h] * k0[u][h] + k1[u][h] * k1[u][h] + krv[u] * krv[u]; }
#pragma unroll
        for (int o = 1; o < 64; o <<= 1) {
#pragma unroll
            for (int u = 0; u < 2; ++u)
#pragma unroll
                for (int h = 0; h < 4; ++h) { sq[u][h] += __shfl_xor(sq[u][h], o); sk[u][h] += __shfl_xor(sk[u][h], o); } }
#pragma unroll
        for (int u = 0; u < 2; ++u) { const int t = tb + u;
#pragma unroll
        for (int h = 0; h < 4; ++h) {
            const float rq = rsq(sq[u][h] * (1.f / 192) + EPS) * QSCL, rk = rsq(sk[u][h] * (1.f / 192) + EPS);
            const float a2 = q2[u][h] * rq * gq2, oa = __shfl_xor(a2, 32), a2r = (lane < 32) ? (a2 * cs[u] - oa * sn[u]) : (oa * sn[u] + a2 * cs[u]);
            const float b2 = krv[u] * rk * gk2, ob = __shfl_xor(b2, 32), b2r = (lane < 32) ? (b2 * cs[u] - ob * sn[u]) : (ob * sn[u] + b2 * cs[u]);
            bf16* qo = MQ + ((size_t)h * S + t) * 192; bf16* ko = MK + ((size_t)h * S + t) * 192; bf16* vo = MV + ((size_t)h * S + t) * 128;
            qo[lane] = (bf16)f2bf(q0[u][h] * rq * gq0); qo[lane + 64] = (bf16)f2bf(q1[u][h] * rq * gq1); qo[lane + 128] = (bf16)f2bf(a2r);
            ko[lane] = (bf16)f2bf(k0[u][h] * rk * gk0); ko[lane + 64] = (bf16)f2bf(k1[u][h] * rk * gk1); ko[lane + 128] = (bf16)f2bf(b2r);
            vo[lane] = (bf16)f2bf(v0[u][h]); vo[lane + 64] = (bf16)f2bf(v1[u][h]); } }
    }
    dil_attention(A, F, l, gw, lane);
}


constexpr int MLA_KROW = 400, MLA_KIMG = 64 * MLA_KROW, MLA_VIMG = 64 * 256;
constexpr int FL_V0 = 2 * MLA_KIMG, FL_P0 = FL_V0 + 2 * MLA_VIMG, FL_PBUF = 8 * 1024, FL_END = FL_P0 + 4 * 2 * FL_PBUF;
constexpr int FL_FLAG = FL_END;
static_assert(FL_FLAG + 64 <= LDSCTL_OFF, "flash LDS map");
#define FL_SB() __builtin_amdgcn_sched_barrier(0)
__device__ __forceinline__ void flash_scores(LAS unsigned char* lds, const bf16* MQ, const bf16* MK, const bf16* MV, float* LP, float c2, int vcu, int G, int w, int lane) {
    const int ql = lane & 31, hh = lane >> 5;
    LAS unsigned char* pw = lds + FL_P0 + w * 2 * FL_PBUF + lane * 16;
    volatile LAS unsigned* flag = (volatile LAS unsigned*)(lds + FL_FLAG + 16 * w); unsigned gen = 0u;
    for (int unit = vcu; unit < 256; unit += G) {
        const int kh = unit & 1, qb = (unit >> 1) & 31, h = unit >> 6;
        const bf16* Kg = MK + ((size_t)h * S + kh * 4096) * 192; const bf16* Vg = MV + ((size_t)h * S + kh * 4096) * 128;
        const int tq = qb * 256 + w * 64 + ql;
        bf16x8 qf0[12], qf1[12];
        { const v4u* src = (const v4u*)(MQ + ((size_t)h * S + tq) * 192 + 8 * hh);
#pragma unroll
          for (int s = 0; s < 12; ++s) { qf0[s] = __builtin_bit_cast(bf16x8, src[2 * s]); qf1[s] = __builtin_bit_cast(bf16x8, src[2 * s + 32 * 24]); } }
        float lsum0 = 0.f, lsum1 = 0.f;
        if (unit == vcu) *flag = 0u;
        __syncthreads();
#pragma unroll 1
        for (int jt = 0; jt < 64; ++jt) {
            const LAS unsigned char* kr0 = lds + (jt & 1) * MLA_KIMG + ql * MLA_KROW + 16 * hh;
            f32x16 s00, s01, s10, s11;
#pragma unroll
            for (int e = 0; e < 16; ++e) { s00[e] = -c2; s01[e] = -c2; s10[e] = -c2; s11[e] = -c2; }
#define KFRAG(f) (*(const LAS bf16x8*)(kr0 + ((f) >= 12 ? 32 * MLA_KROW : 0) + 32 * ((f) % 12)))
#define KLOAD(dst, f0) do { _Pragma("unroll") for (int i_ = 0; i_ < 4; ++i_) dst[i_] = KFRAG((f0) + i_); } while (0)
#define KMMA(src, f0) do { _Pragma("unroll") for (int i_ = 0; i_ < 4; ++i_) { if ((f0) + i_ < 12) { s00 = MFMA32(src[i_], qf0[((f0) + i_) % 12], s00); s10 = MFMA32(src[i_], qf1[((f0) + i_) % 12], s10); } \
                                                                               else { s01 = MFMA32(src[i_], qf0[((f0) + i_) % 12], s01); s11 = MFMA32(src[i_], qf1[((f0) + i_) % 12], s11); } } } while (0)
            bf16x8 kA[4], kB[4];
            KLOAD(kA, 0);
            KLOAD(kB, 4);  FL_SB(); KMMA(kA, 0);  FL_SB();
            KLOAD(kA, 8);  FL_SB(); KMMA(kB, 4);  FL_SB();
            KLOAD(kB, 12); FL_SB(); KMMA(kA, 8);  FL_SB();
            KLOAD(kA, 16); FL_SB(); KMMA(kB, 12); FL_SB();
            KLOAD(kB, 20); FL_SB(); KMMA(kA, 16); FL_SB();
            KMMA(kB, 20); FL_SB();
            *flag = ++gen; FL_SB();
#undef KFRAG
#undef KLOAD
#undef KMMA
            LAS unsigned char* pb = pw + (jt & 1) * FL_PBUF;
#define EXPW(sx, ls, f0) { _Pragma("unroll") for (int e = 0; e < 16; ++e) { const float p_ = __builtin_amdgcn_exp2f(sx[e]); sx[e] = p_; ls += p_; } \
                           *(LAS bf16x8*)(pb + (f0) * 1024) = pack8(sx, 0); *(LAS bf16x8*)(pb + ((f0) + 1) * 1024) = pack8(sx, 1); }
            EXPW(s00, lsum0, 0) EXPW(s01, lsum0, 2) EXPW(s10, lsum1, 4) EXPW(s11, lsum1, 6)
#undef EXPW
            __syncthreads();
        }
        lsum0 += __shfl_xor(lsum0, 32); lsum1 += __shfl_xor(lsum1, 32);
        if (hh == 0) { LP[((size_t)kh * 4 + h) * S + tq] = lsum0; LP[((size_t)kh * 4 + h) * S + tq + 32] = lsum1; }
    }
}
__device__ __forceinline__ void flash_pv(LAS unsigned char* lds, const bf16* MK, const bf16* MV, float* OP, int vcu, int G, int pw, int lane) {
    const int ql = lane & 31, hh = lane >> 5;
    int ksrc[7], vsrc[4];
#pragma unroll
    for (int i = 0; i < 7; ++i) { const int L = (pw + 4 * i) * 1024 + 16 * lane, row = L / MLA_KROW, within = L - row * MLA_KROW; ksrc[i] = (row < 64 ? row : 0) * 192 + (within < 384 ? within / 2 : 0); }
#pragma unroll
    for (int i = 0; i < 4; ++i) { const int L = (pw + 4 * i) * 1024 + 16 * lane, key = L >> 8, pos = (L & 255) >> 4; vsrc[i] = key * 128 + ((((pos >> 2) ^ (key & 3)) << 2) | (pos & 3)) * 8; }
#define FL_DMAK(jt_) { const bf16* kg_ = Kg + (size_t)(jt_) * 64 * 192; LAS unsigned char* kd_ = lds + ((jt_) & 1) * MLA_KIMG; \
        _Pragma("unroll") for (int i_ = 0; i_ < 6; ++i_) __builtin_amdgcn_global_load_lds((const unsigned*)(kg_ + ksrc[i_]), (LAS unsigned*)(kd_ + (pw + 4 * i_) * 1024), 16, 0, 0); \
        if (pw == 0) __builtin_amdgcn_global_load_lds((const unsigned*)(kg_ + ksrc[6]), (LAS unsigned*)(kd_ + 24 * 1024), 16, 0, 0); }
#define FL_DMAV(jt_) { const bf16* vg_ = Vg + (size_t)(jt_) * 64 * 128; LAS unsigned char* vd_ = lds + FL_V0 + ((jt_) & 1) * MLA_VIMG; \
        _Pragma("unroll") for (int i_ = 0; i_ < 4; ++i_) __builtin_amdgcn_global_load_lds((const unsigned*)(vg_ + vsrc[i_]), (LAS unsigned*)(vd_ + (pw + 4 * i_) * 1024), 16, 0, 0); }
    int voff[4];
#pragma unroll
    for (int d0 = 0; d0 < 4; ++d0) voff[d0] = vt_lane_off(lane, d0);
    const LAS unsigned char* pr = lds + FL_P0 + pw * 2 * FL_PBUF + lane * 16;
    volatile LAS unsigned* flag = (volatile LAS unsigned*)(lds + FL_FLAG + 16 * pw); unsigned gen = 0u;
    for (int unit = vcu; unit < 256; unit += G) {
        const int kh = unit & 1, qb = (unit >> 1) & 31, h = unit >> 6;
        const bf16* Kg = MK + ((size_t)h * S + kh * 4096) * 192; const bf16* Vg = MV + ((size_t)h * S + kh * 4096) * 128;
        const int tq = qb * 256 + pw * 64 + ql;
        f32x16 o0[4], o1[4];
#pragma unroll
        for (int d0 = 0; d0 < 4; ++d0)
#pragma unroll
            for (int e = 0; e < 16; ++e) { o0[d0][e] = 0.f; o1[d0][e] = 0.f; }
        FL_DMAK(0) VM_WAIT();
        __syncthreads();
#define PV_TILE(t_, WAITGEN) { const LAS unsigned char* pb = pr + ((t_) & 1) * FL_PBUF; const LAS unsigned char* vimg = lds + FL_V0 + ((t_) & 1) * MLA_VIMG; \
            bf16x8 pf[8]; _Pragma("unroll") for (int f = 0; f < 8; ++f) pf[f] = *(const LAS bf16x8*)(pb + f * 1024); \
            if (WAITGEN) { while (*flag < gen) __builtin_amdgcn_s_sleep(1); } \
            _Pragma("unroll") for (int dd = 0; dd < 4; ++dd) { bf16x8 vf[4]; \
                vf[0] = vt_frag_o<0>(vimg, voff[dd]); vf[1] = vt_frag_o<16>(vimg, voff[dd]); vf[2] = vt_frag_o<32>(vimg, voff[dd]); vf[3] = vt_frag_o<48>(vimg, voff[dd]); \
                _Pragma("unroll") for (int ks = 0; ks < 4; ++ks) { o0[dd] = MFMA32(vf[ks], pf[ks], o0[dd]); o1[dd] = MFMA32(vf[ks], pf[4 + ks], o1[dd]); } } }
#pragma unroll 1
        for (int jt = 0; jt < 64; ++jt) {
            if (jt + 1 < 64) FL_DMAK(jt + 1)
            FL_DMAV(jt)
            ++gen;
            if (jt > 0) PV_TILE(jt - 1, true)
            VM_WAIT();
            __syncthreads();
        }
        PV_TILE(63, false)
#undef PV_TILE
#pragma unroll
        for (int b = 0; b < 2; ++b) { float* orow = OP + (((size_t)kh * 4 + h) * S + tq + 32 * b) * 128 + 4 * hh;
#pragma unroll
            for (int d0 = 0; d0 < 4; ++d0)
#pragma unroll
                for (int k = 0; k < 4; ++k) { const f32x16& oo = b ? o1[d0] : o0[d0]; f32x4 v; v.x = oo[4 * k]; v.y = oo[4 * k + 1]; v.z = oo[4 * k + 2]; v.w = oo[4 * k + 3]; *(f32x4*)(orow + 32 * d0 + 8 * k) = v; } }
    }
}
__device__ __forceinline__ void phase_mla_flash(ArgsP A, const Frame& F, int l) {
    unsigned char* ws = A->ws; const int lane = opq_lane();
    const bf16* MQ = (const bf16*)(ws + WS_MQ); const bf16* MK = (const bf16*)(ws + WS_MK); const bf16* MV = (const bf16*)(ws + WS_MV);
    float* OP = (float*)(ws + WS_MOP); float* LP = (float*)(ws + WS_MLP);
    const float* gqn = A->in[I_MQN] + l * 192; const float* gkn = A->in[I_MKN] + l * 192;
    const float c2 = 19.990625f * wave_max(fmaxf(fmaxf(fabsf(gqn[lane]), fabsf(gqn[lane + 64])), fabsf(gqn[lane + 128]))) * wave_max(fmaxf(fmaxf(fabsf(gkn[lane]), fabsf(gkn[lane + 64])), fabsf(gkn[lane + 128])));
    if (F.wave < 4) flash_scores(F.lds, MQ, MK, MV, LP, c2, F.vcu, F.G, F.wave, lane);
    else flash_pv(F.lds, MK, MV, OP, F.vcu, F.G, F.wave - 4, lane);
    __syncthreads();
}
#undef FL_SB
#undef FL_DMAK
#undef FL_DMAV
__device__ __forceinline__ void dil_combine(ArgsP A, const Frame& F) {
    unsigned char* ws = A->ws; const int lane = opq_lane(); const int gw = opq_s(F.gw); const int gt = gw * 64 + lane;
    const float* OP = (const float*)(ws + WS_DILO); const float* LP = (const float*)(ws + WS_DILL); bf16* z1 = (bf16*)(ws + WS_Z) + (size_t)1 * S * 512;
    for (int base = gt; base < S * 64; base += 2 * F.NGT) {
        f32x4 a[2][6]; float den[2][3];
#pragma unroll
        for (int k = 0; k < 2; ++k) { const int it = base + k * F.NGT, itc = it < S * 64 ? it : gt, t = itc >> 6, ih = (itc & 63) >> 4; const size_t idx = (size_t)itc * 8;
#pragma unroll
            for (int g = 0; g < 3; ++g) { a[k][2 * g] = *(const f32x4*)(OP + (size_t)g * S * 512 + idx); a[k][2 * g + 1] = *(const f32x4*)(OP + (size_t)g * S * 512 + idx + 4); den[k][g] = LP[((size_t)g * S + t) * 4 + ih]; } }
#pragma unroll
        for (int k = 0; k < 2; ++k) { const int it = base + k * F.NGT; if (it >= S * 64) break;
            const float inv = 1.0f / ((den[k][0] + den[k][1]) + den[k][2]); const f32x4 lo = ((a[k][0] + a[k][2]) + a[k][4]) * inv, hi = ((a[k][1] + a[k][3]) + a[k][5]) * inv;
            v4u o; o.x = pk2(lo[0], lo[1]); o.y = pk2(lo[2], lo[3]); o.z = pk2(hi[0], hi[1]); o.w = pk2(hi[2], hi[3]);
            *(v4u*)(z1 + (size_t)it * 8) = o; }
    }
}
__device__ __forceinline__ void phase_mix3(ArgsP A, const Frame& F) {
    unsigned char* ws = A->ws; const int lane = opq_lane(); const int gw = opq_s(F.gw); const int gt = gw * 64 + lane;
    const float* MO = (const float*)(ws + WS_MOP); const float* ML = (const float*)(ws + WS_MLP); bf16* z3 = (bf16*)(ws + WS_Z) + (size_t)3 * S * 512;
    for (int base = gt; base < S * 64; base += 4 * F.NGT) {
        f32x4 a[4][4]; float den[4][2];
#pragma unroll
        for (int k = 0; k < 4; ++k) { const int it = base + k * F.NGT, itc = it < S * 64 ? it : gt, t = itc >> 6, c8 = (itc & 63) * 8, h = c8 >> 7, d = c8 & 127;
            const size_t r0 = (size_t)h * S + t, r1 = ((size_t)4 + h) * S + t;
            a[k][0] = *(const f32x4*)(MO + r0 * 128 + d); a[k][1] = *(const f32x4*)(MO + r0 * 128 + d + 4); a[k][2] = *(const f32x4*)(MO + r1 * 128 + d); a[k][3] = *(const f32x4*)(MO + r1 * 128 + d + 4);
            den[k][0] = ML[r0]; den[k][1] = ML[r1]; }
#pragma unroll
        for (int k = 0; k < 4; ++k) { const int it = base + k * F.NGT; if (it >= S * 64) break;
            const float inv = 1.0f / (den[k][0] + den[k][1]); const f32x4 lo = (a[k][0] + a[k][2]) * inv, hi = (a[k][1] + a[k][3]) * inv;
            v4u o; o.x = pk2(lo[0], lo[1]); o.y = pk2(lo[2], lo[3]); o.z = pk2(hi[0], hi[1]); o.w = pk2(hi[2], hi[3]);
            *(v4u*)(z3 + (size_t)it * 8) = o; }
    }
}

__global__ void __launch_bounds__(NWAVES * 64, 2) mk_fwd(Args args_unused) {
    extern __shared__ __attribute__((aligned(16))) unsigned char lds[];
    Frame F;
    F.lds = (LAS unsigned char*)lds;
    F.MISC = (volatile LAS unsigned*)(F.lds + MISC_OFF);
    F.wave = __builtin_amdgcn_readfirstlane((int)(threadIdx.x >> 6));
    F.G = gridDim.x; { const int bx = blockIdx.x; F.vcu = (F.G % 8 == 0) ? (bx % 8) * (F.G / 8) + bx / 8 : bx; }
    F.gw = F.vcu * NWAVES + F.wave; F.NGW = F.G * NWAVES; F.NGT = F.NGW * 64;
    for (int u = threadIdx.x; u < (LDS_BYTES - LDSCTL_OFF) / 4; u += NWAVES * 64) ((LAS unsigned*)(F.lds + LDSCTL_OFF))[u] = 0u;
    __syncthreads();
    int l_lo, l_hi; bool multi; XcdBarrier bar;
    { ArgsP A = fresh_args(); l_lo = A->l_lo; l_hi = A->l_hi;
      multi = !((l_hi - l_lo) == 1 && (A->ph_hi - A->ph_lo) == 1);
      unsigned* bw = (unsigned*)((gu32*)(A->ws + WS_CTL) + CW_BAR);
      bar.bar = bw; bar.x = 0; bar.st = F.MISC + 8;
      if (multi) bar = xcd_barrier_post(bw, F.MISC + 8); }
#define SEAM() do { if (multi) xcd_barrier(bar); } while (0)
#ifdef ONLY_PHASE
#define IN(k) ((k) == ONLY_PHASE && lo <= (k) && (k) < hi)
#else
#define IN(k) (lo <= (k) && (k) < hi)
#endif
#ifndef G_ALIGN
#define G_ALIGN true
#endif
#ifndef G_SP2
#define G_SP2 true
#endif
#define GEMM(EPI, ORDER) pg8::gemm_phase<EPI, ORDER, G_ALIGN, G_SP2>(Fl.lds + RING_OFF, g, So, E, Fl.wave)
    { ArgsP A = fresh_args(); if (A->l_lo == 0 && A->ph_lo == 0) phase_rope_tables(A, F); }
    for (int l = l_lo; l < l_hi; ++l) {
        int lo, hi; { ArgsP A = fresh_args(); lo = A->ph_lo; hi = A->ph_hi; }
        if (IN(0)) { ArgsP A = fresh_args(); const Frame Fl = fresh_frame(F); unsigned char* ws = A->ws;
            phase_convert(A, Fl, l, Fl.gw, Fl.NGW, 0, CPARTS);
            if (l == 0) phase_prep(Fl, A->in[I_X], (bf16*)(ws + WS_XN), (float*)(ws + WS_SSP));
            SEAM(); }
        if (IN(1)) { ArgsP A = fresh_args(); const Frame Fl = fresh_frame(F); const int bx = opq_s((int)blockIdx.x); unsigned char* ws = A->ws;
            pg8::Gemm g{(const bf16*)(ws + WS_XN), (const bf16*)(ws + (size_t)(l & 1) * WS_SETD + WS_WGU1), S, NGU, D};
            pg8::StaticOrder So; So.init(S, NGU, Fl.G, bx); epi::fill_rstd_table(So, (const float*)(ws + WS_SSP), (LAS float*)(Fl.lds + RSTD_OFF), Fl.wave); __syncthreads();
            epi::EpiSwiglu E{(bf16*)(ws + WS_HID), (const LAS float*)(Fl.lds + RSTD_OFF)}; GEMM(epi::EpiSwiglu, pg8::StaticOrder); tail_convert(A, Fl, l, bx, (S / 256) * (NGU / 256), 0, 128); SEAM(); }
        if (IN(2)) { ArgsP A = fresh_args(); const Frame Fl = fresh_frame(F); const int bx = opq_s((int)blockIdx.x); unsigned char* ws = A->ws; const float* xin = (l == 0) ? A->in[I_X] : (const float*)(ws + WS_X);
            pg8::Gemm g{(const bf16*)(ws + WS_HID), (const bf16*)(ws + (size_t)(l & 1) * WS_SETD + WS_WD1), S, D, FF}; pg8::StaticOrder So; So.init(S, D, Fl.G, bx);
            epi::EpiResid E{xin, (float*)(ws + WS_X), 0.5f, (bf16*)(ws + WS_XN), (float*)(ws + WS_SSP)}; GEMM(epi::EpiResid, pg8::StaticOrder); SEAM(); }
        if (IN(3)) { ArgsP A = fresh_args(); const Frame Fl = fresh_frame(F); const int bx = opq_s((int)blockIdx.x); unsigned char* ws = A->ws;
            pg8::Gemm g{(const bf16*)(ws + WS_XN), (const bf16*)(ws + (size_t)(l & 1) * WS_SETD + WS_WIN), S, NINP, D};
            pg8::StaticOrder So; So.init(S, NINP, Fl.G, bx); epi::fill_rstd_table(So, (const float*)(ws + WS_SSP), (LAS float*)(Fl.lds + RSTD_OFF), Fl.wave); __syncthreads();
            epi::EpiPin E{(bf16*)(ws + WS_P), (const LAS float*)(Fl.lds + RSTD_OFF)}; GEMM(epi::EpiPin, pg8::StaticOrder); tail_convert(A, Fl, l, bx, (S / 256) * (NINP / 256), 128, 288); SEAM(); }
        if (IN(4)) { ArgsP A = fresh_args(); const Frame Fl = fresh_frame(F); phase_mix1(A, Fl, l); SEAM(); }
        if (IN(5)) { ArgsP A = fresh_args(); const Frame Fl = fresh_frame(F); const int bx = opq_s((int)blockIdx.x); unsigned char* ws = A->ws;
            pg8::Gemm g{(const bf16*)(ws + WS_MLAA), (const bf16*)(ws + (size_t)(l & 1) * WS_SETD + WS_WMLA), S, NMLA, opq_s(512)}; pg8::StaticOrder So; So.init(S, NMLA, Fl.G, bx);
            epi::EpiF32 E{(float*)(ws + WS_MLARAW), NMLA, 1}; GEMM(epi::EpiF32, pg8::StaticOrder); SEAM(); }
        if (IN(6)) { ArgsP A = fresh_args(); const Frame Fl = fresh_frame(F); phase_mix2(A, Fl, l); SEAM(); }
        if (IN(7)) { ArgsP A = fresh_args(); const Frame Fl = fresh_frame(F); phase_mla_flash(A, Fl, l); dil_combine(A, Fl); SEAM(); }
        if (IN(8)) { ArgsP A = fresh_args(); const Frame Fl = fresh_frame(F); phase_mix3(A, Fl); SEAM(); }
        if (IN(9)) { ArgsP A = fresh_args(); const Frame Fl = fresh_frame(F); const int bx = opq_s((int)blockIdx.x); unsigned char* ws = A->ws;
            pg8::Gemm g{(const bf16*)(ws + WS_Z), (const bf16*)(ws + (size_t)(l & 1) * WS_SETD + WS_WBR), 4 * S, 4 * D, opq_s(512)}; epi::BranchOrder So; So.so.init(S, D, Fl.G, bx);
            epi::EpiBranchChain E{(bf16*)(ws + WS_MERGEDB), (const bf16*)(ws + WS_P) + PC_GATE}; GEMM(epi::EpiBranchChain, epi::BranchOrder); SEAM(); }
        if (IN(10)) { ArgsP A = fresh_args(); const Frame Fl = fresh_frame(F); const int bx = opq_s((int)blockIdx.x); unsigned char* ws = A->ws;
            pg8::Gemm g{(const bf16*)(ws + WS_MERGEDB), (const bf16*)(ws + (size_t)(l & 1) * WS_SETD + WS_WOUT), S, D, D}; pg8::StaticOrder So; So.init(S, D, Fl.G, bx);
            epi::EpiResid E{(const float*)(ws + WS_X), (float*)(ws + WS_X), 1.0f, (bf16*)(ws + WS_XN), (float*)(ws + WS_SSP)}; GEMM(epi::EpiResid, pg8::StaticOrder); SEAM(); }
        if (IN(11)) { ArgsP A = fresh_args(); const Frame Fl = fresh_frame(F); const int bx = opq_s((int)blockIdx.x); unsigned char* ws = A->ws;
            pg8::Gemm g{(const bf16*)(ws + WS_XN), (const bf16*)(ws + (size_t)(l & 1) * WS_SETD + WS_WGU2), S, NGU, D};
            pg8::StaticOrder So; So.init(S, NGU, Fl.G, bx); epi::fill_rstd_table(So, (const float*)(ws + WS_SSP), (LAS float*)(Fl.lds + RSTD_OFF), Fl.wave); __syncthreads();
            epi::EpiSwiglu E{(bf16*)(ws + WS_HID), (const LAS float*)(Fl.lds + RSTD_OFF)}; GEMM(epi::EpiSwiglu, pg8::StaticOrder); tail_convert(A, Fl, l, bx, (S / 256) * (NGU / 256), 288, CPARTS); SEAM(); }
        if (IN(12)) { ArgsP A = fresh_args(); const Frame Fl = fresh_frame(F); const int bx = opq_s((int)blockIdx.x); unsigned char* ws = A->ws; const bool lastl = (l == NLAYER - 1);
            pg8::Gemm g{(const bf16*)(ws + WS_HID), (const bf16*)(ws + (size_t)(l & 1) * WS_SETD + WS_WD2), S, D, FF}; pg8::StaticOrder So; So.init(S, D, Fl.G, bx);
            epi::EpiResid E{(const float*)(ws + WS_X), lastl ? A->out : (float*)(ws + WS_X), 0.5f, lastl ? (bf16*)nullptr : (bf16*)(ws + WS_XN), (float*)(ws + WS_SSP)}; GEMM(epi::EpiResid, pg8::StaticOrder);
            SEAM(); }
    }
#undef IN
#undef SEAM
#undef GEMM
}


#ifdef DBG_DUMP_OFF
__global__ void dbg_dump(const unsigned char* ws, float* out, int n) {
    for (int i = blockIdx.x * blockDim.x + threadIdx.x; i < n; i += gridDim.x * blockDim.x) {
        if (i >= DBG_DUMP_N) { out[i] = 0.f; continue; }
#if DBG_DUMP_BF16
        out[i] = __uint_as_float(((unsigned)((const unsigned short*)(ws + DBG_DUMP_OFF))[i]) << 16);
#else
        out[i] = ((const float*)(ws + DBG_DUMP_OFF))[i];
#endif
    }
}
#endif
#ifndef MK_ONE_LAUNCH
#define MK_ONE_LAUNCH 0
#endif
extern "C" void kernel_launch(void* const* d_in, const int* in_sizes, int n_in, void* d_out, int out_size, void* d_ws, size_t ws_size, hipStream_t stream) {
    static int grid = 0;
    if (grid == 0) {
        if (n_in != N_INPUTS || out_size != S * D || ws_size < WS_END) { fprintf(stderr, "kernel_launch: unexpected shapes (n_in %d out %d ws %zu)\n", n_in, out_size, ws_size); grid = -1; return; }
        int dev = 0, cus = 0, per_cu = 0;
        if (hipGetDevice(&dev) != hipSuccess || hipDeviceGetAttribute(&cus, hipDeviceAttributeMultiprocessorCount, dev) != hipSuccess) { grid = -1; return; }
        if (hipFuncSetAttribute((const void*)mk_fwd, hipFuncAttributeMaxDynamicSharedMemorySize, LDS_BYTES) != hipSuccess) { fprintf(stderr, "kernel_launch: hipFuncSetAttribute failed\n"); grid = -1; return; }
        if (hipOccupancyMaxActiveBlocksPerMultiprocessor(&per_cu, (const void*)mk_fwd, NWAVES * 64, LDS_BYTES) != hipSuccess || per_cu < 1) fprintf(stderr, "kernel_launch: occupancy query reports %d\n", per_cu);
        (void)hipGetLastError();
        grid = cus;
    }
    if (grid < 0) return;
    if (hipMemsetAsync((char*)d_ws + WS_CTL, 0, CTL_ZERO_BYTES, stream) != hipSuccess) return;
    Args a{};
    for (int i = 0; i < N_INPUTS; ++i) a.in[i] = (const float*)d_in[i];
    a.out = (float*)d_out; a.ws = (unsigned char*)d_ws;
#if MK_ONE_LAUNCH
    a.l_lo = 0; a.l_hi = NLAYER; a.ph_lo = 0; a.ph_hi = NPHASE;
    hipLaunchKernelGGL(mk_fwd, dim3(grid), dim3(NWAVES * 64), LDS_BYTES, stream, a);
#else
    for (int l = 0; l < NLAYER; ++l)
        for (int ph = 0; ph < NPHASE; ++ph) {
#ifdef DBG_DUMP_OFF
            if (l * NPHASE + ph > DBG_LAST) continue;
#endif
            a.l_lo = l; a.l_hi = l + 1; a.ph_lo = ph; a.ph_hi = ph + 1;
            hipLaunchKernelGGL(mk_fwd, dim3(grid), dim3(NWAVES * 64), LDS_BYTES, stream, a);
#ifdef DUP_MASK
            if ((DUP_MASK >> ph) & 1) hipLaunchKernelGGL(mk_fwd, dim3(grid), dim3(NWAVES * 64), LDS_BYTES, stream, a);
#endif
            }
#ifdef DBG_DUMP_OFF
    hipLaunchKernelGGL(dbg_dump, dim3(2048), dim3(256), 0, stream, (const unsigned char*)d_ws, (float*)d_out, S * D);
#endif
#endif
}
```

```cpp
#define MK_ONE_LAUNCH 1
#include <hip/hip_runtime.h>
#include <cstdio>
#include <cstdint>
namespace pg8 {
#define PG8_LAS __attribute__((address_space(3)))
typedef unsigned short bf16_t;
typedef short bf16x8 __attribute__((ext_vector_type(8)));
typedef float f32x4 __attribute__((ext_vector_type(4)));
typedef unsigned u32x4 __attribute__((ext_vector_type(4)));
constexpr int BM = 256, BK = 64, HALF = 128, HTB = HALF * BK * 2  , STAGE_BYTES = 8 * HTB, NXCD = 8, WGM = 4;

__host__ __device__ __forceinline__ int lds_byte(int r, int c) { const int st = (r >> 4) * 2 + (c >> 5), rr = r & 15, cc = c & 31, ob = rr * 64 + cc * 2; return st * 1024 + (ob ^ (((ob >> 9) & 1) << 5)); }
__host__ __device__ __forceinline__ void stage_rc(int b, int& R, int& C) { const int st = b / 1024, sb = b % 1024, swz = sb ^ (((sb >> 9) & 1) << 5); R = (st >> 1) * 16 + swz / 64; C = (st & 1) * 32 + (swz % 64) / 2; }
__host__ __device__ __forceinline__ int perm32(int rho) { const int n = rho >> 4, i = rho & 15; return 8 * (i >> 2) + 4 * n + (i & 3); }

struct Unit { int pm, pn; };
struct Gemm { const bf16_t* A; const bf16_t* Bt; int M, N, K; };

struct StaticOrder {
    int nM, nN, nwg, G, c;
    __host__ __device__ void init(int M, int N, int G_, int c_) { nM = M / BM; nN = N / BM; nwg = nM * nN; G = G_; c = c_; }
    __host__ __device__ bool next(int i, Unit& u) const {
        const long L = (long)i * G + c; if (L >= nwg) return false;
        int wgid = (int)L; { const int q = nwg / NXCD, r = nwg % NXCD, xcd = wgid % NXCD, off = wgid / NXCD; wgid = (xcd < r ? xcd * (q + 1) : r * (q + 1) + (xcd - r) * q) + off; }
        const int nig = WGM * nN, gid = wgid / nig, fm = gid * WGM, gsz = (nM - fm) < WGM ? (nM - fm) : WGM;
        u.pm = fm + ((wgid % nig) % gsz); u.pn = (wgid % nig) / gsz; return true;
    }
    __device__ __forceinline__ void a_ready(const Unit&, int  ) const {}
    __device__ __forceinline__ void done(const Unit&) const {}
};
__device__ __forceinline__ unsigned cvt_pk_bf16(float lo, float hi) { unsigned r; asm volatile("v_cvt_pk_bf16_f32 %0, %1, %2" : "=v"(r) : "v"(lo), "v"(hi)); return r; }
typedef float f32x2 __attribute__((ext_vector_type(2)));
__device__ __forceinline__ f32x2 gelu_pk(f32x2 v) {
    const f32x2 av = __builtin_elementwise_abs(v), d = av * 0.2316418882f + 1.0f;
    f32x2 t; t.x = __builtin_amdgcn_rcpf(d.x); t.y = __builtin_amdgcn_rcpf(d.y);
    f32x2 q = t * 0.5307027145f + (-0.7265760135f); q = q * t + 0.7107068705f; q = q * t + (-0.142248368f); q = q * t + 0.127414796f; q = q * t;
    const f32x2 s = (v * v) * (-0.72134752044f);
    f32x2 e; e.x = __builtin_amdgcn_exp2f(s.x); e.y = __builtin_amdgcn_exp2f(s.y);
    const f32x2 m = v * (q * e), r = v - m;
    f32x2 o; o.x = v.x < 0.f ? m.x : r.x; o.y = v.y < 0.f ? m.y : r.y; return o;
}
template <class Epi, class Sched, bool ALIGN_EPI = false, bool SP2 = false>
__device__ __forceinline__ void gemm_phase(PG8_LAS unsigned char* lds, const Gemm g, const Sched& S, const Epi& E, int wave_in  ) {
    int tid_ = wave_in * 64 + (int)__builtin_amdgcn_mbcnt_hi(~0u, __builtin_amdgcn_mbcnt_lo(~0u, 0u)); asm volatile("" : "+v"(tid_));
    const int tid = tid_, wid = __builtin_amdgcn_readfirstlane(tid >> 6), lane = tid & 63, wr = wid >> 2, wc = wid & 3, fr = lane & 15, fq = lane >> 4;
    const int K = g.K, nt = K / BK;
    unsigned voffA[2], voffB[2];
#pragma unroll
    for (int i = 0; i < 2; ++i) { int R, C; stage_rc(tid * 16 + i * 8192, R, C); const int Rb = Epi::PERM ? ((R & ~31) + perm32(R & 31)) : R;
        voffA[i] = (unsigned)(R * K + C) * 2u; voffB[i] = (unsigned)(Rb * K + C) * 2u; }
    const size_t kstep = (size_t)(BK * 2);
    const size_t hstep = (size_t)HALF * K * 2;
    const size_t tstep = 2 * hstep;
    const unsigned ldsw = (unsigned)wid * 1024u;
    const int aoff = lds_byte(wr * 64 + fr, fq * 8), boff = lds_byte(wc * 32 + fr, fq * 8);
#define PG8_SA(b, h) (((b) * 2 + (h)) * HTB)
#define PG8_SB(b, h) ((4 + (b) * 2 + (h)) * HTB)
#define PG8_STAGE(bufoff, gbase, voff) do { _Pragma("unroll") for (int _i = 0; _i < 2; ++_i) \
        __builtin_amdgcn_global_load_lds((const unsigned*)((const char*)(gbase) + (voff)[_i]), (PG8_LAS unsigned*)(lds + (bufoff) + ldsw + _i * 8192), 16, 0, 0); } while (0)
#define PG8_LDA(dst, b, h) do { _Pragma("unroll") for (int m = 0; m < 4; ++m) _Pragma("unroll") for (int k = 0; k < 2; ++k) dst[m][k] = *(const PG8_LAS bf16x8*)(lds + PG8_SA(b, h) + aoff + m * 2048 + k * 1024); } while (0)
#define PG8_LDB(dst, b, h) do { _Pragma("unroll") for (int n = 0; n < 2; ++n) _Pragma("unroll") for (int k = 0; k < 2; ++k) dst[n][k] = *(const PG8_LAS bf16x8*)(lds + PG8_SB(b, h) + boff + n * 2048 + k * 1024); } while (0)
#define PG8_MMA(ai, bj, At, Bt) do { __builtin_amdgcn_s_setprio(1); _Pragma("unroll") for (int m = 0; m < 4; ++m) _Pragma("unroll") for (int n = 0; n < 2; ++n) _Pragma("unroll") for (int k = 0; k < 2; ++k) \
        acc[ai][bj][m][n] = __builtin_amdgcn_mfma_f32_16x16x32_bf16(Bt[n][k], At[m][k], acc[ai][bj][m][n], 0, 0, 0); __builtin_amdgcn_s_setprio(0); } while (0)
#define PG8_WAIT_V(n) asm volatile("s_waitcnt vmcnt(" #n ")" ::: "memory")
#define PG8_WAIT_L(n) asm volatile("s_waitcnt lgkmcnt(" #n ")" ::: "memory")
#define PG8_BAR __builtin_amdgcn_s_barrier()
#define PG8_SCHED __builtin_amdgcn_sched_barrier(0)
    Unit cur, nxt; int ui = 0;
    if (!S.next(0, cur)) return;
    f32x4 acc[2][2][4][2];
#pragma unroll
    for (int a = 0; a < 2; ++a)
#pragma unroll
        for (int b = 0; b < 2; ++b)
#pragma unroll
            for (int m = 0; m < 4; ++m)
#pragma unroll
                for (int n = 0; n < 2; ++n) acc[a][b][m][n] = (f32x4){0.f, 0.f, 0.f, 0.f};
    bf16x8 At[4][2], B0[2][2], B1[2][2];
    const char* cA = (const char*)g.A + (size_t)cur.pm * tstep; const char* cB = (const char*)g.Bt + (size_t)cur.pn * tstep;
    S.a_ready(cur, 0);
    if constexpr (SP2) {
        PG8_STAGE(PG8_SB(0, 0), cB, voffB); PG8_STAGE(PG8_SB(0, 1), cB + hstep, voffB); PG8_STAGE(PG8_SA(0, 0), cA, voffA); PG8_STAGE(PG8_SA(0, 1), cA + hstep, voffA);
        if (wr == 1) PG8_BAR;
        PG8_WAIT_V(2); PG8_BAR;
        PG8_STAGE(PG8_SB(1, 0), cB + kstep, voffB); PG8_STAGE(PG8_SA(1, 0), cA + kstep, voffA); PG8_STAGE(PG8_SB(1, 1), cB + hstep + kstep, voffB);
        PG8_WAIT_V(6); PG8_BAR;
    } else {
        PG8_STAGE(PG8_SB(0, 0), cB, voffB); PG8_STAGE(PG8_SA(0, 0), cA, voffA); PG8_STAGE(PG8_SB(0, 1), cB + hstep, voffB); PG8_STAGE(PG8_SA(0, 1), cA + hstep, voffA);
        if (wr == 1) PG8_BAR;
        PG8_WAIT_V(4); PG8_BAR;
        PG8_STAGE(PG8_SB(1, 0), cB + kstep, voffB); PG8_STAGE(PG8_SA(1, 0), cA + kstep, voffA); PG8_STAGE(PG8_SB(1, 1), cB + hstep + kstep, voffB);
        PG8_WAIT_V(6); PG8_BAR;
    }
    for (;;) {
        const bool has_next = S.next(ui + 1, nxt);
        const char* nA = has_next ? (const char*)g.A + (size_t)nxt.pm * tstep : cA; const char* nB = has_next ? (const char*)g.Bt + (size_t)nxt.pn * tstep : cB;
        for (int t = 0; t < nt; t += 2) {
            const bool last = (t == nt - 2);
            const char* a1 = cA + (size_t)(t + 1) * kstep;
            const char* a2 = last ? nA : cA + (size_t)(t + 2) * kstep; const char* b2 = last ? nB : cB + (size_t)(t + 2) * kstep;
            const char* a3 = a2 + kstep; const char* b3 = b2 + kstep;
            if (last && has_next) S.a_ready(nxt, ui + 1);
            if constexpr (SP2) {
            PG8_LDB(B0, 0, 0); PG8_LDB(B1, 0, 1); PG8_SCHED; PG8_LDA(At, 0, 0); PG8_STAGE(PG8_SA(1, 1), a1 + hstep, voffA);
            PG8_WAIT_V(8); PG8_WAIT_L(0); PG8_BAR; PG8_MMA(0, 0, At, B0); PG8_MMA(0, 1, At, B1); PG8_BAR; PG8_SCHED;
            PG8_LDA(At, 0, 1); PG8_STAGE(PG8_SB(0, 0), b2, voffB); PG8_STAGE(PG8_SB(0, 1), b2 + hstep, voffB); PG8_STAGE(PG8_SA(0, 0), a2, voffA);
            PG8_WAIT_V(8); PG8_WAIT_L(0); PG8_BAR; PG8_MMA(1, 0, At, B0); PG8_MMA(1, 1, At, B1); PG8_BAR; PG8_SCHED;
            PG8_LDB(B0, 1, 0); PG8_LDB(B1, 1, 1); PG8_SCHED; PG8_LDA(At, 1, 0); PG8_STAGE(PG8_SA(0, 1), a2 + hstep, voffA);
            PG8_WAIT_V(8); PG8_WAIT_L(0); PG8_BAR; PG8_MMA(0, 0, At, B0); PG8_MMA(0, 1, At, B1); PG8_BAR; PG8_SCHED;
            PG8_LDA(At, 1, 1); PG8_STAGE(PG8_SB(1, 0), b3, voffB); PG8_STAGE(PG8_SB(1, 1), b3 + hstep, voffB); PG8_STAGE(PG8_SA(1, 0), a3, voffA);
            PG8_WAIT_V(8); PG8_WAIT_L(0); PG8_BAR; PG8_MMA(1, 0, At, B0); PG8_MMA(1, 1, At, B1); PG8_BAR; PG8_SCHED;
            } else {
            PG8_LDB(B0, 0, 0); PG8_SCHED; PG8_LDA(At, 0, 0); PG8_STAGE(PG8_SA(1, 1), a1 + hstep, voffA);
            PG8_WAIT_L(8); PG8_BAR; PG8_WAIT_L(0); PG8_MMA(0, 0, At, B0); PG8_BAR; PG8_SCHED;
            PG8_LDB(B1, 0, 1); PG8_STAGE(PG8_SB(0, 0), b2, voffB);
            PG8_BAR; PG8_WAIT_L(0); PG8_MMA(0, 1, At, B1); PG8_BAR;
            PG8_LDA(At, 0, 1); PG8_STAGE(PG8_SA(0, 0), a2, voffA);
            PG8_BAR; PG8_WAIT_L(0); PG8_MMA(1, 0, At, B0); PG8_BAR; PG8_SCHED;
            PG8_STAGE(PG8_SB(0, 1), b2 + hstep, voffB);
            PG8_WAIT_V(6); PG8_BAR; PG8_MMA(1, 1, At, B1); PG8_BAR;
            PG8_LDB(B0, 1, 0); PG8_SCHED; PG8_LDA(At, 1, 0); PG8_STAGE(PG8_SA(0, 1), a2 + hstep, voffA);
            PG8_WAIT_L(8); PG8_BAR; PG8_WAIT_L(0); PG8_MMA(0, 0, At, B0); PG8_BAR; PG8_SCHED;
            PG8_LDB(B1, 1, 1); PG8_STAGE(PG8_SB(1, 0), b3, voffB);
            PG8_BAR; PG8_WAIT_L(0); PG8_MMA(0, 1, At, B1); PG8_BAR;
            PG8_LDA(At, 1, 1); PG8_STAGE(PG8_SA(1, 0), a3, voffA);
            PG8_BAR; PG8_WAIT_L(0); PG8_MMA(1, 0, At, B0); PG8_BAR; PG8_SCHED;
            PG8_STAGE(PG8_SB(1, 1), b3 + hstep, voffB);
            PG8_WAIT_V(6); PG8_BAR; PG8_MMA(1, 1, At, B1); PG8_BAR;
            }
        }
        if constexpr (ALIGN_EPI) { if (wr == 0) PG8_BAR; }
        if constexpr (!Epi::AFTER_DRAIN) { E(acc, cur, wr, wc, fr, fq, ui); S.done(cur); }
        if (!has_next) break;
        if constexpr (!Epi::KEEP_ACC) {
#pragma unroll
        for (int a = 0; a < 2; ++a)
#pragma unroll
            for (int b = 0; b < 2; ++b)
#pragma unroll
                for (int m = 0; m < 4; ++m)
#pragma unroll
                    for (int n = 0; n < 2; ++n) acc[a][b][m][n] = (f32x4){0.f, 0.f, 0.f, 0.f};
        }
        cur = nxt; cA = nA; cB = nB; ++ui;
        if constexpr (ALIGN_EPI) { if (wr == 1) PG8_BAR; }
    }
    PG8_WAIT_V(0);
    if constexpr (!ALIGN_EPI) { if (wr == 0) PG8_BAR; }
    PG8_BAR;
    if constexpr (Epi::AFTER_DRAIN) { E.fused(acc, cur, wr, wc, fr, fq, lds, wid, lane); S.done(cur); }
#undef PG8_SA
#undef PG8_SB
#undef PG8_STAGE
#undef PG8_LDA
#undef PG8_LDB
#undef PG8_MMA
#undef PG8_WAIT_V
#undef PG8_WAIT_L
#undef PG8_BAR
#undef PG8_SCHED
}
}
#define GAS __attribute__((address_space(1)))
#define LAS __attribute__((address_space(3)))
typedef unsigned short bf16;
typedef unsigned v4u __attribute__((ext_vector_type(4)));
typedef float f32x4 __attribute__((ext_vector_type(4)));
typedef short bf16x8 __attribute__((ext_vector_type(8)));
typedef GAS unsigned gu32;
typedef GAS unsigned long long gu64;
#define RLX_AGENT __ATOMIC_RELAXED, __HIP_MEMORY_SCOPE_AGENT
#define LDS_WAIT() asm volatile("s_waitcnt lgkmcnt(0)" ::: "memory")
#define VM_WAIT() asm volatile("s_waitcnt vmcnt(0)" ::: "memory")
__device__ __forceinline__ unsigned long long rt() { return __builtin_amdgcn_s_memrealtime(); }
__device__ __forceinline__ unsigned f2bf(float f) { unsigned u = __builtin_bit_cast(unsigned, f); return (u + 0x7fffu + ((u >> 16) & 1u)) >> 16; }
__device__ __forceinline__ unsigned pk2(float lo, float hi) { return f2bf(lo) | (f2bf(hi) << 16); }
#define XB_TMO      128
#define XB_XCNT(j)  (256  + 64 * (j))
#define XB_XSUB(j)  (1280 + 64 * (j))
#define XB_XGEN(j)  (2304 + 64 * (j))
#define XB_TOP      3328
#define XB_TOPGEN   3392
#define XCD_BAR_WORDS 3456
#define XB_SPIN_CAP (1u << 18)

__device__ __forceinline__ unsigned xb_ld(unsigned* p)              { return __hip_atomic_load(p, __ATOMIC_RELAXED, __HIP_MEMORY_SCOPE_AGENT); }
__device__ __forceinline__ unsigned xb_add(unsigned* p, unsigned v) { return __hip_atomic_fetch_add(p, v, __ATOMIC_RELAXED, __HIP_MEMORY_SCOPE_AGENT); }
__device__ __forceinline__ unsigned xb_xcc_id() { return (unsigned)__builtin_amdgcn_s_getreg((3 << 11) | 20) & 0xFu; }
#define XB_SPIN(cond, bar) do { unsigned _sp = 0; while (cond) { __builtin_amdgcn_s_sleep(1); \
    if ((++_sp & 255u) == 0u) { if (xb_ld(&(bar)[XB_TMO])) break; if (_sp > XB_SPIN_CAP) { atomicAdd(&(bar)[XB_TMO], 1u); break; } } } } while (0)

struct XcdBarrier {
    unsigned* bar; unsigned x;
    volatile LAS unsigned* st;
};

__device__ __forceinline__ XcdBarrier xcd_barrier_post(unsigned* bar, volatile LAS unsigned* st) {
    XcdBarrier b; b.bar = bar; b.x = xb_xcc_id(); b.st = st;
    if (threadIdx.x == 0) (void)xb_add(&bar[XB_XCNT(b.x)], 1u);
    return b;
}
__device__ __forceinline__ void xcd_barrier_complete(unsigned* bar, unsigned x, unsigned& nloc, unsigned& nx) {
    const unsigned G = gridDim.x * gridDim.y * gridDim.z;
    unsigned sum, cnt, mine, sp = 0u;
    for (;;) {
        sum = 0u; cnt = 0u; mine = 0u;
#pragma unroll
        for (unsigned j = 0; j < 16; ++j) { const unsigned c = xb_ld(&bar[XB_XCNT(j)]); sum += c; cnt += (c > 0u) ? 1u : 0u; mine = (j == x) ? c : mine; }
        if (sum == G) break;
        __builtin_amdgcn_s_sleep(1);
        if ((++sp & 255u) == 0u) { if (xb_ld(&bar[XB_TMO])) break; if (sp > XB_SPIN_CAP) { atomicAdd(&bar[XB_TMO], 1u); break; } }
    }
    nloc = mine > 0u ? mine : 1u; nx = cnt > 0u ? cnt : 1u;
}

__device__ __forceinline__ void xcd_barrier(const XcdBarrier& b) {
    asm volatile("s_waitcnt vmcnt(0)" ::: "memory");
    __syncthreads();
    if (threadIdx.x == 0) {
        unsigned* bar = b.bar;
        __builtin_amdgcn_s_waitcnt(0);
        unsigned nloc = b.st[0], nx = b.st[1];
        if (nloc == 0u) { xcd_barrier_complete(bar, b.x, nloc, nx); b.st[0] = nloc; b.st[1] = nx; }
        const unsigned old = xb_add(&bar[XB_XSUB(b.x)], 1u);
        const unsigned gen = old / nloc;
        if (old + 1u == (gen + 1u) * nloc) {
            __builtin_amdgcn_fence(__ATOMIC_RELEASE, "agent");
            asm volatile("s_waitcnt vmcnt(0)" ::: "memory");
            const unsigned og = xb_add(&bar[XB_TOP], 1u);
            const unsigned tg = og / nx;
            if (og + 1u == (tg + 1u) * nx) xb_add(&bar[XB_TOPGEN], 1u);
            else XB_SPIN(xb_ld(&bar[XB_TOPGEN]) == tg, bar);
            __builtin_amdgcn_fence(__ATOMIC_ACQUIRE, "agent");
            xb_add(&bar[XB_XGEN(b.x)], 1u);
            asm volatile("s_waitcnt vmcnt(0)" ::: "memory");
        } else {
            XB_SPIN(xb_ld(&bar[XB_XGEN(b.x)]) == gen, bar);
            __builtin_amdgcn_fence(__ATOMIC_ACQUIRE, "agent");
            asm volatile("s_waitcnt vmcnt(0)" ::: "memory");
        }
    }
    __syncthreads();
}
constexpr int S = 8192, D = 2048, FF = 5632, NLAYER = 4;
constexpr int NIN = 14912, NINP = 15104;
constexpr int NGU = 2 * FF;
constexpr float EPS = 1e-6f;
constexpr int PC_GATE = 0, PC_POOL = 8192, PC_DIL = 8704, PC_SGU = 13312, PC_CQ = 14336, PC_CKV = 14720, PC_KR = 14848;
constexpr int NMLA = 1792;

namespace epi {
using pg8::f32x4; using pg8::u32x4; using pg8::Unit; using pg8::bf16_t;
typedef float f32x2_t __attribute__((ext_vector_type(2))); typedef __bf16 bf16x2_t __attribute__((ext_vector_type(2)));
__device__ __forceinline__ unsigned cvt_pk_bf16(float lo, float hi) { f32x2_t v = {lo, hi}; bf16x2_t b = __builtin_convertvector(v, bf16x2_t); return __builtin_bit_cast(unsigned, b); }
constexpr int BM = 256, HALF = 128;
typedef unsigned u32x2 __attribute__((ext_vector_type(2)));
__device__ __forceinline__ float fast_exp(float x) { return __builtin_amdgcn_exp2f(x * 1.44269504089f); }
__device__ __forceinline__ float sigmoid_f(float x) { return __builtin_amdgcn_rcpf(1.0f + fast_exp(-x)); }

struct EpiSwiglu {
    static constexpr bool PERM = true, AFTER_DRAIN = false, KEEP_ACC = false;
    bf16_t* H; const __attribute__((address_space(3))) float* tab;
    __device__ __forceinline__ void operator()(const f32x4 (&acc)[2][2][4][2], const Unit& u, int wr, int wc, int fr, int fq, int ui) const {
        const int row0 = u.pm * BM + wr * 64 + fr, col0 = u.pn * HALF + wc * 32 + 8 * fq; const __attribute__((address_space(3))) float* tb = tab + ui * 256 + wr * 64 + fr;
#pragma unroll
        for (int ai = 0; ai < 2; ++ai)
#pragma unroll
            for (int m = 0; m < 4; ++m) {
                bf16_t* rowp = H + (size_t)(row0 + ai * HALF + m * 16) * FF + col0; const float rs = tb[ai * HALF + m * 16];
                float o[8];
#pragma unroll
                for (int n = 0; n < 2; ++n)
#pragma unroll
                    for (int j = 0; j < 4; ++j) { const float g = acc[ai][0][m][n][j] * rs, up = acc[ai][1][m][n][j] * rs; o[n * 4 + j] = g * sigmoid_f(g) * up; }
                u32x4 w; w.x = cvt_pk_bf16(o[0], o[1]); w.y = cvt_pk_bf16(o[2], o[3]); w.z = cvt_pk_bf16(o[4], o[5]); w.w = cvt_pk_bf16(o[6], o[7]);
                *(u32x4*)rowp = w;
                asm volatile("" ::: "memory");
            }
    }
};
struct EpiResid {
    static constexpr bool PERM = false, AFTER_DRAIN = false, KEEP_ACC = false;
    const float* base; float* out; float alpha; bf16_t* xb; float* ssp;
    __device__ __forceinline__ void operator()(const f32x4 (&acc)[2][2][4][2], const Unit& u, int wr, int wc, int fr, int fq, int ui) const {
        const int row0 = u.pm * BM + wr * 64 + fr, col0 = u.pn * BM + wc * 32 + 4 * fq;
        f32x4 bb[3][4];
#define ER_LOAD(buf, g) { const size_t off_ = (size_t)(row0 + ((g) >> 2) * HALF + ((g) & 3) * 16) * D + col0; _Pragma("unroll") for (int q_ = 0; q_ < 4; ++q_) bb[buf][q_] = *(const f32x4*)(base + off_ + (q_ >> 1) * HALF + (q_ & 1) * 16); }
        ER_LOAD(0, 0) ER_LOAD(1, 1)
#pragma unroll
        for (int g = 0; g < 8; ++g) { const int ai = g >> 2, m = g & 3;
            if (g + 2 < 8) ER_LOAD((g + 2) % 3, g + 2)
            const int r = row0 + ai * HALF + m * 16; const size_t off = (size_t)r * D + col0; float s = 0.f;
#pragma unroll
            for (int q = 0; q < 4; ++q) { const int bj = q >> 1, n = q & 1; const f32x4 v = bb[g % 3][q] + acc[ai][bj][m][n] * alpha;
                *(f32x4*)(out + off + bj * HALF + n * 16) = v;
                if (xb) { s += (v[0] * v[0] + v[1] * v[1]) + (v[2] * v[2] + v[3] * v[3]); u32x2 w; w.x = cvt_pk_bf16(v[0], v[1]); w.y = cvt_pk_bf16(v[2], v[3]); *(u32x2*)(xb + off + bj * HALF + n * 16) = w; } }
            if (xb) { s += __shfl_xor(s, 16); s += __shfl_xor(s, 32); if (fq == 0) ssp[(size_t)r * 32 + u.pn * 4 + wc] = s; }
            asm volatile("" ::: "memory"); }
#undef ER_LOAD
    }
};
struct EpiPin {
    static constexpr bool PERM = true, AFTER_DRAIN = false, KEEP_ACC = false;
    bf16_t* P; const __attribute__((address_space(3))) float* tab;
    template <int KIND> __device__ __forceinline__ void run(const f32x4 (&acc)[2][2][4][2], const Unit& u, int wr, int wc, int fr, int fq, int ui) const {
        const __attribute__((address_space(3))) float* tb = tab + ui * 256 + wr * 64 + fr;
        const int row0 = u.pm * BM + wr * 64 + fr, col0 = u.pn * BM + wc * 32 + 8 * fq;
#pragma unroll
        for (int ai = 0; ai < 2; ++ai)
#pragma unroll
            for (int m = 0; m < 4; ++m) { bf16_t* rowp = P + (size_t)(row0 + ai * HALF + m * 16) * NINP + col0; const float rs = tb[ai * HALF + m * 16];
#pragma unroll
                for (int bj = 0; bj < 2; ++bj) { float o[8];
#pragma unroll
                    for (int n = 0; n < 2; ++n)
#pragma unroll
                        for (int j = 0; j < 4; ++j) { const float x = acc[ai][bj][m][n][j] * rs;
                            o[n * 4 + j] = (KIND == 0) ? x : ((KIND == 1) ? sigmoid_f(x) : x * sigmoid_f(1.5957691216f * (x + 0.044715f * x * x * x))); }
                    u32x4 w; w.x = cvt_pk_bf16(o[0], o[1]); w.y = cvt_pk_bf16(o[2], o[3]); w.z = cvt_pk_bf16(o[4], o[5]); w.w = cvt_pk_bf16(o[6], o[7]);
                    *(u32x4*)(rowp + bj * HALF) = w; }
                asm volatile("" ::: "memory"); }
    }
    __device__ __forceinline__ void operator()(const f32x4 (&acc)[2][2][4][2], const Unit& u, int wr, int wc, int fr, int fq, int ui) const {
        if (u.pn < 32) run<1>(acc, u, wr, wc, fr, fq, ui); else if (u.pn >= 52 && u.pn < 56) run<2>(acc, u, wr, wc, fr, fq, ui); else run<0>(acc, u, wr, wc, fr, fq, ui);
    }
};
struct EpiF32 {
    static constexpr bool PERM = false, AFTER_DRAIN = false, KEEP_ACC = false;
    float* C; int ldc; int colmul;
    __device__ __forceinline__ void operator()(const f32x4 (&acc)[2][2][4][2], const Unit& u, int wr, int wc, int fr, int fq, int ui) const {
        const int row0 = u.pm * BM + wr * 64 + fr, col0 = colmul * u.pn * BM + wc * 32 + 4 * fq;
#pragma unroll
        for (int ai = 0; ai < 2; ++ai)
#pragma unroll
            for (int m = 0; m < 4; ++m) { float* rowp = C + (size_t)(row0 + ai * HALF + m * 16) * ldc + col0;
#pragma unroll
                for (int bj = 0; bj < 2; ++bj)
#pragma unroll
                    for (int n = 0; n < 2; ++n) *(f32x4*)(rowp + bj * HALF + n * 16) = acc[ai][bj][m][n]; }
    }
};
struct EpiExp {
    static constexpr bool PERM = true, AFTER_DRAIN = false, KEEP_ACC = false;
    bf16_t* P;
    __device__ __forceinline__ void operator()(const f32x4 (&acc)[2][2][4][2], const Unit& u, int wr, int wc, int fr, int fq, int ui) const {
        const int row0 = u.pm * BM + wr * 64 + fr, col0 = (u.pn & 31) * BM + wc * 32 + 8 * fq;
#pragma unroll
        for (int ai = 0; ai < 2; ++ai)
#pragma unroll
            for (int m = 0; m < 4; ++m) { bf16_t* rowp = P + (size_t)(row0 + ai * HALF + m * 16) * S + col0;
#pragma unroll
                for (int bj = 0; bj < 2; ++bj) { float o[8];
#pragma unroll
                    for (int n = 0; n < 2; ++n)
#pragma unroll
                        for (int j = 0; j < 4; ++j) o[n * 4 + j] =
#ifdef DBG_NOEXP
                            acc[ai][bj][m][n][j];
#else
                            fast_exp(acc[ai][bj][m][n][j]);
#endif
                    u32x4 w; w.x = cvt_pk_bf16(o[0], o[1]); w.y = cvt_pk_bf16(o[2], o[3]); w.z = cvt_pk_bf16(o[4], o[5]); w.w = cvt_pk_bf16(o[6], o[7]);
                    *(u32x4*)(rowp + bj * HALF) = w; }
                asm volatile("" ::: "memory"); }
    }
};
struct EpiBranch {
    static constexpr bool PERM = false, AFTER_DRAIN = false, KEEP_ACC = false;
    float* merged; bf16_t* mergedb; const bf16_t* gate; int b;
    __device__ __forceinline__ void operator()(const f32x4 (&acc)[2][2][4][2], const Unit& u, int wr, int wc, int fr, int fq, int ui) const {
        const int row0 = u.pm * BM + wr * 64 + fr, col0 = u.pn * BM + wc * 32 + 4 * fq;
#pragma unroll
        for (int ai = 0; ai < 2; ++ai)
#pragma unroll
            for (int m = 0; m < 4; ++m) { const int r = row0 + ai * HALF + m * 16;
#pragma unroll
                for (int bj = 0; bj < 2; ++bj)
#pragma unroll
                    for (int n = 0; n < 2; ++n) { const int c = col0 + bj * HALF + n * 16;
                        const u32x2 gv = *(const u32x2*)(gate + (size_t)r * NINP + c);
                        f32x4 g; g[0] = __uint_as_float(gv.x << 16); g[1] = __uint_as_float(gv.x & 0xffff0000u); g[2] = __uint_as_float(gv.y << 16); g[3] = __uint_as_float(gv.y & 0xffff0000u);
                        f32x4 v = acc[ai][bj][m][n] * g;
                        float* mp = merged + (size_t)r * D + c;
                        if (b != 0) v += *(const f32x4*)mp;
                        if (b != 3) *(f32x4*)mp = v;
                        else { u32x2 w; w.x = cvt_pk_bf16(v[0], v[1]); w.y = cvt_pk_bf16(v[2], v[3]); *(u32x2*)(mergedb + (size_t)r * D + c) = w; } }
                asm volatile("" ::: "memory"); }
    }
};
struct QKOrder {
    int G, c;
    __device__ bool next(int i, Unit& u) const { const int L = i * G + c; if (L >= 4096) return false; const int h = L >> 10, rem = L & 1023; u.pm = h * 32 + (rem >> 5); u.pn = h * 32 + (rem & 31); return true; }
    __device__ __forceinline__ void a_ready(const Unit&, int) const {}
    __device__ __forceinline__ void done(const Unit&) const {}
};
struct PVOrder {
    int G, c;
    __device__ bool next(int i, Unit& u) const { const int L = i * G + c; if (L >= 128) return false; u.pm = L; u.pn = L >> 5; return true; }
    __device__ __forceinline__ void a_ready(const Unit&, int) const {}
    __device__ __forceinline__ void done(const Unit&) const {}
};
struct EpiBranchChain {
    static constexpr bool PERM = true, AFTER_DRAIN = false, KEEP_ACC = true;
    bf16_t* mergedb; const bf16_t* gate;
    __device__ __forceinline__ void operator()(f32x4 (&acc)[2][2][4][2], const Unit& u, int wr, int wc, int fr, int fq, int ui) const {
        const int b = u.pm >> 5, pm0 = u.pm & 31, pn0 = u.pn & 7;
        const int row0 = pm0 * BM + wr * 64 + fr, col0 = pn0 * BM + wc * 32 + 8 * fq;
        u32x4 gg[3][2][2];
#define BC_LOAD(buf, g) { const bf16_t* gp_ = gate + (size_t)(row0 + ((g) >> 2) * HALF + ((g) & 3) * 16) * NINP + b * D + col0; _Pragma("unroll") for (int bj_ = 0; bj_ < 2; ++bj_) { \
            gg[buf][bj_][0] = *(const u32x4*)(gp_ + bj_ * HALF); if (b != 3) gg[buf][bj_][1] = *(const u32x4*)(gp_ + bj_ * HALF + D); } }
        BC_LOAD(0, 0) BC_LOAD(1, 1)
#pragma unroll
        for (int gi = 0; gi < 8; ++gi) { const int ai = gi >> 2, m = gi & 3; const int r = row0 + ai * HALF + m * 16;
            if (gi + 2 < 8) BC_LOAD((gi + 2) % 3, gi + 2)
#pragma unroll
            for (int bj = 0; bj < 2; ++bj) { const int c = col0 + bj * HALF;
                const u32x4 gv = gg[gi % 3][bj][0];
                float g[8] = {__uint_as_float(gv.x << 16), __uint_as_float(gv.x & 0xffff0000u), __uint_as_float(gv.y << 16), __uint_as_float(gv.y & 0xffff0000u),
                              __uint_as_float(gv.z << 16), __uint_as_float(gv.z & 0xffff0000u), __uint_as_float(gv.w << 16), __uint_as_float(gv.w & 0xffff0000u)};
                if (b != 3) {
                    const u32x4 hv = gg[gi % 3][bj][1];
                    const float gn[8] = {__uint_as_float(hv.x << 16), __uint_as_float(hv.x & 0xffff0000u), __uint_as_float(hv.y << 16), __uint_as_float(hv.y & 0xffff0000u),
                                         __uint_as_float(hv.z << 16), __uint_as_float(hv.z & 0xffff0000u), __uint_as_float(hv.w << 16), __uint_as_float(hv.w & 0xffff0000u)};
#pragma unroll
                    for (int n = 0; n < 2; ++n)
#pragma unroll
                        for (int j = 0; j < 4; ++j) acc[ai][bj][m][n][j] *= fmaxf(g[n * 4 + j], 1e-30f) * __builtin_amdgcn_rcpf(fmaxf(gn[n * 4 + j], 1e-30f));
                } else {
                    float o[8];
#pragma unroll
                    for (int n = 0; n < 2; ++n)
#pragma unroll
                        for (int j = 0; j < 4; ++j) o[n * 4 + j] = acc[ai][bj][m][n][j] * fmaxf(g[n * 4 + j], 1e-30f);
                    u32x4 w; w.x = cvt_pk_bf16(o[0], o[1]); w.y = cvt_pk_bf16(o[2], o[3]); w.z = cvt_pk_bf16(o[4], o[5]); w.w = cvt_pk_bf16(o[6], o[7]);
                    *(u32x4*)(mergedb + (size_t)r * D + c) = w;
                } }
            asm volatile("" ::: "memory"); }
#undef BC_LOAD
    }
};
template <class Sched> __device__ __forceinline__ void fill_rstd_table(const Sched& So, const float* ssp, __attribute__((address_space(3))) float* tab, int wave) {
    int t_ = wave * 64 + (int)__builtin_amdgcn_mbcnt_hi(~0u, __builtin_amdgcn_mbcnt_lo(~0u, 0u)); asm volatile("" : "+v"(t_));
    const int t = t_, row = t >> 1, half = t & 1;
#pragma unroll 1
    for (int ui = 0; ui < 8; ++ui) { Unit u; if (!So.next(ui, u)) break;
        const f32x4* p = (const f32x4*)(ssp + (size_t)(u.pm * BM + row) * 32 + half * 16); const f32x4 a = p[0], b = p[1], c = p[2], d = p[3];
        float s = (((a[0] + a[1]) + (a[2] + a[3])) + ((b[0] + b[1]) + (b[2] + b[3]))) + (((c[0] + c[1]) + (c[2] + c[3])) + ((d[0] + d[1]) + (d[2] + d[3])));
        s += __shfl_xor(s, 1);
        if (half == 0) tab[ui * 256 + row] = 1.0f / sqrtf(s * (1.0f / D) + EPS); }
}
struct BranchOrder {
    pg8::StaticOrder so;
    __device__ bool next(int i, Unit& u) const { if (i >= 4) return false; Unit t; if (!so.next(0, t)) return false; u.pm = i * 32 + t.pm; u.pn = i * 8 + t.pn; return true; }
    __device__ __forceinline__ void a_ready(const Unit&, int) const {}
    __device__ __forceinline__ void done(const Unit&) const {}
};
}
constexpr size_t MiB = 1u << 20;
constexpr size_t WS_CTL = 0, CTL_ZERO_BYTES = 1 * MiB;
constexpr size_t WS_COS = 1 * MiB, WS_SIN = 2 * MiB, WS_SSP = 3 * MiB;
constexpr size_t WS_WGU1 = 4 * MiB, WS_WD1 = 48 * MiB, WS_WGU2 = 70 * MiB, WS_WD2 = 114 * MiB;
constexpr size_t WS_WIN = 136 * MiB, WS_WBR = 195 * MiB, WS_WOUT = 203 * MiB, WS_WMLA = 211 * MiB;
constexpr size_t WS_X = 214 * MiB;
constexpr size_t WS_XN = 278 * MiB;
constexpr size_t WS_HID = 310 * MiB;
constexpr size_t WS_P = 398 * MiB;
constexpr size_t WS_Z = 634 * MiB;
constexpr size_t WS_VVN = 666 * MiB, WS_MLAA = 674 * MiB;
constexpr size_t WS_MLARAW = 682 * MiB;
constexpr size_t WS_QP = 1426 * MiB, WS_KP = 1458 * MiB, WS_VT = 770 * MiB;
constexpr int QKP = 256;
constexpr size_t WS_ORAW = 786 * MiB;
constexpr size_t WS_MERGED = 818 * MiB, WS_MERGEDB = 882 * MiB;
constexpr size_t WS_PEXP = 914 * MiB;
constexpr size_t WS_DILO = 1490 * MiB, WS_DILL = 1540 * MiB;
constexpr size_t WS_MQ = WS_QP, WS_MK = WS_KP, WS_MV = WS_VT, WS_MOP = WS_PEXP, WS_MLP = WS_ORAW;
constexpr size_t WS_END = 1541 * MiB;
static_assert(WS_WGU1 + (size_t)NGU * D * 2 <= WS_WD1 && WS_WD1 + (size_t)D * FF * 2 <= WS_WGU2 && WS_WGU2 + (size_t)NGU * D * 2 <= WS_WD2 && WS_WD2 + (size_t)D * FF * 2 <= WS_WIN, "ws map 1");
static_assert(WS_WIN + (size_t)NINP * D * 2 <= WS_WBR && WS_WBR + (size_t)4 * D * 512 * 2 <= WS_WOUT && WS_WOUT + (size_t)D * D * 2 <= WS_WMLA && WS_WMLA + (size_t)NMLA * 512 * 2 <= WS_X, "ws map 2");
static_assert(WS_X + (size_t)S * D * 4 <= WS_XN && WS_XN + (size_t)S * D * 2 <= WS_HID && WS_HID + (size_t)S * FF * 2 <= WS_P && WS_P + (size_t)S * NINP * 2 <= WS_Z, "ws map 3");
static_assert(WS_Z + (size_t)4 * S * 512 * 2 <= WS_VVN && WS_MLARAW + (size_t)S * NMLA * 4 <= WS_VT && WS_KP + (size_t)4 * S * QKP * 2 <= WS_END && WS_ORAW + (size_t)4 * S * 256 * 4 <= WS_MERGED && WS_MERGED + (size_t)S * D * 4 <= WS_MERGEDB && WS_MERGEDB + (size_t)S * D * 2 <= WS_PEXP && WS_PEXP + (size_t)4 * S * S * 2 <= WS_QP, "ws map 4");
constexpr size_t WS_SETD = 956 * MiB;
static_assert(WS_WGU1 + WS_SETD >= WS_PEXP + (size_t)2 * 4 * S * 128 * 4 && WS_X + WS_SETD <= WS_QP, "second weight set");
#ifndef TAILCONV
#define TAILCONV 0
#endif
constexpr int CPARTS = 416;
constexpr int CW_BAR = 4096;

constexpr int NWAVES = 8;
constexpr int RING_OFF = 0, RING_BYTES = 131072;
constexpr int LDS_BYTES = 163840;
constexpr int LDSCTL_OFF = LDS_BYTES - 1024, MISC_OFF = LDSCTL_OFF + 320;
constexpr int RSTD_OFF = RING_BYTES + 1024;

enum { I_X = 0, I_F1N, I_F1G, I_F1U, I_F1D, I_MIXN, I_WIN, I_POOLW, I_POOLS, I_DQN, I_DKN, I_SGUN, I_SGUW, I_SGUB, I_MQAN, I_MWUQ, I_MKVAN, I_MWUKV, I_MQN, I_MKN, I_WBR, I_WOUT, I_F2N, I_F2G, I_F2U, I_F2D, N_INPUTS };

struct Frame {
    LAS unsigned char* lds;
    volatile LAS unsigned* MISC;
    int wave, vcu, G;
    int gw, NGW, NGT;
};
constexpr int NPHASE = 13;
struct Args { const float* in[N_INPUTS]; float* out; unsigned char* ws; int l_lo, l_hi, ph_lo, ph_hi; };
typedef const __attribute__((address_space(4))) Args* ArgsP;
__device__ __forceinline__ ArgsP fresh_args() { ArgsP p = (ArgsP)__builtin_amdgcn_kernarg_segment_ptr(); asm volatile("" : "+s"(p)); return p; }
__device__ __forceinline__ int opq_s(int x) { asm volatile("" : "+s"(x)); return x; }
__device__ __forceinline__ Frame fresh_frame(const Frame& F) { Frame R = F; R.wave = opq_s(F.wave); R.vcu = opq_s(F.vcu); R.G = opq_s(F.G); R.gw = opq_s(F.gw); R.NGW = opq_s(F.NGW); R.NGT = opq_s(F.NGT); return R; }
__device__ __forceinline__ int opq_lane() { int l = (int)__builtin_amdgcn_mbcnt_hi(~0u, __builtin_amdgcn_mbcnt_lo(~0u, 0u)); asm volatile("" : "+v"(l)); return l; }
__device__ __forceinline__ float wave_sum(float v) {
#pragma unroll
    for (int o = 1; o < 64; o <<= 1) v += __shfl_xor(v, o);
    return v;
}
__device__ __forceinline__ float wave_max(float v) {
#pragma unroll
    for (int o = 1; o < 64; o <<= 1) v = fmaxf(v, __shfl_xor(v, o));
    return v;
}
__device__ __forceinline__ float bf2f(unsigned short b) { return __uint_as_float(((unsigned)b) << 16); }
__device__ __forceinline__ float bflo(unsigned u) { return __uint_as_float(u << 16); }
__device__ __forceinline__ float bfhi(unsigned u) { return __uint_as_float(u & 0xffff0000u); }
__device__ __forceinline__ float rsq(float x) { return 1.0f / sqrtf(x); }

typedef float f32x16 __attribute__((ext_vector_type(16)));
#define MFMA32(a, b, c) __builtin_amdgcn_mfma_f32_32x32x16_bf16((a), (b), (c), 0, 0, 0)
__device__ __forceinline__ void transpose_load(f32x4 (&v)[8], const float* W, int ldw, int k0, int n0, int lane) {
    const int pc = lane & 7, kr = lane >> 3;
#pragma unroll
    for (int i = 0; i < 8; ++i) v[i] = __builtin_nontemporal_load((const GAS f32x4*)(W + (size_t)(k0 + 8 * i + kr) * ldw + n0 + 4 * pc));
}
__device__ __forceinline__ void transpose_store(const f32x4 (&v)[8], int k0, bf16* WT, int ldt, int drow0, int dk0, LAS float* scr, int lane, const float* kgain) {
    const int pc = lane & 7, kr = lane >> 3;
#pragma unroll
    for (int i = 0; i < 8; ++i) { LAS float* d = scr + (8 * i + kr) * 33 + 4 * pc; const float gk = kgain ? kgain[k0 + 8 * i + kr] : 1.0f;
        d[0] = v[i].x * gk; d[1] = v[i].y * gk; d[2] = v[i].z * gk; d[3] = v[i].w * gk; }
    LDS_WAIT(); asm volatile("" ::: "memory");
    const int c = lane & 7;
#pragma unroll
    for (int j = 0; j < 4; ++j) { const int n = (lane >> 3) + 8 * j; const LAS float* s = scr + (8 * c) * 33 + n;
        v4u o; o.x = pk2(s[0 * 33], s[1 * 33]); o.y = pk2(s[2 * 33], s[3 * 33]); o.z = pk2(s[4 * 33], s[5 * 33]); o.w = pk2(s[6 * 33], s[7 * 33]);
        *(GAS v4u*)(WT + (size_t)(drow0 + n) * ldt + dk0 + k0 + 8 * c) = o; }
    LDS_WAIT(); asm volatile("" ::: "memory");
}
template <int MAP> __device__ __forceinline__ int map_row(int n0, int roff) {
    if (MAP == 0) return n0 + roff;
    if (MAP == 1) return (n0 >> 7) * 256 + roff + (n0 & 127);
    return (n0 < 6720) ? (n0 + 8192) : (n0 - 6720);
}
template <int MAP> __device__ __forceinline__ void transpose_matrix(const Frame& F, int vgw, int vNGW, int p0, int p1, int lane, const float* W, int K, int N, bf16* WT, int ldt, int roff, int dk0, const float* kgain = nullptr) {
    LAS float* scr = (LAS float*)(F.lds + RING_OFF + (vgw & 7) * 16384);
    const int nblk = N / 32, items = (K / 64) * nblk, lo = (int)((long)items * p0 / CPARTS), hi = (int)((long)items * p1 / CPARTS);
    int it = lo + vgw; if (it >= hi) return;
    f32x4 va[8], vb[8]; transpose_load(va, W, N, 64 * (it / nblk), 32 * (it % nblk), lane);
    for (;;) {
        const int itn = it + vNGW; const bool more = itn < hi;
        if (more) transpose_load(vb, W, N, 64 * (itn / nblk), 32 * (itn % nblk), lane);
        transpose_store(va, 64 * (it / nblk), WT, ldt, map_row<MAP>(32 * (it % nblk), roff), dk0, scr, lane, kgain);
        if (!more) break;
#pragma unroll
        for (int i = 0; i < 8; ++i) va[i] = vb[i];
        it = itn;
    }
}

struct TDesc { const float* W; const float* kgain; bf16* WT; int N, nblk, ldt, roff, dk0, map, first; };
constexpr int TI_FD = (FF / 64) * (D / 32), TI_FG = (D / 64) * (FF / 32), TI_WO = (D / 64) * (D / 32), TI_BR = (512 / 64) * (D / 32), TI_UQ = (384 / 64) * (768 / 32), TI_UKV = (128 / 64) * (1024 / 32), TI_WIN = (D / 64) * (NIN / 32);
constexpr int TS1 = TI_FD, TS2 = TS1 + TI_FG, TS3 = TS2 + TI_FG, TS4 = TS3 + TI_WO, TS5 = TS4 + TI_BR, TS6 = TS5 + TI_BR, TS7 = TS6 + TI_BR, TS8 = TS7 + TI_UQ, TS9 = TS8 + TI_UKV, TS10 = TS9 + TI_WIN, TS11 = TS10 + TI_FD, TS12 = TS11 + TI_FG, TS_ALL = TS12 + TI_FG;
__device__ __forceinline__ TDesc conv_desc(ArgsP A, unsigned char* ws, int l, int it) {
    TDesc d; d.kgain = nullptr; d.roff = 0; d.dk0 = 0; d.map = 0;
    if (it < TS1)       { d.W = A->in[I_F2D] + (size_t)l * FF * D; d.N = D; d.WT = (bf16*)(ws + WS_WD2); d.ldt = FF; d.first = 0; }
    else if (it < TS2)  { d.W = A->in[I_F2G] + (size_t)l * D * FF; d.N = FF; d.WT = (bf16*)(ws + WS_WGU2); d.ldt = D; d.map = 1; d.kgain = A->in[I_F2N] + (size_t)l * D; d.first = TS1; }
    else if (it < TS3)  { d.W = A->in[I_F2U] + (size_t)l * D * FF; d.N = FF; d.WT = (bf16*)(ws + WS_WGU2); d.ldt = D; d.map = 1; d.roff = 128; d.kgain = A->in[I_F2N] + (size_t)l * D; d.first = TS2; }
    else if (it < TS4)  { d.W = A->in[I_WOUT] + (size_t)l * D * D; d.N = D; d.WT = (bf16*)(ws + WS_WOUT); d.ldt = D; d.first = TS3; }
    else if (it < TS7)  { const int b = (it < TS5) ? 1 : (it < TS6) ? 2 : 3; d.W = A->in[I_WBR] + ((size_t)l * 4 + b) * 512 * D; d.N = D; d.WT = (bf16*)(ws + WS_WBR) + (size_t)b * D * 512; d.ldt = 512; d.first = TS4 + (b - 1) * TI_BR; }
    else if (it < TS8)  { d.W = A->in[I_MWUQ] + (size_t)l * 384 * 768; d.N = 768; d.WT = (bf16*)(ws + WS_WMLA); d.ldt = 512; d.first = TS7; }
    else if (it < TS9)  { d.W = A->in[I_MWUKV] + (size_t)l * 128 * 1024; d.N = 1024; d.WT = (bf16*)(ws + WS_WMLA); d.ldt = 512; d.roff = 768; d.dk0 = 384; d.first = TS8; }
    else if (it < TS10) { d.W = A->in[I_WIN] + (size_t)l * D * NIN; d.N = NIN; d.WT = (bf16*)(ws + WS_WIN); d.ldt = D; d.map = 2; d.kgain = A->in[I_MIXN] + (size_t)l * D; d.first = TS9; }
    else if (it < TS11) { d.W = A->in[I_F1D] + (size_t)l * FF * D; d.N = D; d.WT = (bf16*)(ws + WS_WD1); d.ldt = FF; d.first = TS10; }
    else if (it < TS12) { d.W = A->in[I_F1G] + (size_t)l * D * FF; d.N = FF; d.WT = (bf16*)(ws + WS_WGU1); d.ldt = D; d.map = 1; d.kgain = A->in[I_F1N] + (size_t)l * D; d.first = TS11; }
    else                { d.W = A->in[I_F1U] + (size_t)l * D * FF; d.N = FF; d.WT = (bf16*)(ws + WS_WGU1); d.ldt = D; d.map = 1; d.roff = 128; d.kgain = A->in[I_F1N] + (size_t)l * D; d.first = TS12; }
    d.nblk = d.N / 32;
    return d;
}
__device__ __forceinline__ int map_row_rt(int map, int n0, int roff) { return (map == 0) ? n0 + roff : (map == 1) ? (n0 >> 7) * 256 + roff + (n0 & 127) : ((n0 < 6720) ? (n0 + 8192) : (n0 - 6720)); }
__device__ __forceinline__ void transpose_all(ArgsP A, const Frame& F, unsigned char* ws, int l, int vgw, int vNGW, int p0, int p1, int lane) {
    LAS float* scr = (LAS float*)(F.lds + RING_OFF + (vgw & 7) * 16384);
    const int lo = (int)((long)TS_ALL * p0 / CPARTS), hi = (int)((long)TS_ALL * p1 / CPARTS);
    int it = lo + vgw; if (it >= hi) return;
    TDesc dc = conv_desc(A, ws, l, it); int loc = it - dc.first, kb = loc / dc.nblk, nbk = loc - kb * dc.nblk;
    f32x4 va[8], vb[8]; transpose_load(va, dc.W, dc.N, 64 * kb, 32 * nbk, lane);
    for (;;) {
        const int itn = it + vNGW; const bool more = itn < hi;
        TDesc dn = dc; int kbn = 0, nbn = 0;
        if (more) { dn = conv_desc(A, ws, l, itn); const int ln = itn - dn.first; kbn = ln / dn.nblk; nbn = ln - kbn * dn.nblk; transpose_load(vb, dn.W, dn.N, 64 * kbn, 32 * nbn, lane); }
        transpose_store(va, 64 * kb, dc.WT, dc.ldt, map_row_rt(dc.map, 32 * nbk, dc.roff), dc.dk0, scr, lane, dc.kgain);
        if (!more) break;
#pragma unroll
        for (int i = 0; i < 8; ++i) va[i] = vb[i];
        it = itn; dc = dn; kb = kbn; nbk = nbn;
    }
}

__device__ __forceinline__ void phase_convert(ArgsP A, const Frame& F, int l, int vgw, int vNGW, int p0, int p1) {
    unsigned char* ws = A->ws + (size_t)(l & 1) * WS_SETD; const int lane = opq_lane(); const int vgt = vgw * 64 + lane, vNGT = vNGW * 64;
#define TM(MAP, ...) transpose_matrix<MAP>(F, vgw, vNGW, p0, p1, lane, __VA_ARGS__)
#define PART(n, lo, hi) const int lo = (int)((long)(n) * p0 / CPARTS), hi = (int)((long)(n) * p1 / CPARTS)
    transpose_all(A, F, ws, l, vgw, vNGW, p0, p1, lane);
    { bf16* wm = (bf16*)(ws + WS_WMLA);
      { PART(768 * 128, lo, hi); for (int i = lo + vgt; i < hi; i += vNGT) wm[(size_t)(i >> 7) * 512 + 384 + (i & 127)] = 0; }
      { PART(1024 * 384, lo, hi); for (int i = lo + vgt; i < hi; i += vNGT) wm[(size_t)(768 + i / 384) * 512 + (i % 384)] = 0; }
      unsigned* wz = (unsigned*)((bf16*)(ws + WS_WIN) + (size_t)NIN * D);
      { PART((NINP - NIN) * D / 2, lo, hi); for (int i = lo + vgt; i < hi; i += vNGT) wz[i] = 0u; } }
    { const float* pw = A->in[I_POOLW] + (size_t)l * 4 * 128 * 128; const float* ps = A->in[I_POOLS] + (size_t)l * 512; const float* wb = A->in[I_WBR] + (size_t)l * 4 * 512 * D;
      bf16* wt = (bf16*)(ws + WS_WBR);
      PART(1024, lo, hi);
      if ((vgw & 1) == 0)
      for (int blk = lo + (vgw >> 1); blk < hi; blk += (vNGW >> 1)) {
          const int rb = blk >> 6, nb = blk & 63, g = rb >> 2, ql = lane & 31, h = lane >> 5;
          const float* arow = pw + (size_t)(32 * rb + ql) * 128 + 8 * h;
          const float* bcol = wb + (size_t)(g * 128 + 8 * h) * D + 32 * nb + ql;
          const float* psr = ps + g * 128 + 8 * h;
          f32x16 acc;
#pragma unroll
          for (int e = 0; e < 16; ++e) acc[e] = 0.f;
#pragma unroll
          for (int half = 0; half < 2; ++half) {
              f32x4 av[4][2], pv[4][2]; float bv[4][8];
#pragma unroll
              for (int k4 = 0; k4 < 4; ++k4) { const int ks = 4 * half + k4;
                  av[k4][0] = *(const f32x4*)(arow + 16 * ks); av[k4][1] = *(const f32x4*)(arow + 16 * ks + 4); pv[k4][0] = *(const f32x4*)(psr + 16 * ks); pv[k4][1] = *(const f32x4*)(psr + 16 * ks + 4);
#pragma unroll
                  for (int j = 0; j < 8; ++j) bv[k4][j] = bcol[(size_t)(16 * ks + j) * D]; }
#pragma unroll
              for (int k4 = 0; k4 < 4; ++k4) { v4u ah, al, bh, bl;
#define SPLIT2(x0, x1, HI, LO) { const unsigned h0_ = f2bf(x0), h1_ = f2bf(x1); HI = h0_ | (h1_ << 16); LO = f2bf((x0) - __uint_as_float(h0_ << 16)) | (f2bf((x1) - __uint_as_float(h1_ << 16)) << 16); }
                  SPLIT2(av[k4][0][0], av[k4][0][1], ah.x, al.x) SPLIT2(av[k4][0][2], av[k4][0][3], ah.y, al.y) SPLIT2(av[k4][1][0], av[k4][1][1], ah.z, al.z) SPLIT2(av[k4][1][2], av[k4][1][3], ah.w, al.w)
                  const float b0 = bv[k4][0] * pv[k4][0][0], b1 = bv[k4][1] * pv[k4][0][1], b2 = bv[k4][2] * pv[k4][0][2], b3 = bv[k4][3] * pv[k4][0][3];
                  const float b4 = bv[k4][4] * pv[k4][1][0], b5 = bv[k4][5] * pv[k4][1][1], b6 = bv[k4][6] * pv[k4][1][2], b7 = bv[k4][7] * pv[k4][1][3];
                  SPLIT2(b0, b1, bh.x, bl.x) SPLIT2(b2, b3, bh.y, bl.y) SPLIT2(b4, b5, bh.z, bl.z) SPLIT2(b6, b7, bh.w, bl.w)
#undef SPLIT2
                  const bf16x8 Ah = __builtin_bit_cast(bf16x8, ah), Al = __builtin_bit_cast(bf16x8, al), Bh = __builtin_bit_cast(bf16x8, bh), Bl = __builtin_bit_cast(bf16x8, bl);
                  acc = MFMA32(Al, Bh, acc); acc = MFMA32(Ah, Bl, acc); acc = MFMA32(Ah, Bh, acc); } }
          bf16* o = wt + (size_t)(32 * nb + ql) * 512 + 32 * rb + 4 * h;
#pragma unroll
          for (int q = 0; q < 4; ++q) *(unsigned long long*)(o + 8 * q) = (unsigned long long)pk2(acc[4 * q], acc[4 * q + 1]) | ((unsigned long long)pk2(acc[4 * q + 2], acc[4 * q + 3]) << 32);
      } }
#undef TM
#undef PART
}
__device__ __forceinline__ void tail_convert(ArgsP A, const Frame& F, int l, int bx, int nunits, int p0, int p1) {
#if !TAILCONV
    return;
#endif
    const int busy = nunits % F.G; if (busy == 0 || l + 1 >= NLAYER) return;
    const int slot = bx - busy; if (slot < 0) return;
    phase_convert(A, F, l + 1, slot * NWAVES + F.wave, (F.G - busy) * NWAVES, p0, p1);
}
__device__ __forceinline__ void phase_rope_tables(ArgsP A, const Frame& F) {
    unsigned char* ws = A->ws; const int lane = opq_lane(); const int gw = opq_s(F.gw); const int gt = gw * 64 + lane;
    {
        float* ct = (float*)(ws + WS_COS); float* st = (float*)(ws + WS_SIN);
        for (int i = gt; i < S * 32; i += F.NGT) { const int pos = i >> 5, k = i & 31;
            double f = 1.0; for (int j = 0; j < k; ++j) f *= 0.74989420933245582730;
            const float ang = (float)pos * (float)f;
            const double a = (double)ang; const double kq = __builtin_rint(a * 0.63661977236758134308); const double r = (a - kq * 1.5707963267948966192) - kq * 6.123233995736766e-17;
            const double r2 = r * r;
            const double sn = r * (1.0 + r2 * (-1.0 / 6 + r2 * (1.0 / 120 + r2 * (-1.0 / 5040 + r2 * (1.0 / 362880 + r2 * (-1.0 / 39916800 + r2 * (1.0 / 6227020800.0)))))));
            const double cs = 1.0 + r2 * (-0.5 + r2 * (1.0 / 24 + r2 * (-1.0 / 720 + r2 * (1.0 / 40320 + r2 * (-1.0 / 3628800 + r2 * (1.0 / 479001600.0 + r2 * (-1.0 / 87178291200.0)))))));
            const int q = ((int)kq) & 3;
            const double sv = (q == 0) ? sn : (q == 1) ? cs : (q == 2) ? -sn : -cs;
            const double cv = (q == 0) ? cs : (q == 1) ? -sn : (q == 2) ? -cs : sn;
            ct[i] = (float)cv; st[i] = (float)sv; }
    }
}
__device__ __forceinline__ void phase_prep(const Frame& F, const float* x, bf16* xb, float* ssp) {
    const int lane = opq_lane(); const int gw = opq_s(F.gw);
    for (int m = gw; m < S; m += F.NGW) {
        const GAS f32x4* xr = (const GAS f32x4*)(x + (size_t)m * D) + lane;
        f32x4 v[8]; float s = 0.f;
#pragma unroll
        for (int j = 0; j < 8; ++j) { v[j] = xr[64 * j]; s += (v[j].x * v[j].x + v[j].y * v[j].y) + (v[j].z * v[j].z + v[j].w * v[j].w); }
        s = wave_sum(s);
        GAS unsigned long long* o8 = (GAS unsigned long long*)(xb + (size_t)m * D) + lane;
#pragma unroll
        for (int j = 0; j < 8; ++j) o8[64 * j] = (unsigned long long)pk2(v[j].x, v[j].y) | ((unsigned long long)pk2(v[j].z, v[j].w) << 32);
        if (lane < 32) ssp[(size_t)m * 32 + lane] = (lane == 0) ? s : 0.f;
    }
}
__device__ __forceinline__ void phase_mix1(ArgsP A, const Frame& F, int l) {
    unsigned char* ws = A->ws; const int lane = opq_lane(); const int gw = opq_s(F.gw); const int gt = gw * 64 + lane;
    bf16* p = (bf16*)(ws + WS_P); bf16* z0 = (bf16*)(ws + WS_Z); bf16* vvn = (bf16*)(ws + WS_VVN); bf16* mlaA = (bf16*)(ws + WS_MLAA);
    for (int item = gt; item < (S / 16) * 256; item += F.NGT) {
        const int cp = item & 255, t0 = (item >> 8) * 16, g = cp >> 6;
        const bf16* col = p + PC_POOL + 2 * cp;
        float va[32], vb[32];
#pragma unroll
        for (int k = 0; k < 32; ++k) { const int tt = t0 - 8 + k; const bool in = (tt >= 0) && (tt < S); const unsigned u = in ? *(const unsigned*)(col + (size_t)(in ? tt : 0) * NINP) : 0u; va[k] = bflo(u); vb[k] = bfhi(u); }
        unsigned* zo = (unsigned*)(z0 + (size_t)t0 * 512 + 2 * cp);
#define POOL_GROUP(HW) do { \
        _Pragma("unroll") for (int i = 0; i < 16; ++i) { float sa = 0.f, sb = 0.f; \
            _Pragma("unroll") for (int k = 8 + i - (HW); k < 8 + i + (HW); ++k) { sa += va[k]; sb += vb[k]; }     \
            const int t = t0 + i, lo = (t - (HW)) < 0 ? 0 : (t - (HW)), hi = (t + (HW)) > S ? S : (t + (HW)); const float inv = 1.0f / (float)(hi - lo); \
            zo[(size_t)i * 256] = pk2(sa * inv - va[8 + i], sb * inv - vb[8 + i]); } } while (0)
        if (g == 0) POOL_GROUP(1); else if (g == 1) POOL_GROUP(2); else if (g == 2) POOL_GROUP(4); else POOL_GROUP(8);
#undef POOL_GROUP
    }
    const float* gq = A->in[I_DQN] + l * 128; const float* gk = A->in[I_DKN] + l * 128; const float* gs = A->in[I_SGUN] + l * 512;
    const float* gqa = A->in[I_MQAN] + l * 384; const float* gkva = A->in[I_MKVAN] + l * 128;
    const float gq0 = gq[2 * lane], gq1 = gq[2 * lane + 1], gk0 = gk[2 * lane], gk1 = gk[2 * lane + 1];
    float gsv[8];
#pragma unroll
    for (int k = 0; k < 8; ++k) gsv[k] = gs[8 * lane + k];
    const float ga0 = gqa[2 * lane], ga1 = gqa[2 * lane + 1], ga2 = gqa[128 + 2 * lane], ga3 = gqa[129 + 2 * lane], ga4 = gqa[256 + 2 * lane], ga5 = gqa[257 + 2 * lane];
    const float gv0 = gkva[2 * lane], gv1 = gkva[2 * lane + 1];
    for (int t = gw; t < S; t += F.NGW) {
        bf16* prow = p + (size_t)t * NINP;
        unsigned* ptr = (unsigned*)(prow + PC_DIL) + lane; unsigned uu[24]; float ss[24];
#pragma unroll
        for (int hh = 0; hh < 24; ++hh) uu[hh] = ptr[hh * 64];
        const v4u u = *((const v4u*)(prow + PC_SGU + 512) + lane);
        const unsigned* cq = (const unsigned*)(prow + PC_CQ) + lane; const unsigned u0 = cq[0], u1 = cq[64], u2 = cq[128];
        const unsigned uk = *((const unsigned*)(prow + PC_CKV) + lane);
        asm volatile("" ::: "memory");
        {
#pragma unroll
          for (int hh = 0; hh < 24; ++hh) { const float a = bflo(uu[hh]), b = bfhi(uu[hh]); ss[hh] = a * a + b * b; }
#pragma unroll
          for (int o = 1; o < 64; o <<= 1) {
#pragma unroll
              for (int hh = 0; hh < 24; ++hh) ss[hh] += __shfl_xor(ss[hh], o); }
#pragma unroll
          for (int hh = 0; hh < 24; ++hh) { const float rstd = __builtin_amdgcn_rsqf(ss[hh] * (1.f / 128) + EPS);
              ptr[hh * 64] = pk2(bflo(uu[hh]) * rstd * (hh < 12 ? gq0 : gk0), bfhi(uu[hh]) * rstd * (hh < 12 ? gq1 : gk1)); } }
        { float x[8] = {bflo(u.x), bfhi(u.x), bflo(u.y), bfhi(u.y), bflo(u.z), bfhi(u.z), bflo(u.w), bfhi(u.w)}; float s2 = 0.f;
#pragma unroll
          for (int k = 0; k < 8; ++k) s2 += x[k] * x[k];
          const float a0 = bflo(u0), b0 = bfhi(u0), a1 = bflo(u1), b1 = bfhi(u1), a2 = bflo(u2), b2 = bfhi(u2); const float ak = bflo(uk), bk = bfhi(uk);
          float sq = (a0 * a0 + b0 * b0) + (a1 * a1 + b1 * b1) + (a2 * a2 + b2 * b2), sk = ak * ak + bk * bk;
#pragma unroll
          for (int o = 1; o < 64; o <<= 1) { s2 += __shfl_xor(s2, o); sq += __shfl_xor(sq, o); sk += __shfl_xor(sk, o); }
          const float rstd = __builtin_amdgcn_rsqf(s2 * (1.f / 512) + EPS), rq = __builtin_amdgcn_rsqf(sq * (1.f / 384) + EPS), rk = __builtin_amdgcn_rsqf(sk * (1.f / 128) + EPS);
          v4u o; o.x = pk2(x[0] * rstd * gsv[0], x[1] * rstd * gsv[1]); o.y = pk2(x[2] * rstd * gsv[2], x[3] * rstd * gsv[3]); o.z = pk2(x[4] * rstd * gsv[4], x[5] * rstd * gsv[5]); o.w = pk2(x[6] * rstd * gsv[6], x[7] * rstd * gsv[7]);
          *((v4u*)(vvn + (size_t)t * 512) + lane) = o;
          unsigned* om = (unsigned*)(mlaA + (size_t)t * 512) + lane;
          om[0] = pk2(a0 * rq * ga0, b0 * rq * ga1); om[64] = pk2(a1 * rq * ga2, b1 * rq * ga3); om[128] = pk2(a2 * rq * ga4, b2 * rq * ga5);
          om[192] = pk2(ak * rk * gv0, bk * rk * gv1); }
    }
}
typedef short s16x4 __attribute__((ext_vector_type(4)));
typedef short v4i16_t __attribute__((ext_vector_type(4)));
__device__ __forceinline__ int crow(int reg, int h) { return (reg & 3) + 8 * (reg >> 2) + 4 * h; }
__device__ __forceinline__ bf16x8 pack8(const f32x16& x, int s) {
    v4u p; p.x = epi::cvt_pk_bf16(x[8 * s], x[8 * s + 1]); p.y = epi::cvt_pk_bf16(x[8 * s + 2], x[8 * s + 3]); p.z = epi::cvt_pk_bf16(x[8 * s + 4], x[8 * s + 5]); p.w = epi::cvt_pk_bf16(x[8 * s + 6], x[8 * s + 7]);
    return __builtin_bit_cast(bf16x8, p);
}
__device__ __forceinline__ s16x4 tr_read(const LAS unsigned char* p) { return __builtin_bit_cast(s16x4, __builtin_amdgcn_ds_read_tr16_b64_v4i16((LAS v4i16_t*)p)); }
__device__ __forceinline__ int vimg_off(int key, int piece  ) { return key * 256 + (((piece >> 2) ^ (key & 3)) << 6) + ((piece & 3) << 4); }
__device__ __forceinline__ bf16x8 vt_frag(const LAS unsigned char* img, int key0, int d0, int lane) {
    const int h = lane >> 5, blk = (lane >> 4) & 1, q = (lane & 15) >> 2, pp = lane & 3;
    const int ka = key0 + 4 * h + q, kb = ka + 8;
    const int col = ((d0 ^ q) << 6) + (16 * blk + 4 * pp) * 2;
    const s16x4 lo = tr_read(img + ka * 256 + col), hi = tr_read(img + kb * 256 + col);
    return __builtin_shufflevector(lo, hi, 0, 1, 2, 3, 4, 5, 6, 7);
}
__device__ __forceinline__ int vt_lane_off(int lane, int d0) { const int h = lane >> 5, blk = (lane >> 4) & 1, q = (lane & 15) >> 2, pp = lane & 3; return (4 * h + q) * 256 + ((d0 ^ q) << 6) + (16 * blk + 4 * pp) * 2; }
template <int KEY0> __device__ __forceinline__ bf16x8 vt_frag_o(const LAS unsigned char* img, int voff) {
    const s16x4 lo = tr_read(img + voff + KEY0 * 256), hi = tr_read(img + voff + (KEY0 + 8) * 256);
    return __builtin_shufflevector(lo, hi, 0, 1, 2, 3, 4, 5, 6, 7);
}
__device__ __forceinline__ bf16x8 tr_frag(const LAS unsigned char* img, int ra, int rb, int cb, int lane) {
    const int blk = (lane >> 4) & 1, q = (lane & 15) >> 2, pp = lane & 3;
    const int col = ((cb ^ q) << 6) + (16 * blk + 4 * pp) * 2;
    const s16x4 lo = tr_read(img + (ra + q) * 256 + col), hi = tr_read(img + (rb + q) * 256 + col);
    return __builtin_shufflevector(lo, hi, 0, 1, 2, 3, 4, 5, 6, 7);
}
__device__ __forceinline__ void sgu_mix_mfma(ArgsP A, const Frame& F, int l, int lane) {
    unsigned char* ws = A->ws; const bf16* p = (const bf16*)(ws + WS_P); const bf16* vvn = (const bf16*)(ws + WS_VVN); bf16* z2 = (bf16*)(ws + WS_Z) + (size_t)2 * S * 512;
    const float* sw = A->in[I_SGUW] + (size_t)l * 4 * 128 * 128; const float* sb = A->in[I_SGUB] + (size_t)l * 4 * 128;
    LAS unsigned char* img = F.lds + RING_OFF;
    const int w = F.wave, tid = w * 64 + lane, ql = lane & 31, h = lane >> 5, tb = 32 * (w & 3), cb0 = 2 * (w >> 2);
    for (int unit = F.vcu; unit < 256; unit += F.G) {
        const int n = unit >> 2, g = unit & 3;
#pragma unroll
        for (int i = 0; i < 4; ++i) { const int idx = i * 512 + tid, s = idx >> 4, piece = idx & 15;
            *(LAS v4u*)(img + vimg_off(s, piece)) = *(const v4u*)(vvn + (size_t)(n * 128 + s) * 512 + g * 128 + piece * 8); }
        __syncthreads();
        f32x16 acc0, acc1;
#pragma unroll
        for (int e = 0; e < 16; ++e) { acc0[e] = 0.f; acc1[e] = 0.f; }
        const float* wrow = sw + ((size_t)g * 128 + tb + ql) * 128 + 8 * h;
#pragma unroll
        for (int ks = 0; ks < 8; ++ks) {
            const f32x4 a0 = *(const f32x4*)(wrow + 16 * ks), a1 = *(const f32x4*)(wrow + 16 * ks + 4);
            v4u ap; ap.x = epi::cvt_pk_bf16(a0.x, a0.y); ap.y = epi::cvt_pk_bf16(a0.z, a0.w); ap.z = epi::cvt_pk_bf16(a1.x, a1.y); ap.w = epi::cvt_pk_bf16(a1.z, a1.w);
            const bf16x8 af = __builtin_bit_cast(bf16x8, ap);
            acc0 = MFMA32(af, tr_frag(img, 16 * ks + 8 * h, 16 * ks + 8 * h + 4, cb0, lane), acc0);
            acc1 = MFMA32(af, tr_frag(img, 16 * ks + 8 * h, 16 * ks + 8 * h + 4, cb0 + 1, lane), acc1);
        }
        { const int c0 = g * 128 + 32 * cb0 + ql; float bias[16], u0[16], u1[16];
#pragma unroll
          for (int e = 0; e < 16; ++e) { const int tl = tb + crow(e, h), t = n * 128 + tl; bias[e] = sb[g * 128 + tl];
              u0[e] = bf2f(p[(size_t)t * NINP + PC_SGU + c0]); u1[e] = bf2f(p[(size_t)t * NINP + PC_SGU + c0 + 32]); }
#pragma unroll
          for (int e = 0; e < 16; ++e) { const int tl = tb + crow(e, h), t = n * 128 + tl;
              z2[(size_t)t * 512 + c0] = (bf16)f2bf(u0[e] * (acc0[e] + bias[e])); z2[(size_t)t * 512 + c0 + 32] = (bf16)f2bf(u1[e] * (acc1[e] + bias[e])); } }
        __syncthreads();
    }
}
__device__ __forceinline__ void dil_attention(ArgsP A, const Frame& F, int l, int gw, int lane) {
    unsigned char* ws = A->ws; const bf16* p = (const bf16*)(ws + WS_P);
    float* OP = (float*)(ws + WS_DILO); float* LP = (float*)(ws + WS_DILL);
    LAS unsigned char* img = F.lds + RING_OFF + (gw & 7) * 8192;
    const float* gq = A->in[I_DQN] + l * 128; const float* gk = A->in[I_DKN] + l * 128;
    const float cbound = 11.313708499f * wave_max(fmaxf(fabsf(gq[lane]), fabsf(gq[lane + 64]))) * wave_max(fmaxf(fabsf(gk[lane]), fabsf(gk[lane + 64])));
    const int ql = lane & 31, h = lane >> 5;
    const int nun = ((gw & 7) < 4) ? 2 : 1;
    for (int kk = 0; kk < ((F.G == 256) ? nun : 1 << 30); ++kk) {
        const int unit = (F.G == 256) ? (gw >> 3) * 12 + (gw & 7) + 8 * kk : gw + kk * F.NGW; if (unit >= 12 * 256) break;
        const int hq = unit >> 8, blk = unit & 255, g = hq >> 2, ih = hq & 3, dl = 1 << (2 * g), L = S >> (2 * g), nb = 256 >> (2 * g);
        const int r = blk / nb, b = blk % nb;
        const float slope = __builtin_amdgcn_exp2f(-8.0f * (float)(hq + 1) / 12.0f) * (float)dl;
        const int tq = r + dl * (32 * b + ql);
        bf16x8 qf[8];
        { const v4u* src = (const v4u*)(p + (size_t)tq * NINP + PC_DIL + hq * 128 + 8 * h);
#pragma unroll
          for (int s = 0; s < 8; ++s) qf[s] = __builtin_bit_cast(bf16x8, src[2 * s]); }
        f32x16 o[4]; float lsum = 0.f;
#pragma unroll
        for (int d0 = 0; d0 < 4; ++d0)
#pragma unroll
            for (int e = 0; e < 16; ++e) o[d0][e] = 0.f;
        const int c_lo = (b >= 2) ? -2 : -b, c_hi = (b + 2 <= (L >> 5) - 1) ? 2 : (L >> 5) - 1 - b;
        v4u vreg[8]; bf16x8 kf[8];
#define DIL_LOADK(c_) { const v4u* src_ = (const v4u*)(p + (size_t)(r + dl * (32 * (b + (c_)) + ql)) * NINP + PC_DIL + 1536 + hq * 128 + 8 * h); _Pragma("unroll") for (int s_ = 0; s_ < 8; ++s_) kf[s_] = __builtin_bit_cast(bf16x8, src_[2 * s_]); }
#define DIL_LOADV(c_) { _Pragma("unroll") for (int i_ = 0; i_ < 8; ++i_) { const int idx_ = i_ * 64 + lane, key_ = idx_ >> 4, piece_ = idx_ & 15; \
            vreg[i_] = *(const v4u*)(p + (size_t)(r + dl * (32 * (b + (c_)) + key_)) * NINP + PC_DIL + 3072 + hq * 128 + piece_ * 8); } }
        DIL_LOADK(c_lo) DIL_LOADV(c_lo)
#pragma unroll 1
        for (int c = c_lo; c <= c_hi; ++c) {
            const int cn = (c < c_hi) ? c + 1 : c;
            f32x16 sacc;
#pragma unroll
            for (int e = 0; e < 16; ++e) sacc[e] = 0.f;
#pragma unroll
            for (int s = 0; s < 8; ++s) sacc = MFMA32(kf[s], qf[s], sacc);
#pragma unroll
            for (int i = 0; i < 8; ++i) { const int idx = i * 64 + lane, key = idx >> 4, piece = idx & 15; *(LAS v4u*)(img + vimg_off(key, piece)) = vreg[i]; }
            DIL_LOADV(cn)
#pragma unroll
            for (int e = 0; e < 16; ++e) { const int rel = 32 * c + crow(e, h) - ql, arel = rel < 0 ? -rel : rel;
                const float sv = sacc[e] * 0.08838834764831845f - slope * (float)arel - cbound;
                const float pe = (arel <= 64) ? epi::fast_exp(sv) : 0.f; sacc[e] = pe; lsum += pe; }
            const bf16x8 pb0 = pack8(sacc, 0), pb1 = pack8(sacc, 1);
            DIL_LOADK(cn)
#pragma unroll
            for (int d0 = 0; d0 < 4; ++d0) { o[d0] = MFMA32(vt_frag(img, 0, d0, lane), pb0, o[d0]); o[d0] = MFMA32(vt_frag(img, 16, d0, lane), pb1, o[d0]); }
        }
#undef DIL_LOADK
#undef DIL_LOADV
        lsum += __shfl_xor(lsum, 32);
        float* orow = OP + ((size_t)g * S + tq) * 512 + ih * 128 + 4 * h;
#pragma unroll
        for (int d0 = 0; d0 < 4; ++d0)
#pragma unroll
            for (int k = 0; k < 4; ++k) { f32x4 v; v.x = o[d0][4 * k]; v.y = o[d0][4 * k + 1]; v.z = o[d0][4 * k + 2]; v.w = o[d0][4 * k + 3]; *(f32x4*)(orow + 32 * d0 + 8 * k) = v; }
        if (h == 0) LP[((size_t)g * S + tq) * 4 + ih] = lsum;
    }
}
__device__ __forceinline__ void phase_mix2(ArgsP A, const Frame& F, int l) {
    unsigned char* ws = A->ws; const int lane = opq_lane(); const int gw = opq_s(F.gw); const int gt = gw * 64 + lane;
    const bf16* p = (const bf16*)(ws + WS_P); const float* raw = (const float*)(ws + WS_MLARAW);
    const float* ct = (const float*)(ws + WS_COS); const float* st = (const float*)(ws + WS_SIN);
    const float* gqn = A->in[I_MQN] + l * 192; const float* gkn = A->in[I_MKN] + l * 192;
    const float QSCL = 0.07216878364870322f * 1.4426950408889634f;
    bf16* MQ = (bf16*)(ws + WS_MQ); bf16* MK = (bf16*)(ws + WS_MK); bf16* MV = (bf16*)(ws + WS_MV);
    sgu_mix_mfma(A, F, l, lane);
    const int w8 = gw & 7, tok0 = (gw >> 3) * 32 + (w8 < 4 ? 2 * w8 : 8 + 6 * (w8 - 4)), npair = (w8 < 4) ? 1 : 3;
    const float gq0 = gqn[lane], gq1 = gqn[lane + 64], gq2 = gqn[lane + 128], gk0 = gkn[lane], gk1 = gkn[lane + 64], gk2 = gkn[lane + 128];
    for (int jj = 0; jj < ((F.G == 256) ? npair : 1 << 30); ++jj) { const int tb = (F.G == 256) ? tok0 + 2 * jj : 2 * (gw + jj * F.NGW); if (tb >= S) break;
        float cs[2], sn[2], krv[2], q0[2][4], q1[2][4], q2[2][4], k0[2][4], k1[2][4], v0[2][4], v1[2][4], sq[2][4], sk[2][4];
#pragma unroll
        for (int u = 0; u < 2; ++u) { const int t = tb + u; cs[u] = ct[t * 32 + (lane & 31)]; sn[u] = st[t * 32 + (lane & 31)];
            const float* rr = raw + (size_t)t * NMLA; krv[u] = bf2f(p[(size_t)t * NINP + PC_KR + lane]);
#pragma unroll
            for (int h = 0; h < 4; ++h) { q0[u][h] = rr[h * 192 + lane]; q1[u][h] = rr[h * 192 + 64 + lane]; q2[u][h] = rr[h * 192 + 128 + lane];
                k0[u][h] = rr[768 + h * 256 + lane]; k1[u][h] = rr[768 + h * 256 + 64 + lane]; v0[u][h] = rr[768 + h * 256 + 128 + lane]; v1[u][h] = rr[768 + h * 256 + 192 + lane]; } }
#pragma unroll
        for (int u = 0; u < 2; ++u)
#pragma unroll
            for (int h = 0; h < 4; ++h) { sq[u][h] = q0[u][h] * q0[u][h] + q1[u][h] * q1[u][h] + q2[u][h] * q2[u][h]; sk[u][h] = k0[u][h] * k0[u][h] + k1[u][h] * k1[u][h] + krv[u] * krv[u]; }
#pragma unroll
        for (int o = 1; o < 64; o <<= 1) {
#pragma unroll
            for (int u = 0; u < 2; ++u)
#pragma unroll
                for (int h = 0; h < 4; ++h) { sq[u][h] += __shfl_xor(sq[u][h], o); sk[u][h] += __shfl_xor(sk[u][h], o); } }
#pragma unroll
        for (int u = 0; u < 2; ++u) { const int t = tb + u;
#pragma unroll
        for (int h = 0; h < 4; ++h) {
            const float rq = rsq(sq[u][h] * (1.f / 192) + EPS) * QSCL, rk = rsq(sk[u][h] * (1.f / 192) + EPS);
            const float a2 = q2[u][h] * rq * gq2, oa = __shfl_xor(a2, 32), a2r = (lane < 32) ? (a2 * cs[u] - oa * sn[u]) : (oa * sn[u] + a2 * cs[u]);
            const float b2 = krv[u] * rk * gk2, ob = __shfl_xor(b2, 32), b2r = (lane < 32) ? (b2 * cs[u] - ob * sn[u]) : (ob * sn[u] + b2 * cs[u]);
            bf16* qo = MQ + ((size_t)h * S + t) * 192; bf16* ko = MK + ((size_t)h * S + t) * 192; bf16* vo = MV + ((size_t)h * S + t) * 128;
            qo[lane] = (bf16)f2bf(q0[u][h] * rq * gq0); qo[lane + 64] = (bf16)f2bf(q1[u][h] * rq * gq1); qo[lane + 128] = (bf16)f2bf(a2r);
            ko[lane] = (bf16)f2bf(k0[u][h] * rk * gk0); ko[lane + 64] = (bf16)f2bf(k1[u][h] * rk * gk1); ko[lane + 128] = (bf16)f2bf(b2r);
            vo[lane] = (bf16)f2bf(v0[u][h]); vo[lane + 64] = (bf16)f2bf(v1[u][h]); } }
    }
    dil_attention(A, F, l, gw, lane);
}


constexpr int MLA_KROW = 400, MLA_KIMG = 64 * MLA_KROW, MLA_VIMG = 64 * 256;
constexpr int FL_V0 = 2 * MLA_KIMG, FL_P0 = FL_V0 + 2 * MLA_VIMG, FL_PBUF = 8 * 1024, FL_END = FL_P0 + 4 * 2 * FL_PBUF;
constexpr int FL_FLAG = FL_END;
static_assert(FL_FLAG + 64 <= LDSCTL_OFF, "flash LDS map");
#define FL_SB() __builtin_amdgcn_sched_barrier(0)
__device__ __forceinline__ void flash_scores(LAS unsigned char* lds, const bf16* MQ, const bf16* MK, const bf16* MV, float* LP, float c2, int vcu, int G, int w, int lane) {
    const int ql = lane & 31, hh = lane >> 5;
    LAS unsigned char* pw = lds + FL_P0 + w * 2 * FL_PBUF + lane * 16;
    volatile LAS unsigned* flag = (volatile LAS unsigned*)(lds + FL_FLAG + 16 * w); unsigned gen = 0u;
    for (int unit = vcu; unit < 256; unit += G) {
        const int kh = unit & 1, qb = (unit >> 1) & 31, h = unit >> 6;
        const bf16* Kg = MK + ((size_t)h * S + kh * 4096) * 192; const bf16* Vg = MV + ((size_t)h * S + kh * 4096) * 128;
        const int tq = qb * 256 + w * 64 + ql;
        bf16x8 qf0[12], qf1[12];
        { const v4u* src = (const v4u*)(MQ + ((size_t)h * S + tq) * 192 + 8 * hh);
#pragma unroll
          for (int s = 0; s < 12; ++s) { qf0[s] = __builtin_bit_cast(bf16x8, src[2 * s]); qf1[s] = __builtin_bit_cast(bf16x8, src[2 * s + 32 * 24]); } }
        float lsum0 = 0.f, lsum1 = 0.f;
        if (unit == vcu) *flag = 0u;
        __syncthreads();
#pragma unroll 1
        for (int jt = 0; jt < 64; ++jt) {
            const LAS unsigned char* kr0 = lds + (jt & 1) * MLA_KIMG + ql * MLA_KROW + 16 * hh;
            f32x16 s00, s01, s10, s11;
#pragma unroll
            for (int e = 0; e < 16; ++e) { s00[e] = -c2; s01[e] = -c2; s10[e] = -c2; s11[e] = -c2; }
#define KFRAG(f) (*(const LAS bf16x8*)(kr0 + ((f) >= 12 ? 32 * MLA_KROW : 0) + 32 * ((f) % 12)))
#define KLOAD(dst, f0) do { _Pragma("unroll") for (int i_ = 0; i_ < 4; ++i_) dst[i_] = KFRAG((f0) + i_); } while (0)
#define KMMA(src, f0) do { _Pragma("unroll") for (int i_ = 0; i_ < 4; ++i_) { if ((f0) + i_ < 12) { s00 = MFMA32(src[i_], qf0[((f0) + i_) % 12], s00); s10 = MFMA32(src[i_], qf1[((f0) + i_) % 12], s10); } \
                                                                               else { s01 = MFMA32(src[i_], qf0[((f0) + i_) % 12], s01); s11 = MFMA32(src[i_], qf1[((f0) + i_) % 12], s11); } } } while (0)
            bf16x8 kA[4], kB[4];
            KLOAD(kA, 0);
            KLOAD(kB, 4);  FL_SB(); KMMA(kA, 0);  FL_SB();
            KLOAD(kA, 8);  FL_SB(); KMMA(kB, 4);  FL_SB();
            KLOAD(kB, 12); FL_SB(); KMMA(kA, 8);  FL_SB();
            KLOAD(kA, 16); FL_SB(); KMMA(kB, 12); FL_SB();
            KLOAD(kB, 20); FL_SB(); KMMA(kA, 16); FL_SB();
            KMMA(kB, 20); FL_SB();
            *flag = ++gen; FL_SB();
#undef KFRAG
#undef KLOAD
#undef KMMA
            LAS unsigned char* pb = pw + (jt & 1) * FL_PBUF;
#define EXPW(sx, ls, f0) { _Pragma("unroll") for (int e = 0; e < 16; ++e) { const float p_ = __builtin_amdgcn_exp2f(sx[e]); sx[e] = p_; ls += p_; } \
                           *(LAS bf16x8*)(pb + (f0) * 1024) = pack8(sx, 0); *(LAS bf16x8*)(pb + ((f0) + 1) * 1024) = pack8(sx, 1); }
            EXPW(s00, lsum0, 0) EXPW(s01, lsum0, 2) EXPW(s10, lsum1, 4) EXPW(s11, lsum1, 6)
#undef EXPW
            __syncthreads();
        }
        lsum0 += __shfl_xor(lsum0, 32); lsum1 += __shfl_xor(lsum1, 32);
        if (hh == 0) { LP[((size_t)kh * 4 + h) * S + tq] = lsum0; LP[((size_t)kh * 4 + h) * S + tq + 32] = lsum1; }
    }
}
__device__ __forceinline__ void flash_pv(LAS unsigned char* lds, const bf16* MK, const bf16* MV, float* OP, int vcu, int G, int pw, int lane) {
    const int ql = lane & 31, hh = lane >> 5;
    int ksrc[7], vsrc[4];
#pragma unroll
    for (int i = 0; i < 7; ++i) { const int L = (pw + 4 * i) * 1024 + 16 * lane, row = L / MLA_KROW, within = L - row * MLA_KROW; ksrc[i] = (row < 64 ? row : 0) * 192 + (within < 384 ? within / 2 : 0); }
#pragma unroll
    for (int i = 0; i < 4; ++i) { const int L = (pw + 4 * i) * 1024 + 16 * lane, key = L >> 8, pos = (L & 255) >> 4; vsrc[i] = key * 128 + ((((pos >> 2) ^ (key & 3)) << 2) | (pos & 3)) * 8; }
#define FL_DMAK(jt_) { const bf16* kg_ = Kg + (size_t)(jt_) * 64 * 192; LAS unsigned char* kd_ = lds + ((jt_) & 1) * MLA_KIMG; \
        _Pragma("unroll") for (int i_ = 0; i_ < 6; ++i_) __builtin_amdgcn_global_load_lds((const unsigned*)(kg_ + ksrc[i_]), (LAS unsigned*)(kd_ + (pw + 4 * i_) * 1024), 16, 0, 0); \
        if (pw == 0) __builtin_amdgcn_global_load_lds((const unsigned*)(kg_ + ksrc[6]), (LAS unsigned*)(kd_ + 24 * 1024), 16, 0, 0); }
#define FL_DMAV(jt_) { const bf16* vg_ = Vg + (size_t)(jt_) * 64 * 128; LAS unsigned char* vd_ = lds + FL_V0 + ((jt_) & 1) * MLA_VIMG; \
        _Pragma("unroll") for (int i_ = 0; i_ < 4; ++i_) __builtin_amdgcn_global_load_lds((const unsigned*)(vg_ + vsrc[i_]), (LAS unsigned*)(vd_ + (pw + 4 * i_) * 1024), 16, 0, 0); }
    int voff[4];
#pragma unroll
    for (int d0 = 0; d0 < 4; ++d0) voff[d0] = vt_lane_off(lane, d0);
    const LAS unsigned char* pr = lds + FL_P0 + pw * 2 * FL_PBUF + lane * 16;
    volatile LAS unsigned* flag = (volatile LAS unsigned*)(lds + FL_FLAG + 16 * pw); unsigned gen = 0u;
    for (int unit = vcu; unit < 256; unit += G) {
        const int kh = unit & 1, qb = (unit >> 1) & 31, h = unit >> 6;
        const bf16* Kg = MK + ((size_t)h * S + kh * 4096) * 192; const bf16* Vg = MV + ((size_t)h * S + kh * 4096) * 128;
        const int tq = qb * 256 + pw * 64 + ql;
        f32x16 o0[4], o1[4];
#pragma unroll
        for (int d0 = 0; d0 < 4; ++d0)
#pragma unroll
            for (int e = 0; e < 16; ++e) { o0[d0][e] = 0.f; o1[d0][e] = 0.f; }
        FL_DMAK(0) VM_WAIT();
        __syncthreads();
#define PV_TILE(t_, WAITGEN) { const LAS unsigned char* pb = pr + ((t_) & 1) * FL_PBUF; const LAS unsigned char* vimg = lds + FL_V0 + ((t_) & 1) * MLA_VIMG; \
            bf16x8 pf[8]; _Pragma("unroll") for (int f = 0; f < 8; ++f) pf[f] = *(const LAS bf16x8*)(pb + f * 1024); \
            if (WAITGEN) { while (*flag < gen) __builtin_amdgcn_s_sleep(1); } \
            _Pragma("unroll") for (int dd = 0; dd < 4; ++dd) { bf16x8 vf[4]; \
                vf[0] = vt_frag_o<0>(vimg, voff[dd]); vf[1] = vt_frag_o<16>(vimg, voff[dd]); vf[2] = vt_frag_o<32>(vimg, voff[dd]); vf[3] = vt_frag_o<48>(vimg, voff[dd]); \
                _Pragma("unroll") for (int ks = 0; ks < 4; ++ks) { o0[dd] = MFMA32(vf[ks], pf[ks], o0[dd]); o1[dd] = MFMA32(vf[ks], pf[4 + ks], o1[dd]); } } }
#pragma unroll 1
        for (int jt = 0; jt < 64; ++jt) {
            if (jt + 1 < 64) FL_DMAK(jt + 1)
            FL_DMAV(jt)
            ++gen;
            if (jt > 0) PV_TILE(jt - 1, true)
            VM_WAIT();
            __syncthreads();
        }
        PV_TILE(63, false)
#undef PV_TILE
#pragma unroll
        for (int b = 0; b < 2; ++b) { float* orow = OP + (((size_t)kh * 4 + h) * S + tq + 32 * b) * 128 + 4 * hh;
#pragma unroll
            for (int d0 = 0; d0 < 4; ++d0)
#pragma unroll
                for (int k = 0; k < 4; ++k) { const f32x16& oo = b ? o1[d0] : o0[d0]; f32x4 v; v.x = oo[4 * k]; v.y = oo[4 * k + 1]; v.z = oo[4 * k + 2]; v.w = oo[4 * k + 3]; *(f32x4*)(orow + 32 * d0 + 8 * k) = v; } }
    }
}
__device__ __forceinline__ void phase_mla_flash(ArgsP A, const Frame& F, int l) {
    unsigned char* ws = A->ws; const int lane = opq_lane();
    const bf16* MQ = (const bf16*)(ws + WS_MQ); const bf16* MK = (const bf16*)(ws + WS_MK); const bf16* MV = (const bf16*)(ws + WS_MV);
    float* OP = (float*)(ws + WS_MOP); float* LP = (float*)(ws + WS_MLP);
    const float* gqn = A->in[I_MQN] + l * 192; const float* gkn = A->in[I_MKN] + l * 192;
    const float c2 = 19.990625f * wave_max(fmaxf(fmaxf(fabsf(gqn[lane]), fabsf(gqn[lane + 64])), fabsf(gqn[lane + 128]))) * wave_max(fmaxf(fmaxf(fabsf(gkn[lane]), fabsf(gkn[lane + 64])), fabsf(gkn[lane + 128])));
    if (F.wave < 4) flash_scores(F.lds, MQ, MK, MV, LP, c2, F.vcu, F.G, F.wave, lane);
    else flash_pv(F.lds, MK, MV, OP, F.vcu, F.G, F.wave - 4, lane);
    __syncthreads();
}
#undef FL_SB
#undef FL_DMAK
#undef FL_DMAV
__device__ __forceinline__ void dil_combine(ArgsP A, const Frame& F) {
    unsigned char* ws = A->ws; const int lane = opq_lane(); const int gw = opq_s(F.gw); const int gt = gw * 64 + lane;
    const float* OP = (const float*)(ws + WS_DILO); const float* LP = (const float*)(ws + WS_DILL); bf16* z1 = (bf16*)(ws + WS_Z) + (size_t)1 * S * 512;
    for (int base = gt; base < S * 64; base += 2 * F.NGT) {
        f32x4 a[2][6]; float den[2][3];
#pragma unroll
        for (int k = 0; k < 2; ++k) { const int it = base + k * F.NGT, itc = it < S * 64 ? it : gt, t = itc >> 6, ih = (itc & 63) >> 4; const size_t idx = (size_t)itc * 8;
#pragma unroll
            for (int g = 0; g < 3; ++g) { a[k][2 * g] = *(const f32x4*)(OP + (size_t)g * S * 512 + idx); a[k][2 * g + 1] = *(const f32x4*)(OP + (size_t)g * S * 512 + idx + 4); den[k][g] = LP[((size_t)g * S + t) * 4 + ih]; } }
#pragma unroll
        for (int k = 0; k < 2; ++k) { const int it = base + k * F.NGT; if (it >= S * 64) break;
            const float inv = 1.0f / ((den[k][0] + den[k][1]) + den[k][2]); const f32x4 lo = ((a[k][0] + a[k][2]) + a[k][4]) * inv, hi = ((a[k][1] + a[k][3]) + a[k][5]) * inv;
            v4u o; o.x = pk2(lo[0], lo[1]); o.y = pk2(lo[2], lo[3]); o.z = pk2(hi[0], hi[1]); o.w = pk2(hi[2], hi[3]);
            *(v4u*)(z1 + (size_t)it * 8) = o; }
    }
}
__device__ __forceinline__ void phase_mix3(ArgsP A, const Frame& F) {
    unsigned char* ws = A->ws; const int lane = opq_lane(); const int gw = opq_s(F.gw); const int gt = gw * 64 + lane;
    const float* MO = (const float*)(ws + WS_MOP); const float* ML = (const float*)(ws + WS_MLP); bf16* z3 = (bf16*)(ws + WS_Z) + (size_t)3 * S * 512;
    for (int base = gt; base < S * 64; base += 4 * F.NGT) {
        f32x4 a[4][4]; float den[4][2];
#pragma unroll
        for (int k = 0; k < 4; ++k) { const int it = base + k * F.NGT, itc = it < S * 64 ? it : gt, t = itc >> 6, c8 = (itc & 63) * 8, h = c8 >> 7, d = c8 & 127;
            const size_t r0 = (size_t)h * S + t, r1 = ((size_t)4 + h) * S + t;
            a[k][0] = *(const f32x4*)(MO + r0 * 128 + d); a[k][1] = *(const f32x4*)(MO + r0 * 128 + d + 4); a[k][2] = *(const f32x4*)(MO + r1 * 128 + d); a[k][3] = *(const f32x4*)(MO + r1 * 128 + d + 4);
            den[k][0] = ML[r0]; den[k][1] = ML[r1]; }
#pragma unroll
        for (int k = 0; k < 4; ++k) { const int it = base + k * F.NGT; if (it >= S * 64) break;
            const float inv = 1.0f / (den[k][0] + den[k][1]); const f32x4 lo = (a[k][0] + a[k][2]) * inv, hi = (a[k][1] + a[k][3]) * inv;
            v4u o; o.x = pk2(lo[0], lo[1]); o.y = pk2(lo[2], lo[3]); o.z = pk2(hi[0], hi[1]); o.w = pk2(hi[2], hi[3]);
            *(v4u*)(z3 + (size_t)it * 8) = o; }
    }
}

__global__ void __launch_bounds__(NWAVES * 64, 2) mk_fwd(Args args_unused) {
    extern __shared__ __attribute__((aligned(16))) unsigned char lds[];
    Frame F;
    F.lds = (LAS unsigned char*)lds;
    F.MISC = (volatile LAS unsigned*)(F.lds + MISC_OFF);
    F.wave = __builtin_amdgcn_readfirstlane((int)(threadIdx.x >> 6));
    F.G = gridDim.x; { const int bx = blockIdx.x; F.vcu = (F.G % 8 == 0) ? (bx % 8) * (F.G / 8) + bx / 8 : bx; }
    F.gw = F.vcu * NWAVES + F.wave; F.NGW = F.G * NWAVES; F.NGT = F.NGW * 64;
    for (int u = threadIdx.x; u < (LDS_BYTES - LDSCTL_OFF) / 4; u += NWAVES * 64) ((LAS unsigned*)(F.lds + LDSCTL_OFF))[u] = 0u;
    __syncthreads();
    int l_lo, l_hi; bool multi; XcdBarrier bar;
    { ArgsP A = fresh_args(); l_lo = A->l_lo; l_hi = A->l_hi;
      multi = !((l_hi - l_lo) == 1 && (A->ph_hi - A->ph_lo) == 1);
      unsigned* bw = (unsigned*)((gu32*)(A->ws + WS_CTL) + CW_BAR);
      bar.bar = bw; bar.x = 0; bar.st = F.MISC + 8;
      if (multi) bar = xcd_barrier_post(bw, F.MISC + 8); }
#define SEAM() do { if (multi) xcd_barrier(bar); } while (0)
#ifdef ONLY_PHASE
#define IN(k) ((k) == ONLY_PHASE && lo <= (k) && (k) < hi)
#else
#define IN(k) (lo <= (k) && (k) < hi)
#endif
#ifndef G_ALIGN
#define G_ALIGN true
#endif
#ifndef G_SP2
#define G_SP2 true
#endif
#define GEMM(EPI, ORDER) pg8::gemm_phase<EPI, ORDER, G_ALIGN, G_SP2>(Fl.lds + RING_OFF, g, So, E, Fl.wave)
    { ArgsP A = fresh_args(); if (A->l_lo == 0 && A->ph_lo == 0) phase_rope_tables(A, F); }
    for (int l = l_lo; l < l_hi; ++l) {
        int lo, hi; { ArgsP A = fresh_args(); lo = A->ph_lo; hi = A->ph_hi; }
        if (IN(0)) { ArgsP A = fresh_args(); const Frame Fl = fresh_frame(F); unsigned char* ws = A->ws;
            phase_convert(A, Fl, l, Fl.gw, Fl.NGW, 0, CPARTS);
            if (l == 0) phase_prep(Fl, A->in[I_X], (bf16*)(ws + WS_XN), (float*)(ws + WS_SSP));
            SEAM(); }
        if (IN(1)) { ArgsP A = fresh_args(); const Frame Fl = fresh_frame(F); const int bx = opq_s((int)blockIdx.x); unsigned char* ws = A->ws;
            pg8::Gemm g{(const bf16*)(ws + WS_XN), (const bf16*)(ws + (size_t)(l & 1) * WS_SETD + WS_WGU1), S, NGU, D};
            pg8::StaticOrder So; So.init(S, NGU, Fl.G, bx); epi::fill_rstd_table(So, (const float*)(ws + WS_SSP), (LAS float*)(Fl.lds + RSTD_OFF), Fl.wave); __syncthreads();
            epi::EpiSwiglu E{(bf16*)(ws + WS_HID), (const LAS float*)(Fl.lds + RSTD_OFF)}; GEMM(epi::EpiSwiglu, pg8::StaticOrder); tail_convert(A, Fl, l, bx, (S / 256) * (NGU / 256), 0, 128); SEAM(); }
        if (IN(2)) { ArgsP A = fresh_args(); const Frame Fl = fresh_frame(F); const int bx = opq_s((int)blockIdx.x); unsigned char* ws = A->ws; const float* xin = (l == 0) ? A->in[I_X] : (const float*)(ws + WS_X);
            pg8::Gemm g{(const bf16*)(ws + WS_HID), (const bf16*)(ws + (size_t)(l & 1) * WS_SETD + WS_WD1), S, D, FF}; pg8::StaticOrder So; So.init(S, D, Fl.G, bx);
            epi::EpiResid E{xin, (float*)(ws + WS_X), 0.5f, (bf16*)(ws + WS_XN), (float*)(ws + WS_SSP)}; GEMM(epi::EpiResid, pg8::StaticOrder); SEAM(); }
        if (IN(3)) { ArgsP A = fresh_args(); const Frame Fl = fresh_frame(F); const int bx = opq_s((int)blockIdx.x); unsigned char* ws = A->ws;
            pg8::Gemm g{(const bf16*)(ws + WS_XN), (const bf16*)(ws + (size_t)(l & 1) * WS_SETD + WS_WIN), S, NINP, D};
            pg8::StaticOrder So; So.init(S, NINP, Fl.G, bx); epi::fill_rstd_table(So, (const float*)(ws + WS_SSP), (LAS float*)(Fl.lds + RSTD_OFF), Fl.wave); __syncthreads();
            epi::EpiPin E{(bf16*)(ws + WS_P), (const LAS float*)(Fl.lds + RSTD_OFF)}; GEMM(epi::EpiPin, pg8::StaticOrder); tail_convert(A, Fl, l, bx, (S / 256) * (NINP / 256), 128, 288); SEAM(); }
        if (IN(4)) { ArgsP A = fresh_args(); const Frame Fl = fresh_frame(F); phase_mix1(A, Fl, l); SEAM(); }
        if (IN(5)) { ArgsP A = fresh_args(); const Frame Fl = fresh_frame(F); const int bx = opq_s((int)blockIdx.x); unsigned char* ws = A->ws;
            pg8::Gemm g{(const bf16*)(ws + WS_MLAA), (const bf16*)(ws + (size_t)(l & 1) * WS_SETD + WS_WMLA), S, NMLA, opq_s(512)}; pg8::StaticOrder So; So.init(S, NMLA, Fl.G, bx);
            epi::EpiF32 E{(float*)(ws + WS_MLARAW), NMLA, 1}; GEMM(epi::EpiF32, pg8::StaticOrder); SEAM(); }
        if (IN(6)) { ArgsP A = fresh_args(); const Frame Fl = fresh_frame(F); phase_mix2(A, Fl, l); SEAM(); }
        if (IN(7)) { ArgsP A = fresh_args(); const Frame Fl = fresh_frame(F); phase_mla_flash(A, Fl, l); dil_combine(A, Fl); SEAM(); }
        if (IN(8)) { ArgsP A = fresh_args(); const Frame Fl = fresh_frame(F); phase_mix3(A, Fl); SEAM(); }
        if (IN(9)) { ArgsP A = fresh_args(); const Frame Fl = fresh_frame(F); const int bx = opq_s((int)blockIdx.x); unsigned char* ws = A->ws;
            pg8::Gemm g{(const bf16*)(ws + WS_Z), (const bf16*)(ws + (size_t)(l & 1) * WS_SETD + WS_WBR), 4 * S, 4 * D, opq_s(512)}; epi::BranchOrder So; So.so.init(S, D, Fl.G, bx);
            epi::EpiBranchChain E{(bf16*)(ws + WS_MERGEDB), (const bf16*)(ws + WS_P) + PC_GATE}; GEMM(epi::EpiBranchChain, epi::BranchOrder); SEAM(); }
        if (IN(10)) { ArgsP A = fresh_args(); const Frame Fl = fresh_frame(F); const int bx = opq_s((int)blockIdx.x); unsigned char* ws = A->ws;
            pg8::Gemm g{(const bf16*)(ws + WS_MERGEDB), (const bf16*)(ws + (size_t)(l & 1) * WS_SETD + WS_WOUT), S, D, D}; pg8::StaticOrder So; So.init(S, D, Fl.G, bx);
            epi::EpiResid E{(const float*)(ws + WS_X), (float*)(ws + WS_X), 1.0f, (bf16*)(ws + WS_XN), (float*)(ws + WS_SSP)}; GEMM(epi::EpiResid, pg8::StaticOrder); SEAM(); }
        if (IN(11)) { ArgsP A = fresh_args(); const Frame Fl = fresh_frame(F); const int bx = opq_s((int)blockIdx.x); unsigned char* ws = A->ws;
            pg8::Gemm g{(const bf16*)(ws + WS_XN), (const bf16*)(ws + (size_t)(l & 1) * WS_SETD + WS_WGU2), S, NGU, D};
            pg8::StaticOrder So; So.init(S, NGU, Fl.G, bx); epi::fill_rstd_table(So, (const float*)(ws + WS_SSP), (LAS float*)(Fl.lds + RSTD_OFF), Fl.wave); __syncthreads();
            epi::EpiSwiglu E{(bf16*)(ws + WS_HID), (const LAS float*)(Fl.lds + RSTD_OFF)}; GEMM(epi::EpiSwiglu, pg8::StaticOrder); tail_convert(A, Fl, l, bx, (S / 256) * (NGU / 256), 288, CPARTS); SEAM(); }
        if (IN(12)) { ArgsP A = fresh_args(); const Frame Fl = fresh_frame(F); const int bx = opq_s((int)blockIdx.x); unsigned char* ws = A->ws; const bool lastl = (l == NLAYER - 1);
            pg8::Gemm g{(const bf16*)(ws + WS_HID), (const bf16*)(ws + (size_t)(l & 1) * WS_SETD + WS_WD2), S, D, FF}; pg8::StaticOrder So; So.init(S, D, Fl.G, bx);
            epi::EpiResid E{(const float*)(ws + WS_X), lastl ? A->out : (float*)(ws + WS_X), 0.5f, lastl ? (bf16*)nullptr : (bf16*)(ws + WS_XN), (float*)(ws + WS_SSP)}; GEMM(epi::EpiResid, pg8::StaticOrder);
            SEAM(); }
    }
#undef IN
#undef SEAM
#undef GEMM
}


#ifdef DBG_DUMP_OFF
__global__ void dbg_dump(const unsigned char* ws, float* out, int n) {
    for (int i = blockIdx.x * blockDim.x + threadIdx.x; i < n; i += gridDim.x * blockDim.x) {
        if (i >= DBG_DUMP_N) { out[i] = 0.f; continue; }
#if DBG_DUMP_BF16
        out[i] = __uint_as_float(((unsigned)((const unsigned short*)(ws + DBG_DUMP_OFF))[i]) << 16);
#else
        out[i] = ((const float*)(ws + DBG_DUMP_OFF))[i];
#endif
    }
}
#endif
#ifndef MK_ONE_LAUNCH
#define MK_ONE_LAUNCH 0
#endif
extern "C" void kernel_launch(void* const* d_in, const int* in_sizes, int n_in, void* d_out, int out_size, void* d_ws, size_t ws_size, hipStream_t stream) {
    static int grid = 0;
    if (grid == 0) {
        if (n_in != N_INPUTS || out_size != S * D || ws_size < WS_END) { fprintf(stderr, "kernel_launch: unexpected shapes (n_in %d out %d ws %zu)\n", n_in, out_size, ws_size); grid = -1; return; }
        int dev = 0, cus = 0, per_cu = 0;
        if (hipGetDevice(&dev) != hipSuccess || hipDeviceGetAttribute(&cus, hipDeviceAttributeMultiprocessorCount, dev) != hipSuccess) { grid = -1; return; }
        if (hipFuncSetAttribute((const void*)mk_fwd, hipFuncAttributeMaxDynamicSharedMemorySize, LDS_BYTES) != hipSuccess) { fprintf(stderr, "kernel_launch: hipFuncSetAttribute failed\n"); grid = -1; return; }
        if (hipOccupancyMaxActiveBlocksPerMultiprocessor(&per_cu, (const void*)mk_fwd, NWAVES * 64, LDS_BYTES) != hipSuccess || per_cu < 1) fprintf(stderr, "kernel_launch: occupancy query reports %d\n", per_cu);
        (void)hipGetLastError();
        grid = cus;
    }
    if (grid < 0) return;
    if (hipMemsetAsync((char*)d_ws + WS_CTL, 0, CTL_ZERO_BYTES, stream) != hipSuccess) return;
    Args a{};
    for (int i = 0; i < N_INPUTS; ++i) a.in[i] = (const float*)d_in[i];
    a.out = (float*)d_out; a.ws = (unsigned char*)d_ws;
#if MK_ONE_LAUNCH
    a.l_lo = 0; a.l_hi = NLAYER; a.ph_lo = 0; a.ph_hi = NPHASE;
    hipLaunchKernelGGL(mk_fwd, dim3(grid), dim3(NWAVES * 64), LDS_BYTES, stream, a);
#else
    for (int l = 0; l < NLAYER; ++l)
        for (int ph = 0; ph < NPHASE; ++ph) {
#ifdef DBG_DUMP_OFF
            if (l * NPHASE + ph > DBG_LAST) continue;
#endif
            a.l_lo = l; a.l_hi = l + 1; a.ph_lo = ph; a.ph_hi = ph + 1;
            hipLaunchKernelGGL(mk_fwd, dim3(grid), dim3(NWAVES * 64), LDS_BYTES, stream, a);
#ifdef DUP_MASK
            if ((DUP_MASK >> ph) & 1) hipLaunchKernelGGL(mk_fwd, dim3(grid), dim3(NWAVES * 64), LDS_BYTES, stream, a);
#endif
            }
#ifdef DBG_DUMP_OFF
    hipLaunchKernelGGL(dbg_dump, dim3(2048), dim3(256), 0, stream, (const unsigned char*)d_ws, (float*)d_out, S * D);
#endif
#endif
}
```

```cpp
#define MK_ONE_LAUNCH 1
#define TAILCONV 1
#include <hip/hip_runtime.h>
#include <cstdio>
#include <cstdint>
namespace pg8 {
#define PG8_LAS __attribute__((address_space(3)))
typedef unsigned short bf16_t;
typedef short bf16x8 __attribute__((ext_vector_type(8)));
typedef float f32x4 __attribute__((ext_vector_type(4)));
typedef unsigned u32x4 __attribute__((ext_vector_type(4)));
constexpr int BM = 256, BK = 64, HALF = 128, HTB = HALF * BK * 2  , STAGE_BYTES = 8 * HTB, NXCD = 8, WGM = 4;

__host__ __device__ __forceinline__ int lds_byte(int r, int c) { const int st = (r >> 4) * 2 + (c >> 5), rr = r & 15, cc = c & 31, ob = rr * 64 + cc * 2; return st * 1024 + (ob ^ (((ob >> 9) & 1) << 5)); }
__host__ __device__ __forceinline__ void stage_rc(int b, int& R, int& C) { const int st = b / 1024, sb = b % 1024, swz = sb ^ (((sb >> 9) & 1) << 5); R = (st >> 1) * 16 + swz / 64; C = (st & 1) * 32 + (swz % 64) / 2; }
__host__ __device__ __forceinline__ int perm32(int rho) { const int n = rho >> 4, i = rho & 15; return 8 * (i >> 2) + 4 * n + (i & 3); }

struct Unit { int pm, pn; };
struct Gemm { const bf16_t* A; const bf16_t* Bt; int M, N, K; };

struct StaticOrder {
    int nM, nN, nwg, G, c;
    __host__ __device__ void init(int M, int N, int G_, int c_) { nM = M / BM; nN = N / BM; nwg = nM * nN; G = G_; c = c_; }
    __host__ __device__ bool next(int i, Unit& u) const {
        const long L = (long)i * G + c; if (L >= nwg) return false;
        int wgid = (int)L; { const int q = nwg / NXCD, r = nwg % NXCD, xcd = wgid % NXCD, off = wgid / NXCD; wgid = (xcd < r ? xcd * (q + 1) : r * (q + 1) + (xcd - r) * q) + off; }
        const int nig = WGM * nN, gid = wgid / nig, fm = gid * WGM, gsz = (nM - fm) < WGM ? (nM - fm) : WGM;
        u.pm = fm + ((wgid % nig) % gsz); u.pn = (wgid % nig) / gsz; return true;
    }
    __device__ __forceinline__ void a_ready(const Unit&, int  ) const {}
    __device__ __forceinline__ void done(const Unit&) const {}
};
__device__ __forceinline__ unsigned cvt_pk_bf16(float lo, float hi) { unsigned r; asm volatile("v_cvt_pk_bf16_f32 %0, %1, %2" : "=v"(r) : "v"(lo), "v"(hi)); return r; }
typedef float f32x2 __attribute__((ext_vector_type(2)));
__device__ __forceinline__ f32x2 gelu_pk(f32x2 v) {
    const f32x2 av = __builtin_elementwise_abs(v), d = av * 0.2316418882f + 1.0f;
    f32x2 t; t.x = __builtin_amdgcn_rcpf(d.x); t.y = __builtin_amdgcn_rcpf(d.y);
    f32x2 q = t * 0.5307027145f + (-0.7265760135f); q = q * t + 0.7107068705f; q = q * t + (-0.142248368f); q = q * t + 0.127414796f; q = q * t;
    const f32x2 s = (v * v) * (-0.72134752044f);
    f32x2 e; e.x = __builtin_amdgcn_exp2f(s.x); e.y = __builtin_amdgcn_exp2f(s.y);
    const f32x2 m = v * (q * e), r = v - m;
    f32x2 o; o.x = v.x < 0.f ? m.x : r.x; o.y = v.y < 0.f ? m.y : r.y; return o;
}
template <class Epi, class Sched, bool ALIGN_EPI = false, bool SP2 = false>
__device__ __forceinline__ void gemm_phase(PG8_LAS unsigned char* lds, const Gemm g, const Sched& S, const Epi& E, int wave_in  ) {
    int tid_ = wave_in * 64 + (int)__builtin_amdgcn_mbcnt_hi(~0u, __builtin_amdgcn_mbcnt_lo(~0u, 0u)); asm volatile("" : "+v"(tid_));
    const int tid = tid_, wid = __builtin_amdgcn_readfirstlane(tid >> 6), lane = tid & 63, wr = wid >> 2, wc = wid & 3, fr = lane & 15, fq = lane >> 4;
    const int K = g.K, nt = K / BK;
    unsigned voffA[2], voffB[2];
#pragma unroll
    for (int i = 0; i < 2; ++i) { int R, C; stage_rc(tid * 16 + i * 8192, R, C); const int Rb = Epi::PERM ? ((R & ~31) + perm32(R & 31)) : R;
        voffA[i] = (unsigned)(R * K + C) * 2u; voffB[i] = (unsigned)(Rb * K + C) * 2u; }
    const size_t kstep = (size_t)(BK * 2);
    const size_t hstep = (size_t)HALF * K * 2;
    const size_t tstep = 2 * hstep;
    const unsigned ldsw = (unsigned)wid * 1024u;
    const int aoff = lds_byte(wr * 64 + fr, fq * 8), boff = lds_byte(wc * 32 + fr, fq * 8);
#define PG8_SA(b, h) (((b) * 2 + (h)) * HTB)
#define PG8_SB(b, h) ((4 + (b) * 2 + (h)) * HTB)
#define PG8_STAGE(bufoff, gbase, voff) do { _Pragma("unroll") for (int _i = 0; _i < 2; ++_i) \
        __builtin_amdgcn_global_load_lds((const unsigned*)((const char*)(gbase) + (voff)[_i]), (PG8_LAS unsigned*)(lds + (bufoff) + ldsw + _i * 8192), 16, 0, 0); } while (0)
#define PG8_LDA(dst, b, h) do { _Pragma("unroll") for (int m = 0; m < 4; ++m) _Pragma("unroll") for (int k = 0; k < 2; ++k) dst[m][k] = *(const PG8_LAS bf16x8*)(lds + PG8_SA(b, h) + aoff + m * 2048 + k * 1024); } while (0)
#define PG8_LDB(dst, b, h) do { _Pragma("unroll") for (int n = 0; n < 2; ++n) _Pragma("unroll") for (int k = 0; k < 2; ++k) dst[n][k] = *(const PG8_LAS bf16x8*)(lds + PG8_SB(b, h) + boff + n * 2048 + k * 1024); } while (0)
#define PG8_MMA(ai, bj, At, Bt) do { __builtin_amdgcn_s_setprio(1); _Pragma("unroll") for (int m = 0; m < 4; ++m) _Pragma("unroll") for (int n = 0; n < 2; ++n) _Pragma("unroll") for (int k = 0; k < 2; ++k) \
        acc[ai][bj][m][n] = __builtin_amdgcn_mfma_f32_16x16x32_bf16(Bt[n][k], At[m][k], acc[ai][bj][m][n], 0, 0, 0); __builtin_amdgcn_s_setprio(0); } while (0)
#define PG8_WAIT_V(n) asm volatile("s_waitcnt vmcnt(" #n ")" ::: "memory")
#define PG8_WAIT_L(n) asm volatile("s_waitcnt lgkmcnt(" #n ")" ::: "memory")
#define PG8_BAR __builtin_amdgcn_s_barrier()
#define PG8_SCHED __builtin_amdgcn_sched_barrier(0)
    Unit cur, nxt; int ui = 0;
    if (!S.next(0, cur)) return;
    f32x4 acc[2][2][4][2];
#pragma unroll
    for (int a = 0; a < 2; ++a)
#pragma unroll
        for (int b = 0; b < 2; ++b)
#pragma unroll
            for (int m = 0; m < 4; ++m)
#pragma unroll
                for (int n = 0; n < 2; ++n) acc[a][b][m][n] = (f32x4){0.f, 0.f, 0.f, 0.f};
    bf16x8 At[4][2], B0[2][2], B1[2][2];
    const char* cA = (const char*)g.A + (size_t)cur.pm * tstep; const char* cB = (const char*)g.Bt + (size_t)cur.pn * tstep;
    S.a_ready(cur, 0);
    if constexpr (SP2) {
        PG8_STAGE(PG8_SB(0, 0), cB, voffB); PG8_STAGE(PG8_SB(0, 1), cB + hstep, voffB); PG8_STAGE(PG8_SA(0, 0), cA, voffA); PG8_STAGE(PG8_SA(0, 1), cA + hstep, voffA);
        if (wr == 1) PG8_BAR;
        PG8_WAIT_V(2); PG8_BAR;
        PG8_STAGE(PG8_SB(1, 0), cB + kstep, voffB); PG8_STAGE(PG8_SA(1, 0), cA + kstep, voffA); PG8_STAGE(PG8_SB(1, 1), cB + hstep + kstep, voffB);
        PG8_WAIT_V(6); PG8_BAR;
    } else {
        PG8_STAGE(PG8_SB(0, 0), cB, voffB); PG8_STAGE(PG8_SA(0, 0), cA, voffA); PG8_STAGE(PG8_SB(0, 1), cB + hstep, voffB); PG8_STAGE(PG8_SA(0, 1), cA + hstep, voffA);
        if (wr == 1) PG8_BAR;
        PG8_WAIT_V(4); PG8_BAR;
        PG8_STAGE(PG8_SB(1, 0), cB + kstep, voffB); PG8_STAGE(PG8_SA(1, 0), cA + kstep, voffA); PG8_STAGE(PG8_SB(1, 1), cB + hstep + kstep, voffB);
        PG8_WAIT_V(6); PG8_BAR;
    }
    for (;;) {
        const bool has_next = S.next(ui + 1, nxt);
        const char* nA = has_next ? (const char*)g.A + (size_t)nxt.pm * tstep : cA; const char* nB = has_next ? (const char*)g.Bt + (size_t)nxt.pn * tstep : cB;
        for (int t = 0; t < nt; t += 2) {
            const bool last = (t == nt - 2);
            const char* a1 = cA + (size_t)(t + 1) * kstep;
            const char* a2 = last ? nA : cA + (size_t)(t + 2) * kstep; const char* b2 = last ? nB : cB + (size_t)(t + 2) * kstep;
            const char* a3 = a2 + kstep; const char* b3 = b2 + kstep;
            if (last && has_next) S.a_ready(nxt, ui + 1);
            if constexpr (SP2) {
            PG8_LDB(B0, 0, 0); PG8_LDB(B1, 0, 1); PG8_SCHED; PG8_LDA(At, 0, 0); PG8_STAGE(PG8_SA(1, 1), a1 + hstep, voffA);
            PG8_WAIT_V(8); PG8_WAIT_L(0); PG8_BAR; PG8_MMA(0, 0, At, B0); PG8_MMA(0, 1, At, B1); PG8_BAR; PG8_SCHED;
            PG8_LDA(At, 0, 1); PG8_STAGE(PG8_SB(0, 0), b2, voffB); PG8_STAGE(PG8_SB(0, 1), b2 + hstep, voffB); PG8_STAGE(PG8_SA(0, 0), a2, voffA);
            PG8_WAIT_V(8); PG8_WAIT_L(0); PG8_BAR; PG8_MMA(1, 0, At, B0); PG8_MMA(1, 1, At, B1); PG8_BAR; PG8_SCHED;
            PG8_LDB(B0, 1, 0); PG8_LDB(B1, 1, 1); PG8_SCHED; PG8_LDA(At, 1, 0); PG8_STAGE(PG8_SA(0, 1), a2 + hstep, voffA);
            PG8_WAIT_V(8); PG8_WAIT_L(0); PG8_BAR; PG8_MMA(0, 0, At, B0); PG8_MMA(0, 1, At, B1); PG8_BAR; PG8_SCHED;
            PG8_LDA(At, 1, 1); PG8_STAGE(PG8_SB(1, 0), b3, voffB); PG8_STAGE(PG8_SB(1, 1), b3 + hstep, voffB); PG8_STAGE(PG8_SA(1, 0), a3, voffA);
            PG8_WAIT_V(8); PG8_WAIT_L(0); PG8_BAR; PG8_MMA(1, 0, At, B0); PG8_MMA(1, 1, At, B1); PG8_BAR; PG8_SCHED;
            } else {
            PG8_LDB(B0, 0, 0); PG8_SCHED; PG8_LDA(At, 0, 0); PG8_STAGE(PG8_SA(1, 1), a1 + hstep, voffA);
            PG8_WAIT_L(8); PG8_BAR; PG8_WAIT_L(0); PG8_MMA(0, 0, At, B0); PG8_BAR; PG8_SCHED;
            PG8_LDB(B1, 0, 1); PG8_STAGE(PG8_SB(0, 0), b2, voffB);
            PG8_BAR; PG8_WAIT_L(0); PG8_MMA(0, 1, At, B1); PG8_BAR;
            PG8_LDA(At, 0, 1); PG8_STAGE(PG8_SA(0, 0), a2, voffA);
            PG8_BAR; PG8_WAIT_L(0); PG8_MMA(1, 0, At, B0); PG8_BAR; PG8_SCHED;
            PG8_STAGE(PG8_SB(0, 1), b2 + hstep, voffB);
            PG8_WAIT_V(6); PG8_BAR; PG8_MMA(1, 1, At, B1); PG8_BAR;
            PG8_LDB(B0, 1, 0); PG8_SCHED; PG8_LDA(At, 1, 0); PG8_STAGE(PG8_SA(0, 1), a2 + hstep, voffA);
            PG8_WAIT_L(8); PG8_BAR; PG8_WAIT_L(0); PG8_MMA(0, 0, At, B0); PG8_BAR; PG8_SCHED;
            PG8_LDB(B1, 1, 1); PG8_STAGE(PG8_SB(1, 0), b3, voffB);
            PG8_BAR; PG8_WAIT_L(0); PG8_MMA(0, 1, At, B1); PG8_BAR;
            PG8_LDA(At, 1, 1); PG8_STAGE(PG8_SA(1, 0), a3, voffA);
            PG8_BAR; PG8_WAIT_L(0); PG8_MMA(1, 0, At, B0); PG8_BAR; PG8_SCHED;
            PG8_STAGE(PG8_SB(1, 1), b3 + hstep, voffB);
            PG8_WAIT_V(6); PG8_BAR; PG8_MMA(1, 1, At, B1); PG8_BAR;
            }
        }
        if constexpr (ALIGN_EPI) { if (wr == 0) PG8_BAR; }
        if constexpr (!Epi::AFTER_DRAIN) { E(acc, cur, wr, wc, fr, fq, ui); S.done(cur); }
        if (!has_next) break;
        if constexpr (!Epi::KEEP_ACC) {
#pragma unroll
        for (int a = 0; a < 2; ++a)
#pragma unroll
            for (int b = 0; b < 2; ++b)
#pragma unroll
                for (int m = 0; m < 4; ++m)
#pragma unroll
                    for (int n = 0; n < 2; ++n) acc[a][b][m][n] = (f32x4){0.f, 0.f, 0.f, 0.f};
        }
        cur = nxt; cA = nA; cB = nB; ++ui;
        if constexpr (ALIGN_EPI) { if (wr == 1) PG8_BAR; }
    }
    PG8_WAIT_V(0);
    if constexpr (!ALIGN_EPI) { if (wr == 0) PG8_BAR; }
    PG8_BAR;
    if constexpr (Epi::AFTER_DRAIN) { E.fused(acc, cur, wr, wc, fr, fq, lds, wid, lane); S.done(cur); }
#undef PG8_SA
#undef PG8_SB
#undef PG8_STAGE
#undef PG8_LDA
#undef PG8_LDB
#undef PG8_MMA
#undef PG8_WAIT_V
#undef PG8_WAIT_L
#undef PG8_BAR
#undef PG8_SCHED
}
}
#define GAS __attribute__((address_space(1)))
#define LAS __attribute__((address_space(3)))
typedef unsigned short bf16;
typedef unsigned v4u __attribute__((ext_vector_type(4)));
typedef float f32x4 __attribute__((ext_vector_type(4)));
typedef short bf16x8 __attribute__((ext_vector_type(8)));
typedef GAS unsigned gu32;
typedef GAS unsigned long long gu64;
#define RLX_AGENT __ATOMIC_RELAXED, __HIP_MEMORY_SCOPE_AGENT
#define LDS_WAIT() asm volatile("s_waitcnt lgkmcnt(0)" ::: "memory")
#define VM_WAIT() asm volatile("s_waitcnt vmcnt(0)" ::: "memory")
__device__ __forceinline__ unsigned long long rt() { return __builtin_amdgcn_s_memrealtime(); }
__device__ __forceinline__ unsigned f2bf(float f) { unsigned u = __builtin_bit_cast(unsigned, f); return (u + 0x7fffu + ((u >> 16) & 1u)) >> 16; }
__device__ __forceinline__ unsigned pk2(float lo, float hi) { return f2bf(lo) | (f2bf(hi) << 16); }
#define XB_TMO      128
#define XB_XCNT(j)  (256  + 64 * (j))
#define XB_XSUB(j)  (1280 + 64 * (j))
#define XB_XGEN(j)  (2304 + 64 * (j))
#define XB_TOP      3328
#define XB_TOPGEN   3392
#define XCD_BAR_WORDS 3456
#define XB_SPIN_CAP (1u << 18)

__device__ __forceinline__ unsigned xb_ld(unsigned* p)              { return __hip_atomic_load(p, __ATOMIC_RELAXED, __HIP_MEMORY_SCOPE_AGENT); }
__device__ __forceinline__ unsigned xb_add(unsigned* p, unsigned v) { return __hip_atomic_fetch_add(p, v, __ATOMIC_RELAXED, __HIP_MEMORY_SCOPE_AGENT); }
__device__ __forceinline__ unsigned xb_xcc_id() { return (unsigned)__builtin_amdgcn_s_getreg((3 << 11) | 20) & 0xFu; }
#define XB_SPIN(cond, bar) do { unsigned _sp = 0; while (cond) { __builtin_amdgcn_s_sleep(1); \
    if ((++_sp & 255u) == 0u) { if (xb_ld(&(bar)[XB_TMO])) break; if (_sp > XB_SPIN_CAP) { atomicAdd(&(bar)[XB_TMO], 1u); break; } } } } while (0)

struct XcdBarrier {
    unsigned* bar; unsigned x;
    volatile LAS unsigned* st;
};

__device__ __forceinline__ XcdBarrier xcd_barrier_post(unsigned* bar, volatile LAS unsigned* st) {
    XcdBarrier b; b.bar = bar; b.x = xb_xcc_id(); b.st = st;
    if (threadIdx.x == 0) (void)xb_add(&bar[XB_XCNT(b.x)], 1u);
    return b;
}
__device__ __forceinline__ void xcd_barrier_complete(unsigned* bar, unsigned x, unsigned& nloc, unsigned& nx) {
    const unsigned G = gridDim.x * gridDim.y * gridDim.z;
    unsigned sum, cnt, mine, sp = 0u;
    for (;;) {
        sum = 0u; cnt = 0u; mine = 0u;
#pragma unroll
        for (unsigned j = 0; j < 16; ++j) { const unsigned c = xb_ld(&bar[XB_XCNT(j)]); sum += c; cnt += (c > 0u) ? 1u : 0u; mine = (j == x) ? c : mine; }
        if (sum == G) break;
        __builtin_amdgcn_s_sleep(1);
        if ((++sp & 255u) == 0u) { if (xb_ld(&bar[XB_TMO])) break; if (sp > XB_SPIN_CAP) { atomicAdd(&bar[XB_TMO], 1u); break; } }
    }
    nloc = mine > 0u ? mine : 1u; nx = cnt > 0u ? cnt : 1u;
}

__device__ __forceinline__ void xcd_barrier(const XcdBarrier& b) {
    asm volatile("s_waitcnt vmcnt(0)" ::: "memory");
    __syncthreads();
    if (threadIdx.x == 0) {
        unsigned* bar = b.bar;
        __builtin_amdgcn_s_waitcnt(0);
        unsigned nloc = b.st[0], nx = b.st[1];
        if (nloc == 0u) { xcd_barrier_complete(bar, b.x, nloc, nx); b.st[0] = nloc; b.st[1] = nx; }
        const unsigned old = xb_add(&bar[XB_XSUB(b.x)], 1u);
        const unsigned gen = old / nloc;
        if (old + 1u == (gen + 1u) * nloc) {
            __builtin_amdgcn_fence(__ATOMIC_RELEASE, "agent");
            asm volatile("s_waitcnt vmcnt(0)" ::: "memory");
            const unsigned og = xb_add(&bar[XB_TOP], 1u);
            const unsigned tg = og / nx;
            if (og + 1u == (tg + 1u) * nx) xb_add(&bar[XB_TOPGEN], 1u);
            else XB_SPIN(xb_ld(&bar[XB_TOPGEN]) == tg, bar);
            __builtin_amdgcn_fence(__ATOMIC_ACQUIRE, "agent");
            xb_add(&bar[XB_XGEN(b.x)], 1u);
            asm volatile("s_waitcnt vmcnt(0)" ::: "memory");
        } else {
            XB_SPIN(xb_ld(&bar[XB_XGEN(b.x)]) == gen, bar);
            __builtin_amdgcn_fence(__ATOMIC_ACQUIRE, "agent");
            asm volatile("s_waitcnt vmcnt(0)" ::: "memory");
        }
    }
    __syncthreads();
}
constexpr int S = 8192, D = 2048, FF = 5632, NLAYER = 4;
constexpr int NIN = 14912, NINP = 15104;
constexpr int NGU = 2 * FF;
constexpr float EPS = 1e-6f;
constexpr int PC_GATE = 0, PC_POOL = 8192, PC_DIL = 8704, PC_SGU = 13312, PC_CQ = 14336, PC_CKV = 14720, PC_KR = 14848;
constexpr int NMLA = 1792;

namespace epi {
using pg8::f32x4; using pg8::u32x4; using pg8::Unit; using pg8::bf16_t;
typedef float f32x2_t __attribute__((ext_vector_type(2))); typedef __bf16 bf16x2_t __attribute__((ext_vector_type(2)));
__device__ __forceinline__ unsigned cvt_pk_bf16(float lo, float hi) { f32x2_t v = {lo, hi}; bf16x2_t b = __builtin_convertvector(v, bf16x2_t); return __builtin_bit_cast(unsigned, b); }
constexpr int BM = 256, HALF = 128;
typedef unsigned u32x2 __attribute__((ext_vector_type(2)));
__device__ __forceinline__ float fast_exp(float x) { return __builtin_amdgcn_exp2f(x * 1.44269504089f); }
__device__ __forceinline__ float sigmoid_f(float x) { return __builtin_amdgcn_rcpf(1.0f + fast_exp(-x)); }

struct EpiSwiglu {
    static constexpr bool PERM = true, AFTER_DRAIN = false, KEEP_ACC = false;
    bf16_t* H; const __attribute__((address_space(3))) float* tab;
    __device__ __forceinline__ void operator()(const f32x4 (&acc)[2][2][4][2], const Unit& u, int wr, int wc, int fr, int fq, int ui) const {
        const int row0 = u.pm * BM + wr * 64 + fr, col0 = u.pn * HALF + wc * 32 + 8 * fq; const __attribute__((address_space(3))) float* tb = tab + ui * 256 + wr * 64 + fr;
#pragma unroll
        for (int ai = 0; ai < 2; ++ai)
#pragma unroll
            for (int m = 0; m < 4; ++m) {
                bf16_t* rowp = H + (size_t)(row0 + ai * HALF + m * 16) * FF + col0; const float rs = tb[ai * HALF + m * 16];
                float o[8];
#pragma unroll
                for (int n = 0; n < 2; ++n)
#pragma unroll
                    for (int j = 0; j < 4; ++j) { const float g = acc[ai][0][m][n][j] * rs, up = acc[ai][1][m][n][j] * rs; o[n * 4 + j] = g * sigmoid_f(g) * up; }
                u32x4 w; w.x = cvt_pk_bf16(o[0], o[1]); w.y = cvt_pk_bf16(o[2], o[3]); w.z = cvt_pk_bf16(o[4], o[5]); w.w = cvt_pk_bf16(o[6], o[7]);
                *(u32x4*)rowp = w;
            }
    }
};
struct EpiResid {
    static constexpr bool PERM = true, AFTER_DRAIN = false, KEEP_ACC = false;
    const float* base32; float* out32; float alpha; bf16_t* x; float* ssp;
    __device__ __forceinline__ void operator()(const f32x4 (&acc)[2][2][4][2], const Unit& u, int wr, int wc, int fr, int fq, int ui) const {
        const int row0 = u.pm * BM + wr * 64 + fr, col0 = u.pn * BM + wc * 32 + 8 * fq;
        if (base32 == nullptr) {
            u32x4 bb[4][2];
#define ER_LOAD(buf, g) { const bf16_t* p_ = x + (size_t)(row0 + ((g) >> 2) * HALF + ((g) & 3) * 16) * D + col0; bb[buf][0] = *(const u32x4*)p_; bb[buf][1] = *(const u32x4*)(p_ + HALF); }
            ER_LOAD(0, 0) ER_LOAD(1, 1) ER_LOAD(2, 2)
#pragma unroll
            for (int g = 0; g < 8; ++g) { const int ai = g >> 2, m = g & 3;
                if (g + 3 < 8) { ER_LOAD((g + 3) % 4, g + 3) asm volatile("" ::: "memory"); }
                const int r = row0 + ai * HALF + m * 16; const size_t off = (size_t)r * D + col0; float s = 0.f;
#pragma unroll
                for (int bj = 0; bj < 2; ++bj) { const u32x4 b = bb[g % 4][bj];
                    const float bv[8] = {__uint_as_float(b.x << 16), __uint_as_float(b.x & 0xffff0000u), __uint_as_float(b.y << 16), __uint_as_float(b.y & 0xffff0000u),
                                         __uint_as_float(b.z << 16), __uint_as_float(b.z & 0xffff0000u), __uint_as_float(b.w << 16), __uint_as_float(b.w & 0xffff0000u)};
                    float v[8];
#pragma unroll
                    for (int n = 0; n < 2; ++n)
#pragma unroll
                        for (int j = 0; j < 4; ++j) { v[n * 4 + j] = bv[n * 4 + j] + acc[ai][bj][m][n][j] * alpha; s += v[n * 4 + j] * v[n * 4 + j]; }
                    if (out32) { *(f32x4*)(out32 + off + bj * HALF) = (f32x4){v[0], v[1], v[2], v[3]}; *(f32x4*)(out32 + off + bj * HALF + 4) = (f32x4){v[4], v[5], v[6], v[7]}; }
                    else { u32x4 w; w.x = cvt_pk_bf16(v[0], v[1]); w.y = cvt_pk_bf16(v[2], v[3]); w.z = cvt_pk_bf16(v[4], v[5]); w.w = cvt_pk_bf16(v[6], v[7]); *(u32x4*)(x + off + bj * HALF) = w; } }
                if (!out32) { s += __shfl_xor(s, 16); s += __shfl_xor(s, 32); if (fq == 0) ssp[(size_t)r * 32 + u.pn * 4 + wc] = s; }
                  }
#undef ER_LOAD
        } else {
#pragma unroll
            for (int g = 0; g < 8; ++g) { const int ai = g >> 2, m = g & 3;
                const int r = row0 + ai * HALF + m * 16; const size_t off = (size_t)r * D + col0; float s = 0.f;
#pragma unroll
                for (int bj = 0; bj < 2; ++bj) { const f32x4 b0 = *(const f32x4*)(base32 + off + bj * HALF), b1 = *(const f32x4*)(base32 + off + bj * HALF + 4);
                    float v[8];
#pragma unroll
                    for (int j = 0; j < 4; ++j) { v[j] = b0[j] + acc[ai][bj][m][0][j] * alpha; v[4 + j] = b1[j] + acc[ai][bj][m][1][j] * alpha; }
#pragma unroll
                    for (int e = 0; e < 8; ++e) s += v[e] * v[e];
                    u32x4 w; w.x = cvt_pk_bf16(v[0], v[1]); w.y = cvt_pk_bf16(v[2], v[3]); w.z = cvt_pk_bf16(v[4], v[5]); w.w = cvt_pk_bf16(v[6], v[7]); *(u32x4*)(x + off + bj * HALF) = w; }
                s += __shfl_xor(s, 16); s += __shfl_xor(s, 32); if (fq == 0) ssp[(size_t)r * 32 + u.pn * 4 + wc] = s; }
        }
    }
};
struct EpiPin {
    static constexpr bool PERM = true, AFTER_DRAIN = false, KEEP_ACC = false;
    bf16_t* P; const __attribute__((address_space(3))) float* tab; int pn0;
    float* dsq;
    template <int KIND> __device__ __forceinline__ void run(const f32x4 (&acc)[2][2][4][2], const Unit& u, int wr, int wc, int fr, int fq, int ui) const {
        const __attribute__((address_space(3))) float* tb = tab + ui * 256 + wr * 64 + fr;
        const int row0 = u.pm * BM + wr * 64 + fr, col0 = (u.pn + pn0) * BM + wc * 32 + 8 * fq;
#pragma unroll
        for (int ai = 0; ai < 2; ++ai)
#pragma unroll
            for (int m = 0; m < 4; ++m) { bf16_t* rowp = P + (size_t)(row0 + ai * HALF + m * 16) * NINP + col0; const float rs = tb[ai * HALF + m * 16];
#pragma unroll
                for (int bj = 0; bj < 2; ++bj) { float o[8];
#pragma unroll
                    for (int n = 0; n < 2; ++n)
#pragma unroll
                        for (int j = 0; j < 4; ++j) { const float x = acc[ai][bj][m][n][j] * rs;
                            o[n * 4 + j] = (KIND == 0 || KIND == 3) ? x : ((KIND == 1) ? sigmoid_f(x) : x * sigmoid_f(1.5957691216f * (x + 0.044715f * x * x * x))); }
                    u32x4 w; w.x = cvt_pk_bf16(o[0], o[1]); w.y = cvt_pk_bf16(o[2], o[3]); w.z = cvt_pk_bf16(o[4], o[5]); w.w = cvt_pk_bf16(o[6], o[7]);
                    *(u32x4*)(rowp + bj * HALF) = w;
                    if (KIND == 3) {
                        float sq = 0.f;
#pragma unroll
                        for (int e = 0; e < 4; ++e) { const unsigned ww = (e == 0) ? w.x : (e == 1) ? w.y : (e == 2) ? w.z : w.w; const float a = __uint_as_float(ww << 16), b = __uint_as_float(ww & 0xffff0000u); sq += a * a + b * b; }
                        sq += __shfl_xor(sq, 16); sq += __shfl_xor(sq, 32);
                        if (fq == 0) dsq[((size_t)(row0 + ai * HALF + m * 16) * 24 + (u.pn + pn0 - 34) * 2 + bj) * 4 + wc] = sq; } }
                  }
    }
    __device__ __forceinline__ void run_gates(const f32x4 (&acc)[2][2][4][2], const Unit& u, int wr, int wc, int fr, int fq, int ui) const {
        const __attribute__((address_space(3))) float* tb = tab + ui * 256 + wr * 64 + fr;
        const int row0 = u.pm * BM + wr * 64 + fr, col0 = (u.pn + pn0) * BM + wc * 32 + 8 * fq;
#pragma unroll
        for (int ai = 0; ai < 2; ++ai)
#pragma unroll
            for (int m = 0; m < 4; ++m) { unsigned char* rowp = (unsigned char*)(P + (size_t)(row0 + ai * HALF + m * 16) * NINP) + col0; const float rs = tb[ai * HALF + m * 16];
#pragma unroll
                for (int bj = 0; bj < 2; ++bj) { unsigned q[8];
#pragma unroll
                    for (int n = 0; n < 2; ++n)
#pragma unroll
                        for (int j = 0; j < 4; ++j) { const unsigned v = (unsigned)(sigmoid_f(acc[ai][bj][m][n][j] * rs) * 255.f + 0.5f); q[n * 4 + j] = v < 1u ? 1u : (v > 255u ? 255u : v); }
                    u32x2 w; w.x = q[0] | (q[1] << 8) | (q[2] << 16) | (q[3] << 24); w.y = q[4] | (q[5] << 8) | (q[6] << 16) | (q[7] << 24);
                    *(u32x2*)(rowp + bj * HALF) = w; }
                  }
    }
    __device__ __forceinline__ void operator()(const f32x4 (&acc)[2][2][4][2], const Unit& u, int wr, int wc, int fr, int fq, int ui) const {
        const int pt = u.pn + pn0;
        if (pt >= 34 && pt < 46) { run<3>(acc, u, wr, wc, fr, fq, ui); return; }
        if (pt < 32) { run_gates(acc, u, wr, wc, fr, fq, ui); return; }
        if (pt < 32) run<1>(acc, u, wr, wc, fr, fq, ui); else if (pt >= 52 && pt < 56) run<2>(acc, u, wr, wc, fr, fq, ui); else run<0>(acc, u, wr, wc, fr, fq, ui);
    }
};
struct EpiBf16 {
    static constexpr bool PERM = true, AFTER_DRAIN = false, KEEP_ACC = false;
    bf16_t* C; int ldc;
    __device__ __forceinline__ void operator()(const f32x4 (&acc)[2][2][4][2], const Unit& u, int wr, int wc, int fr, int fq, int ui) const {
        const int row0 = u.pm * BM + wr * 64 + fr, col0 = u.pn * BM + wc * 32 + 8 * fq;
#pragma unroll
        for (int ai = 0; ai < 2; ++ai)
#pragma unroll
            for (int m = 0; m < 4; ++m) { bf16_t* rowp = C + (size_t)(row0 + ai * HALF + m * 16) * ldc + col0;
#pragma unroll
                for (int bj = 0; bj < 2; ++bj) { u32x4 w; w.x = cvt_pk_bf16(acc[ai][bj][m][0][0], acc[ai][bj][m][0][1]); w.y = cvt_pk_bf16(acc[ai][bj][m][0][2], acc[ai][bj][m][0][3]);
                    w.z = cvt_pk_bf16(acc[ai][bj][m][1][0], acc[ai][bj][m][1][1]); w.w = cvt_pk_bf16(acc[ai][bj][m][1][2], acc[ai][bj][m][1][3]);
                    *(u32x4*)(rowp + bj * HALF) = w; } }
    }
};
struct EpiF32 {
    static constexpr bool PERM = false, AFTER_DRAIN = false, KEEP_ACC = false;
    float* C; int ldc; int colmul;
    __device__ __forceinline__ void operator()(const f32x4 (&acc)[2][2][4][2], const Unit& u, int wr, int wc, int fr, int fq, int ui) const {
        const int row0 = u.pm * BM + wr * 64 + fr, col0 = colmul * u.pn * BM + wc * 32 + 4 * fq;
#pragma unroll
        for (int ai = 0; ai < 2; ++ai)
#pragma unroll
            for (int m = 0; m < 4; ++m) { float* rowp = C + (size_t)(row0 + ai * HALF + m * 16) * ldc + col0;
#pragma unroll
                for (int bj = 0; bj < 2; ++bj)
#pragma unroll
                    for (int n = 0; n < 2; ++n) *(f32x4*)(rowp + bj * HALF + n * 16) = acc[ai][bj][m][n]; }
    }
};
struct EpiExp {
    static constexpr bool PERM = true, AFTER_DRAIN = false, KEEP_ACC = false;
    bf16_t* P;
    __device__ __forceinline__ void operator()(const f32x4 (&acc)[2][2][4][2], const Unit& u, int wr, int wc, int fr, int fq, int ui) const {
        const int row0 = u.pm * BM + wr * 64 + fr, col0 = (u.pn & 31) * BM + wc * 32 + 8 * fq;
#pragma unroll
        for (int ai = 0; ai < 2; ++ai)
#pragma unroll
            for (int m = 0; m < 4; ++m) { bf16_t* rowp = P + (size_t)(row0 + ai * HALF + m * 16) * S + col0;
#pragma unroll
                for (int bj = 0; bj < 2; ++bj) { float o[8];
#pragma unroll
                    for (int n = 0; n < 2; ++n)
#pragma unroll
                        for (int j = 0; j < 4; ++j) o[n * 4 + j] =
#ifdef DBG_NOEXP
                            acc[ai][bj][m][n][j];
#else
                            fast_exp(acc[ai][bj][m][n][j]);
#endif
                    u32x4 w; w.x = cvt_pk_bf16(o[0], o[1]); w.y = cvt_pk_bf16(o[2], o[3]); w.z = cvt_pk_bf16(o[4], o[5]); w.w = cvt_pk_bf16(o[6], o[7]);
                    *(u32x4*)(rowp + bj * HALF) = w; }
                asm volatile("" ::: "memory"); }
    }
};
struct EpiBranch {
    static constexpr bool PERM = false, AFTER_DRAIN = false, KEEP_ACC = false;
    float* merged; bf16_t* mergedb; const bf16_t* gate; int b;
    __device__ __forceinline__ void operator()(const f32x4 (&acc)[2][2][4][2], const Unit& u, int wr, int wc, int fr, int fq, int ui) const {
        const int row0 = u.pm * BM + wr * 64 + fr, col0 = u.pn * BM + wc * 32 + 4 * fq;
#pragma unroll
        for (int ai = 0; ai < 2; ++ai)
#pragma unroll
            for (int m = 0; m < 4; ++m) { const int r = row0 + ai * HALF + m * 16;
#pragma unroll
                for (int bj = 0; bj < 2; ++bj)
#pragma unroll
                    for (int n = 0; n < 2; ++n) { const int c = col0 + bj * HALF + n * 16;
                        const u32x2 gv = *(const u32x2*)(gate + (size_t)r * NINP + c);
                        f32x4 g; g[0] = __uint_as_float(gv.x << 16); g[1] = __uint_as_float(gv.x & 0xffff0000u); g[2] = __uint_as_float(gv.y << 16); g[3] = __uint_as_float(gv.y & 0xffff0000u);
                        f32x4 v = acc[ai][bj][m][n] * g;
                        float* mp = merged + (size_t)r * D + c;
                        if (b != 0) v += *(const f32x4*)mp;
                        if (b != 3) *(f32x4*)mp = v;
                        else { u32x2 w; w.x = cvt_pk_bf16(v[0], v[1]); w.y = cvt_pk_bf16(v[2], v[3]); *(u32x2*)(mergedb + (size_t)r * D + c) = w; } }
                asm volatile("" ::: "memory"); }
    }
};
struct QKOrder {
    int G, c;
    __device__ bool next(int i, Unit& u) const { const int L = i * G + c; if (L >= 4096) return false; const int h = L >> 10, rem = L & 1023; u.pm = h * 32 + (rem >> 5); u.pn = h * 32 + (rem & 31); return true; }
    __device__ __forceinline__ void a_ready(const Unit&, int) const {}
    __device__ __forceinline__ void done(const Unit&) const {}
};
struct PVOrder {
    int G, c;
    __device__ bool next(int i, Unit& u) const { const int L = i * G + c; if (L >= 128) return false; u.pm = L; u.pn = L >> 5; return true; }
    __device__ __forceinline__ void a_ready(const Unit&, int) const {}
    __device__ __forceinline__ void done(const Unit&) const {}
};
struct EpiBranchChain {
    static constexpr bool PERM = true, AFTER_DRAIN = false, KEEP_ACC = true;
    bf16_t* mergedb; const bf16_t* gate;
    __device__ __forceinline__ void operator()(f32x4 (&acc)[2][2][4][2], const Unit& u, int wr, int wc, int fr, int fq, int ui) const {
        const int b = u.pm >> 5, pm0 = u.pm & 31, pn0 = u.pn & 7;
        const int row0 = pm0 * BM + wr * 64 + fr, col0 = pn0 * BM + wc * 32 + 8 * fq;
        const unsigned char* gbase = (const unsigned char*)gate;
        u32x2 gg[3][2][2];
#define BC_LOAD(buf, g) { const unsigned char* gp_ = gbase + (size_t)(row0 + ((g) >> 2) * HALF + ((g) & 3) * 16) * (2 * NINP) + b * D + col0; _Pragma("unroll") for (int bj_ = 0; bj_ < 2; ++bj_) { \
            gg[buf][bj_][0] = *(const u32x2*)(gp_ + bj_ * HALF); if (b != 3) gg[buf][bj_][1] = *(const u32x2*)(gp_ + bj_ * HALF + D); } }
        BC_LOAD(0, 0) BC_LOAD(1, 1)
#pragma unroll
        for (int gi = 0; gi < 8; ++gi) { const int ai = gi >> 2, m = gi & 3; const int r = row0 + ai * HALF + m * 16;
            if (gi + 2 < 8) { BC_LOAD((gi + 2) % 3, gi + 2) asm volatile("" ::: "memory"); }
#pragma unroll
            for (int bj = 0; bj < 2; ++bj) { const int c = col0 + bj * HALF;
                const u32x2 gv = gg[gi % 3][bj][0];
                float g[8];
#pragma unroll
                for (int e = 0; e < 8; ++e) g[e] = (float)(((e < 4 ? gv.x : gv.y) >> (8 * (e & 3))) & 0xffu);
                if (b != 3) {
                    const u32x2 hv = gg[gi % 3][bj][1];
#pragma unroll
                    for (int n = 0; n < 2; ++n)
#pragma unroll
                        for (int j = 0; j < 4; ++j) { const int e = n * 4 + j; const float gn = (float)(((e < 4 ? hv.x : hv.y) >> (8 * (e & 3))) & 0xffu); acc[ai][bj][m][n][j] *= g[e] * __builtin_amdgcn_rcpf(gn); }
                } else {
                    float o[8];
#pragma unroll
                    for (int n = 0; n < 2; ++n)
#pragma unroll
                        for (int j = 0; j < 4; ++j) o[n * 4 + j] = acc[ai][bj][m][n][j] * (g[n * 4 + j] * (1.0f / 255.0f));
                    u32x4 w; w.x = cvt_pk_bf16(o[0], o[1]); w.y = cvt_pk_bf16(o[2], o[3]); w.z = cvt_pk_bf16(o[4], o[5]); w.w = cvt_pk_bf16(o[6], o[7]);
                    *(u32x4*)(mergedb + (size_t)r * D + c) = w;
                } }
              }
#undef BC_LOAD
    }
};
template <class Sched> __device__ __forceinline__ void fill_rstd_table(const Sched& So, const float* ssp, __attribute__((address_space(3))) float* tab, int wave) {
    int t_ = wave * 64 + (int)__builtin_amdgcn_mbcnt_hi(~0u, __builtin_amdgcn_mbcnt_lo(~0u, 0u)); asm volatile("" : "+v"(t_));
    const int t = t_, row = t >> 1, half = t & 1;
#pragma unroll 1
    for (int ui = 0; ui < 8; ++ui) { Unit u; if (!So.next(ui, u)) break;
        const f32x4* p = (const f32x4*)(ssp + (size_t)(u.pm * BM + row) * 32 + half * 16); const f32x4 a = p[0], b = p[1], c = p[2], d = p[3];
        float s = (((a[0] + a[1]) + (a[2] + a[3])) + ((b[0] + b[1]) + (b[2] + b[3]))) + (((c[0] + c[1]) + (c[2] + c[3])) + ((d[0] + d[1]) + (d[2] + d[3])));
        s += __shfl_xor(s, 1);
        if (half == 0) tab[ui * 256 + row] = 1.0f / sqrtf(s * (1.0f / D) + EPS); }
}
struct BranchOrder {
    pg8::StaticOrder so;
    __device__ bool next(int i, Unit& u) const { if (i >= 4) return false; Unit t; if (!so.next(0, t)) return false; u.pm = i * 32 + t.pm; u.pn = i * 8 + t.pn; return true; }
    __device__ __forceinline__ void a_ready(const Unit&, int) const {}
    __device__ __forceinline__ void done(const Unit&) const {}
};
}
constexpr size_t MiB = 1u << 20;
constexpr size_t WS_CTL = 0, CTL_ZERO_BYTES = 1 * MiB;
constexpr size_t WS_COS = 1 * MiB, WS_SIN = 2 * MiB, WS_SSP = 3 * MiB;
constexpr size_t WS_WGU1 = 4 * MiB, WS_WD1 = 48 * MiB, WS_WGU2 = 70 * MiB, WS_WD2 = 114 * MiB;
constexpr size_t WS_WIN = 136 * MiB, WS_WBR = 195 * MiB, WS_WOUT = 203 * MiB, WS_WMLA = 211 * MiB;
constexpr size_t WS_X = 214 * MiB;
constexpr size_t WS_DSQ = WS_X;
constexpr size_t WS_XN = 278 * MiB;
constexpr size_t WS_HID = 310 * MiB;
constexpr size_t WS_P = 398 * MiB;
constexpr size_t WS_Z = 634 * MiB;
constexpr size_t WS_VVN = 666 * MiB, WS_MLAA = 674 * MiB;
constexpr size_t WS_MLARAW = 682 * MiB;
constexpr size_t WS_QP = 1426 * MiB, WS_KP = 1458 * MiB, WS_VT = 770 * MiB;
constexpr int QKP = 256;
constexpr size_t WS_ORAW = 786 * MiB;
constexpr size_t WS_MERGED = 818 * MiB, WS_MERGEDB = 882 * MiB;
constexpr size_t WS_PEXP = 914 * MiB;
constexpr size_t WS_DILO = 1490 * MiB, WS_DILL = 1540 * MiB;
constexpr size_t WS_MQ = WS_QP, WS_MK = WS_KP, WS_MV = WS_VT, WS_MOP = WS_PEXP, WS_MLP = WS_ORAW;
constexpr size_t WS_END = 1541 * MiB;
static_assert(WS_WGU1 + (size_t)NGU * D * 2 <= WS_WD1 && WS_WD1 + (size_t)D * FF * 2 <= WS_WGU2 && WS_WGU2 + (size_t)NGU * D * 2 <= WS_WD2 && WS_WD2 + (size_t)D * FF * 2 <= WS_WIN, "ws map 1");
static_assert(WS_WIN + (size_t)NINP * D * 2 <= WS_WBR && WS_WBR + (size_t)4 * D * 512 * 2 <= WS_WOUT && WS_WOUT + (size_t)D * D * 2 <= WS_WMLA && WS_WMLA + (size_t)NMLA * 512 * 2 <= WS_X, "ws map 2");
static_assert(WS_X + (size_t)S * D * 4 <= WS_XN && WS_XN + (size_t)S * D * 2 <= WS_HID && WS_HID + (size_t)S * FF * 2 <= WS_P && WS_P + (size_t)S * NINP * 2 <= WS_Z, "ws map 3");
static_assert(WS_Z + (size_t)4 * S * 512 * 2 <= WS_VVN && WS_MLARAW + (size_t)S * NMLA * 4 <= WS_VT && WS_KP + (size_t)4 * S * QKP * 2 <= WS_END && WS_ORAW + (size_t)4 * S * 256 * 4 <= WS_MERGED && WS_MERGED + (size_t)S * D * 4 <= WS_MERGEDB && WS_MERGEDB + (size_t)S * D * 2 <= WS_PEXP && WS_PEXP + (size_t)4 * S * S * 2 <= WS_QP, "ws map 4");
constexpr size_t WS_SETD = 956 * MiB;
static_assert(WS_WGU1 + WS_SETD >= WS_PEXP + (size_t)2 * 4 * S * 128 * 4 && WS_X + WS_SETD <= WS_QP, "second weight set");
#ifndef TAILCONV
#define TAILCONV 0
#endif
#ifndef TC1
#define TC1 128
#define TC2 160
#define TC3 128
#endif
constexpr int CPARTS = 416;
constexpr int CW_BAR = 4096;

constexpr int NWAVES = 8;
constexpr int RING_OFF = 0, RING_BYTES = 131072;
constexpr int LDS_BYTES = 163840;
constexpr int LDSCTL_OFF = LDS_BYTES - 1024, MISC_OFF = LDSCTL_OFF + 320;
constexpr int RSTD_OFF = RING_BYTES + 1024;

enum { I_X = 0, I_F1N, I_F1G, I_F1U, I_F1D, I_MIXN, I_WIN, I_POOLW, I_POOLS, I_DQN, I_DKN, I_SGUN, I_SGUW, I_SGUB, I_MQAN, I_MWUQ, I_MKVAN, I_MWUKV, I_MQN, I_MKN, I_WBR, I_WOUT, I_F2N, I_F2G, I_F2U, I_F2D, N_INPUTS };

struct Frame {
    LAS unsigned char* lds;
    volatile LAS unsigned* MISC;
    int wave, vcu, G;
    int gw, NGW, NGT;
};
constexpr int NPHASE = 14;
struct Args { const float* in[N_INPUTS]; float* out; unsigned char* ws; int l_lo, l_hi, ph_lo, ph_hi; };
typedef const __attribute__((address_space(4))) Args* ArgsP;
__device__ __forceinline__ ArgsP fresh_args() { ArgsP p = (ArgsP)__builtin_amdgcn_kernarg_segment_ptr(); asm volatile("" : "+s"(p)); return p; }
__device__ __forceinline__ int opq_s(int x) { asm volatile("" : "+s"(x)); return x; }
__device__ __forceinline__ Frame fresh_frame(const Frame& F) { Frame R = F; R.wave = opq_s(F.wave); R.vcu = opq_s(F.vcu); R.G = opq_s(F.G); R.gw = opq_s(F.gw); R.NGW = opq_s(F.NGW); R.NGT = opq_s(F.NGT); return R; }
__device__ __forceinline__ int opq_lane() { int l = (int)__builtin_amdgcn_mbcnt_hi(~0u, __builtin_amdgcn_mbcnt_lo(~0u, 0u)); asm volatile("" : "+v"(l)); return l; }
template <int CTRL> __device__ __forceinline__ float dpp_mov(float x) { return __int_as_float(__builtin_amdgcn_update_dpp(0, __float_as_int(x), CTRL, 0xF, 0xF, true)); }
__device__ __forceinline__ float lane_bcast(float x, int l) { return __int_as_float(__builtin_amdgcn_readlane(__float_as_int(x), l)); }
__device__ __forceinline__ float wave_sum(float v) {
    v += dpp_mov<0xB1>(v); v += dpp_mov<0x4E>(v); v += dpp_mov<0x141>(v); v += dpp_mov<0x140>(v);
    return (lane_bcast(v, 0) + lane_bcast(v, 16)) + (lane_bcast(v, 32) + lane_bcast(v, 48));
}
__device__ __forceinline__ float wave_max(float v) {
    v = fmaxf(v, dpp_mov<0xB1>(v)); v = fmaxf(v, dpp_mov<0x4E>(v)); v = fmaxf(v, dpp_mov<0x141>(v)); v = fmaxf(v, dpp_mov<0x140>(v));
    return fmaxf(fmaxf(lane_bcast(v, 0), lane_bcast(v, 16)), fmaxf(lane_bcast(v, 32), lane_bcast(v, 48)));
}
__device__ __forceinline__ float bf2f(unsigned short b) { return __uint_as_float(((unsigned)b) << 16); }
__device__ __forceinline__ float bflo(unsigned u) { return __uint_as_float(u << 16); }
__device__ __forceinline__ float bfhi(unsigned u) { return __uint_as_float(u & 0xffff0000u); }
__device__ __forceinline__ float rsq(float x) { return 1.0f / sqrtf(x); }

typedef float f32x16 __attribute__((ext_vector_type(16)));
#define MFMA32(a, b, c) __builtin_amdgcn_mfma_f32_32x32x16_bf16((a), (b), (c), 0, 0, 0)
__device__ __forceinline__ void transpose_load(f32x4 (&v)[8], float (&gk)[8], const float* kgain, const float* W, int ldw, int k0, int n0, int lane) {
    const int pc = lane & 7, kr = lane >> 3;
#pragma unroll
    for (int i = 0; i < 8; ++i) v[i] = __builtin_nontemporal_load((const GAS f32x4*)(W + (size_t)(k0 + 8 * i + kr) * ldw + n0 + 4 * pc));
#pragma unroll
    for (int i = 0; i < 8; ++i) gk[i] = kgain ? kgain[k0 + 8 * i + kr] : 1.0f;
    asm volatile("" ::: "memory");
}
__device__ __forceinline__ void transpose_store(const f32x4 (&v)[8], const float (&gkv)[8], int k0, bf16* WT, int ldt, int drow0, int dk0, LAS float* scr, int lane) {
    const int pc = lane & 7, kr = lane >> 3;
#pragma unroll
    for (int i = 0; i < 8; ++i) { LAS float* d = scr + (8 * i + kr) * 33 + 4 * pc; const float gk = gkv[i];
        d[0] = v[i].x * gk; d[1] = v[i].y * gk; d[2] = v[i].z * gk; d[3] = v[i].w * gk; }
    LDS_WAIT(); asm volatile("" ::: "memory");
    const int c = lane & 7;
#pragma unroll
    for (int j = 0; j < 4; ++j) { const int n = (lane >> 3) + 8 * j; const LAS float* s = scr + (8 * c) * 33 + n;
        v4u o; o.x = pk2(s[0 * 33], s[1 * 33]); o.y = pk2(s[2 * 33], s[3 * 33]); o.z = pk2(s[4 * 33], s[5 * 33]); o.w = pk2(s[6 * 33], s[7 * 33]);
        *(GAS v4u*)(WT + (size_t)(drow0 + n) * ldt + dk0 + k0 + 8 * c) = o; }
    LDS_WAIT(); asm volatile("" ::: "memory");
}
template <int MAP> __device__ __forceinline__ int map_row(int n0, int roff) {
    if (MAP == 0) return n0 + roff;
    if (MAP == 1) return (n0 >> 7) * 256 + roff + (n0 & 127);
    return (n0 < 6720) ? (n0 + 8192) : (n0 - 6720);
}
template <int MAP> __device__ __forceinline__ void transpose_matrix(const Frame& F, int vgw, int vNGW, int p0, int p1, int lane, const float* W, int K, int N, bf16* WT, int ldt, int roff, int dk0, const float* kgain = nullptr) {
    LAS float* scr = (LAS float*)(F.lds + RING_OFF + (vgw & 7) * 16384);
    const int nblk = N / 32, items = (K / 64) * nblk, lo = (int)((long)items * p0 / CPARTS), hi = (int)((long)items * p1 / CPARTS);
    int it = lo + vgw; if (it >= hi) return;
    f32x4 va[8], vb[8]; float ga[8], gb[8]; transpose_load(va, ga, kgain, W, N, 64 * (it / nblk), 32 * (it % nblk), lane);
    for (;;) {
        const int itn = it + vNGW; const bool more = itn < hi;
        if (more) transpose_load(vb, gb, kgain, W, N, 64 * (itn / nblk), 32 * (itn % nblk), lane);
        transpose_store(va, ga, 64 * (it / nblk), WT, ldt, map_row<MAP>(32 * (it % nblk), roff), dk0, scr, lane);
        if (!more) break;
#pragma unroll
        for (int i = 0; i < 8; ++i) { va[i] = vb[i]; ga[i] = gb[i]; }
        it = itn;
    }
}

struct TDesc { const float* W; const float* kgain; bf16* WT; int N, nblk, ldt, roff, dk0, map, first; };
constexpr int TI_FD = (FF / 64) * (D / 32), TI_FG = (D / 64) * (FF / 32), TI_WO = (D / 64) * (D / 32), TI_BR = (512 / 64) * (D / 32), TI_UQ = (384 / 64) * (768 / 32), TI_UKV = (128 / 64) * (1024 / 32), TI_WIN = (D / 64) * (NIN / 32);
constexpr int TS1 = TI_FD, TS2 = TS1 + TI_FG, TS3 = TS2 + TI_FG, TS4 = TS3 + TI_WO, TS5 = TS4 + TI_BR, TS6 = TS5 + TI_BR, TS7 = TS6 + TI_BR, TS8 = TS7 + TI_UQ, TS9 = TS8 + TI_UKV, TS10 = TS9 + TI_WIN, TS11 = TS10 + TI_FD, TS12 = TS11 + TI_FG, TS_ALL = TS12 + TI_FG;
__device__ __forceinline__ TDesc conv_desc(ArgsP A, unsigned char* ws, int l, int it) {
    TDesc d; d.kgain = nullptr; d.roff = 0; d.dk0 = 0; d.map = 0;
    if (it < TS1)       { d.W = A->in[I_F2D] + (size_t)l * FF * D; d.N = D; d.WT = (bf16*)(ws + WS_WD2); d.ldt = FF; d.first = 0; }
    else if (it < TS2)  { d.W = A->in[I_F2G] + (size_t)l * D * FF; d.N = FF; d.WT = (bf16*)(ws + WS_WGU2); d.ldt = D; d.map = 1; d.kgain = A->in[I_F2N] + (size_t)l * D; d.first = TS1; }
    else if (it < TS3)  { d.W = A->in[I_F2U] + (size_t)l * D * FF; d.N = FF; d.WT = (bf16*)(ws + WS_WGU2); d.ldt = D; d.map = 1; d.roff = 128; d.kgain = A->in[I_F2N] + (size_t)l * D; d.first = TS2; }
    else if (it < TS4)  { d.W = A->in[I_WOUT] + (size_t)l * D * D; d.N = D; d.WT = (bf16*)(ws + WS_WOUT); d.ldt = D; d.first = TS3; }
    else if (it < TS7)  { const int b = (it < TS5) ? 1 : (it < TS6) ? 2 : 3; d.W = A->in[I_WBR] + ((size_t)l * 4 + b) * 512 * D; d.N = D; d.WT = (bf16*)(ws + WS_WBR) + (size_t)b * D * 512; d.ldt = 512; d.first = TS4 + (b - 1) * TI_BR; }
    else if (it < TS8)  { d.W = A->in[I_MWUQ] + (size_t)l * 384 * 768; d.N = 768; d.WT = (bf16*)(ws + WS_WMLA); d.ldt = 512; d.first = TS7; }
    else if (it < TS9)  { d.W = A->in[I_MWUKV] + (size_t)l * 128 * 1024; d.N = 1024; d.WT = (bf16*)(ws + WS_WMLA); d.ldt = 512; d.roff = 768; d.dk0 = 384; d.first = TS8; }
    else if (it < TS10) { d.W = A->in[I_WIN] + (size_t)l * D * NIN; d.N = NIN; d.WT = (bf16*)(ws + WS_WIN); d.ldt = D; d.map = 2; d.kgain = A->in[I_MIXN] + (size_t)l * D; d.first = TS9; }
    else if (it < TS11) { d.W = A->in[I_F1D] + (size_t)l * FF * D; d.N = D; d.WT = (bf16*)(ws + WS_WD1); d.ldt = FF; d.first = TS10; }
    else if (it < TS12) { d.W = A->in[I_F1G] + (size_t)l * D * FF; d.N = FF; d.WT = (bf16*)(ws + WS_WGU1); d.ldt = D; d.map = 1; d.kgain = A->in[I_F1N] + (size_t)l * D; d.first = TS11; }
    else                { d.W = A->in[I_F1U] + (size_t)l * D * FF; d.N = FF; d.WT = (bf16*)(ws + WS_WGU1); d.ldt = D; d.map = 1; d.roff = 128; d.kgain = A->in[I_F1N] + (size_t)l * D; d.first = TS12; }
    d.nblk = d.N / 32;
    return d;
}
__device__ __forceinline__ int map_row_rt(int map, int n0, int roff) { return (map == 0) ? n0 + roff : (map == 1) ? (n0 >> 7) * 256 + roff + (n0 & 127) : ((n0 < 6720) ? (n0 + 8192) : (n0 - 6720)); }
__device__ __forceinline__ void transpose_all(ArgsP A, const Frame& F, unsigned char* ws, int l, int vgw, int vNGW, int p0, int p1, int lane) {
    LAS float* scr = (LAS float*)(F.lds + RING_OFF + (vgw & 7) * 16384);
    const int lo = (int)((long)TS_ALL * p0 / CPARTS), hi = (int)((long)TS_ALL * p1 / CPARTS);
    int it = lo + vgw; if (it >= hi) return;
    TDesc dc = conv_desc(A, ws, l, it); int loc = it - dc.first, kb = loc / dc.nblk, nbk = loc - kb * dc.nblk;
    f32x4 va[8], vb[8]; float ga[8], gb[8]; transpose_load(va, ga, dc.kgain, dc.W, dc.N, 64 * kb, 32 * nbk, lane);
    for (;;) {
        const int itn = it + vNGW; const bool more = itn < hi;
        TDesc dn = dc; int kbn = 0, nbn = 0;
        if (more) { dn = conv_desc(A, ws, l, itn); const int ln = itn - dn.first; kbn = ln / dn.nblk; nbn = ln - kbn * dn.nblk; transpose_load(vb, gb, dn.kgain, dn.W, dn.N, 64 * kbn, 32 * nbn, lane); }
        transpose_store(va, ga, 64 * kb, dc.WT, dc.ldt, map_row_rt(dc.map, 32 * nbk, dc.roff), dc.dk0, scr, lane);
        if (!more) break;
#pragma unroll
        for (int i = 0; i < 8; ++i) { va[i] = vb[i]; ga[i] = gb[i]; }
        it = itn; dc = dn; kb = kbn; nbk = nbn;
    }
}

__device__ __forceinline__ void phase_convert(ArgsP A, const Frame& F, int l, int vgw, int vNGW, int p0, int p1) {
    unsigned char* ws = A->ws + (size_t)(l & 1) * WS_SETD; const int lane = opq_lane(); const int vgt = vgw * 64 + lane, vNGT = vNGW * 64;
#define TM(MAP, ...) transpose_matrix<MAP>(F, vgw, vNGW, p0, p1, lane, __VA_ARGS__)
#define PART(n, lo, hi) const int lo = (int)((long)(n) * p0 / CPARTS), hi = (int)((long)(n) * p1 / CPARTS)
    transpose_all(A, F, ws, l, vgw, vNGW, p0, p1, lane);
    { bf16* wm = (bf16*)(ws + WS_WMLA);
      { PART(768 * 128, lo, hi); for (int i = lo + vgt; i < hi; i += vNGT) wm[(size_t)(i >> 7) * 512 + 384 + (i & 127)] = 0; }
      { PART(1024 * 384, lo, hi); for (int i = lo + vgt; i < hi; i += vNGT) wm[(size_t)(768 + i / 384) * 512 + (i % 384)] = 0; }
      unsigned* wz = (unsigned*)((bf16*)(ws + WS_WIN) + (size_t)NIN * D);
      { PART((NINP - NIN) * D / 2, lo, hi); for (int i = lo + vgt; i < hi; i += vNGT) wz[i] = 0u; } }
    { const float* pw = A->in[I_POOLW] + (size_t)l * 4 * 128 * 128; const float* ps = A->in[I_POOLS] + (size_t)l * 512; const float* wb = A->in[I_WBR] + (size_t)l * 4 * 512 * D;
      bf16* wt = (bf16*)(ws + WS_WBR);
      PART(1024, lo, hi);
      if ((vgw & 1) == 0)
      for (int blk = lo + (vgw >> 1); blk < hi; blk += (vNGW >> 1)) {
          const int rb = blk >> 6, nb = blk & 63, g = rb >> 2, ql = lane & 31, h = lane >> 5;
          const float* arow = pw + (size_t)(32 * rb + ql) * 128 + 8 * h;
          const float* bcol = wb + (size_t)(g * 128 + 8 * h) * D + 32 * nb + ql;
          const float* psr = ps + g * 128 + 8 * h;
          f32x16 acc;
#pragma unroll
          for (int e = 0; e < 16; ++e) acc[e] = 0.f;
#pragma unroll
          for (int half = 0; half < 2; ++half) {
              f32x4 av[4][2], pv[4][2]; float bv[4][8];
#pragma unroll
              for (int k4 = 0; k4 < 4; ++k4) { const int ks = 4 * half + k4;
                  av[k4][0] = *(const f32x4*)(arow + 16 * ks); av[k4][1] = *(const f32x4*)(arow + 16 * ks + 4); pv[k4][0] = *(const f32x4*)(psr + 16 * ks); pv[k4][1] = *(const f32x4*)(psr + 16 * ks + 4);
#pragma unroll
                  for (int j = 0; j < 8; ++j) bv[k4][j] = bcol[(size_t)(16 * ks + j) * D]; }
#pragma unroll
              for (int k4 = 0; k4 < 4; ++k4) { v4u ah, al, bh, bl;
#define SPLIT2(x0, x1, HI, LO) { const unsigned h0_ = f2bf(x0), h1_ = f2bf(x1); HI = h0_ | (h1_ << 16); LO = f2bf((x0) - __uint_as_float(h0_ << 16)) | (f2bf((x1) - __uint_as_float(h1_ << 16)) << 16); }
                  SPLIT2(av[k4][0][0], av[k4][0][1], ah.x, al.x) SPLIT2(av[k4][0][2], av[k4][0][3], ah.y, al.y) SPLIT2(av[k4][1][0], av[k4][1][1], ah.z, al.z) SPLIT2(av[k4][1][2], av[k4][1][3], ah.w, al.w)
                  const float b0 = bv[k4][0] * pv[k4][0][0], b1 = bv[k4][1] * pv[k4][0][1], b2 = bv[k4][2] * pv[k4][0][2], b3 = bv[k4][3] * pv[k4][0][3];
                  const float b4 = bv[k4][4] * pv[k4][1][0], b5 = bv[k4][5] * pv[k4][1][1], b6 = bv[k4][6] * pv[k4][1][2], b7 = bv[k4][7] * pv[k4][1][3];
                  SPLIT2(b0, b1, bh.x, bl.x) SPLIT2(b2, b3, bh.y, bl.y) SPLIT2(b4, b5, bh.z, bl.z) SPLIT2(b6, b7, bh.w, bl.w)
#undef SPLIT2
                  const bf16x8 Ah = __builtin_bit_cast(bf16x8, ah), Al = __builtin_bit_cast(bf16x8, al), Bh = __builtin_bit_cast(bf16x8, bh), Bl = __builtin_bit_cast(bf16x8, bl);
                  acc = MFMA32(Al, Bh, acc); acc = MFMA32(Ah, Bl, acc); acc = MFMA32(Ah, Bh, acc); } }
          bf16* o = wt + (size_t)(32 * nb + ql) * 512 + 32 * rb + 4 * h;
#pragma unroll
          for (int q = 0; q < 4; ++q) *(unsigned long long*)(o + 8 * q) = (unsigned long long)pk2(acc[4 * q], acc[4 * q + 1]) | ((unsigned long long)pk2(acc[4 * q + 2], acc[4 * q + 3]) << 32);
      } }
#undef TM
#undef PART
}
__device__ __forceinline__ bool tails_enabled(int G) { return TAILCONV && ((S / 256) * (NGU / 256)) % G != 0 && ((S / 256) * ((NINP - 8192) / 256)) % G != 0; }
__device__ __forceinline__ void tail_convert(ArgsP A, const Frame& F, int l, int bx, int nunits, int p0, int p1) {
#if !TAILCONV
    return;
#endif
    if (!tails_enabled(F.G)) return;
    const int busy = nunits % F.G; if (busy == 0 || l + 1 >= NLAYER) return;
    const int slot = bx - busy; if (slot < 0) return;
    phase_convert(A, F, l + 1, slot * NWAVES + F.wave, (F.G - busy) * NWAVES, p0, p1);
}
__device__ __forceinline__ void phase_rope_tables(ArgsP A, const Frame& F) {
    unsigned char* ws = A->ws; const int lane = opq_lane(); const int gw = opq_s(F.gw); const int gt = gw * 64 + lane;
    {
        float* ct = (float*)(ws + WS_COS); float* st = (float*)(ws + WS_SIN);
        for (int i = gt; i < S * 32; i += F.NGT) { const int pos = i >> 5, k = i & 31;
            double f = 1.0; for (int j = 0; j < k; ++j) f *= 0.74989420933245582730;
            const float ang = (float)pos * (float)f;
            const double a = (double)ang; const double kq = __builtin_rint(a * 0.63661977236758134308); const double r = (a - kq * 1.5707963267948966192) - kq * 6.123233995736766e-17;
            const double r2 = r * r;
            const double sn = r * (1.0 + r2 * (-1.0 / 6 + r2 * (1.0 / 120 + r2 * (-1.0 / 5040 + r2 * (1.0 / 362880 + r2 * (-1.0 / 39916800 + r2 * (1.0 / 6227020800.0)))))));
            const double cs = 1.0 + r2 * (-0.5 + r2 * (1.0 / 24 + r2 * (-1.0 / 720 + r2 * (1.0 / 40320 + r2 * (-1.0 / 3628800 + r2 * (1.0 / 479001600.0 + r2 * (-1.0 / 87178291200.0)))))));
            const int q = ((int)kq) & 3;
            const double sv = (q == 0) ? sn : (q == 1) ? cs : (q == 2) ? -sn : -cs;
            const double cv = (q == 0) ? cs : (q == 1) ? -sn : (q == 2) ? -cs : sn;
            ct[i] = (float)cv; st[i] = (float)sv; }
    }
}
__device__ __forceinline__ void phase_prep(const Frame& F, const float* x, bf16* xb, float* ssp) {
    const int lane = opq_lane(); const int gw = opq_s(F.gw);
    for (int m = gw; m < S; m += F.NGW) {
        const GAS f32x4* xr = (const GAS f32x4*)(x + (size_t)m * D) + lane;
        f32x4 v[8]; float s = 0.f;
#pragma unroll
        for (int j = 0; j < 8; ++j) { v[j] = xr[64 * j]; s += (v[j].x * v[j].x + v[j].y * v[j].y) + (v[j].z * v[j].z + v[j].w * v[j].w); }
        s = wave_sum(s);
        GAS unsigned long long* o8 = (GAS unsigned long long*)(xb + (size_t)m * D) + lane;
#pragma unroll
        for (int j = 0; j < 8; ++j) o8[64 * j] = (unsigned long long)pk2(v[j].x, v[j].y) | ((unsigned long long)pk2(v[j].z, v[j].w) << 32);
        if (lane < 32) ssp[(size_t)m * 32 + lane] = (lane == 0) ? s : 0.f;
    }
}
__device__ __forceinline__ void phase_mix1(ArgsP A, const Frame& F, int l) {
    unsigned char* ws = A->ws; const int lane = opq_lane(); const int gw = opq_s(F.gw); const int gt = gw * 64 + lane;
    bf16* p = (bf16*)(ws + WS_P); bf16* z0 = (bf16*)(ws + WS_Z); bf16* vvn = (bf16*)(ws + WS_VVN); bf16* mlaA = (bf16*)(ws + WS_MLAA);
    for (int item = gt; item < (S / 16) * 256; item += F.NGT) {
        const int cp = item & 255, t0 = (item >> 8) * 16, g = cp >> 6;
        const bf16* col = p + PC_POOL + 2 * cp;
        float va[32], vb[32];
#pragma unroll
        for (int k = 0; k < 32; ++k) { const int tt = t0 - 8 + k; const bool in = (tt >= 0) && (tt < S); const unsigned u = in ? *(const unsigned*)(col + (size_t)(in ? tt : 0) * NINP) : 0u; va[k] = bflo(u); vb[k] = bfhi(u); }
        unsigned* zo = (unsigned*)(z0 + (size_t)t0 * 512 + 2 * cp);
#define POOL_GROUP(HW) do { \
        _Pragma("unroll") for (int i = 0; i < 16; ++i) { float sa = 0.f, sb = 0.f; \
            _Pragma("unroll") for (int k = 8 + i - (HW); k < 8 + i + (HW); ++k) { sa += va[k]; sb += vb[k]; }     \
            const int t = t0 + i, lo = (t - (HW)) < 0 ? 0 : (t - (HW)), hi = (t + (HW)) > S ? S : (t + (HW)); const float inv = 1.0f / (float)(hi - lo); \
            zo[(size_t)i * 256] = pk2(sa * inv - va[8 + i], sb * inv - vb[8 + i]); } } while (0)
        if (g == 0) POOL_GROUP(1); else if (g == 1) POOL_GROUP(2); else if (g == 2) POOL_GROUP(4); else POOL_GROUP(8);
#undef POOL_GROUP
    }
    const float* gq = A->in[I_DQN] + l * 128; const float* gk = A->in[I_DKN] + l * 128; const float* gs = A->in[I_SGUN] + l * 512;
    const float* gqa = A->in[I_MQAN] + l * 384; const float* gkva = A->in[I_MKVAN] + l * 128;
    float gsv[8];
#pragma unroll
    for (int k = 0; k < 8; ++k) gsv[k] = gs[8 * lane + k];
    const float ga0 = gqa[2 * lane], ga1 = gqa[2 * lane + 1], ga2 = gqa[128 + 2 * lane], ga3 = gqa[129 + 2 * lane], ga4 = gqa[256 + 2 * lane], ga5 = gqa[257 + 2 * lane];
    const float gv0 = gkva[2 * lane], gv1 = gkva[2 * lane + 1];
    for (int t = gw; t < S; t += F.NGW) {
        bf16* prow = p + (size_t)t * NINP;
        const v4u u = *((const v4u*)(prow + PC_SGU + 512) + lane);
        const unsigned* cq = (const unsigned*)(prow + PC_CQ) + lane; const unsigned u0 = cq[0], u1 = cq[64], u2 = cq[128];
        const unsigned uk = *((const unsigned*)(prow + PC_CKV) + lane);
        asm volatile("" ::: "memory");
        { float x[8] = {bflo(u.x), bfhi(u.x), bflo(u.y), bfhi(u.y), bflo(u.z), bfhi(u.z), bflo(u.w), bfhi(u.w)}; float s2 = 0.f;
#pragma unroll
          for (int k = 0; k < 8; ++k) s2 += x[k] * x[k];
          const float a0 = bflo(u0), b0 = bfhi(u0), a1 = bflo(u1), b1 = bfhi(u1), a2 = bflo(u2), b2 = bfhi(u2); const float ak = bflo(uk), bk = bfhi(uk);
          float sq = (a0 * a0 + b0 * b0) + (a1 * a1 + b1 * b1) + (a2 * a2 + b2 * b2), sk = ak * ak + bk * bk;
          s2 = wave_sum(s2); sq = wave_sum(sq); sk = wave_sum(sk);
          const float rstd = __builtin_amdgcn_rsqf(s2 * (1.f / 512) + EPS), rq = __builtin_amdgcn_rsqf(sq * (1.f / 384) + EPS), rk = __builtin_amdgcn_rsqf(sk * (1.f / 128) + EPS);
          v4u o; o.x = pk2(x[0] * rstd * gsv[0], x[1] * rstd * gsv[1]); o.y = pk2(x[2] * rstd * gsv[2], x[3] * rstd * gsv[3]); o.z = pk2(x[4] * rstd * gsv[4], x[5] * rstd * gsv[5]); o.w = pk2(x[6] * rstd * gsv[6], x[7] * rstd * gsv[7]);
          *((v4u*)(vvn + (size_t)t * 512) + lane) = o;
          unsigned* om = (unsigned*)(mlaA + (size_t)t * 512) + lane;
          om[0] = pk2(a0 * rq * ga0, b0 * rq * ga1); om[64] = pk2(a1 * rq * ga2, b1 * rq * ga3); om[128] = pk2(a2 * rq * ga4, b2 * rq * ga5);
          om[192] = pk2(ak * rk * gv0, bk * rk * gv1); }
    }
}
typedef short s16x4 __attribute__((ext_vector_type(4)));
typedef short v4i16_t __attribute__((ext_vector_type(4)));
__device__ __forceinline__ int crow(int reg, int h) { return (reg & 3) + 8 * (reg >> 2) + 4 * h; }
__device__ __forceinline__ bf16x8 pack8(const f32x16& x, int s) {
    v4u p; p.x = epi::cvt_pk_bf16(x[8 * s], x[8 * s + 1]); p.y = epi::cvt_pk_bf16(x[8 * s + 2], x[8 * s + 3]); p.z = epi::cvt_pk_bf16(x[8 * s + 4], x[8 * s + 5]); p.w = epi::cvt_pk_bf16(x[8 * s + 6], x[8 * s + 7]);
    return __builtin_bit_cast(bf16x8, p);
}
__device__ __forceinline__ s16x4 tr_read(const LAS unsigned char* p) { return __builtin_bit_cast(s16x4, __builtin_amdgcn_ds_read_tr16_b64_v4i16((LAS v4i16_t*)p)); }
__device__ __forceinline__ int vimg_off(int key, int piece  ) { return key * 256 + (((piece >> 2) ^ (key & 3)) << 6) + ((piece & 3) << 4); }
__device__ __forceinline__ bf16x8 vt_frag(const LAS unsigned char* img, int key0, int d0, int lane) {
    const int h = lane >> 5, blk = (lane >> 4) & 1, q = (lane & 15) >> 2, pp = lane & 3;
    const int ka = key0 + 4 * h + q, kb = ka + 8;
    const int col = ((d0 ^ q) << 6) + (16 * blk + 4 * pp) * 2;
    const s16x4 lo = tr_read(img + ka * 256 + col), hi = tr_read(img + kb * 256 + col);
    return __builtin_shufflevector(lo, hi, 0, 1, 2, 3, 4, 5, 6, 7);
}
__device__ __forceinline__ int vt_lane_off(int lane, int d0) { const int h = lane >> 5, blk = (lane >> 4) & 1, q = (lane & 15) >> 2, pp = lane & 3; return (4 * h + q) * 256 + ((d0 ^ q) << 6) + (16 * blk + 4 * pp) * 2; }
template <int KEY0> __device__ __forceinline__ bf16x8 vt_frag_o(const LAS unsigned char* img, int voff) {
    const s16x4 lo = tr_read(img + voff + KEY0 * 256), hi = tr_read(img + voff + (KEY0 + 8) * 256);
    return __builtin_shufflevector(lo, hi, 0, 1, 2, 3, 4, 5, 6, 7);
}
__device__ __forceinline__ bf16x8 tr_frag(const LAS unsigned char* img, int ra, int rb, int cb, int lane) {
    const int blk = (lane >> 4) & 1, q = (lane & 15) >> 2, pp = lane & 3;
    const int col = ((cb ^ q) << 6) + (16 * blk + 4 * pp) * 2;
    const s16x4 lo = tr_read(img + (ra + q) * 256 + col), hi = tr_read(img + (rb + q) * 256 + col);
    return __builtin_shufflevector(lo, hi, 0, 1, 2, 3, 4, 5, 6, 7);
}
__device__ __forceinline__ void sgu_mix_mfma(ArgsP A, const Frame& F, int l, int lane) {
    unsigned char* ws = A->ws; const bf16* p = (const bf16*)(ws + WS_P); const bf16* vvn = (const bf16*)(ws + WS_VVN); bf16* z2 = (bf16*)(ws + WS_Z) + (size_t)2 * S * 512;
    const float* sw = A->in[I_SGUW] + (size_t)l * 4 * 128 * 128; const float* sb = A->in[I_SGUB] + (size_t)l * 4 * 128;
    LAS unsigned char* img = F.lds + RING_OFF;
    const int w = F.wave, tid = w * 64 + lane, ql = lane & 31, h = lane >> 5, tb = 32 * (w & 3), cb0 = 2 * (w >> 2);
    for (int unit = F.vcu; unit < 256; unit += F.G) {
        const int n = unit >> 2, g = unit & 3;
#pragma unroll
        for (int i = 0; i < 4; ++i) { const int idx = i * 512 + tid, s = idx >> 4, piece = idx & 15;
            *(LAS v4u*)(img + vimg_off(s, piece)) = *(const v4u*)(vvn + (size_t)(n * 128 + s) * 512 + g * 128 + piece * 8); }
        __syncthreads();
        f32x16 acc0, acc1;
#pragma unroll
        for (int e = 0; e < 16; ++e) { acc0[e] = 0.f; acc1[e] = 0.f; }
        const float* wrow = sw + ((size_t)g * 128 + tb + ql) * 128 + 8 * h;
#pragma unroll
        for (int ks = 0; ks < 8; ++ks) {
            const f32x4 a0 = *(const f32x4*)(wrow + 16 * ks), a1 = *(const f32x4*)(wrow + 16 * ks + 4);
            v4u ap; ap.x = epi::cvt_pk_bf16(a0.x, a0.y); ap.y = epi::cvt_pk_bf16(a0.z, a0.w); ap.z = epi::cvt_pk_bf16(a1.x, a1.y); ap.w = epi::cvt_pk_bf16(a1.z, a1.w);
            const bf16x8 af = __builtin_bit_cast(bf16x8, ap);
            acc0 = MFMA32(af, tr_frag(img, 16 * ks + 8 * h, 16 * ks + 8 * h + 4, cb0, lane), acc0);
            acc1 = MFMA32(af, tr_frag(img, 16 * ks + 8 * h, 16 * ks + 8 * h + 4, cb0 + 1, lane), acc1);
        }
        { const int c0 = g * 128 + 32 * cb0 + ql; float bias[16]; unsigned r0[16], r1[16];
#pragma unroll
          for (int e = 0; e < 16; ++e) { const int tl = tb + crow(e, h), t = n * 128 + tl; bias[e] = sb[g * 128 + tl];
              r0[e] = p[(size_t)t * NINP + PC_SGU + c0]; r1[e] = p[(size_t)t * NINP + PC_SGU + c0 + 32]; }
          asm volatile("" : "+v"(r0[0]), "+v"(r0[1]), "+v"(r0[2]), "+v"(r0[3]), "+v"(r0[4]), "+v"(r0[5]), "+v"(r0[6]), "+v"(r0[7]), "+v"(r0[8]), "+v"(r0[9]), "+v"(r0[10]), "+v"(r0[11]), "+v"(r0[12]), "+v"(r0[13]), "+v"(r0[14]), "+v"(r0[15]));
          asm volatile("" : "+v"(r1[0]), "+v"(r1[1]), "+v"(r1[2]), "+v"(r1[3]), "+v"(r1[4]), "+v"(r1[5]), "+v"(r1[6]), "+v"(r1[7]), "+v"(r1[8]), "+v"(r1[9]), "+v"(r1[10]), "+v"(r1[11]), "+v"(r1[12]), "+v"(r1[13]), "+v"(r1[14]), "+v"(r1[15]));
#pragma unroll
          for (int e = 0; e < 16; ++e) { const int tl = tb + crow(e, h), t = n * 128 + tl; const float u0 = __uint_as_float(r0[e] << 16), u1 = __uint_as_float(r1[e] << 16);
              z2[(size_t)t * 512 + c0] = (bf16)f2bf(u0 * (acc0[e] + bias[e])); z2[(size_t)t * 512 + c0 + 32] = (bf16)f2bf(u1 * (acc1[e] + bias[e])); } }
        __syncthreads();
    }
}
__device__ __forceinline__ void dil_attention(ArgsP A, const Frame& F, int l, int gw, int lane) {
    unsigned char* ws = A->ws; const bf16* p = (const bf16*)(ws + WS_P);
    bf16* OP = (bf16*)(ws + WS_DILO); float* LP = (float*)(ws + WS_DILL);
    LAS unsigned char* img = F.lds + RING_OFF + (gw & 7) * 8192;
    const float* gq = A->in[I_DQN] + l * 128; const float* gk = A->in[I_DKN] + l * 128;
    const float* dsq = (const float*)(ws + WS_DSQ);
    LAS float* rkl = (LAS float*)(F.lds + RING_OFF + 65536 + (gw & 7) * 128);
    const float cbound = 11.313708499f * wave_max(fmaxf(fabsf(gq[lane]), fabsf(gq[lane + 64]))) * wave_max(fmaxf(fabsf(gk[lane]), fabsf(gk[lane + 64])));
    const int ql = lane & 31, h = lane >> 5;
    const int nun = ((gw & 7) < 4) ? 2 : 1;
    for (int kk = 0; kk < ((F.G == 256) ? nun : 1 << 30); ++kk) {
        const int unit = (F.G == 256) ? (gw >> 3) * 12 + (gw & 7) + 8 * kk : gw + kk * F.NGW; if (unit >= 12 * 256) break;
        const int hq = unit >> 8, blk = unit & 255, g = hq >> 2, ih = hq & 3, dl = 1 << (2 * g), L = S >> (2 * g), nb = 256 >> (2 * g);
        const int r = blk / nb, b = blk % nb;
        const float slope = __builtin_amdgcn_exp2f(-8.0f * (float)(hq + 1) / 12.0f) * (float)dl;
        const int tq = r + dl * (32 * b + ql);
        bf16x8 qf[8];
        { const v4u* src = (const v4u*)(p + (size_t)tq * NINP + PC_DIL + hq * 128 + 8 * h);
          const f32x4 pq = *(const f32x4*)(dsq + ((size_t)tq * 24 + hq) * 4); const float rq = __builtin_amdgcn_rsqf(((pq[0] + pq[1]) + (pq[2] + pq[3])) * (1.f / 128) + EPS);
#pragma unroll
          for (int s = 0; s < 8; ++s) { const v4u u = src[2 * s]; const f32x4 ga = *(const f32x4*)(gq + 16 * s + 8 * h), gb = *(const f32x4*)(gq + 16 * s + 8 * h + 4), ka = *(const f32x4*)(gk + 16 * s + 8 * h), kb = *(const f32x4*)(gk + 16 * s + 8 * h + 4);
              v4u w; w.x = pk2(bflo(u.x) * rq * ga[0] * ka[0], bfhi(u.x) * rq * ga[1] * ka[1]); w.y = pk2(bflo(u.y) * rq * ga[2] * ka[2], bfhi(u.y) * rq * ga[3] * ka[3]);
              w.z = pk2(bflo(u.z) * rq * gb[0] * kb[0], bfhi(u.z) * rq * gb[1] * kb[1]); w.w = pk2(bflo(u.w) * rq * gb[2] * kb[2], bfhi(u.w) * rq * gb[3] * kb[3]);
              qf[s] = __builtin_bit_cast(bf16x8, w); } }
        f32x16 o[4]; float lsum = 0.f;
#pragma unroll
        for (int d0 = 0; d0 < 4; ++d0)
#pragma unroll
            for (int e = 0; e < 16; ++e) o[d0][e] = 0.f;
        const int c_lo = (b >= 2) ? -2 : -b, c_hi = (b + 2 <= (L >> 5) - 1) ? 2 : (L >> 5) - 1 - b;
        v4u vreg[8]; bf16x8 kf[8]; f32x4 pk4;
#define DIL_LOADK(c_) { pk4 = *(const f32x4*)(dsq + ((size_t)(r + dl * (32 * (b + (c_)) + ql)) * 24 + 12 + hq) * 4); \
           const v4u* src_ = (const v4u*)(p + (size_t)(r + dl * (32 * (b + (c_)) + ql)) * NINP + PC_DIL + 1536 + hq * 128 + 8 * h); _Pragma("unroll") for (int s_ = 0; s_ < 8; ++s_) kf[s_] = __builtin_bit_cast(bf16x8, src_[2 * s_]); }
#define DIL_LOADV(c_) { _Pragma("unroll") for (int i_ = 0; i_ < 8; ++i_) { const int idx_ = i_ * 64 + lane, key_ = idx_ >> 4, piece_ = idx_ & 15; \
            vreg[i_] = *(const v4u*)(p + (size_t)(r + dl * (32 * (b + (c_)) + key_)) * NINP + PC_DIL + 3072 + hq * 128 + piece_ * 8); } }
        DIL_LOADK(c_lo) DIL_LOADV(c_lo)
#pragma unroll 1
        for (int c = c_lo; c <= c_hi; ++c) {
            const int cn = (c < c_hi) ? c + 1 : c;
            f32x16 sacc;
#pragma unroll
            for (int e = 0; e < 16; ++e) sacc[e] = 0.f;
            asm volatile("" : "+v"(kf[0]), "+v"(kf[1]), "+v"(kf[2]), "+v"(kf[3]), "+v"(kf[4]), "+v"(kf[5]), "+v"(kf[6]), "+v"(kf[7]));
#pragma unroll
            for (int s = 0; s < 8; ++s) sacc = MFMA32(kf[s], qf[s], sacc);
            if (h == 0) rkl[ql] = __builtin_amdgcn_rsqf(((pk4[0] + pk4[1]) + (pk4[2] + pk4[3])) * (1.f / 128) + EPS) * 0.08838834764831845f;
#pragma unroll
            for (int i = 0; i < 8; ++i) { const int idx = i * 64 + lane, key = idx >> 4, piece = idx & 15; *(LAS v4u*)(img + vimg_off(key, piece)) = vreg[i]; }
            DIL_LOADV(cn) asm volatile("" ::: "memory");
#pragma unroll
            for (int e = 0; e < 16; ++e) { const int rel = 32 * c + crow(e, h) - ql, arel = rel < 0 ? -rel : rel;
                const float sv = sacc[e] * rkl[crow(e, h)] - slope * (float)arel - cbound;
                const float pe = (arel <= 64) ? epi::fast_exp(sv) : 0.f; sacc[e] = pe; lsum += pe; }
            const bf16x8 pb0 = pack8(sacc, 0), pb1 = pack8(sacc, 1);
            DIL_LOADK(cn) asm volatile("" ::: "memory");
#pragma unroll
            for (int d0 = 0; d0 < 4; ++d0) { o[d0] = MFMA32(vt_frag(img, 0, d0, lane), pb0, o[d0]); o[d0] = MFMA32(vt_frag(img, 16, d0, lane), pb1, o[d0]); }
        }
#undef DIL_LOADK
#undef DIL_LOADV
        lsum += __shfl_xor(lsum, 32);
        bf16* orow = OP + ((size_t)g * S + tq) * 512 + ih * 128 + 4 * h;
#pragma unroll
        for (int d0 = 0; d0 < 4; ++d0)
#pragma unroll
            for (int k = 0; k < 4; ++k) *(unsigned long long*)(orow + 32 * d0 + 8 * k) = (unsigned long long)pk2(o[d0][4 * k], o[d0][4 * k + 1]) | ((unsigned long long)pk2(o[d0][4 * k + 2], o[d0][4 * k + 3]) << 32);
        if (h == 0) LP[((size_t)g * S + tq) * 4 + ih] = lsum;
    }
}
__device__ __forceinline__ void phase_mix2(ArgsP A, const Frame& F, int l) {
    unsigned char* ws = A->ws; const int lane = opq_lane(); const int gw = opq_s(F.gw); const int gt = gw * 64 + lane;
    const bf16* p = (const bf16*)(ws + WS_P); const bf16* raw = (const bf16*)(ws + WS_MLARAW);
    const float* ct = (const float*)(ws + WS_COS); const float* st = (const float*)(ws + WS_SIN);
    const float* gqn = A->in[I_MQN] + l * 192; const float* gkn = A->in[I_MKN] + l * 192;
    const float QSCL = 0.07216878364870322f * 1.4426950408889634f;
    bf16* MQ = (bf16*)(ws + WS_MQ); bf16* MK = (bf16*)(ws + WS_MK); bf16* MV = (bf16*)(ws + WS_MV);
    sgu_mix_mfma(A, F, l, lane);
    const int w8 = gw & 7, tok0 = (gw >> 3) * 32 + (w8 < 4 ? 2 * w8 : 8 + 6 * (w8 - 4)), npair = (w8 < 4) ? 1 : 3;
    const float gq0 = gqn[lane], gq1 = gqn[lane + 64], gq2 = gqn[lane + 128], gk0 = gkn[lane], gk1 = gkn[lane + 64], gk2 = gkn[lane + 128];
    struct PairRegs { float cs[2], sn[2], krv[2], q0[2][4], q1[2][4], q2[2][4], k0[2][4], k1[2][4]; unsigned rw[2][21]; };
#define MP_LOAD(R, tb_) { _Pragma("unroll") for (int u = 0; u < 2; ++u) { const int t = (tb_) + u; R.cs[u] = ct[t * 32 + (lane & 31)]; R.sn[u] = st[t * 32 + (lane & 31)]; \
            const bf16* rr = raw + (size_t)t * NMLA; R.rw[u][20] = p[(size_t)t * NINP + PC_KR + lane]; \
            _Pragma("unroll") for (int h = 0; h < 4; ++h) { R.rw[u][5 * h] = rr[h * 192 + lane]; R.rw[u][5 * h + 1] = rr[h * 192 + 64 + lane]; R.rw[u][5 * h + 2] = rr[h * 192 + 128 + lane]; \
                R.rw[u][5 * h + 3] = rr[768 + h * 256 + lane]; R.rw[u][5 * h + 4] = rr[768 + h * 256 + 64 + lane]; } } }
#define MP_ALL(R_, u_) "+v"(R_.rw[u_][0]), "+v"(R_.rw[u_][1]), "+v"(R_.rw[u_][2]), "+v"(R_.rw[u_][3]), "+v"(R_.rw[u_][4]), "+v"(R_.rw[u_][5]), "+v"(R_.rw[u_][6]), "+v"(R_.rw[u_][7]), "+v"(R_.rw[u_][8]), "+v"(R_.rw[u_][9]), "+v"(R_.rw[u_][10]), \
        "+v"(R_.rw[u_][11]), "+v"(R_.rw[u_][12]), "+v"(R_.rw[u_][13]), "+v"(R_.rw[u_][14]), "+v"(R_.rw[u_][15]), "+v"(R_.rw[u_][16]), "+v"(R_.rw[u_][17]), "+v"(R_.rw[u_][18]), "+v"(R_.rw[u_][19]), "+v"(R_.rw[u_][20])
#define MP_COMP(R, tb_) { float sq[2][4], sk[2][4], rq[2][4], rk[2][4], a2[2][4], b2[2][4], oa[2][4], ob[2][4]; \
        asm volatile("" : MP_ALL(R, 0)); asm volatile("" : MP_ALL(R, 1)); \
        _Pragma("unroll") for (int u = 0; u < 2; ++u) { R.krv[u] = __uint_as_float(R.rw[u][20] << 16); _Pragma("unroll") for (int h = 0; h < 4; ++h) { R.q0[u][h] = __uint_as_float(R.rw[u][5 * h] << 16); R.q1[u][h] = __uint_as_float(R.rw[u][5 * h + 1] << 16); \
            R.q2[u][h] = __uint_as_float(R.rw[u][5 * h + 2] << 16); R.k0[u][h] = __uint_as_float(R.rw[u][5 * h + 3] << 16); R.k1[u][h] = __uint_as_float(R.rw[u][5 * h + 4] << 16); } } \
        _Pragma("unroll") for (int u = 0; u < 2; ++u) _Pragma("unroll") for (int h = 0; h < 4; ++h) { \
            sq[u][h] = wave_sum(R.q0[u][h] * R.q0[u][h] + R.q1[u][h] * R.q1[u][h] + R.q2[u][h] * R.q2[u][h]); sk[u][h] = wave_sum(R.k0[u][h] * R.k0[u][h] + R.k1[u][h] * R.k1[u][h] + R.krv[u] * R.krv[u]); } \
        _Pragma("unroll") for (int u = 0; u < 2; ++u) _Pragma("unroll") for (int h = 0; h < 4; ++h) { rq[u][h] = __builtin_amdgcn_rsqf(sq[u][h] * (1.f / 192) + EPS) * QSCL; rk[u][h] = __builtin_amdgcn_rsqf(sk[u][h] * (1.f / 192) + EPS); \
            a2[u][h] = R.q2[u][h] * rq[u][h] * gq2; b2[u][h] = R.krv[u] * rk[u][h] * gk2; } \
        _Pragma("unroll") for (int u = 0; u < 2; ++u) _Pragma("unroll") for (int h = 0; h < 4; ++h) { oa[u][h] = __shfl_xor(a2[u][h], 32); ob[u][h] = __shfl_xor(b2[u][h], 32); } \
        _Pragma("unroll") for (int u = 0; u < 2; ++u) { const int t = (tb_) + u; _Pragma("unroll") for (int h = 0; h < 4; ++h) { \
            const float a2r = (lane < 32) ? (a2[u][h] * R.cs[u] - oa[u][h] * R.sn[u]) : (oa[u][h] * R.sn[u] + a2[u][h] * R.cs[u]); \
            const float b2r = (lane < 32) ? (b2[u][h] * R.cs[u] - ob[u][h] * R.sn[u]) : (ob[u][h] * R.sn[u] + b2[u][h] * R.cs[u]); \
            bf16* qo = MQ + ((size_t)h * S + t) * 192; bf16* ko = MK + ((size_t)h * S + t) * 192; \
            qo[lane] = (bf16)f2bf(R.q0[u][h] * rq[u][h] * gq0); qo[lane + 64] = (bf16)f2bf(R.q1[u][h] * rq[u][h] * gq1); qo[lane + 128] = (bf16)f2bf(a2r); \
            ko[lane] = (bf16)f2bf(R.k0[u][h] * rk[u][h] * gk0); ko[lane + 64] = (bf16)f2bf(R.k1[u][h] * rk[u][h] * gk1); ko[lane + 128] = (bf16)f2bf(b2r); \
            } } }
    if (F.G == 256) {
        PairRegs RA, RB;
        MP_LOAD(RA, tok0)
        if (npair > 1) { MP_LOAD(RB, tok0 + 2) }
        MP_COMP(RA, tok0)
        if (npair > 1) { MP_LOAD(RA, tok0 + 4) MP_COMP(RB, tok0 + 2) MP_COMP(RA, tok0 + 4) }
    } else {
        for (int jj = 0; ; ++jj) { const int tb = 2 * (gw + jj * F.NGW); if (tb >= S) break; PairRegs RA; MP_LOAD(RA, tb) MP_COMP(RA, tb) }
    }
#undef MP_LOAD
#undef MP_COMP
#undef MP_ALL
    dil_attention(A, F, l, gw, lane);
}


constexpr int MLA_KROW = 400, MLA_KIMG = 64 * MLA_KROW, MLA_VIMG = 64 * 256;
constexpr int FL_V0 = 2 * MLA_KIMG, FL_P0 = FL_V0 + 2 * MLA_VIMG, FL_PBUF = 8 * 1024, FL_END = FL_P0 + 4 * 2 * FL_PBUF;
constexpr int FL_FLAG = FL_END;
static_assert(FL_FLAG + 64 <= LDSCTL_OFF, "flash LDS map");
#define FL_SB() __builtin_amdgcn_sched_barrier(0)
__device__ __forceinline__ void flash_scores(LAS unsigned char* lds, const bf16* MQ, const bf16* MK, const bf16* MV, float* LP, float c2, int vcu, int G, int w, int lane) {
    const int ql = lane & 31, hh = lane >> 5;
    LAS unsigned char* pw = lds + FL_P0 + w * 2 * FL_PBUF + lane * 16;
    volatile LAS unsigned* flag = (volatile LAS unsigned*)(lds + FL_FLAG + 16 * w); unsigned gen = 0u;
    for (int unit = vcu; unit < 256; unit += G) {
        const int kh = unit & 1, qb = (unit >> 1) & 31, h = unit >> 6;
        const bf16* Kg = MK + ((size_t)h * S + kh * 4096) * 192; const bf16* Vg = MV + (size_t)(kh * 4096) * NMLA + 768 + h * 256 + 128;
        const int tq = qb * 256 + w * 64 + ql;
        bf16x8 qf0[12], qf1[12];
        { const v4u* src = (const v4u*)(MQ + ((size_t)h * S + tq) * 192 + 8 * hh);
#pragma unroll
          for (int s = 0; s < 12; ++s) { qf0[s] = __builtin_bit_cast(bf16x8, src[2 * s]); qf1[s] = __builtin_bit_cast(bf16x8, src[2 * s + 32 * 24]); } }
        float lsum0 = 0.f, lsum1 = 0.f;
        if (unit == vcu) *flag = 0u;
        __syncthreads();
#pragma unroll 1
        for (int jt = 0; jt < 64; ++jt) {
            const LAS unsigned char* kr0 = lds + (jt & 1) * MLA_KIMG + ql * MLA_KROW + 16 * hh;
            f32x16 s00, s01, s10, s11;
#pragma unroll
            for (int e = 0; e < 16; ++e) { s00[e] = -c2; s01[e] = -c2; s10[e] = -c2; s11[e] = -c2; }
#define KFRAG(f) (*(const LAS bf16x8*)(kr0 + ((f) >= 12 ? 32 * MLA_KROW : 0) + 32 * ((f) % 12)))
#define KLOAD(dst, f0) do { _Pragma("unroll") for (int i_ = 0; i_ < 4; ++i_) dst[i_] = KFRAG((f0) + i_); } while (0)
#define KMMA(src, f0) do { _Pragma("unroll") for (int i_ = 0; i_ < 4; ++i_) { if ((f0) + i_ < 12) { s00 = MFMA32(src[i_], qf0[((f0) + i_) % 12], s00); s10 = MFMA32(src[i_], qf1[((f0) + i_) % 12], s10); } \
                                                                               else { s01 = MFMA32(src[i_], qf0[((f0) + i_) % 12], s01); s11 = MFMA32(src[i_], qf1[((f0) + i_) % 12], s11); } } } while (0)
            bf16x8 kA[4], kB[4];
            KLOAD(kA, 0);
            KLOAD(kB, 4);  FL_SB(); KMMA(kA, 0);  FL_SB();
            KLOAD(kA, 8);  FL_SB(); KMMA(kB, 4);  FL_SB();
            KLOAD(kB, 12); FL_SB(); KMMA(kA, 8);  FL_SB();
            KLOAD(kA, 16); FL_SB(); KMMA(kB, 12); FL_SB();
            KLOAD(kB, 20); FL_SB(); KMMA(kA, 16); FL_SB();
            KMMA(kB, 20); FL_SB();
            *flag = ++gen; FL_SB();
#undef KFRAG
#undef KLOAD
#undef KMMA
            LAS unsigned char* pb = pw + (jt & 1) * FL_PBUF;
#define EXPW(sx, ls, f0) { _Pragma("unroll") for (int e = 0; e < 16; ++e) { const float p_ = __builtin_amdgcn_exp2f(sx[e]); sx[e] = p_; ls += p_; } \
                           *(LAS bf16x8*)(pb + (f0) * 1024) = pack8(sx, 0); *(LAS bf16x8*)(pb + ((f0) + 1) * 1024) = pack8(sx, 1); }
            EXPW(s00, lsum0, 0) EXPW(s01, lsum0, 2) EXPW(s10, lsum1, 4) EXPW(s11, lsum1, 6)
#undef EXPW
            __syncthreads();
        }
        lsum0 += __shfl_xor(lsum0, 32); lsum1 += __shfl_xor(lsum1, 32);
        if (hh == 0) { LP[((size_t)kh * 4 + h) * S + tq] = lsum0; LP[((size_t)kh * 4 + h) * S + tq + 32] = lsum1; }
    }
}
__device__ __forceinline__ void flash_pv(LAS unsigned char* lds, const bf16* MK, const bf16* MV, bf16* OP, int vcu, int G, int pw, int lane) {
    const int ql = lane & 31, hh = lane >> 5;
    int ksrc[7], vsrc[4];
#pragma unroll
    for (int i = 0; i < 7; ++i) { const int L = (pw + 4 * i) * 1024 + 16 * lane, row = L / MLA_KROW, within = L - row * MLA_KROW; ksrc[i] = (row < 64 ? row : 0) * 192 + (within < 384 ? within / 2 : 0); }
#pragma unroll
    for (int i = 0; i < 4; ++i) { const int L = (pw + 4 * i) * 1024 + 16 * lane, key = L >> 8, pos = (L & 255) >> 4; vsrc[i] = key * NMLA + ((((pos >> 2) ^ (key & 3)) << 2) | (pos & 3)) * 8; }
#define FL_DMAK(jt_) { const bf16* kg_ = Kg + (size_t)(jt_) * 64 * 192; LAS unsigned char* kd_ = lds + ((jt_) & 1) * MLA_KIMG; \
        _Pragma("unroll") for (int i_ = 0; i_ < 6; ++i_) __builtin_amdgcn_global_load_lds((const unsigned*)(kg_ + ksrc[i_]), (LAS unsigned*)(kd_ + (pw + 4 * i_) * 1024), 16, 0, 0); \
        if (pw == 0) __builtin_amdgcn_global_load_lds((const unsigned*)(kg_ + ksrc[6]), (LAS unsigned*)(kd_ + 24 * 1024), 16, 0, 0); }
#define FL_DMAV(jt_) { const bf16* vg_ = Vg + (size_t)(jt_) * 64 * NMLA; LAS unsigned char* vd_ = lds + FL_V0 + ((jt_) & 1) * MLA_VIMG; \
        _Pragma("unroll") for (int i_ = 0; i_ < 4; ++i_) __builtin_amdgcn_global_load_lds((const unsigned*)(vg_ + vsrc[i_]), (LAS unsigned*)(vd_ + (pw + 4 * i_) * 1024), 16, 0, 0); }
    int voff[4];
#pragma unroll
    for (int d0 = 0; d0 < 4; ++d0) voff[d0] = vt_lane_off(lane, d0);
    const LAS unsigned char* pr = lds + FL_P0 + pw * 2 * FL_PBUF + lane * 16;
    volatile LAS unsigned* flag = (volatile LAS unsigned*)(lds + FL_FLAG + 16 * pw); unsigned gen = 0u;
    for (int unit = vcu; unit < 256; unit += G) {
        const int kh = unit & 1, qb = (unit >> 1) & 31, h = unit >> 6;
        const bf16* Kg = MK + ((size_t)h * S + kh * 4096) * 192; const bf16* Vg = MV + (size_t)(kh * 4096) * NMLA + 768 + h * 256 + 128;
        const int tq = qb * 256 + pw * 64 + ql;
        f32x16 o0[4], o1[4];
#pragma unroll
        for (int d0 = 0; d0 < 4; ++d0)
#pragma unroll
            for (int e = 0; e < 16; ++e) { o0[d0][e] = 0.f; o1[d0][e] = 0.f; }
        FL_DMAK(0) VM_WAIT();
        __syncthreads();
#define PV_TILE(t_, WAITGEN) { const LAS unsigned char* pb = pr + ((t_) & 1) * FL_PBUF; const LAS unsigned char* vimg = lds + FL_V0 + ((t_) & 1) * MLA_VIMG; \
            bf16x8 pf[8]; _Pragma("unroll") for (int f = 0; f < 8; ++f) pf[f] = *(const LAS bf16x8*)(pb + f * 1024); \
            if (WAITGEN) { while (*flag < gen) __builtin_amdgcn_s_sleep(1); } \
            _Pragma("unroll") for (int dd = 0; dd < 4; ++dd) { bf16x8 vf[4]; \
                vf[0] = vt_frag_o<0>(vimg, voff[dd]); vf[1] = vt_frag_o<16>(vimg, voff[dd]); vf[2] = vt_frag_o<32>(vimg, voff[dd]); vf[3] = vt_frag_o<48>(vimg, voff[dd]); \
                _Pragma("unroll") for (int ks = 0; ks < 4; ++ks) { o0[dd] = MFMA32(vf[ks], pf[ks], o0[dd]); o1[dd] = MFMA32(vf[ks], pf[4 + ks], o1[dd]); } } }
#pragma unroll 1
        for (int jt = 0; jt < 64; ++jt) {
            if (jt + 1 < 64) FL_DMAK(jt + 1)
            FL_DMAV(jt)
            ++gen;
            if (jt > 0) PV_TILE(jt - 1, true)
            VM_WAIT();
            __syncthreads();
        }
        PV_TILE(63, false)
#undef PV_TILE
#pragma unroll
        for (int b = 0; b < 2; ++b) { bf16* orow = OP + (((size_t)kh * 4 + h) * S + tq + 32 * b) * 128 + 4 * hh;
#pragma unroll
            for (int d0 = 0; d0 < 4; ++d0)
#pragma unroll
                for (int k = 0; k < 4; ++k) { const f32x16& oo = b ? o1[d0] : o0[d0];
                    *(unsigned long long*)(orow + 32 * d0 + 8 * k) = (unsigned long long)pk2(oo[4 * k], oo[4 * k + 1]) | ((unsigned long long)pk2(oo[4 * k + 2], oo[4 * k + 3]) << 32); } }
    }
}
__device__ __forceinline__ void phase_mla_flash(ArgsP A, const Frame& F, int l) {
    unsigned char* ws = A->ws; const int lane = opq_lane();
    const bf16* MQ = (const bf16*)(ws + WS_MQ); const bf16* MK = (const bf16*)(ws + WS_MK); const bf16* MV = (const bf16*)(ws + WS_MLARAW);
    bf16* OP = (bf16*)(ws + WS_MOP); float* LP = (float*)(ws + WS_MLP);
    const float* gqn = A->in[I_MQN] + l * 192; const float* gkn = A->in[I_MKN] + l * 192;
    const float c2 = 19.990625f * wave_max(fmaxf(fmaxf(fabsf(gqn[lane]), fabsf(gqn[lane + 64])), fabsf(gqn[lane + 128]))) * wave_max(fmaxf(fmaxf(fabsf(gkn[lane]), fabsf(gkn[lane + 64])), fabsf(gkn[lane + 128])));
    if (F.wave < 4) flash_scores(F.lds, MQ, MK, MV, LP, c2, F.vcu, F.G, F.wave, lane);
    else flash_pv(F.lds, MK, MV, OP, F.vcu, F.G, F.wave - 4, lane);
    __syncthreads();
}
#undef FL_SB
#undef FL_DMAK
#undef FL_DMAV
__device__ __forceinline__ void dil_combine(ArgsP A, const Frame& F) {
    unsigned char* ws = A->ws; const int lane = opq_lane(); const int gw = opq_s(F.gw); const int gt = gw * 64 + lane;
    const bf16* OP = (const bf16*)(ws + WS_DILO); const float* LP = (const float*)(ws + WS_DILL); bf16* z1 = (bf16*)(ws + WS_Z) + (size_t)1 * S * 512;
    for (int base = gt; base < S * 64; base += 2 * F.NGT) {
        v4u a[2][3]; float den[2][3];
#pragma unroll
        for (int k = 0; k < 2; ++k) { const int it = base + k * F.NGT, itc = it < S * 64 ? it : gt, t = itc >> 6, ih = (itc & 63) >> 4; const size_t idx = (size_t)itc * 8;
#pragma unroll
            for (int g = 0; g < 3; ++g) { a[k][g] = *(const v4u*)(OP + (size_t)g * S * 512 + idx); den[k][g] = LP[((size_t)g * S + t) * 4 + ih]; } }
#pragma unroll
        for (int k = 0; k < 2; ++k) { const int it = base + k * F.NGT; if (it >= S * 64) break;
            const float inv = 1.0f / ((den[k][0] + den[k][1]) + den[k][2]);
#define SUM3(c) ((bflo(a[k][0].c) + bflo(a[k][1].c)) + bflo(a[k][2].c)) * inv, ((bfhi(a[k][0].c) + bfhi(a[k][1].c)) + bfhi(a[k][2].c)) * inv
            v4u o; o.x = pk2(SUM3(x)); o.y = pk2(SUM3(y)); o.z = pk2(SUM3(z)); o.w = pk2(SUM3(w));
#undef SUM3
            *(v4u*)(z1 + (size_t)it * 8) = o; }
    }
}
__device__ __forceinline__ void phase_mix3(ArgsP A, const Frame& F) {
    unsigned char* ws = A->ws; const int lane = opq_lane(); const int gw = opq_s(F.gw); const int gt = gw * 64 + lane;
    const bf16* MO = (const bf16*)(ws + WS_MOP); const float* ML = (const float*)(ws + WS_MLP); bf16* z3 = (bf16*)(ws + WS_Z) + (size_t)3 * S * 512;
    for (int base = gt; base < S * 64; base += 4 * F.NGT) {
        v4u a[4][2]; float den[4][2];
#pragma unroll
        for (int k = 0; k < 4; ++k) { const int it = base + k * F.NGT, itc = it < S * 64 ? it : gt, t = itc >> 6, c8 = (itc & 63) * 8, h = c8 >> 7, d = c8 & 127;
            const size_t r0 = (size_t)h * S + t, r1 = ((size_t)4 + h) * S + t;
            a[k][0] = *(const v4u*)(MO + r0 * 128 + d); a[k][1] = *(const v4u*)(MO + r1 * 128 + d);
            den[k][0] = ML[r0]; den[k][1] = ML[r1]; }
#pragma unroll
        for (int k = 0; k < 4; ++k) { const int it = base + k * F.NGT; if (it >= S * 64) break;
            const float inv = 1.0f / (den[k][0] + den[k][1]);
#define SUM2(c) (bflo(a[k][0].c) + bflo(a[k][1].c)) * inv, (bfhi(a[k][0].c) + bfhi(a[k][1].c)) * inv
            v4u o; o.x = pk2(SUM2(x)); o.y = pk2(SUM2(y)); o.z = pk2(SUM2(z)); o.w = pk2(SUM2(w));
#undef SUM2
            *(v4u*)(z3 + (size_t)it * 8) = o; }
    }
}

__global__ void __launch_bounds__(NWAVES * 64, 2) mk_fwd(Args args_unused) {
    extern __shared__ __attribute__((aligned(16))) unsigned char lds[];
    Frame F;
    F.lds = (LAS unsigned char*)lds;
    F.MISC = (volatile LAS unsigned*)(F.lds + MISC_OFF);
    F.wave = __builtin_amdgcn_readfirstlane((int)(threadIdx.x >> 6));
    F.G = gridDim.x; { const int bx = blockIdx.x; F.vcu = (F.G % 8 == 0) ? (bx % 8) * (F.G / 8) + bx / 8 : bx; }
    F.gw = F.vcu * NWAVES + F.wave; F.NGW = F.G * NWAVES; F.NGT = F.NGW * 64;
    for (int u = threadIdx.x; u < (LDS_BYTES - LDSCTL_OFF) / 4; u += NWAVES * 64) ((LAS unsigned*)(F.lds + LDSCTL_OFF))[u] = 0u;
    __syncthreads();
    int l_lo, l_hi; bool multi; XcdBarrier bar;
    { ArgsP A = fresh_args(); l_lo = A->l_lo; l_hi = A->l_hi;
      multi = !((l_hi - l_lo) == 1 && (A->ph_hi - A->ph_lo) == 1);
      unsigned* bw = (unsigned*)((gu32*)(A->ws + WS_CTL) + CW_BAR);
      bar.bar = bw; bar.x = 0; bar.st = F.MISC + 8;
      if (multi) bar = xcd_barrier_post(bw, F.MISC + 8); }
#define SEAM() do { if (multi) xcd_barrier(bar); } while (0)
#ifdef ONLY_PHASE
#define IN(k) ((k) == ONLY_PHASE && lo <= (k) && (k) < hi)
#else
#define IN(k) (lo <= (k) && (k) < hi)
#endif
#ifndef G_ALIGN
#define G_ALIGN true
#endif
#ifndef G_SP2
#define G_SP2 true
#endif
#define GEMM(EPI, ORDER) pg8::gemm_phase<EPI, ORDER, G_ALIGN, G_SP2>(Fl.lds + RING_OFF, g, So, E, Fl.wave)
    { ArgsP A = fresh_args(); if (A->l_lo == 0 && A->ph_lo == 0) phase_rope_tables(A, F); }
    for (int l = l_lo; l < l_hi; ++l) {
        int lo, hi; { ArgsP A = fresh_args(); lo = A->ph_lo; hi = A->ph_hi; }
        if (IN(0)) { ArgsP A = fresh_args(); const Frame Fl = fresh_frame(F); unsigned char* ws = A->ws;
            const bool tails = tails_enabled(Fl.G);
            if (!tails || l == 0) phase_convert(A, Fl, l, Fl.gw, Fl.NGW, 0, CPARTS);
            else { if (TC1 < 128) phase_convert(A, Fl, l, Fl.gw, Fl.NGW, TC1, 128); if (TC2 < 160) phase_convert(A, Fl, l, Fl.gw, Fl.NGW, 128 + TC2, 288); if (TC3 < 128) phase_convert(A, Fl, l, Fl.gw, Fl.NGW, 288 + TC3, CPARTS); }
            if (l == 0) phase_prep(Fl, A->in[I_X], (bf16*)(ws + WS_XN), (float*)(ws + WS_SSP));
            if (!tails || l == 0 || TC1 < 128 || TC2 < 160 || TC3 < 128) SEAM(); }
        if (IN(1)) { ArgsP A = fresh_args(); const Frame Fl = fresh_frame(F); const int bx = opq_s((int)blockIdx.x); unsigned char* ws = A->ws;
            pg8::Gemm g{(const bf16*)(ws + WS_XN), (const bf16*)(ws + (size_t)(l & 1) * WS_SETD + WS_WGU1), S, NGU, D};
            pg8::StaticOrder So; So.init(S, NGU, Fl.G, bx); epi::fill_rstd_table(So, (const float*)(ws + WS_SSP), (LAS float*)(Fl.lds + RSTD_OFF), Fl.wave); __syncthreads();
            epi::EpiSwiglu E{(bf16*)(ws + WS_HID), (const LAS float*)(Fl.lds + RSTD_OFF)}; GEMM(epi::EpiSwiglu, pg8::StaticOrder); tail_convert(A, Fl, l, bx, (S / 256) * (NGU / 256), 0, TC1); SEAM(); }
        if (IN(2)) { ArgsP A = fresh_args(); const Frame Fl = fresh_frame(F); const int bx = opq_s((int)blockIdx.x); unsigned char* ws = A->ws; const float* xin = (l == 0) ? A->in[I_X] : (const float*)(ws + WS_X);
            pg8::Gemm g{(const bf16*)(ws + WS_HID), (const bf16*)(ws + (size_t)(l & 1) * WS_SETD + WS_WD1), S, D, FF}; pg8::StaticOrder So; So.init(S, D, Fl.G, bx);
            epi::EpiResid E{(l == 0) ? A->in[I_X] : (const float*)nullptr, (float*)nullptr, 0.5f, (bf16*)(ws + WS_XN), (float*)(ws + WS_SSP)}; GEMM(epi::EpiResid, pg8::StaticOrder); SEAM(); }
        if (IN(3)) { ArgsP A = fresh_args(); const Frame Fl = fresh_frame(F); const int bx = opq_s((int)blockIdx.x); unsigned char* ws = A->ws;
            pg8::Gemm g{(const bf16*)(ws + WS_XN), (const bf16*)(ws + (size_t)(l & 1) * WS_SETD + WS_WIN) + (size_t)8192 * D, S, NINP - 8192, D};
            pg8::StaticOrder So; So.init(S, NINP - 8192, Fl.G, bx); epi::fill_rstd_table(So, (const float*)(ws + WS_SSP), (LAS float*)(Fl.lds + RSTD_OFF), Fl.wave); __syncthreads();
            epi::EpiPin E{(bf16*)(ws + WS_P), (const LAS float*)(Fl.lds + RSTD_OFF), 32, (float*)(ws + WS_DSQ)}; GEMM(epi::EpiPin, pg8::StaticOrder); tail_convert(A, Fl, l, bx, (S / 256) * ((NINP - 8192) / 256), 128, 128 + TC2); SEAM(); }
        if (IN(4)) { ArgsP A = fresh_args(); const Frame Fl = fresh_frame(F); phase_mix1(A, Fl, l); SEAM(); }
        if (IN(5)) { ArgsP A = fresh_args(); const Frame Fl = fresh_frame(F); const int bx = opq_s((int)blockIdx.x); unsigned char* ws = A->ws;
            pg8::Gemm g{(const bf16*)(ws + WS_MLAA), (const bf16*)(ws + (size_t)(l & 1) * WS_SETD + WS_WMLA), S, NMLA, opq_s(512)}; pg8::StaticOrder So; So.init(S, NMLA, Fl.G, bx);
            epi::EpiBf16 E{(bf16*)(ws + WS_MLARAW), NMLA}; GEMM(epi::EpiBf16, pg8::StaticOrder); SEAM(); }
        if (IN(6)) { ArgsP A = fresh_args(); const Frame Fl = fresh_frame(F); phase_mix2(A, Fl, l); SEAM(); }
        if (IN(7)) { ArgsP A = fresh_args(); const Frame Fl = fresh_frame(F); phase_mla_flash(A, Fl, l); dil_combine(A, Fl); SEAM(); }
        if (IN(8)) { ArgsP A = fresh_args(); const Frame Fl = fresh_frame(F); phase_mix3(A, Fl); if (!multi) SEAM(); }
        if (IN(9)) { ArgsP A = fresh_args(); const Frame Fl = fresh_frame(F); const int bx = opq_s((int)blockIdx.x); unsigned char* ws = A->ws;
            pg8::Gemm g{(const bf16*)(ws + WS_XN), (const bf16*)(ws + (size_t)(l & 1) * WS_SETD + WS_WIN), S, 8192, D};
            pg8::StaticOrder So; So.init(S, 8192, Fl.G, bx); epi::fill_rstd_table(So, (const float*)(ws + WS_SSP), (LAS float*)(Fl.lds + RSTD_OFF), Fl.wave); __syncthreads();
            epi::EpiPin E{(bf16*)(ws + WS_P), (const LAS float*)(Fl.lds + RSTD_OFF), 0, (float*)nullptr}; GEMM(epi::EpiPin, pg8::StaticOrder); SEAM(); }
        if (IN(10)) { ArgsP A = fresh_args(); const Frame Fl = fresh_frame(F); const int bx = opq_s((int)blockIdx.x); unsigned char* ws = A->ws;
            pg8::Gemm g{(const bf16*)(ws + WS_Z), (const bf16*)(ws + (size_t)(l & 1) * WS_SETD + WS_WBR), 4 * S, 4 * D, opq_s(512)}; epi::BranchOrder So; So.so.init(S, D, Fl.G, bx);
            epi::EpiBranchChain E{(bf16*)(ws + WS_MERGEDB), (const bf16*)(ws + WS_P) + PC_GATE}; GEMM(epi::EpiBranchChain, epi::BranchOrder); SEAM(); }
        if (IN(11)) { ArgsP A = fresh_args(); const Frame Fl = fresh_frame(F); const int bx = opq_s((int)blockIdx.x); unsigned char* ws = A->ws;
            pg8::Gemm g{(const bf16*)(ws + WS_MERGEDB), (const bf16*)(ws + (size_t)(l & 1) * WS_SETD + WS_WOUT), S, D, D}; pg8::StaticOrder So; So.init(S, D, Fl.G, bx);
            epi::EpiResid E{(const float*)nullptr, (float*)nullptr, 1.0f, (bf16*)(ws + WS_XN), (float*)(ws + WS_SSP)}; GEMM(epi::EpiResid, pg8::StaticOrder); SEAM(); }
        if (IN(12)) { ArgsP A = fresh_args(); const Frame Fl = fresh_frame(F); const int bx = opq_s((int)blockIdx.x); unsigned char* ws = A->ws;
            pg8::Gemm g{(const bf16*)(ws + WS_XN), (const bf16*)(ws + (size_t)(l & 1) * WS_SETD + WS_WGU2), S, NGU, D};
            pg8::StaticOrder So; So.init(S, NGU, Fl.G, bx); epi::fill_rstd_table(So, (const float*)(ws + WS_SSP), (LAS float*)(Fl.lds + RSTD_OFF), Fl.wave); __syncthreads();
            epi::EpiSwiglu E{(bf16*)(ws + WS_HID), (const LAS float*)(Fl.lds + RSTD_OFF)}; GEMM(epi::EpiSwiglu, pg8::StaticOrder); tail_convert(A, Fl, l, bx, (S / 256) * (NGU / 256), 288, 288 + TC3); SEAM(); }
        if (IN(13)) { ArgsP A = fresh_args(); const Frame Fl = fresh_frame(F); const int bx = opq_s((int)blockIdx.x); unsigned char* ws = A->ws; const bool lastl = (l == NLAYER - 1);
            pg8::Gemm g{(const bf16*)(ws + WS_HID), (const bf16*)(ws + (size_t)(l & 1) * WS_SETD + WS_WD2), S, D, FF}; pg8::StaticOrder So; So.init(S, D, Fl.G, bx);
            epi::EpiResid E{(const float*)nullptr, lastl ? A->out : (float*)nullptr, 0.5f, (bf16*)(ws + WS_XN), (float*)(ws + WS_SSP)}; GEMM(epi::EpiResid, pg8::StaticOrder);
            SEAM(); }
    }
#undef IN
#undef SEAM
#undef GEMM
}


#ifdef DBG_DUMP_OFF
__global__ void dbg_dump(const unsigned char* ws, float* out, int n) {
    for (int i = blockIdx.x * blockDim.x + threadIdx.x; i < n; i += gridDim.x * blockDim.x) {
        if (i >= DBG_DUMP_N) { out[i] = 0.f; continue; }
#if DBG_DUMP_BF16
        out[i] = __uint_as_float(((unsigned)((const unsigned short*)(ws + DBG_DUMP_OFF))[i]) << 16);
#else
        out[i] = ((const float*)(ws + DBG_DUMP_OFF))[i];
#endif
    }
}
#endif
#ifndef MK_ONE_LAUNCH
#define MK_ONE_LAUNCH 0
#endif
extern "C" void kernel_launch(void* const* d_in, const int* in_sizes, int n_in, void* d_out, int out_size, void* d_ws, size_t ws_size, hipStream_t stream) {
    static int grid = 0;
    if (grid == 0) {
        if (n_in != N_INPUTS || out_size != S * D || ws_size < WS_END) { fprintf(stderr, "kernel_launch: unexpected shapes (n_in %d out %d ws %zu)\n", n_in, out_size, ws_size); grid = -1; return; }
        int dev = 0, cus = 0, per_cu = 0;
        if (hipGetDevice(&dev) != hipSuccess || hipDeviceGetAttribute(&cus, hipDeviceAttributeMultiprocessorCount, dev) != hipSuccess) { grid = -1; return; }
        if (hipFuncSetAttribute((const void*)mk_fwd, hipFuncAttributeMaxDynamicSharedMemorySize, LDS_BYTES) != hipSuccess) { fprintf(stderr, "kernel_launch: hipFuncSetAttribute failed\n"); grid = -1; return; }
        if (hipOccupancyMaxActiveBlocksPerMultiprocessor(&per_cu, (const void*)mk_fwd, NWAVES * 64, LDS_BYTES) != hipSuccess || per_cu < 1) fprintf(stderr, "kernel_launch: occupancy query reports %d\n", per_cu);
        (void)hipGetLastError();
        grid = cus;
    }
    if (grid < 0) return;
    if (hipMemsetAsync((char*)d_ws + WS_CTL, 0, CTL_ZERO_BYTES, stream) != hipSuccess) return;
    Args a{};
    for (int i = 0; i < N_INPUTS; ++i) a.in[i] = (const float*)d_in[i];
    a.out = (float*)d_out; a.ws = (unsigned char*)d_ws;
#if MK_ONE_LAUNCH
    a.l_lo = 0; a.l_hi = NLAYER; a.ph_lo = 0; a.ph_hi = NPHASE;
    hipLaunchKernelGGL(mk_fwd, dim3(grid), dim3(NWAVES * 64), LDS_BYTES, stream, a);
#else
    for (int l = 0; l < NLAYER; ++l)
        for (int ph = 0; ph < NPHASE; ++ph) {
#ifdef DBG_DUMP_OFF
            if (l * NPHASE + ph > DBG_LAST) continue;
#endif
            a.l_lo = l; a.l_hi = l + 1; a.ph_lo = ph; a.ph_hi = ph + 1;
            hipLaunchKernelGGL(mk_fwd, dim3(grid), dim3(NWAVES * 64), LDS_BYTES, stream, a);
#ifdef DUP_MASK
            if ((DUP_MASK >> ph) & 1) hipLaunchKernelGGL(mk_fwd, dim3(grid), dim3(NWAVES * 64), LDS_BYTES, stream, a);
#endif
            }
#ifdef DBG_DUMP_OFF
    hipLaunchKernelGGL(dbg_dump, dim3(2048), dim3(256), 0, stream, (const unsigned char*)d_ws, (float*)d_out, S * D);
#endif
#endif
}
```
